# Optimizing an MI355X kernel written in HIP

```python
import jax, jax.numpy as jnp
from jax import lax
import numpy as np

D_MODEL = 1024
BATCH = 16
SEQ = 4096
DEPTH = 4
DEC_BATCH = 1
DEC_SEQ = 16384
PAST_LEN = 128

GRID_W = 64
NA_HEADS = 8
NA_HEAD_DIM = 64
NA_WIDTH = NA_HEADS * NA_HEAD_DIM
NA_WH = 8
NA_WW = 16
RET_HEADS = 4
RET_QK_DIM = 128
RET_V_DIM = 256
RET_QK_WIDTH = RET_HEADS * RET_QK_DIM
RET_V_WIDTH = RET_HEADS * RET_V_DIM
RET_CHUNK = 128
ROPE_BASE = 10000.0
D_FF = 2816
CONV_WIDTH = 3
EPS = 1e-6
SPLIT_SIZES = (NA_WIDTH, NA_WIDTH, NA_WIDTH,
               RET_QK_WIDTH, RET_QK_WIDTH, RET_V_WIDTH, RET_V_WIDTH,
               D_MODEL, D_MODEL)
D_IN = sum(SPLIT_SIZES)

kernel_name = "hybrid_natten_retnet_encoder"


def rms_norm(x, g):
    xf = x.astype(jnp.float32)
    y = xf * lax.rsqrt(jnp.mean(xf * xf, axis=-1, keepdims=True) + EPS)
    return (y * g.astype(jnp.float32)).astype(x.dtype)


def rope_tables(seq_len):
    inv_freq = ROPE_BASE ** (-jnp.arange(0, RET_QK_DIM, 2, dtype=jnp.float32) / RET_QK_DIM)
    ang = jnp.arange(seq_len, dtype=jnp.float32)[:, None] * inv_freq[None, :]
    return jnp.cos(ang)[:, None, :], jnp.sin(ang)[:, None, :]


def apply_rope(x, cos, sin):
    x1, x2 = jnp.split(x, 2, axis=-1)
    return jnp.concatenate([x1 * cos - x2 * sin, x1 * sin + x2 * cos], axis=-1)


def neighborhood_attention(q, k, v, rel_bias):
    B, S, H, dh = q.shape
    rows = S // GRID_W
    wh = min(NA_WH, rows)
    scale = dh ** -0.5
    q = q.reshape(B, rows, GRID_W, H, dh)
    k = k.reshape(B, rows, GRID_W, H, dh)
    v = v.reshape(B, rows, GRID_W, H, dh)
    col = np.arange(GRID_W)
    col_start = np.clip(col - NA_WW // 2, 0, GRID_W - NA_WW)
    col_idx = col_start[:, None] + np.arange(NA_WW)[None, :]
    col_bias_idx = (col_idx - col[:, None]) + (NA_WW - 1)

    def one_row(r):
        rs = jnp.clip(r - wh // 2, 0, rows - wh)
        q_r = lax.dynamic_index_in_dim(q, r, axis=1, keepdims=False)
        k_band = lax.dynamic_slice_in_dim(k, rs, wh, axis=1)
        v_band = lax.dynamic_slice_in_dim(v, rs, wh, axis=1)
        k_win = k_band[:, :, col_idx]
        v_win = v_band[:, :, col_idx]
        s = jnp.einsum('bqhd,bwqchd->bhqwc', q_r, k_win).astype(jnp.float32) * scale
        row_bias_idx = (rs + jnp.arange(wh) - r) + (NA_WH - 1)
        bias = rel_bias[:, row_bias_idx[:, None, None], col_bias_idx[None, :, :]]
        s = s + jnp.transpose(bias, (0, 2, 1, 3)).astype(jnp.float32)[None]
        p = jax.nn.softmax(s.reshape(B, H, GRID_W, wh * NA_WW), axis=-1)
        p = p.reshape(B, H, GRID_W, wh, NA_WW).astype(v.dtype)
        return jnp.einsum('bhqwc,bwqchd->bqhd', p, v_win)

    out = lax.map(one_row, jnp.arange(rows))
    return jnp.transpose(out, (1, 0, 2, 3, 4)).reshape(B, S, H * dh)


def retention_scan(q, k, v, log_gamma, inclusive):
    B, H, S, dk = q.shape
    dv = v.shape[-1]
    C = RET_CHUNK
    N = S // C
    qc = jnp.transpose(q.reshape(B, H, N, C, dk), (2, 0, 1, 3, 4))
    kc = jnp.transpose(k.reshape(B, H, N, C, dk), (2, 0, 1, 3, 4))
    vc = jnp.transpose(v.reshape(B, H, N, C, dv), (2, 0, 1, 3, 4))
    idx = jnp.arange(C, dtype=jnp.float32)
    diff = idx[:, None] - idx[None, :]
    mask = diff >= 0 if inclusive else diff > 0
    lg = log_gamma[:, None, None]
    d_intra = jnp.where(mask[None], jnp.exp(jnp.maximum(diff, 0.0)[None] * lg), 0.0)
    q_decay = jnp.exp((idx + 1.0)[None, :] * log_gamma[:, None])[None, :, :, None]
    k_decay = jnp.exp((C - 1.0 - idx)[None, :] * log_gamma[:, None])[None, :, :, None]
    chunk_decay = jnp.exp(C * log_gamma)[None, :, None, None]

    def step(state, inp):
        q_i, k_i, v_i = inp
        intra = jnp.einsum('bhid,bhjd->bhij', q_i, k_i) * d_intra[None]
        o = jnp.einsum('bhij,bhjv->bhiv', intra, v_i) + \
            jnp.einsum('bhid,bhdv->bhiv', q_i * q_decay, state)
        state = state * chunk_decay + jnp.einsum('bhjd,bhjv->bhdv', k_i * k_decay, v_i)
        return state, o

    state0 = jnp.zeros((B, H, dk, dv), jnp.float32)
    _, o = lax.scan(step, state0, (qc, kc, vc))
    return jnp.transpose(o, (1, 2, 0, 3, 4)).reshape(B, H, S, dv)


def bidirectional_retention(q, k, v, lg_fwd, lg_bwd):
    q = jnp.transpose(q, (0, 2, 1, 3))
    k = jnp.transpose(k, (0, 2, 1, 3))
    v = jnp.transpose(v, (0, 2, 1, 3))
    fwd = retention_scan(q, k, v, lg_fwd, True)
    bwd = retention_scan(q[:, :, ::-1], k[:, :, ::-1], v[:, :, ::-1], lg_bwd, False)[:, :, ::-1]
    return fwd + bwd


def head_group_norm(o, g):
    mu = jnp.mean(o, axis=-1, keepdims=True)
    var = jnp.mean(jnp.square(o - mu), axis=-1, keepdims=True)
    y = (o - mu) * lax.rsqrt(var + EPS)
    B, H, S, dv = o.shape
    y = jnp.transpose(y, (0, 2, 1, 3)).reshape(B, S, H * dv)
    return y * g.astype(jnp.float32)


def centred_depthwise_conv(u, w):
    up = jnp.pad(u, ((0, 0), (1, 1), (0, 0)))
    return up[:, :-2] * w[0] + up[:, 1:-1] * w[1] + up[:, 2:] * w[2]


def trunk(x, norm_mix_g, w_in, na_rel_bias, ret_decay_fwd, ret_decay_bwd, ret_norm_g,
          w_branch_attn, w_branch_ret, w_out, norm_ffn_g, w_up, ffn_conv_w, w_down, norm_final_g):
    B, S, _ = x.shape
    cos, sin = rope_tables(S)
    split_at = np.cumsum(SPLIT_SIZES)[:-1].tolist()
    for l in range(DEPTH):
        h = rms_norm(x, norm_mix_g[l])
        proj = h @ w_in[l]
        na_q, na_k, na_v, r_q, r_k, r_v, r_g, gate_a, gate_r = jnp.split(proj, split_at, axis=-1)
        a = neighborhood_attention(na_q.reshape(B, S, NA_HEADS, NA_HEAD_DIM),
                                   na_k.reshape(B, S, NA_HEADS, NA_HEAD_DIM),
                                   na_v.reshape(B, S, NA_HEADS, NA_HEAD_DIM),
                                   na_rel_bias[l])
        rq = apply_rope(r_q.astype(jnp.float32).reshape(B, S, RET_HEADS, RET_QK_DIM), cos, sin)
        rk = apply_rope(r_k.astype(jnp.float32).reshape(B, S, RET_HEADS, RET_QK_DIM), cos, sin) * (RET_QK_DIM ** -0.5)
        rv = r_v.astype(jnp.float32).reshape(B, S, RET_HEADS, RET_V_DIM)
        ro = bidirectional_retention(rq, rk, rv,
                                     jax.nn.log_sigmoid(ret_decay_fwd[l].astype(jnp.float32)),
                                     jax.nn.log_sigmoid(ret_decay_bwd[l].astype(jnp.float32)))
        ro = (jax.nn.silu(r_g.astype(jnp.float32)) * head_group_norm(ro, ret_norm_g[l])).astype(x.dtype)
        y_a = a @ w_branch_attn[l]
        y_r = ro @ w_branch_ret[l]
        mixed = jax.nn.sigmoid(gate_a) * y_a + jax.nn.sigmoid(gate_r) * y_r
        x = x + mixed @ w_out[l]
        h = rms_norm(x, norm_ffn_g[l])
        u = centred_depthwise_conv(h @ w_up[l], ffn_conv_w[l])
        gate, val = jnp.split(u, 2, axis=-1)
        x = x + (jax.nn.gelu(gate) * val) @ w_down[l]
    return rms_norm(x, norm_final_g)


def setup_inputs(seed: int = 0) -> dict:
    key = jax.random.key(seed)
    ks = jax.random.split(key, 16)
    f32 = jnp.float32

    def nrm(k, shape, scale):
        return jax.random.normal(k, shape, f32) * scale

    base_decay = jnp.log(2.0 ** (5.0 + jnp.arange(RET_HEADS, dtype=f32)) - 1.0)
    return {
        "x_prompt": nrm(ks[0], (BATCH, SEQ, D_MODEL), 1.0),
        "x_sample": nrm(ks[1], (DEC_BATCH, DEC_SEQ, D_MODEL), 1.0),
        "norm_mix_g": 1.0 + nrm(ks[2], (DEPTH, D_MODEL), 0.02),
        "w_in": nrm(ks[3], (DEPTH, D_MODEL, D_IN), D_MODEL ** -0.5),
        "na_rel_bias": nrm(ks[4], (DEPTH, NA_HEADS, 2 * NA_WH - 1, 2 * NA_WW - 1), 0.1),
        "ret_decay_fwd": base_decay[None, :] + nrm(ks[5], (DEPTH, RET_HEADS), 0.1),
        "ret_decay_bwd": base_decay[None, :] + nrm(ks[6], (DEPTH, RET_HEADS), 0.1),
        "ret_norm_g": 1.0 + nrm(ks[7], (DEPTH, RET_V_WIDTH), 0.02),
        "w_branch_attn": nrm(ks[8], (DEPTH, NA_WIDTH, D_MODEL), NA_WIDTH ** -0.5),
        "w_branch_ret": nrm(ks[9], (DEPTH, RET_V_WIDTH, D_MODEL), RET_V_WIDTH ** -0.5),
        "w_out": nrm(ks[10], (DEPTH, D_MODEL, D_MODEL), D_MODEL ** -0.5),
        "norm_ffn_g": 1.0 + nrm(ks[11], (DEPTH, D_MODEL), 0.02),
        "w_up": nrm(ks[12], (DEPTH, D_MODEL, 2 * D_FF), D_MODEL ** -0.5),
        "ffn_conv_w": nrm(ks[13], (DEPTH, CONV_WIDTH, 2 * D_FF), CONV_WIDTH ** -0.5),
        "w_down": nrm(ks[14], (DEPTH, D_FF, D_MODEL), D_FF ** -0.5),
        "norm_final_g": 1.0 + nrm(ks[15], (D_MODEL,), 0.02),
    }


def reference(x_prompt, x_sample, norm_mix_g, w_in, na_rel_bias, ret_decay_fwd, ret_decay_bwd,
              ret_norm_g, w_branch_attn, w_branch_ret, w_out, norm_ffn_g, w_up, ffn_conv_w,
              w_down, norm_final_g):
    y_prompt = trunk(x_prompt, norm_mix_g, w_in, na_rel_bias, ret_decay_fwd, ret_decay_bwd, ret_norm_g,
                     w_branch_attn, w_branch_ret, w_out, norm_ffn_g, w_up, ffn_conv_w, w_down, norm_final_g)
    y_sample = trunk(x_sample, norm_mix_g, w_in, na_rel_bias, ret_decay_fwd, ret_decay_bwd, ret_norm_g,
                     w_branch_attn, w_branch_ret, w_out, norm_ffn_g, w_up, ffn_conv_w, w_down, norm_final_g)
    return (y_prompt, y_sample)
```

```cpp
#include <hip/hip_runtime.h>
#include <hip/hip_cooperative_groups.h>
#include <cstdio>
namespace cg = cooperative_groups;

#define LAS __attribute__((address_space(3)))
typedef unsigned short bf16_t;
typedef short bf16x8 __attribute__((ext_vector_type(8)));
typedef short bf16x4 __attribute__((ext_vector_type(4)));
typedef float f32x4 __attribute__((ext_vector_type(4)));
typedef float f32x16 __attribute__((ext_vector_type(16)));
typedef unsigned u32x4 __attribute__((ext_vector_type(4)));
typedef unsigned u32x2 __attribute__((ext_vector_type(2)));

constexpr int D = 1024, MG = 16384, NPROJ = 5120, NPT = 2048, DFF = 2816, DFF2 = 5632, DEPTH = 4, NGROUPS = 5, DIN = 6656;
constexpr float EPS = 1e-6f;
constexpr int NTHREADS = 512;
constexpr int LDS_BYTES = 131072 + 1024;

constexpr size_t WS_CTL = 0;
constexpr size_t WS_ROWSS1 = 262144;
constexpr size_t WS_ROWSS2 = WS_ROWSS1 + (size_t)MG * 16 * 4;
constexpr size_t WS_COSN = WS_ROWSS2 + (size_t)MG * 16 * 4;
constexpr size_t TAB_BYTES = (size_t)16384 * 64 * 4;
constexpr size_t WS_SINN = WS_COSN + TAB_BYTES;
constexpr size_t WS_COST = WS_SINN + TAB_BYTES;
constexpr size_t WS_SINT = WS_COST + TAB_BYTES;
constexpr size_t WS_W = WS_SINT + TAB_BYTES;
constexpr size_t W_IN_OFF = 0;
constexpr size_t W_A_OFF = W_IN_OFF + (size_t)7168 * 1024 * 2;
constexpr size_t W_R_OFF = W_A_OFF + (size_t)1024 * 512 * 2;
constexpr size_t W_O_OFF = W_R_OFF + (size_t)1024 * 1024 * 2;
constexpr size_t W_UP_OFF = W_O_OFF + (size_t)1024 * 1024 * 2;
constexpr size_t W_D_OFF = W_UP_OFF + (size_t)5632 * 1024 * 2;
constexpr size_t W_LAYER = W_D_OFF + (size_t)1024 * 2816 * 2;
constexpr size_t WS_XB = WS_W + W_LAYER * DEPTH;
constexpr size_t WS_PROJ = WS_XB + (size_t)MG * D * 2;
constexpr size_t WS_PROJT = WS_PROJ + (size_t)MG * NPROJ * 2;
constexpr size_t WS_A = WS_PROJT + (size_t)NPT * MG * 2;
constexpr size_t WS_RO = WS_A + (size_t)MG * 512 * 2;
constexpr size_t WS_TMP = WS_RO + (size_t)MG * D * 2;
constexpr size_t WS_MIXED = WS_TMP + (size_t)MG * D * 2;
constexpr size_t WS_STLOC = WS_MIXED + (size_t)MG * D * 2;
constexpr size_t WS_ST = WS_STLOC + (size_t)128 * 4 * 2 * 32768 * 4;
constexpr size_t WS_END = WS_ST + (size_t)128 * 4 * 2 * 32768 * 2;
static_assert((size_t)MG * DFF2 * 2 <= (size_t)MG * NPROJ * 2 + (size_t)NPT * MG * 2, "u must fit over proj+projT");
static_assert((size_t)MG * DFF * 2 <= (size_t)128 * 4 * 2 * 32768 * 4, "act must fit over STloc");
static_assert(WS_END <= ((size_t)1 << 30), "workspace over 1 GiB");

struct Params {
    const float* x_prompt; const float* x_sample; const float* norm_mix_g; const float* w_in; const float* na_rel_bias;
    const float* dec_f; const float* dec_b; const float* ret_norm_g; const float* w_ba; const float* w_br; const float* w_out;
    const float* norm_ffn_g; const float* w_up; const float* conv_w; const float* w_down; const float* norm_final_g;
    float* out; unsigned char* ws;
};

__device__ __forceinline__ unsigned cvt_pk_bf16(float lo, float hi) { unsigned r; asm("v_cvt_pk_bf16_f32 %0, %1, %2" : "=v"(r) : "v"(lo), "v"(hi)); return r; }
__device__ __forceinline__ float bf_lo(unsigned w) { return __uint_as_float(w << 16); }
__device__ __forceinline__ float bf_hi(unsigned w) { return __uint_as_float(w & 0xffff0000u); }
__device__ __forceinline__ float bf2f(bf16_t b) { return __uint_as_float(((unsigned)b) << 16); }
__device__ __forceinline__ float sigmoidf_(float x) { return 1.0f / (1.0f + __expf(-x)); }
__device__ __forceinline__ void unpack8(const u32x4 w, float* f) { f[0] = bf_lo(w.x); f[1] = bf_hi(w.x); f[2] = bf_lo(w.y); f[3] = bf_hi(w.y); f[4] = bf_lo(w.z); f[5] = bf_hi(w.z); f[6] = bf_lo(w.w); f[7] = bf_hi(w.w); }
__device__ __forceinline__ u32x4 pack8(const float* f) { u32x4 w; w.x = cvt_pk_bf16(f[0], f[1]); w.y = cvt_pk_bf16(f[2], f[3]); w.z = cvt_pk_bf16(f[4], f[5]); w.w = cvt_pk_bf16(f[6], f[7]); return w; }
__device__ __forceinline__ f32x16 mfma32(bf16x8 a, bf16x8 b, f32x16 c) { return __builtin_amdgcn_mfma_f32_32x32x16_bf16(a, b, c, 0, 0, 0); }
__device__ __forceinline__ int otid() { int t = threadIdx.x; asm volatile("" : "+v"(t)); return t; }
__device__ __forceinline__ int ogrid() { int g = gridDim.x; asm volatile("" : "+s"(g)); return g; }
__device__ __forceinline__ f32x16 zero16() { return (f32x16){0.f, 0.f, 0.f, 0.f, 0.f, 0.f, 0.f, 0.f, 0.f, 0.f, 0.f, 0.f, 0.f, 0.f, 0.f, 0.f}; }
__device__ __forceinline__ float sum16(const float* p) { const f32x4 a = *(const f32x4*)p, b = *(const f32x4*)(p + 4), c = *(const f32x4*)(p + 8), d = *(const f32x4*)(p + 12); const f32x4 t = (a + b) + (c + d); return (t[0] + t[1]) + (t[2] + t[3]); }
__device__ __forceinline__ float wave_sum(float v) { v += __shfl_xor(v, 32); v += __shfl_xor(v, 16); v += __shfl_xor(v, 8); v += __shfl_xor(v, 4); v += __shfl_xor(v, 2); v += __shfl_xor(v, 1); return v; }

namespace pg8 {
constexpr int BM = 256, BK = 64, HALF = 128, HTB = HALF * BK * 2, STAGE_BYTES = 8 * HTB, NXCD = 8, WGM = 8;
__host__ __device__ __forceinline__ int lds_byte(int r, int c) { const int st = (r >> 4) * 2 + (c >> 5), rr = r & 15, cc = c & 31, ob = rr * 64 + cc * 2; return st * 1024 + (ob ^ (((ob >> 9) & 1) << 5)); }
__host__ __device__ __forceinline__ void stage_rc(int b, int& R, int& C) { const int st = b / 1024, sb = b % 1024, swz = sb ^ (((sb >> 9) & 1) << 5); R = (st >> 1) * 16 + swz / 64; C = (st & 1) * 32 + (swz % 64) / 2; }
__host__ __device__ __forceinline__ int perm32(int rho) { const int n = rho >> 4, i = rho & 15; return 8 * (i >> 2) + 4 * n + (i & 3); }
struct Unit { int pm, pn; };
struct Gemm { const bf16_t* A; const bf16_t* Bt; int M, N, K; };
struct StaticOrder {
    int nM, nN, nwg, G, c;
    __host__ __device__ void init(int M, int N, int G_, int c_) { nM = M / BM; nN = N / BM; nwg = nM * nN; G = G_; c = c_; }
    __host__ __device__ bool next(int i, Unit& u) const {
        const long L = (long)i * G + c; if (L >= nwg) return false;
        int wgid = (int)L; { const int q = nwg / NXCD, r = nwg % NXCD, xcd = wgid % NXCD, off = wgid / NXCD; wgid = (xcd < r ? xcd * (q + 1) : r * (q + 1) + (xcd - r) * q) + off; }
        const int nig = WGM * nN, gid = wgid / nig, fm = gid * WGM, gsz = (nM - fm) < WGM ? (nM - fm) : WGM;
        u.pm = fm + ((wgid % nig) % gsz); u.pn = (wgid % nig) / gsz; return true;
    }
    __device__ __forceinline__ void a_ready(const Unit&) const {}
    __device__ __forceinline__ void done(const Unit&) const {}
};

template <class Epi, class Sched>
__device__ __forceinline__ void gemm_phase(LAS unsigned char* lds, const Gemm g, const Sched& S, const Epi& E) {
    const int tid = otid(), wid = __builtin_amdgcn_readfirstlane(tid >> 6), lane = tid & 63, wr = wid >> 2, wc = wid & 3, fr = lane & 15, fq = lane >> 4;
    const int K = g.K, nt = K / BK;
    unsigned voffA[2], voffB[2];
#pragma unroll
    for (int i = 0; i < 2; ++i) { int R, C; stage_rc(tid * 16 + i * 8192, R, C); const int Rb = Epi::PERM ? ((R & ~31) + perm32(R & 31)) : R;
        voffA[i] = (unsigned)(R * K + C) * 2u; voffB[i] = (unsigned)(Rb * K + C) * 2u; }
    const size_t kstep = (size_t)(BK * 2);
    const size_t hstep = (size_t)HALF * K * 2;
    const size_t tstep = 2 * hstep;
    const unsigned ldsw = (unsigned)wid * 1024u;
    const int aoff = lds_byte(wr * 64 + fr, fq * 8), boff = lds_byte(wc * 32 + fr, fq * 8);
#define PG8_SA(b, h) (((b) * 2 + (h)) * HTB)
#define PG8_SB(b, h) ((4 + (b) * 2 + (h)) * HTB)
#define PG8_STAGE(bufoff, gbase, voff) do { _Pragma("unroll") for (int _i = 0; _i < 2; ++_i) \
        __builtin_amdgcn_global_load_lds((const unsigned*)((const char*)(gbase) + (voff)[_i]), (LAS unsigned*)(lds + (bufoff) + ldsw + _i * 8192), 16, 0, 0); } while (0)
#define PG8_LDA(dst, b, h) do { _Pragma("unroll") for (int m = 0; m < 4; ++m) _Pragma("unroll") for (int k = 0; k < 2; ++k) dst[m][k] = *(const LAS bf16x8*)(lds + PG8_SA(b, h) + aoff + m * 2048 + k * 1024); } while (0)
#define PG8_LDB(dst, b, h) do { _Pragma("unroll") for (int n = 0; n < 2; ++n) _Pragma("unroll") for (int k = 0; k < 2; ++k) dst[n][k] = *(const LAS bf16x8*)(lds + PG8_SB(b, h) + boff + n * 2048 + k * 1024); } while (0)
#define PG8_MMA(ai, bj, At, Bt) do { __builtin_amdgcn_s_setprio(1); _Pragma("unroll") for (int m = 0; m < 4; ++m) _Pragma("unroll") for (int n = 0; n < 2; ++n) _Pragma("unroll") for (int k = 0; k < 2; ++k) \
        acc[ai][bj][m][n] = __builtin_amdgcn_mfma_f32_16x16x32_bf16(Bt[n][k], At[m][k], acc[ai][bj][m][n], 0, 0, 0); __builtin_amdgcn_s_setprio(0); } while (0)
#define PG8_WAIT_V(n) asm volatile("s_waitcnt vmcnt(" #n ")" ::: "memory")
#define PG8_WAIT_L(n) asm volatile("s_waitcnt lgkmcnt(" #n ")" ::: "memory")
#define PG8_BAR __builtin_amdgcn_s_barrier()
#define PG8_SCHED __builtin_amdgcn_sched_barrier(0)
    Unit cur, nxt; int ui = 0;
    if (!S.next(0, cur)) return;
    f32x4 acc[2][2][4][2];
#pragma unroll
    for (int a = 0; a < 2; ++a)
#pragma unroll
        for (int b = 0; b < 2; ++b)
#pragma unroll
            for (int m = 0; m < 4; ++m)
#pragma unroll
                for (int n = 0; n < 2; ++n) acc[a][b][m][n] = (f32x4){0.f, 0.f, 0.f, 0.f};
    bf16x8 At[4][2], B0[2][2], B1[2][2];
    const char* cA = (const char*)g.A + (size_t)cur.pm * tstep; const char* cB = (const char*)g.Bt + (size_t)cur.pn * tstep;
    S.a_ready(cur);
    PG8_STAGE(PG8_SB(0, 0), cB, voffB); PG8_STAGE(PG8_SA(0, 0), cA, voffA); PG8_STAGE(PG8_SB(0, 1), cB + hstep, voffB); PG8_STAGE(PG8_SA(0, 1), cA + hstep, voffA);
    if (wr == 1) PG8_BAR;
    PG8_WAIT_V(4); PG8_BAR;
    PG8_STAGE(PG8_SB(1, 0), cB + kstep, voffB); PG8_STAGE(PG8_SA(1, 0), cA + kstep, voffA); PG8_STAGE(PG8_SB(1, 1), cB + hstep + kstep, voffB);
    PG8_WAIT_V(6); PG8_BAR;
    for (;;) {
        const bool has_next = S.next(ui + 1, nxt);
        const char* nA = has_next ? (const char*)g.A + (size_t)nxt.pm * tstep : cA; const char* nB = has_next ? (const char*)g.Bt + (size_t)nxt.pn * tstep : cB;
        for (int t = 0; t < nt; t += 2) {
            const bool last = (t == nt - 2);
            const char* a1 = cA + (size_t)(t + 1) * kstep;
            const char* a2 = last ? nA : cA + (size_t)(t + 2) * kstep; const char* b2 = last ? nB : cB + (size_t)(t + 2) * kstep;
            const char* a3 = a2 + kstep; const char* b3 = b2 + kstep;
            if (last && has_next) S.a_ready(nxt);
            PG8_LDB(B0, 0, 0); PG8_SCHED; PG8_LDA(At, 0, 0); PG8_STAGE(PG8_SA(1, 1), a1 + hstep, voffA);
            PG8_WAIT_L(8); PG8_BAR; PG8_WAIT_L(0); PG8_MMA(0, 0, At, B0); PG8_BAR; PG8_SCHED;
            PG8_LDB(B1, 0, 1); PG8_STAGE(PG8_SB(0, 0), b2, voffB);
            PG8_BAR; PG8_WAIT_L(0); PG8_MMA(0, 1, At, B1); PG8_BAR;
            PG8_LDA(At, 0, 1); PG8_STAGE(PG8_SA(0, 0), a2, voffA);
            PG8_BAR; PG8_WAIT_L(0); PG8_MMA(1, 0, At, B0); PG8_BAR; PG8_SCHED;
            PG8_STAGE(PG8_SB(0, 1), b2 + hstep, voffB);
            PG8_WAIT_V(6); PG8_BAR; PG8_MMA(1, 1, At, B1); PG8_BAR;
            PG8_LDB(B0, 1, 0); PG8_SCHED; PG8_LDA(At, 1, 0); PG8_STAGE(PG8_SA(0, 1), a2 + hstep, voffA);
            PG8_WAIT_L(8); PG8_BAR; PG8_WAIT_L(0); PG8_MMA(0, 0, At, B0); PG8_BAR; PG8_SCHED;
            PG8_LDB(B1, 1, 1); PG8_STAGE(PG8_SB(1, 0), b3, voffB);
            PG8_BAR; PG8_WAIT_L(0); PG8_MMA(0, 1, At, B1); PG8_BAR;
            PG8_LDA(At, 1, 1); PG8_STAGE(PG8_SA(1, 0), a3, voffA);
            PG8_BAR; PG8_WAIT_L(0); PG8_MMA(1, 0, At, B0); PG8_BAR; PG8_SCHED;
            PG8_STAGE(PG8_SB(1, 1), b3 + hstep, voffB);
            PG8_WAIT_V(6); PG8_BAR; PG8_MMA(1, 1, At, B1); PG8_BAR;
        }
        E(acc, cur, wr, wc, fr, fq); S.done(cur);
        if (!has_next) break;
#pragma unroll
        for (int a = 0; a < 2; ++a)
#pragma unroll
            for (int b = 0; b < 2; ++b)
#pragma unroll
                for (int m = 0; m < 4; ++m)
#pragma unroll
                    for (int n = 0; n < 2; ++n) acc[a][b][m][n] = (f32x4){0.f, 0.f, 0.f, 0.f};
        cur = nxt; cA = nA; cB = nB; ++ui;
    }
    PG8_WAIT_V(0);
    if (wr == 0) PG8_BAR;
    PG8_BAR;
#undef PG8_SA
#undef PG8_SB
#undef PG8_STAGE
#undef PG8_LDA
#undef PG8_LDB
#undef PG8_MMA
#undef PG8_WAIT_V
#undef PG8_WAIT_L
#undef PG8_BAR
#undef PG8_SCHED
}

struct EpiRowScale {
    static constexpr bool PERM = true;
    bf16_t* O; int ldc; const float* rowss;
    __device__ __forceinline__ void operator()(const f32x4 (&acc)[2][2][4][2], const Unit& u, int wr, int wc, int fr, int fq) const {
        const int row0 = u.pm * BM + wr * 64 + fr, col0 = u.pn * BM + wc * 32 + 8 * fq;
#pragma unroll
        for (int ai = 0; ai < 2; ++ai)
#pragma unroll
            for (int m = 0; m < 4; ++m) { const int row = row0 + ai * HALF + m * 16; const float rs = rsqrtf(sum16(rowss + (size_t)row * 16) * (1.0f / 1024.0f) + EPS);
                bf16_t* rowp = O + (size_t)row * ldc + col0;
#pragma unroll
                for (int bj = 0; bj < 2; ++bj) { const f32x4 v0 = acc[ai][bj][m][0] * rs, v1 = acc[ai][bj][m][1] * rs;
                    u32x4 w; w.x = cvt_pk_bf16(v0[0], v0[1]); w.y = cvt_pk_bf16(v0[2], v0[3]); w.z = cvt_pk_bf16(v1[0], v1[1]); w.w = cvt_pk_bf16(v1[2], v1[3]);
                    *(u32x4*)(rowp + bj * HALF) = w; } }
    }
};
struct EpiColScale {
    static constexpr bool PERM = true;
    bf16_t* O; int ldc; const float* colss;
    __device__ __forceinline__ void operator()(const f32x4 (&acc)[2][2][4][2], const Unit& u, int wr, int wc, int fr, int fq) const {
        const int row0 = u.pm * BM + wr * 64 + fr, col0 = u.pn * BM + wc * 32 + 8 * fq;
        f32x4 sc[2][2];
#pragma unroll
        for (int bj = 0; bj < 2; ++bj)
#pragma unroll
            for (int n = 0; n < 2; ++n) { f32x4 s;
#pragma unroll
                for (int j = 0; j < 4; ++j) s[j] = sum16(colss + (size_t)(col0 + bj * HALF + 4 * n + j) * 16);
                sc[bj][n] = (f32x4){rsqrtf(s[0] * (1.0f / 1024.0f) + EPS), rsqrtf(s[1] * (1.0f / 1024.0f) + EPS), rsqrtf(s[2] * (1.0f / 1024.0f) + EPS), rsqrtf(s[3] * (1.0f / 1024.0f) + EPS)}; }
#pragma unroll
        for (int ai = 0; ai < 2; ++ai)
#pragma unroll
            for (int m = 0; m < 4; ++m) { const int row = row0 + ai * HALF + m * 16; bf16_t* rowp = O + (size_t)row * ldc + col0;
#pragma unroll
                for (int bj = 0; bj < 2; ++bj) { const f32x4 v0 = acc[ai][bj][m][0] * sc[bj][0], v1 = acc[ai][bj][m][1] * sc[bj][1];
                    u32x4 w; w.x = cvt_pk_bf16(v0[0], v0[1]); w.y = cvt_pk_bf16(v0[2], v0[3]); w.z = cvt_pk_bf16(v1[0], v1[1]); w.w = cvt_pk_bf16(v1[2], v1[3]);
                    *(u32x4*)(rowp + bj * HALF) = w; } }
    }
};
struct EpiGate {
    static constexpr bool PERM = true;
    const bf16_t* gate; const bf16_t* addsrc; bf16_t* O;
    __device__ __forceinline__ void operator()(const f32x4 (&acc)[2][2][4][2], const Unit& u, int wr, int wc, int fr, int fq) const {
        const int row0 = u.pm * BM + wr * 64 + fr, col0 = u.pn * BM + wc * 32 + 8 * fq;
#pragma unroll
        for (int ai = 0; ai < 2; ++ai)
#pragma unroll
            for (int m = 0; m < 4; ++m) { const int row = row0 + ai * HALF + m * 16;
#pragma unroll
                for (int bj = 0; bj < 2; ++bj) { const int col = col0 + bj * HALF;
                    float gf[8], r[8]; unpack8(*(const u32x4*)(gate + (size_t)row * NPROJ + col), gf);
                    const f32x4 v0 = acc[ai][bj][m][0], v1 = acc[ai][bj][m][1];
#pragma unroll
                    for (int j = 0; j < 4; ++j) { r[j] = v0[j] * sigmoidf_(gf[j]); r[4 + j] = v1[j] * sigmoidf_(gf[4 + j]); }
                    if (addsrc) { float af[8]; unpack8(*(const u32x4*)(addsrc + (size_t)row * D + col), af);
#pragma unroll
                        for (int j = 0; j < 8; ++j) r[j] += af[j]; }
                    *(u32x4*)(O + (size_t)row * D + col) = pack8(r); } }
    }
};
struct EpiResid {
    static constexpr bool PERM = true;
    const float* base; float* out; bf16_t* xb; float* rowss;
    __device__ __forceinline__ void operator()(const f32x4 (&acc)[2][2][4][2], const Unit& u, int wr, int wc, int fr, int fq) const {
        const int row0 = u.pm * BM + wr * 64 + fr, col0 = u.pn * BM + wc * 32 + 8 * fq;
#pragma unroll
        for (int ai = 0; ai < 2; ++ai)
#pragma unroll
            for (int m = 0; m < 4; ++m) { const int row = row0 + ai * HALF + m * 16; float ss = 0.f;
#pragma unroll
                for (int bj = 0; bj < 2; ++bj) { const size_t off = (size_t)row * D + col0 + bj * HALF;
                    const f32x4 b0 = *(const f32x4*)(base + off), b1 = *(const f32x4*)(base + off + 4);
                    const f32x4 v0 = acc[ai][bj][m][0] + b0, v1 = acc[ai][bj][m][1] + b1;
                    *(f32x4*)(out + off) = v0; *(f32x4*)(out + off + 4) = v1;
                    u32x4 w; w.x = cvt_pk_bf16(v0[0], v0[1]); w.y = cvt_pk_bf16(v0[2], v0[3]); w.z = cvt_pk_bf16(v1[0], v1[1]); w.w = cvt_pk_bf16(v1[2], v1[3]);
                    *(u32x4*)(xb + off) = w;
                    ss += v0[0] * v0[0] + v0[1] * v0[1] + v0[2] * v0[2] + v0[3] * v0[3] + v1[0] * v1[0] + v1[1] * v1[1] + v1[2] * v1[2] + v1[3] * v1[3]; }
                ss += __shfl_xor(ss, 16); ss += __shfl_xor(ss, 32);
                if (fq == 0) rowss[(size_t)row * 16 + u.pn * 4 + wc] = ss; }
    }
};
}

__device__ __forceinline__ int win_srccol(int nd) {
    if (nd < 1024) return nd;
    if (nd < 1536) return 1536 + (nd - 1024);
    if (nd < 2048) return 2048 + (nd - 1536);
    if (nd < 3072) return 3584 + (nd - 2048);
    if (nd < 4096) return 4608 + (nd - 3072);
    if (nd < 5120) return 5632 + (nd - 4096);
    nd -= 5120;
    if (nd < 512) return 1024 + nd;
    if (nd < 1024) return 2048 + (nd - 512);
    return 2560 + (nd - 1024);
}
__device__ __forceinline__ void conv_tile(const float* __restrict__ src, int ld_src, int k0, int nsrc0, bf16_t* dst, int ldd, int ndst0, const float* gsc, LAS float* tile) {
    const int t = otid();
#pragma unroll
    for (int i = 0; i < 2; ++i) { const int r = (t >> 4) + 32 * i, c = (t & 15) * 4;
        const float4 v = *(const float4*)(src + (size_t)(k0 + r) * ld_src + nsrc0 + c);
        const float s = gsc ? gsc[k0 + r] : 1.0f;
        tile[r * 65 + c] = v.x * s; tile[r * 65 + c + 1] = v.y * s; tile[r * 65 + c + 2] = v.z * s; tile[r * 65 + c + 3] = v.w * s; }
    __syncthreads();
    { const int n = t >> 3, k8 = (t & 7) * 8; float f[8];
#pragma unroll
      for (int j = 0; j < 8; ++j) f[j] = tile[(k8 + j) * 65 + n];
      *(u32x4*)(dst + (size_t)(ndst0 + n) * ldd + k0 + k8) = pack8(f); }
    __syncthreads();
}
__device__ __forceinline__ void phase_prologue(const Params& P, LAS unsigned char* lds) {
    LAS float* tile = (LAS float*)lds;
    constexpr int T_IN = 16 * 112, T_A = 8 * 16, T_R = 16 * 16, T_O = 16 * 16, T_UP = 16 * 88, T_D = 44 * 16, T_L = T_IN + T_A + T_R + T_O + T_UP + T_D;
    for (int job = blockIdx.x; job < T_L * DEPTH; job += ogrid()) {
        const int l = job / T_L; int r = job % T_L;
        unsigned char* wl = P.ws + WS_W + (size_t)l * W_LAYER;
        if (r < T_IN) { const int kt = r / 112, ntile = r % 112; conv_tile(P.w_in + (size_t)l * D * DIN, DIN, kt * 64, win_srccol(ntile * 64), (bf16_t*)(wl + W_IN_OFF), 1024, ntile * 64, P.norm_mix_g + l * D, tile); continue; }
        r -= T_IN;
        if (r < T_A) { const int kt = r / 16, ntile = r % 16; conv_tile(P.w_ba + (size_t)l * 512 * D, D, kt * 64, ntile * 64, (bf16_t*)(wl + W_A_OFF), 512, ntile * 64, nullptr, tile); continue; }
        r -= T_A;
        if (r < T_R) { const int kt = r / 16, ntile = r % 16; conv_tile(P.w_br + (size_t)l * D * D, D, kt * 64, ntile * 64, (bf16_t*)(wl + W_R_OFF), 1024, ntile * 64, nullptr, tile); continue; }
        r -= T_R;
        if (r < T_O) { const int kt = r / 16, ntile = r % 16; conv_tile(P.w_out + (size_t)l * D * D, D, kt * 64, ntile * 64, (bf16_t*)(wl + W_O_OFF), 1024, ntile * 64, nullptr, tile); continue; }
        r -= T_O;
        if (r < T_UP) { const int kt = r / 88, ntile = r % 88; conv_tile(P.w_up + (size_t)l * D * DFF2, DFF2, kt * 64, ntile * 64, (bf16_t*)(wl + W_UP_OFF), 1024, ntile * 64, P.norm_ffn_g + l * D, tile); continue; }
        r -= T_UP;
        { const int kt = r / 16, ntile = r % 16; conv_tile(P.w_down + (size_t)l * DFF * D, D, kt * 64, ntile * 64, (bf16_t*)(wl + W_D_OFF), DFF, ntile * 64, nullptr, tile); }
    }
    float* cosN = (float*)(P.ws + WS_COSN); float* sinN = (float*)(P.ws + WS_SINN); float* cosT = (float*)(P.ws + WS_COST); float* sinT = (float*)(P.ws + WS_SINT);
    for (int idx = blockIdx.x * NTHREADS + otid(); idx < 16384 * 64; idx += ogrid() * NTHREADS) {
        const int pos = idx >> 6, i = idx & 63;
        const float invf = powf(10000.0f, -(float)i / 64.0f);
        const float ang = (float)pos * invf;
        const float c = cosf(ang), s = sinf(ang);
        cosN[idx] = c; sinN[idx] = s; cosT[(size_t)i * 16384 + pos] = c; sinT[(size_t)i * 16384 + pos] = s;
    }
}

__device__ __forceinline__ void phase_init(const float* __restrict__ xin, bf16_t* xb, float* rowss1, float* rowss2) {
    const int tid = otid(), lane = tid & 63, nw = ogrid() * 8;
    for (int row = blockIdx.x * 8 + (tid >> 6); row < MG; row += nw) {
        const float4* p = (const float4*)(xin + (size_t)row * D); float ss = 0.f;
#pragma unroll
        for (int i = 0; i < 4; ++i) { const float4 v = p[lane + 64 * i]; ss += v.x * v.x + v.y * v.y + v.z * v.z + v.w * v.w;
            u32x2 w; w.x = cvt_pk_bf16(v.x, v.y); w.y = cvt_pk_bf16(v.z, v.w); *(u32x2*)(xb + (size_t)row * D + (lane + 64 * i) * 4) = w; }
        ss = wave_sum(ss);
        if (lane < 16) rowss1[(size_t)row * 16 + lane] = lane == 0 ? ss : 0.f;
    }
}
__device__ __forceinline__ void phase_final(float* xo, const float* rowss1, const float* __restrict__ gfin) {
    const int tid = otid(), lane = tid & 63, nw = ogrid() * 8;
    for (int row = blockIdx.x * 8 + (tid >> 6); row < MG; row += nw) {
        float4* p = (float4*)(xo + (size_t)row * D); const float rs = rsqrtf(sum16(rowss1 + (size_t)row * 16) * (1.0f / 1024.0f) + EPS);
#pragma unroll
        for (int i = 0; i < 4; ++i) { float4 v = p[lane + 64 * i]; const float4 g = ((const float4*)gfin)[lane + 64 * i];
            v.x *= rs * g.x; v.y *= rs * g.y; v.z *= rs * g.z; v.w *= rs * g.w; p[lane + 64 * i] = v; }
    }
}
__device__ __forceinline__ float gelu_tanh(float x) { const float y = 1.5957691216057308f * (x + 0.044715f * x * x * x); return x / (1.0f + __expf(-y)); }
__device__ __forceinline__ void phase_convact(const bf16_t* __restrict__ u, bf16_t* act, const float* __restrict__ cw  , int seqlen, float* rowss2) {
    const int gt = blockIdx.x * NTHREADS + otid(), nth = ogrid() * NTHREADS;
    for (int id = gt; id < 1024 * 352; id += nth) {
        const int tb = id / 352, c = (id % 352) * 8, t0 = tb * 16;
        float wg[3][8], wv[3][8];
#pragma unroll
        for (int k = 0; k < 3; ++k) {
            const f32x4 a0 = *(const f32x4*)(cw + k * DFF2 + c), a1 = *(const f32x4*)(cw + k * DFF2 + c + 4);
            const f32x4 b0 = *(const f32x4*)(cw + k * DFF2 + DFF + c), b1 = *(const f32x4*)(cw + k * DFF2 + DFF + c + 4);
#pragma unroll
            for (int j = 0; j < 4; ++j) { wg[k][j] = a0[j]; wg[k][4 + j] = a1[j]; wv[k][j] = b0[j]; wv[k][4 + j] = b1[j]; } }
        const u32x4 z = (u32x4){0u, 0u, 0u, 0u};
        u32x4 gp = z, vp = z;
        if ((t0 % seqlen) != 0) { gp = *(const u32x4*)(u + (size_t)(t0 - 1) * DFF2 + c); vp = *(const u32x4*)(u + (size_t)(t0 - 1) * DFF2 + DFF + c); }
        u32x4 gc = *(const u32x4*)(u + (size_t)t0 * DFF2 + c), vc = *(const u32x4*)(u + (size_t)t0 * DFF2 + DFF + c);
        for (int i = 0; i < 16; ++i) {
            const int t = t0 + i; u32x4 gn = z, vn = z;
            if (((t + 1) % seqlen) != 0) { gn = *(const u32x4*)(u + (size_t)(t + 1) * DFF2 + c); vn = *(const u32x4*)(u + (size_t)(t + 1) * DFF2 + DFF + c); }
            float a[8], b[8], cc[8], r[8], gg[8], vv[8];
            unpack8(gp, a); unpack8(gc, b); unpack8(gn, cc);
#pragma unroll
            for (int j = 0; j < 8; ++j) gg[j] = a[j] * wg[0][j] + b[j] * wg[1][j] + cc[j] * wg[2][j];
            unpack8(vp, a); unpack8(vc, b); unpack8(vn, cc);
#pragma unroll
            for (int j = 0; j < 8; ++j) vv[j] = a[j] * wv[0][j] + b[j] * wv[1][j] + cc[j] * wv[2][j];
#pragma unroll
            for (int j = 0; j < 8; ++j) r[j] = gelu_tanh(gg[j]) * vv[j];
            *(u32x4*)(act + (size_t)t * DFF + c) = pack8(r);
            gp = gc; gc = gn; vp = vc; vc = vn;
        }
    }
}

__device__ __forceinline__ void na_item(const bf16_t* __restrict__ proj, const bf16_t* __restrict__ projT, bf16_t* aout, const float* __restrict__ relb  , int item, int seqlen, LAS unsigned char* lds) {
    const int tid = otid(), w = __builtin_amdgcn_readfirstlane(tid >> 6), lane = tid & 63, c = lane & 31, hh = lane >> 5;
    const int R = item >> 3, h = item & 7;
    const int rps = seqlen >> 6, seq = R / rps, r = R % rps;
    int rs = r - 4; rs = rs < 0 ? 0 : rs; rs = rs > rps - 8 ? rps - 8 : rs;
    const int qtok0 = seq * seqlen + r * 64, ktok0 = seq * seqlen + rs * 64;
    LAS float* bias = (LAS float*)lds;
    LAS float* Ow = (LAS float*)(lds + 2048);
    LAS float* ML = (LAS float*)(lds + 2048 + 8 * 32 * 68 * 4);
    for (int i = tid; i < 465; i += NTHREADS) bias[i] = relb[h * 465 + i];
    __syncthreads();
    const int qh = w & 1, kg = w >> 1;
    bf16x8 qf[4];
    { const bf16_t* qp = proj + (size_t)(qtok0 + 32 * qh + c) * NPROJ + h * 64 + 8 * hh;
#pragma unroll
      for (int s = 0; s < 4; ++s) qf[s] = *(const bf16x8*)(qp + 16 * s); }
    f32x16 X[4];
#pragma unroll
    for (int kt = 0; kt < 4; ++kt) {
        const bf16_t* kp = proj + (size_t)(ktok0 + 128 * kg + 32 * kt + c) * NPROJ + 512 + h * 64 + 8 * hh;
        f32x16 x = zero16();
#pragma unroll
        for (int s = 0; s < 4; ++s) { const bf16x8 kf = *(const bf16x8*)(kp + 16 * s); x = mfma32(kf, qf[s], x); }
        X[kt] = x;
    }
    const int qc = 32 * qh + c; int cs = qc - 8; cs = cs < 0 ? 0 : cs; cs = cs > 48 ? 48 : cs;
    float mx = -1e30f;
#pragma unroll
    for (int kt = 0; kt < 4; ++kt) { const int kr = rs + 2 * kg + (kt >> 1); const int brow = (kr - r + 7) * 31;
#pragma unroll
        for (int rg = 0; rg < 16; ++rg) { const int i = (rg & 3) + 8 * (rg >> 2) + 4 * hh; const int kc = 32 * (kt & 1) + i;
            const bool valid = (kc >= cs) && (kc < cs + 16);
            float sv = -1e30f;
            if (valid) sv = X[kt][rg] * 0.125f + bias[brow + kc - qc + 15];
            X[kt][rg] = sv; mx = fmaxf(mx, sv); } }
    mx = fmaxf(mx, __shfl_xor(mx, 32));
    float lsum = 0.f;
#pragma unroll
    for (int kt = 0; kt < 4; ++kt)
#pragma unroll
        for (int rg = 0; rg < 16; ++rg) { const float sv = X[kt][rg]; const float p = (sv > -1e29f) ? __expf(sv - mx) : 0.f; X[kt][rg] = p; lsum += p; }
    lsum += __shfl_xor(lsum, 32);
    f32x16 O[2];
#pragma unroll
    for (int dt = 0; dt < 2; ++dt) O[dt] = zero16();
#pragma unroll
    for (int kt = 0; kt < 4; ++kt)
#pragma unroll
        for (int s2 = 0; s2 < 2; ++s2) {
            bf16x8 pb; { u32x4 pw; pw.x = cvt_pk_bf16(X[kt][8 * s2 + 0], X[kt][8 * s2 + 1]); pw.y = cvt_pk_bf16(X[kt][8 * s2 + 2], X[kt][8 * s2 + 3]);
                pw.z = cvt_pk_bf16(X[kt][8 * s2 + 4], X[kt][8 * s2 + 5]); pw.w = cvt_pk_bf16(X[kt][8 * s2 + 6], X[kt][8 * s2 + 7]); pb = __builtin_bit_cast(bf16x8, pw); }
#pragma unroll
            for (int dt = 0; dt < 2; ++dt) {
                const bf16_t* vp = projT + (size_t)(h * 64 + dt * 32 + c) * MG + (ktok0 + 128 * kg + 32 * kt + 16 * s2 + 4 * hh);
                const u32x2 lo = *(const u32x2*)vp, hi = *(const u32x2*)(vp + 8);
                u32x4 aw; aw.x = lo.x; aw.y = lo.y; aw.z = hi.x; aw.w = hi.y;
                O[dt] = mfma32(__builtin_bit_cast(bf16x8, aw), pb, O[dt]); } }
#pragma unroll
    for (int dt = 0; dt < 2; ++dt)
#pragma unroll
        for (int g4 = 0; g4 < 4; ++g4) { const int d = dt * 32 + 8 * g4 + 4 * hh;
            *(LAS f32x4*)(Ow + (w * 32 + c) * 68 + d) = (f32x4){O[dt][4 * g4], O[dt][4 * g4 + 1], O[dt][4 * g4 + 2], O[dt][4 * g4 + 3]}; }
    if (hh == 0) { ML[(w * 32 + c) * 2] = mx; ML[(w * 32 + c) * 2 + 1] = lsum; }
    __syncthreads();
    { const int qh2 = tid >> 8, q = (tid >> 3) & 31, d8 = (tid & 7) * 8;
      float mk[4], M = -1e30f;
#pragma unroll
      for (int k = 0; k < 4; ++k) { mk[k] = ML[((2 * k + qh2) * 32 + q) * 2]; M = fmaxf(M, mk[k]); }
      float L = 0.f, o[8];
#pragma unroll
      for (int j = 0; j < 8; ++j) o[j] = 0.f;
#pragma unroll
      for (int k = 0; k < 4; ++k) { const float wk = __expf(mk[k] - M); L += wk * ML[((2 * k + qh2) * 32 + q) * 2 + 1];
          const f32x4 a0 = *(const LAS f32x4*)(Ow + ((2 * k + qh2) * 32 + q) * 68 + d8), a1 = *(const LAS f32x4*)(Ow + ((2 * k + qh2) * 32 + q) * 68 + d8 + 4);
#pragma unroll
          for (int j = 0; j < 4; ++j) { o[j] += wk * a0[j]; o[4 + j] += wk * a1[j]; } }
      const float inv = 1.0f / L;
#pragma unroll
      for (int j = 0; j < 8; ++j) o[j] *= inv;
      *(u32x4*)(aout + (size_t)(qtok0 + 32 * qh2 + q) * 512 + h * 64 + d8) = pack8(o); }
    __syncthreads();
}

constexpr int KT_STRIDE = 136;
__device__ __forceinline__ void r1_item(const bf16_t* __restrict__ projT, float* stloc, const float* __restrict__ cosT, const float* __restrict__ sinT, float lgf2, float lgb2, int item, int seqlen, LAS unsigned char* lds) {
    const int tid = otid(), w = __builtin_amdgcn_readfirstlane(tid >> 6), lane = tid & 63, c = lane & 31, hh = lane >> 5;
    const int ch = item >> 2, h = item & 3, tok0 = ch * 128, pos0 = tok0 % seqlen;
    LAS bf16_t* KTf = (LAS bf16_t*)lds; LAS bf16_t* KTb = (LAS bf16_t*)(lds + 128 * KT_STRIDE * 2);
    const float scale = 0.08838834764831845f;
#pragma unroll
    for (int it = 0; it < 2; ++it) {
        const int id = tid + NTHREADS * it, d = id >> 4, t8 = id & 15;
        float k1[8], k2[8];
        unpack8(*(const u32x4*)(projT + (size_t)(512 + h * 128 + d) * MG + tok0 + 8 * t8), k1);
        unpack8(*(const u32x4*)(projT + (size_t)(512 + h * 128 + d + 64) * MG + tok0 + 8 * t8), k2);
        const f32x4 c0 = *(const f32x4*)(cosT + (size_t)d * 16384 + pos0 + 8 * t8), c1 = *(const f32x4*)(cosT + (size_t)d * 16384 + pos0 + 8 * t8 + 4);
        const f32x4 s0 = *(const f32x4*)(sinT + (size_t)d * 16384 + pos0 + 8 * t8), s1 = *(const f32x4*)(sinT + (size_t)d * 16384 + pos0 + 8 * t8 + 4);
        float f1[8], f2[8], b1[8], b2[8];
#pragma unroll
        for (int j = 0; j < 8; ++j) { const float cv = j < 4 ? c0[j & 3] : c1[j & 3], sv = j < 4 ? s0[j & 3] : s1[j & 3];
            const float r1 = (k1[j] * cv - k2[j] * sv) * scale, r2 = (k1[j] * sv + k2[j] * cv) * scale;
            const int tl = 8 * t8 + j; const float df = exp2f((float)(127 - tl) * lgf2), db = exp2f((float)tl * lgb2);
            f1[j] = r1 * df; f2[j] = r2 * df; b1[j] = r1 * db; b2[j] = r2 * db; }
        *(LAS u32x4*)(KTf + d * KT_STRIDE + 8 * t8) = pack8(f1); *(LAS u32x4*)(KTf + (d + 64) * KT_STRIDE + 8 * t8) = pack8(f2);
        *(LAS u32x4*)(KTb + d * KT_STRIDE + 8 * t8) = pack8(b1); *(LAS u32x4*)(KTb + (d + 64) * KT_STRIDE + 8 * t8) = pack8(b2);
    }
    __syncthreads();
    bf16x8 af[8];
    { const bf16_t* vp = projT + (size_t)(1024 + h * 256 + 32 * w + c) * MG + tok0 + 8 * hh;
#pragma unroll
      for (int s = 0; s < 8; ++s) af[s] = *(const bf16x8*)(vp + 16 * s); }
#pragma unroll
    for (int dir = 0; dir < 2; ++dir) {
        LAS bf16_t* KT = dir ? KTb : KTf;
        float* dst = stloc + ((size_t)(ch * 4 + h) * 2 + dir) * 32768;
#pragma unroll
        for (int ct = 0; ct < 4; ++ct) {
            f32x16 acc = zero16();
#pragma unroll
            for (int s = 0; s < 8; ++s) { const bf16x8 bfr = *(const LAS bf16x8*)(KT + (32 * ct + c) * KT_STRIDE + 16 * s + 8 * hh); acc = mfma32(af[s], bfr, acc); }
#pragma unroll
            for (int rg = 0; rg < 16; ++rg) { const int dv = 32 * w + (rg & 3) + 8 * (rg >> 2) + 4 * hh; dst[dv * 128 + 32 * ct + c] = acc[rg]; }
        }
    }
    __syncthreads();
}

__device__ __forceinline__ void phase_scan(const float* __restrict__ stloc, bf16_t* st, const float* __restrict__ decf, const float* __restrict__ decb, int seqlen) {
    const int nch = seqlen >> 7, nseq = MG / seqlen;
    const int ntask = nseq * 4 * 2 * 8192;
    for (int id = blockIdx.x * NTHREADS + otid(); id < ntask; id += ogrid() * NTHREADS) {
        const int e4 = id & 8191, dir = (id >> 13) & 1, h = (id >> 14) & 3, seq = id >> 16;
        const float x = dir ? decb[h] : decf[h];
        const float lg2 = -log1pf(expf(-x)) * 1.4426950408889634f;
        const float cd = exp2f(128.0f * lg2);
        f32x4 S = (f32x4){0.f, 0.f, 0.f, 0.f};
        for (int i = 0; i < nch; ++i) {
            const int ch = seq * nch + (dir ? (nch - 1 - i) : i);
            const size_t off = ((size_t)(ch * 4 + h) * 2 + dir) * 32768 + (size_t)e4 * 4;
            const f32x4 loc = *(const f32x4*)(stloc + off);
            u32x2 wv; wv.x = cvt_pk_bf16(S[0], S[1]); wv.y = cvt_pk_bf16(S[2], S[3]);
            *(u32x2*)(st + off) = wv;
            S = S * cd + loc;
        }
    }
}

constexpr int OL_STRIDE = 264;
__device__ __forceinline__ void r3_item(const bf16_t* __restrict__ proj, const bf16_t* __restrict__ projT, const bf16_t* __restrict__ st, bf16_t* ro,
                        const float* __restrict__ cosN, const float* __restrict__ sinN, const float* __restrict__ gn  , float lgf2, float lgb2,
                        int item, int seqlen, LAS unsigned char* lds) {
    const int tid = otid(), w = __builtin_amdgcn_readfirstlane(tid >> 6), lane = tid & 63, c = lane & 31, hh = lane >> 5;
    const int ch = item >> 2, h = item & 3, tok0 = ch * 128, pos0 = tok0 % seqlen;
    LAS bf16_t* Ql = (LAS bf16_t*)lds; LAS bf16_t* Kl = (LAS bf16_t*)(lds + 34816); LAS bf16_t* Pl = (LAS bf16_t*)(lds + 69632);
    LAS float* stat = (LAS float*)(lds + 104448);
    LAS bf16_t* Ol = (LAS bf16_t*)lds;
    const float scale = 0.08838834764831845f;
#pragma unroll
    for (int it = 0; it < 2; ++it) {
        const int id = tid + NTHREADS * it, t = id >> 3, d8 = (id & 7) * 8;
        const f32x4 c0 = *(const f32x4*)(cosN + (size_t)(pos0 + t) * 64 + d8), c1 = *(const f32x4*)(cosN + (size_t)(pos0 + t) * 64 + d8 + 4);
        const f32x4 s0 = *(const f32x4*)(sinN + (size_t)(pos0 + t) * 64 + d8), s1 = *(const f32x4*)(sinN + (size_t)(pos0 + t) * 64 + d8 + 4);
        float a[8], b[8], o1[8], o2[8];
        const bf16_t* qp = proj + (size_t)(tok0 + t) * NPROJ + 1024 + h * 128 + d8;
        unpack8(*(const u32x4*)qp, a); unpack8(*(const u32x4*)(qp + 64), b);
#pragma unroll
        for (int j = 0; j < 8; ++j) { const float cv = j < 4 ? c0[j & 3] : c1[j & 3], sv = j < 4 ? s0[j & 3] : s1[j & 3]; o1[j] = a[j] * cv - b[j] * sv; o2[j] = a[j] * sv + b[j] * cv; }
        *(LAS u32x4*)(Ql + t * KT_STRIDE + d8) = pack8(o1); *(LAS u32x4*)(Ql + t * KT_STRIDE + 64 + d8) = pack8(o2);
        const bf16_t* kp = proj + (size_t)(tok0 + t) * NPROJ + 1536 + h * 128 + d8;
        unpack8(*(const u32x4*)kp, a); unpack8(*(const u32x4*)(kp + 64), b);
#pragma unroll
        for (int j = 0; j < 8; ++j) { const float cv = j < 4 ? c0[j & 3] : c1[j & 3], sv = j < 4 ? s0[j & 3] : s1[j & 3]; o1[j] = (a[j] * cv - b[j] * sv) * scale; o2[j] = (a[j] * sv + b[j] * cv) * scale; }
        *(LAS u32x4*)(Kl + t * KT_STRIDE + d8) = pack8(o1); *(LAS u32x4*)(Kl + t * KT_STRIDE + 64 + d8) = pack8(o2);
    }
    __syncthreads();
    { const int kt = w >> 1;
      bf16x8 kf[8];
#pragma unroll
      for (int s = 0; s < 8; ++s) kf[s] = *(const LAS bf16x8*)(Kl + (32 * kt + c) * KT_STRIDE + 16 * s + 8 * hh);
#pragma unroll
      for (int q2 = 0; q2 < 2; ++q2) { const int tqt = 2 * (w & 1) + q2;
          f32x16 x = zero16();
#pragma unroll
          for (int s = 0; s < 8; ++s) { const bf16x8 qf = *(const LAS bf16x8*)(Ql + (32 * tqt + c) * KT_STRIDE + 16 * s + 8 * hh); x = mfma32(kf[s], qf, x); }
          const int n = 32 * tqt + c;
#pragma unroll
          for (int g4 = 0; g4 < 4; ++g4) { float pv[4];
#pragma unroll
              for (int j = 0; j < 4; ++j) { const int mk = 32 * kt + 8 * g4 + 4 * hh + j; const int diff = n - mk;
                  const float dec = diff >= 0 ? exp2f((float)diff * lgf2) : exp2f((float)(-diff) * lgb2); pv[j] = x[4 * g4 + j] * dec; }
              u32x2 pw; pw.x = cvt_pk_bf16(pv[0], pv[1]); pw.y = cvt_pk_bf16(pv[2], pv[3]);
              *(LAS u32x2*)(Pl + n * KT_STRIDE + 32 * kt + 8 * g4 + 4 * hh) = pw; } } }
    __syncthreads();
    f32x16 acc[4];
#pragma unroll
    for (int q = 0; q < 4; ++q) acc[q] = zero16();
    const size_t stb = ((size_t)(ch * 4 + h) * 2) * 32768 + (size_t)(32 * w + c) * 128 + 8 * hh;
#pragma unroll
    for (int s = 0; s < 8; ++s) { const bf16x8 a = *(const bf16x8*)(st + stb + 32768 + 16 * s);
#pragma unroll
        for (int q = 0; q < 4; ++q) { const bf16x8 b = *(const LAS bf16x8*)(Ql + (32 * q + c) * KT_STRIDE + 16 * s + 8 * hh); acc[q] = mfma32(a, b, acc[q]); } }
#pragma unroll
    for (int q = 0; q < 4; ++q) { const int n = 32 * q + c; const float f = exp2f((float)(128 - n) * lgb2 - (float)(n + 1) * lgf2); acc[q] *= f; }
#pragma unroll
    for (int s = 0; s < 8; ++s) { const bf16x8 a = *(const bf16x8*)(st + stb + 16 * s);
#pragma unroll
        for (int q = 0; q < 4; ++q) { const bf16x8 b = *(const LAS bf16x8*)(Ql + (32 * q + c) * KT_STRIDE + 16 * s + 8 * hh); acc[q] = mfma32(a, b, acc[q]); } }
#pragma unroll
    for (int q = 0; q < 4; ++q) { const int n = 32 * q + c; const float f = exp2f((float)(n + 1) * lgf2); acc[q] *= f; }
    { const bf16_t* vp = projT + (size_t)(1024 + h * 256 + 32 * w + c) * MG + tok0 + 8 * hh;
#pragma unroll
      for (int s = 0; s < 8; ++s) { const bf16x8 a = *(const bf16x8*)(vp + 16 * s);
#pragma unroll
          for (int q = 0; q < 4; ++q) { const bf16x8 b = *(const LAS bf16x8*)(Pl + (32 * q + c) * KT_STRIDE + 16 * s + 8 * hh); acc[q] = mfma32(a, b, acc[q]); } } }
#pragma unroll
    for (int q = 0; q < 4; ++q) { float s1 = 0.f, s2 = 0.f;
#pragma unroll
        for (int i = 0; i < 16; ++i) { s1 += acc[q][i]; s2 += acc[q][i] * acc[q][i]; }
        s1 += __shfl_xor(s1, 32); s2 += __shfl_xor(s2, 32);
        if (hh == 0) { stat[(w * 128 + 32 * q + c) * 2] = s1; stat[(w * 128 + 32 * q + c) * 2 + 1] = s2; } }
    __syncthreads();
#pragma unroll
    for (int q = 0; q < 4; ++q) { float s1 = 0.f, s2 = 0.f; const int n = 32 * q + c;
#pragma unroll
        for (int k = 0; k < 8; ++k) { s1 += stat[(k * 128 + n) * 2]; s2 += stat[(k * 128 + n) * 2 + 1]; }
        const float mu = s1 * (1.0f / 256.0f); float var = s2 * (1.0f / 256.0f) - mu * mu; var = var < 0.f ? 0.f : var; const float rs = rsqrtf(var + EPS);
#pragma unroll
        for (int g4 = 0; g4 < 4; ++g4) { u32x2 pw; pw.x = cvt_pk_bf16((acc[q][4 * g4] - mu) * rs, (acc[q][4 * g4 + 1] - mu) * rs); pw.y = cvt_pk_bf16((acc[q][4 * g4 + 2] - mu) * rs, (acc[q][4 * g4 + 3] - mu) * rs);
            *(LAS u32x2*)(Ol + n * OL_STRIDE + 32 * w + 8 * g4 + 4 * hh) = pw; } }
    __syncthreads();
#pragma unroll
    for (int it = 0; it < 8; ++it) { const int id = tid + NTHREADS * it, tq = id >> 5, d8 = (id & 31) * 8;
        float y[8], rg[8], o[8]; unpack8(*(const LAS u32x4*)(Ol + tq * OL_STRIDE + d8), y);
        unpack8(*(const u32x4*)(proj + (size_t)(tok0 + tq) * NPROJ + 2048 + h * 256 + d8), rg);
        const f32x4 g0 = *(const f32x4*)(gn + h * 256 + d8), g1 = *(const f32x4*)(gn + h * 256 + d8 + 4);
#pragma unroll
        for (int j = 0; j < 8; ++j) { const float gv = j < 4 ? g0[j & 3] : g1[j & 3]; o[j] = rg[j] * sigmoidf_(rg[j]) * y[j] * gv; }
        *(u32x4*)(ro + (size_t)(tok0 + tq) * D + h * 256 + d8) = pack8(o); }
    __syncthreads();
}


#define XB_TMO      128
#define XB_XCNT(j)  (256  + 64 * (j))
#define XB_XSUB(j)  (1280 + 64 * (j))
#define XB_XGEN(j)  (2304 + 64 * (j))
#define XB_TOP      3328
#define XB_TOPGEN   3392
#define XCD_BAR_WORDS 3456
#define XB_SPIN_CAP (1u << 22)
__device__ __forceinline__ unsigned xb_ld(unsigned* p)              { return __hip_atomic_load(p, __ATOMIC_RELAXED, __HIP_MEMORY_SCOPE_AGENT); }
__device__ __forceinline__ unsigned xb_add(unsigned* p, unsigned v) { return __hip_atomic_fetch_add(p, v, __ATOMIC_RELAXED, __HIP_MEMORY_SCOPE_AGENT); }
__device__ __forceinline__ unsigned xb_xcc_id() { return (unsigned)__builtin_amdgcn_s_getreg((3 << 11) | 20) & 0xFu; }
#define XB_SPIN(cond, bar) do { unsigned _sp = 0; while (cond) { __builtin_amdgcn_s_sleep(1); \
    if ((++_sp & 255u) == 0u) { if (xb_ld(&(bar)[XB_TMO])) break; if (_sp > XB_SPIN_CAP) { atomicAdd(&(bar)[XB_TMO], 1u); break; } } } } while (0)
struct XcdBarrier { unsigned* bar; unsigned x; volatile LAS unsigned* st; };
__device__ __forceinline__ XcdBarrier xcd_barrier_post(unsigned* bar, volatile LAS unsigned* st) {
    XcdBarrier b; b.bar = bar; b.x = xb_xcc_id(); b.st = st;
    if (threadIdx.x == 0) (void)xb_add(&bar[XB_XCNT(b.x)], 1u);
    return b;
}
__device__ __forceinline__ void xcd_barrier_complete(unsigned* bar, unsigned x, unsigned& nloc, unsigned& nx) {
    const unsigned G = gridDim.x * gridDim.y * gridDim.z;
    unsigned sum, cnt, mine, sp = 0u;
    for (;;) {
        sum = 0u; cnt = 0u; mine = 0u;
#pragma unroll
        for (unsigned j = 0; j < 16; ++j) { const unsigned c = xb_ld(&bar[XB_XCNT(j)]); sum += c; cnt += (c > 0u) ? 1u : 0u; mine = (j == x) ? c : mine; }
        if (sum == G) break;
        __builtin_amdgcn_s_sleep(1);
        if ((++sp & 255u) == 0u) { if (xb_ld(&bar[XB_TMO])) break; if (sp > XB_SPIN_CAP) { atomicAdd(&bar[XB_TMO], 1u); break; } }
    }
    nloc = mine > 0u ? mine : 1u; nx = cnt > 0u ? cnt : 1u;
}
__device__ __forceinline__ void xcd_barrier(const XcdBarrier& b) {
    asm volatile("s_waitcnt vmcnt(0)" ::: "memory");
    __syncthreads();
    if (threadIdx.x == 0) {
        unsigned* bar = b.bar;
        __builtin_amdgcn_s_waitcnt(0);
        unsigned nloc = b.st[0], nx = b.st[1];
        if (nloc == 0u) { xcd_barrier_complete(bar, b.x, nloc, nx); b.st[0] = nloc; b.st[1] = nx; }
        const unsigned old = xb_add(&bar[XB_XSUB(b.x)], 1u);
        const unsigned gen = old / nloc;
        if (old + 1u == (gen + 1u) * nloc) {
            __builtin_amdgcn_fence(__ATOMIC_RELEASE, "agent");
            asm volatile("s_waitcnt vmcnt(0)" ::: "memory");
            const unsigned og = xb_add(&bar[XB_TOP], 1u);
            const unsigned tg = og / nx;
            if (og + 1u == (tg + 1u) * nx) xb_add(&bar[XB_TOPGEN], 1u);
            else XB_SPIN(xb_ld(&bar[XB_TOPGEN]) == tg, bar);
            __builtin_amdgcn_fence(__ATOMIC_ACQUIRE, "agent");
            xb_add(&bar[XB_XGEN(b.x)], 1u);
            asm volatile("s_waitcnt vmcnt(0)" ::: "memory");
        } else {
            XB_SPIN(xb_ld(&bar[XB_XGEN(b.x)]) == gen, bar);
            __builtin_amdgcn_fence(__ATOMIC_ACQUIRE, "agent");
            asm volatile("s_waitcnt vmcnt(0)" ::: "memory");
        }
    }
    __syncthreads();
}

__device__ __forceinline__ unsigned char* opq(unsigned char* p) { asm volatile("" : "+s"(p)); return p; }
#define WSP(T, off) ((T*)(opq(P.ws) + (off)))
#define XBAR() do { XcdBarrier _b; _b.bar = (unsigned*)(opq(P.ws) + WS_CTL); _b.x = (unsigned)__builtin_amdgcn_readfirstlane((int)xb_xcc_id()); _b.st = (volatile LAS unsigned*)(lds + 131072); xcd_barrier(_b); } while (0)
__global__ void __launch_bounds__(NTHREADS, 2) fwd_megakernel(Params P) {
    extern __shared__ __attribute__((aligned(16))) unsigned char lds_raw[];
    LAS unsigned char* lds = (LAS unsigned char*)lds_raw;
    cg::grid_group grid = cg::this_grid();
    const int G = ogrid(), bid = blockIdx.x;
    volatile LAS unsigned* xst = (volatile LAS unsigned*)(lds + 131072);
    if (threadIdx.x < 4) xst[threadIdx.x] = 0u;
    __syncthreads();
    (void)xcd_barrier_post((unsigned*)(P.ws + WS_CTL), xst);

    phase_prologue(P, lds);
    grid.sync();
    XBAR();

    for (int grp = 0; grp < NGROUPS; ++grp) {
        const float* xin = grp < 4 ? P.x_prompt + (size_t)grp * MG * D : P.x_sample;
        float* xo = P.out + (size_t)grp * MG * D;
        const int seqlen = grp < 4 ? 4096 : 16384;
        phase_init(xin, WSP(bf16_t, WS_XB), WSP(float, WS_ROWSS1), WSP(float, WS_ROWSS2));
        XBAR();
        for (int l = 0; l < DEPTH; ++l) {
            const size_t wl = WS_W + (size_t)l * W_LAYER;
            { pg8::Gemm g{WSP(bf16_t, WS_XB), WSP(const bf16_t, wl + W_IN_OFF), MG, NPROJ, D}; pg8::StaticOrder S; S.init(MG, NPROJ, G, bid);
              pg8::EpiRowScale E{WSP(bf16_t, WS_PROJ), NPROJ, WSP(float, WS_ROWSS1)}; pg8::gemm_phase(lds, g, S, E); }
            { pg8::Gemm g{WSP(const bf16_t, wl + W_IN_OFF + (size_t)NPROJ * D * 2), WSP(bf16_t, WS_XB), NPT, MG, D}; pg8::StaticOrder S; S.init(NPT, MG, G, bid);
              pg8::EpiColScale E{WSP(bf16_t, WS_PROJT), MG, WSP(float, WS_ROWSS1)}; pg8::gemm_phase(lds, g, S, E); }
            XBAR();
            { for (int it = bid; it < 2048; it += G) na_item(WSP(bf16_t, WS_PROJ), WSP(bf16_t, WS_PROJT), WSP(bf16_t, WS_A), P.na_rel_bias + (size_t)l * 8 * 465, it, seqlen, lds);
              for (int it = bid; it < 512; it += G) { const int h = it & 3;
                  const float lgf2 = -log1pf(expf(-P.dec_f[l * 4 + h])) * 1.4426950408889634f, lgb2 = -log1pf(expf(-P.dec_b[l * 4 + h])) * 1.4426950408889634f;
                  r1_item(WSP(bf16_t, WS_PROJT), WSP(float, WS_STLOC), WSP(float, WS_COST), WSP(float, WS_SINT), lgf2, lgb2, it, seqlen, lds); } }
            XBAR();
            phase_scan(WSP(float, WS_STLOC), WSP(bf16_t, WS_ST), P.dec_f + l * 4, P.dec_b + l * 4, seqlen);
            XBAR();
            for (int it = bid; it < 512; it += G) { const int h = it & 3;
                const float lgf2 = -log1pf(expf(-P.dec_f[l * 4 + h])) * 1.4426950408889634f, lgb2 = -log1pf(expf(-P.dec_b[l * 4 + h])) * 1.4426950408889634f;
                r3_item(WSP(bf16_t, WS_PROJ), WSP(bf16_t, WS_PROJT), WSP(bf16_t, WS_ST), WSP(bf16_t, WS_RO), WSP(float, WS_COSN), WSP(float, WS_SINN), P.ret_norm_g + (size_t)l * 1024, lgf2, lgb2, it, seqlen, lds); }
            XBAR();
            { pg8::Gemm g{WSP(bf16_t, WS_A), WSP(const bf16_t, wl + W_A_OFF), MG, D, 512}; pg8::StaticOrder S; S.init(MG, D, G, bid);
              pg8::EpiGate E{WSP(bf16_t, WS_PROJ) + 3072, nullptr, WSP(bf16_t, WS_TMP)}; pg8::gemm_phase(lds, g, S, E); }
            { pg8::Gemm g{WSP(bf16_t, WS_RO), WSP(const bf16_t, wl + W_R_OFF), MG, D, D}; pg8::StaticOrder S; S.init(MG, D, G, bid);
              pg8::EpiGate E{WSP(bf16_t, WS_PROJ) + 4096, WSP(bf16_t, WS_TMP), WSP(bf16_t, WS_MIXED)}; pg8::gemm_phase(lds, g, S, E); }
            XBAR();
            { pg8::Gemm g{WSP(bf16_t, WS_MIXED), WSP(const bf16_t, wl + W_O_OFF), MG, D, D}; pg8::StaticOrder S; S.init(MG, D, G, bid);
              pg8::EpiResid E{l == 0 ? xin : xo, xo, WSP(bf16_t, WS_XB), WSP(float, WS_ROWSS2)}; pg8::gemm_phase(lds, g, S, E); }
            XBAR();
            { pg8::Gemm g{WSP(bf16_t, WS_XB), WSP(const bf16_t, wl + W_UP_OFF), MG, DFF2, D}; pg8::StaticOrder S; S.init(MG, DFF2, G, bid);
              pg8::EpiRowScale E{WSP(bf16_t, WS_PROJ), DFF2, WSP(float, WS_ROWSS2)}; pg8::gemm_phase(lds, g, S, E); }
            XBAR();
            phase_convact(WSP(bf16_t, WS_PROJ), WSP(bf16_t, WS_STLOC), P.conv_w + (size_t)l * 3 * DFF2, seqlen, WSP(float, WS_ROWSS2));
            XBAR();
            { pg8::Gemm g{WSP(bf16_t, WS_STLOC), WSP(const bf16_t, wl + W_D_OFF), MG, D, DFF}; pg8::StaticOrder S; S.init(MG, D, G, bid);
              pg8::EpiResid E{xo, xo, WSP(bf16_t, WS_XB), WSP(float, WS_ROWSS1)}; pg8::gemm_phase(lds, g, S, E); }
            XBAR();
        }
        phase_final(xo, WSP(float, WS_ROWSS1), P.norm_final_g);
        XBAR();
    }
}

extern "C" void kernel_launch(void* const* d_in, const int* in_sizes, int n_in, void* d_out, int out_size, void* d_ws, size_t ws_size, hipStream_t stream) {
    static int grid_blocks = 0;
    if (grid_blocks == 0) {
        if (n_in != 16 || ws_size < WS_END) { fprintf(stderr, "kernel_launch: unexpected n_in %d or ws_size %zu (< %zu)\n", n_in, ws_size, (size_t)WS_END); grid_blocks = -1; return; }
        int dev = 0, cus = 0, per_cu = 0;
        hipGetDevice(&dev);
        hipDeviceGetAttribute(&cus, hipDeviceAttributeMultiprocessorCount, dev);
        if (hipFuncSetAttribute((const void*)fwd_megakernel, hipFuncAttributeMaxDynamicSharedMemorySize, LDS_BYTES) != hipSuccess) { fprintf(stderr, "kernel_launch: hipFuncSetAttribute failed\n"); grid_blocks = -1; return; }
        hipOccupancyMaxActiveBlocksPerMultiprocessor(&per_cu, (const void*)fwd_megakernel, NTHREADS, LDS_BYTES);
        if (per_cu < 1) { fprintf(stderr, "kernel_launch: occupancy query says %d blocks per CU\n", per_cu); per_cu = 1; }
        (void)hipGetLastError();
        grid_blocks = cus;
    }
    if (grid_blocks < 0) return;
    if (hipMemsetAsync((char*)d_ws + WS_CTL, 0, 16384, stream) != hipSuccess) { fprintf(stderr, "kernel_launch: memset of barrier words failed\n"); return; }
    Params p{};
    p.x_prompt = (const float*)d_in[0]; p.x_sample = (const float*)d_in[1]; p.norm_mix_g = (const float*)d_in[2]; p.w_in = (const float*)d_in[3]; p.na_rel_bias = (const float*)d_in[4];
    p.dec_f = (const float*)d_in[5]; p.dec_b = (const float*)d_in[6]; p.ret_norm_g = (const float*)d_in[7]; p.w_ba = (const float*)d_in[8]; p.w_br = (const float*)d_in[9]; p.w_out = (const float*)d_in[10];
    p.norm_ffn_g = (const float*)d_in[11]; p.w_up = (const float*)d_in[12]; p.conv_w = (const float*)d_in[13]; p.w_down = (const float*)d_in[14]; p.norm_final_g = (const float*)d_in[15];
    p.out = (float*)d_out; p.ws = (unsigned char*)d_ws;
    void* args[] = {&p};
    hipError_t e = hipLaunchCooperativeKernel((const void*)fwd_megakernel, dim3(grid_blocks), dim3(NTHREADS), args, LDS_BYTES, stream);
    if (e != hipSuccess) fprintf(stderr, "kernel_launch: cooperative launch failed: %s (grid %d)\n", hipGetErrorString(e), grid_blocks);
}
```

```cpp
#include <hip/hip_runtime.h>
#include <hip/hip_cooperative_groups.h>
#include <cstdio>
namespace cg = cooperative_groups;

#define LAS __attribute__((address_space(3)))
typedef unsigned short bf16_t;
typedef short bf16x8 __attribute__((ext_vector_type(8)));
typedef short bf16x4 __attribute__((ext_vector_type(4)));
typedef float f32x4 __attribute__((ext_vector_type(4)));
typedef float f32x16 __attribute__((ext_vector_type(16)));
typedef unsigned u32x4 __attribute__((ext_vector_type(4)));
typedef unsigned u32x2 __attribute__((ext_vector_type(2)));

constexpr int D = 1024, MG = 16384, NPROJ = 5120, NPT = 2048, DFF = 2816, DFF2 = 5632, DEPTH = 4, NGROUPS = 5, DIN = 6656;
constexpr float EPS = 1e-6f;
constexpr int NTHREADS = 512;
constexpr int LDS_BYTES = 131072 + 1024;

constexpr size_t WS_CTL = 0;
constexpr size_t WS_LG2 = 32768;
constexpr size_t WS_ROWSS1 = 262144;
constexpr size_t WS_ROWSS2 = WS_ROWSS1 + (size_t)MG * 16 * 4;
constexpr size_t WS_COSN = WS_ROWSS2 + (size_t)MG * 16 * 4;
constexpr size_t TAB_BYTES = (size_t)16384 * 64 * 4;
constexpr size_t WS_SINN = WS_COSN + TAB_BYTES;
constexpr size_t WS_COST = WS_SINN + TAB_BYTES;
constexpr size_t WS_SINT = WS_COST + TAB_BYTES;
constexpr size_t WS_W = WS_SINT + TAB_BYTES;
constexpr size_t W_IN_OFF = 0;
constexpr size_t W_A_OFF = W_IN_OFF + (size_t)7168 * 1024 * 2;
constexpr size_t W_R_OFF = W_A_OFF + (size_t)1024 * 512 * 2;
constexpr size_t W_O_OFF = W_R_OFF + (size_t)1024 * 1024 * 2;
constexpr size_t W_UP_OFF = W_O_OFF + (size_t)1024 * 1024 * 2;
constexpr size_t W_D_OFF = W_UP_OFF + (size_t)5632 * 1024 * 2;
constexpr size_t W_LAYER = W_D_OFF + (size_t)1024 * 2816 * 2;
constexpr size_t WS_XB = WS_W + W_LAYER * DEPTH;
constexpr size_t WS_PROJ = WS_XB + (size_t)MG * D * 2;
constexpr size_t WS_PROJT = WS_PROJ + (size_t)MG * NPROJ * 2;
constexpr size_t WS_A = WS_PROJT + (size_t)NPT * MG * 2;
constexpr size_t WS_RO = WS_A + (size_t)MG * 512 * 2;
constexpr size_t WS_TMP = WS_RO + (size_t)MG * D * 2;
constexpr size_t WS_MIXED = WS_TMP + (size_t)MG * D * 2;
constexpr size_t WS_STLOC = WS_MIXED + (size_t)MG * D * 2;
constexpr size_t WS_ST = WS_STLOC + (size_t)128 * 4 * 2 * 32768 * 4;
constexpr size_t WS_END = WS_ST + (size_t)128 * 4 * 2 * 32768 * 2;
static_assert((size_t)MG * DFF2 * 2 <= (size_t)MG * NPROJ * 2 + (size_t)NPT * MG * 2, "u must fit over proj+projT");
static_assert((size_t)MG * DFF * 2 <= (size_t)128 * 4 * 2 * 32768 * 4, "act must fit over STloc");
static_assert(WS_END <= ((size_t)1 << 30), "workspace over 1 GiB");

struct Params {
    const float* x_prompt; const float* x_sample; const float* norm_mix_g; const float* w_in; const float* na_rel_bias;
    const float* dec_f; const float* dec_b; const float* ret_norm_g; const float* w_ba; const float* w_br; const float* w_out;
    const float* norm_ffn_g; const float* w_up; const float* conv_w; const float* w_down; const float* norm_final_g;
    float* out; unsigned char* ws;
};

typedef __bf16 bf16v2_t __attribute__((ext_vector_type(2)));
typedef float f32v2_t __attribute__((ext_vector_type(2)));
__device__ __forceinline__ unsigned cvt_pk_bf16(float lo, float hi) { const f32v2_t v = {lo, hi}; const bf16v2_t r = __builtin_convertvector(v, bf16v2_t); return __builtin_bit_cast(unsigned, r); }
__device__ __forceinline__ float bf_lo(unsigned w) { return __uint_as_float(w << 16); }
__device__ __forceinline__ float bf_hi(unsigned w) { return __uint_as_float(w & 0xffff0000u); }
__device__ __forceinline__ float bf2f(bf16_t b) { return __uint_as_float(((unsigned)b) << 16); }
__device__ __forceinline__ float sigmoidf_(float x) { return 1.0f / (1.0f + __expf(-x)); }
__device__ __forceinline__ void unpack8(const u32x4 w, float* f) { f[0] = bf_lo(w.x); f[1] = bf_hi(w.x); f[2] = bf_lo(w.y); f[3] = bf_hi(w.y); f[4] = bf_lo(w.z); f[5] = bf_hi(w.z); f[6] = bf_lo(w.w); f[7] = bf_hi(w.w); }
__device__ __forceinline__ u32x4 pack8(const float* f) { u32x4 w; w.x = cvt_pk_bf16(f[0], f[1]); w.y = cvt_pk_bf16(f[2], f[3]); w.z = cvt_pk_bf16(f[4], f[5]); w.w = cvt_pk_bf16(f[6], f[7]); return w; }
__device__ __forceinline__ f32x16 mfma32(bf16x8 a, bf16x8 b, f32x16 c) { return __builtin_amdgcn_mfma_f32_32x32x16_bf16(a, b, c, 0, 0, 0); }
__device__ __forceinline__ int otid() { int t = threadIdx.x; asm volatile("" : "+v"(t)); return t; }
__device__ __forceinline__ int ogrid() { int g = gridDim.x; asm volatile("" : "+s"(g)); return g; }
__device__ __forceinline__ f32x16 zero16() { return (f32x16){0.f, 0.f, 0.f, 0.f, 0.f, 0.f, 0.f, 0.f, 0.f, 0.f, 0.f, 0.f, 0.f, 0.f, 0.f, 0.f}; }
__device__ __forceinline__ float sum16(const float* p) { const f32x4 a = *(const f32x4*)p, b = *(const f32x4*)(p + 4), c = *(const f32x4*)(p + 8), d = *(const f32x4*)(p + 12); const f32x4 t = (a + b) + (c + d); return (t[0] + t[1]) + (t[2] + t[3]); }
__device__ __forceinline__ float shx(float v, int m, int lane) { return __int_as_float(__builtin_amdgcn_ds_bpermute((lane ^ m) << 2, __float_as_int(v))); }
__device__ __forceinline__ float wave_sum(float v, int lane) { v += shx(v, 32, lane); v += shx(v, 16, lane); v += shx(v, 8, lane); v += shx(v, 4, lane); v += shx(v, 2, lane); v += shx(v, 1, lane); return v; }

namespace pg8 {
constexpr int BM = 256, BK = 64, HALF = 128, HTB = HALF * BK * 2, STAGE_BYTES = 8 * HTB, NXCD = 8, WGM = 8;
__host__ __device__ __forceinline__ int lds_byte(int r, int c) { const int st = (r >> 4) * 2 + (c >> 5), rr = r & 15, cc = c & 31, ob = rr * 64 + cc * 2; return st * 1024 + (ob ^ (((ob >> 9) & 1) << 5)); }
__host__ __device__ __forceinline__ void stage_rc(int b, int& R, int& C) { const int st = b / 1024, sb = b % 1024, swz = sb ^ (((sb >> 9) & 1) << 5); R = (st >> 1) * 16 + swz / 64; C = (st & 1) * 32 + (swz % 64) / 2; }
__host__ __device__ __forceinline__ int perm32(int rho) { const int n = rho >> 4, i = rho & 15; return 8 * (i >> 2) + 4 * n + (i & 3); }
struct Unit { int pm, pn; };
struct Gemm { const bf16_t* A; const bf16_t* Bt; int M, N, K; };
struct StaticOrder {
    int nM, nN, nwg, G, c;
    __host__ __device__ void init(int M, int N, int G_, int c_) { nM = M / BM; nN = N / BM; nwg = nM * nN; G = G_; c = c_; }
    __host__ __device__ bool next(int i, Unit& u) const {
        const long L = (long)i * G + c; if (L >= nwg) return false;
        int wgid = (int)L; { const int q = nwg / NXCD, r = nwg % NXCD, xcd = wgid % NXCD, off = wgid / NXCD; wgid = (xcd < r ? xcd * (q + 1) : r * (q + 1) + (xcd - r) * q) + off; }
        const int nig = WGM * nN, gid = wgid / nig, fm = gid * WGM, gsz = (nM - fm) < WGM ? (nM - fm) : WGM;
        u.pm = fm + ((wgid % nig) % gsz); u.pn = (wgid % nig) / gsz; return true;
    }
    __device__ __forceinline__ void a_ready(const Unit&) const {}
    __device__ __forceinline__ void done(const Unit&) const {}
};

template <class Epi, class Sched>
__device__ __forceinline__ void gemm_phase(LAS unsigned char* lds, const Gemm g, const Sched& S, const Epi& E) {
    const int tid = otid(), wid = __builtin_amdgcn_readfirstlane(tid >> 6), lane = tid & 63, wr = wid >> 2, wc = wid & 3, fr = lane & 15, fq = lane >> 4;
    const int K = g.K, nt = K / BK;
    unsigned voffA[2], voffB[2];
#pragma unroll
    for (int i = 0; i < 2; ++i) { int R, C; stage_rc(tid * 16 + i * 8192, R, C); const int Rb = Epi::PERM ? ((R & ~31) + perm32(R & 31)) : R;
        voffA[i] = (unsigned)(R * K + C) * 2u; voffB[i] = (unsigned)(Rb * K + C) * 2u; }
    const size_t kstep = (size_t)(BK * 2);
    const size_t hstep = (size_t)HALF * K * 2;
    const size_t tstep = 2 * hstep;
    const unsigned ldsw = (unsigned)wid * 1024u;
    const int aoff = lds_byte(wr * 64 + fr, fq * 8), boff = lds_byte(wc * 32 + fr, fq * 8);
#define PG8_SA(b, h) (((b) * 2 + (h)) * HTB)
#define PG8_SB(b, h) ((4 + (b) * 2 + (h)) * HTB)
#define PG8_STAGE(bufoff, gbase, voff) do { _Pragma("unroll") for (int _i = 0; _i < 2; ++_i) \
        __builtin_amdgcn_global_load_lds((const unsigned*)((const char*)(gbase) + (voff)[_i]), (LAS unsigned*)(lds + (bufoff) + ldsw + _i * 8192), 16, 0, 0); } while (0)
#define PG8_LDA(dst, b, h) do { _Pragma("unroll") for (int m = 0; m < 4; ++m) _Pragma("unroll") for (int k = 0; k < 2; ++k) dst[m][k] = *(const LAS bf16x8*)(lds + PG8_SA(b, h) + aoff + m * 2048 + k * 1024); } while (0)
#define PG8_LDB(dst, b, h) do { _Pragma("unroll") for (int n = 0; n < 2; ++n) _Pragma("unroll") for (int k = 0; k < 2; ++k) dst[n][k] = *(const LAS bf16x8*)(lds + PG8_SB(b, h) + boff + n * 2048 + k * 1024); } while (0)
#define PG8_MMA(ai, bj, At, Bt) do { __builtin_amdgcn_s_setprio(1); _Pragma("unroll") for (int m = 0; m < 4; ++m) _Pragma("unroll") for (int n = 0; n < 2; ++n) _Pragma("unroll") for (int k = 0; k < 2; ++k) \
        acc[ai][bj][m][n] = __builtin_amdgcn_mfma_f32_16x16x32_bf16(Bt[n][k], At[m][k], acc[ai][bj][m][n], 0, 0, 0); __builtin_amdgcn_s_setprio(0); } while (0)
#define PG8_WAIT_V(n) asm volatile("s_waitcnt vmcnt(" #n ")" ::: "memory")
#define PG8_WAIT_L(n) asm volatile("s_waitcnt lgkmcnt(" #n ")" ::: "memory")
#define PG8_BAR __builtin_amdgcn_s_barrier()
#define PG8_SCHED __builtin_amdgcn_sched_barrier(0)
    Unit cur, nxt; int ui = 0;
    if (!S.next(0, cur)) return;
    f32x4 acc[2][2][4][2];
#pragma unroll
    for (int a = 0; a < 2; ++a)
#pragma unroll
        for (int b = 0; b < 2; ++b)
#pragma unroll
            for (int m = 0; m < 4; ++m)
#pragma unroll
                for (int n = 0; n < 2; ++n) acc[a][b][m][n] = (f32x4){0.f, 0.f, 0.f, 0.f};
    bf16x8 At[4][2], B0[2][2], B1[2][2];
    const char* cA = (const char*)g.A + (size_t)cur.pm * tstep; const char* cB = (const char*)g.Bt + (size_t)cur.pn * tstep;
    S.a_ready(cur);
    PG8_STAGE(PG8_SB(0, 0), cB, voffB); PG8_STAGE(PG8_SA(0, 0), cA, voffA); PG8_STAGE(PG8_SB(0, 1), cB + hstep, voffB); PG8_STAGE(PG8_SA(0, 1), cA + hstep, voffA);
    if (wr == 1) PG8_BAR;
    PG8_WAIT_V(4); PG8_BAR;
    PG8_STAGE(PG8_SB(1, 0), cB + kstep, voffB); PG8_STAGE(PG8_SA(1, 0), cA + kstep, voffA); PG8_STAGE(PG8_SB(1, 1), cB + hstep + kstep, voffB);
    PG8_WAIT_V(6); PG8_BAR;
    for (;;) {
        const bool has_next = S.next(ui + 1, nxt);
        const char* nA = has_next ? (const char*)g.A + (size_t)nxt.pm * tstep : cA; const char* nB = has_next ? (const char*)g.Bt + (size_t)nxt.pn * tstep : cB;
        for (int t = 0; t < nt; t += 2) {
            const bool last = (t == nt - 2);
            const char* a1 = cA + (size_t)(t + 1) * kstep;
            const char* a2 = last ? nA : cA + (size_t)(t + 2) * kstep; const char* b2 = last ? nB : cB + (size_t)(t + 2) * kstep;
            const char* a3 = a2 + kstep; const char* b3 = b2 + kstep;
            if (last && has_next) S.a_ready(nxt);
            PG8_LDB(B0, 0, 0); PG8_SCHED; PG8_LDA(At, 0, 0); PG8_STAGE(PG8_SA(1, 1), a1 + hstep, voffA);
            PG8_WAIT_L(8); PG8_BAR; PG8_WAIT_L(0); PG8_MMA(0, 0, At, B0); PG8_BAR; PG8_SCHED;
            PG8_LDB(B1, 0, 1); PG8_STAGE(PG8_SB(0, 0), b2, voffB);
            PG8_BAR; PG8_WAIT_L(0); PG8_MMA(0, 1, At, B1); PG8_BAR;
            PG8_LDA(At, 0, 1); PG8_STAGE(PG8_SA(0, 0), a2, voffA);
            PG8_BAR; PG8_WAIT_L(0); PG8_MMA(1, 0, At, B0); PG8_BAR; PG8_SCHED;
            PG8_STAGE(PG8_SB(0, 1), b2 + hstep, voffB);
            PG8_WAIT_V(6); PG8_BAR; PG8_MMA(1, 1, At, B1); PG8_BAR;
            PG8_LDB(B0, 1, 0); PG8_SCHED; PG8_LDA(At, 1, 0); PG8_STAGE(PG8_SA(0, 1), a2 + hstep, voffA);
            PG8_WAIT_L(8); PG8_BAR; PG8_WAIT_L(0); PG8_MMA(0, 0, At, B0); PG8_BAR; PG8_SCHED;
            PG8_LDB(B1, 1, 1); PG8_STAGE(PG8_SB(1, 0), b3, voffB);
            PG8_BAR; PG8_WAIT_L(0); PG8_MMA(0, 1, At, B1); PG8_BAR;
            PG8_LDA(At, 1, 1); PG8_STAGE(PG8_SA(1, 0), a3, voffA);
            PG8_BAR; PG8_WAIT_L(0); PG8_MMA(1, 0, At, B0); PG8_BAR; PG8_SCHED;
            PG8_STAGE(PG8_SB(1, 1), b3 + hstep, voffB);
            PG8_WAIT_V(6); PG8_BAR; PG8_MMA(1, 1, At, B1); PG8_BAR;
        }
        E(acc, cur, wr, wc, fr, fq); S.done(cur);
        if (!has_next) break;
#pragma unroll
        for (int a = 0; a < 2; ++a)
#pragma unroll
            for (int b = 0; b < 2; ++b)
#pragma unroll
                for (int m = 0; m < 4; ++m)
#pragma unroll
                    for (int n = 0; n < 2; ++n) acc[a][b][m][n] = (f32x4){0.f, 0.f, 0.f, 0.f};
        cur = nxt; cA = nA; cB = nB; ++ui;
    }
    PG8_WAIT_V(0);
    if (wr == 0) PG8_BAR;
    PG8_BAR;
#undef PG8_SA
#undef PG8_SB
#undef PG8_STAGE
#undef PG8_LDA
#undef PG8_LDB
#undef PG8_MMA
#undef PG8_WAIT_V
#undef PG8_WAIT_L
#undef PG8_BAR
#undef PG8_SCHED
}

struct EpiRowScale {
    static constexpr bool PERM = true;
    bf16_t* O; int ldc; const float* rowss;
    __device__ __forceinline__ void operator()(const f32x4 (&acc)[2][2][4][2], const Unit& u, int wr, int wc, int fr, int fq) const {
        const int row0 = u.pm * BM + wr * 64 + fr, col0 = u.pn * BM + wc * 32 + 8 * fq;
#pragma unroll
        for (int ai = 0; ai < 2; ++ai)
#pragma unroll
            for (int m = 0; m < 4; ++m) { const int row = row0 + ai * HALF + m * 16; const float rs = rsqrtf(sum16(rowss + (size_t)row * 16) * (1.0f / 1024.0f) + EPS);
                bf16_t* rowp = O + (size_t)row * ldc + col0;
#pragma unroll
                for (int bj = 0; bj < 2; ++bj) { const f32x4 v0 = acc[ai][bj][m][0] * rs, v1 = acc[ai][bj][m][1] * rs;
                    u32x4 w; w.x = cvt_pk_bf16(v0[0], v0[1]); w.y = cvt_pk_bf16(v0[2], v0[3]); w.z = cvt_pk_bf16(v1[0], v1[1]); w.w = cvt_pk_bf16(v1[2], v1[3]);
                    *(u32x4*)(rowp + bj * HALF) = w; } }
    }
};
struct EpiColScale {
    static constexpr bool PERM = true;
    bf16_t* O; int ldc; const float* colss;
    __device__ __forceinline__ void operator()(const f32x4 (&acc)[2][2][4][2], const Unit& u, int wr, int wc, int fr, int fq) const {
        const int row0 = u.pm * BM + wr * 64 + fr, col0 = u.pn * BM + wc * 32 + 8 * fq;
        f32x4 sc[2][2];
#pragma unroll
        for (int bj = 0; bj < 2; ++bj)
#pragma unroll
            for (int n = 0; n < 2; ++n) { f32x4 s;
#pragma unroll
                for (int j = 0; j < 4; ++j) s[j] = sum16(colss + (size_t)(col0 + bj * HALF + 4 * n + j) * 16);
                sc[bj][n] = (f32x4){rsqrtf(s[0] * (1.0f / 1024.0f) + EPS), rsqrtf(s[1] * (1.0f / 1024.0f) + EPS), rsqrtf(s[2] * (1.0f / 1024.0f) + EPS), rsqrtf(s[3] * (1.0f / 1024.0f) + EPS)}; }
#pragma unroll
        for (int ai = 0; ai < 2; ++ai)
#pragma unroll
            for (int m = 0; m < 4; ++m) { const int row = row0 + ai * HALF + m * 16; bf16_t* rowp = O + (size_t)row * ldc + col0;
#pragma unroll
                for (int bj = 0; bj < 2; ++bj) { const f32x4 v0 = acc[ai][bj][m][0] * sc[bj][0], v1 = acc[ai][bj][m][1] * sc[bj][1];
                    u32x4 w; w.x = cvt_pk_bf16(v0[0], v0[1]); w.y = cvt_pk_bf16(v0[2], v0[3]); w.z = cvt_pk_bf16(v1[0], v1[1]); w.w = cvt_pk_bf16(v1[2], v1[3]);
                    *(u32x4*)(rowp + bj * HALF) = w; } }
    }
};
struct EpiGate {
    static constexpr bool PERM = true;
    const bf16_t* gate; const bf16_t* addsrc; bf16_t* O;
    __device__ __forceinline__ void operator()(const f32x4 (&acc)[2][2][4][2], const Unit& u, int wr, int wc, int fr, int fq) const {
        const int row0 = u.pm * BM + wr * 64 + fr, col0 = u.pn * BM + wc * 32 + 8 * fq;
#pragma unroll
        for (int ai = 0; ai < 2; ++ai)
#pragma unroll
            for (int m = 0; m < 4; ++m) { const int row = row0 + ai * HALF + m * 16;
#pragma unroll
                for (int bj = 0; bj < 2; ++bj) { const int col = col0 + bj * HALF;
                    float gf[8], r[8]; unpack8(*(const u32x4*)(gate + (size_t)row * NPROJ + col), gf);
                    const f32x4 v0 = acc[ai][bj][m][0], v1 = acc[ai][bj][m][1];
#pragma unroll
                    for (int j = 0; j < 4; ++j) { r[j] = v0[j] * sigmoidf_(gf[j]); r[4 + j] = v1[j] * sigmoidf_(gf[4 + j]); }
                    if (addsrc) { float af[8]; unpack8(*(const u32x4*)(addsrc + (size_t)row * D + col), af);
#pragma unroll
                        for (int j = 0; j < 8; ++j) r[j] += af[j]; }
                    *(u32x4*)(O + (size_t)row * D + col) = pack8(r); } }
    }
};
struct EpiResid {
    static constexpr bool PERM = true;
    const float* base; float* out; bf16_t* xb; float* rowss;
    __device__ __forceinline__ void operator()(const f32x4 (&acc)[2][2][4][2], const Unit& u, int wr, int wc, int fr, int fq) const {
        const int row0 = u.pm * BM + wr * 64 + fr, col0 = u.pn * BM + wc * 32 + 8 * fq;
#pragma unroll
        for (int ai = 0; ai < 2; ++ai)
#pragma unroll
            for (int m = 0; m < 4; ++m) { const int row = row0 + ai * HALF + m * 16; float ss = 0.f;
#pragma unroll
                for (int bj = 0; bj < 2; ++bj) { const size_t off = (size_t)row * D + col0 + bj * HALF;
                    const f32x4 b0 = *(const f32x4*)(base + off), b1 = *(const f32x4*)(base + off + 4);
                    const f32x4 v0 = acc[ai][bj][m][0] + b0, v1 = acc[ai][bj][m][1] + b1;
                    *(f32x4*)(out + off) = v0; *(f32x4*)(out + off + 4) = v1;
                    u32x4 w; w.x = cvt_pk_bf16(v0[0], v0[1]); w.y = cvt_pk_bf16(v0[2], v0[3]); w.z = cvt_pk_bf16(v1[0], v1[1]); w.w = cvt_pk_bf16(v1[2], v1[3]);
                    *(u32x4*)(xb + off) = w;
                    ss += v0[0] * v0[0] + v0[1] * v0[1] + v0[2] * v0[2] + v0[3] * v0[3] + v1[0] * v1[0] + v1[1] * v1[1] + v1[2] * v1[2] + v1[3] * v1[3]; }
                { const int ln = fr + 16 * fq; ss += shx(ss, 16, ln); ss += shx(ss, 32, ln); }
                if (fq == 0) rowss[(size_t)row * 16 + u.pn * 4 + wc] = ss; }
    }
};
}

__device__ __forceinline__ int win_srccol(int nd) {
    if (nd < 1024) return nd;
    if (nd < 1536) return 1536 + (nd - 1024);
    if (nd < 2048) return 2048 + (nd - 1536);
    if (nd < 3072) return 3584 + (nd - 2048);
    if (nd < 4096) return 4608 + (nd - 3072);
    if (nd < 5120) return 5632 + (nd - 4096);
    nd -= 5120;
    if (nd < 512) return 1024 + nd;
    if (nd < 1024) return 2048 + (nd - 512);
    return 2560 + (nd - 1024);
}
__device__ __forceinline__ void conv_tile(const float* __restrict__ src, int ld_src, int k0, int nsrc0, bf16_t* dst, int ldd, int ndst0, const float* gsc, LAS float* tile) {
    const int t = otid();
#pragma unroll
    for (int i = 0; i < 2; ++i) { const int r = (t >> 4) + 32 * i, c = (t & 15) * 4;
        const float4 v = *(const float4*)(src + (size_t)(k0 + r) * ld_src + nsrc0 + c);
        const float s = gsc ? gsc[k0 + r] : 1.0f;
        tile[r * 65 + c] = v.x * s; tile[r * 65 + c + 1] = v.y * s; tile[r * 65 + c + 2] = v.z * s; tile[r * 65 + c + 3] = v.w * s; }
    __syncthreads();
    { const int n = t >> 3, k8 = (t & 7) * 8; float f[8];
#pragma unroll
      for (int j = 0; j < 8; ++j) f[j] = tile[(k8 + j) * 65 + n];
      *(u32x4*)(dst + (size_t)(ndst0 + n) * ldd + k0 + k8) = pack8(f); }
    __syncthreads();
}
__device__ __forceinline__ void phase_prologue(const Params& P, LAS unsigned char* lds) {
    LAS float* tile = (LAS float*)lds;
    constexpr int T_IN = 16 * 112, T_A = 8 * 16, T_R = 16 * 16, T_O = 16 * 16, T_UP = 16 * 88, T_D = 44 * 16, T_L = T_IN + T_A + T_R + T_O + T_UP + T_D;
    for (int job = blockIdx.x; job < T_L * DEPTH; job += ogrid()) {
        const int l = job / T_L; int r = job % T_L;
        unsigned char* wl = P.ws + WS_W + (size_t)l * W_LAYER;
        if (r < T_IN) { const int kt = r / 112, ntile = r % 112; conv_tile(P.w_in + (size_t)l * D * DIN, DIN, kt * 64, win_srccol(ntile * 64), (bf16_t*)(wl + W_IN_OFF), 1024, ntile * 64, P.norm_mix_g + l * D, tile); continue; }
        r -= T_IN;
        if (r < T_A) { const int kt = r / 16, ntile = r % 16; conv_tile(P.w_ba + (size_t)l * 512 * D, D, kt * 64, ntile * 64, (bf16_t*)(wl + W_A_OFF), 512, ntile * 64, nullptr, tile); continue; }
        r -= T_A;
        if (r < T_R) { const int kt = r / 16, ntile = r % 16; conv_tile(P.w_br + (size_t)l * D * D, D, kt * 64, ntile * 64, (bf16_t*)(wl + W_R_OFF), 1024, ntile * 64, nullptr, tile); continue; }
        r -= T_R;
        if (r < T_O) { const int kt = r / 16, ntile = r % 16; conv_tile(P.w_out + (size_t)l * D * D, D, kt * 64, ntile * 64, (bf16_t*)(wl + W_O_OFF), 1024, ntile * 64, nullptr, tile); continue; }
        r -= T_O;
        if (r < T_UP) { const int kt = r / 88, ntile = r % 88; conv_tile(P.w_up + (size_t)l * D * DFF2, DFF2, kt * 64, ntile * 64, (bf16_t*)(wl + W_UP_OFF), 1024, ntile * 64, P.norm_ffn_g + l * D, tile); continue; }
        r -= T_UP;
        { const int kt = r / 16, ntile = r % 16; conv_tile(P.w_down + (size_t)l * DFF * D, D, kt * 64, ntile * 64, (bf16_t*)(wl + W_D_OFF), DFF, ntile * 64, nullptr, tile); }
    }
    if (blockIdx.x == 0 && otid() < DEPTH * 4) { const int i = otid(); float* tab = (float*)(P.ws + WS_LG2);
        tab[2 * i] = -log1pf(expf(-P.dec_f[i])) * 1.4426950408889634f; tab[2 * i + 1] = -log1pf(expf(-P.dec_b[i])) * 1.4426950408889634f; }
    float* cosN = (float*)(P.ws + WS_COSN); float* sinN = (float*)(P.ws + WS_SINN); float* cosT = (float*)(P.ws + WS_COST); float* sinT = (float*)(P.ws + WS_SINT);
    for (int idx = blockIdx.x * NTHREADS + otid(); idx < 16384 * 64; idx += ogrid() * NTHREADS) {
        const int pos = idx >> 6, i = idx & 63;
        const float invf = powf(10000.0f, -(float)i / 64.0f);
        const float ang = (float)pos * invf;
        const float c = cosf(ang), s = sinf(ang);
        cosN[idx] = c; sinN[idx] = s; cosT[(size_t)i * 16384 + pos] = c; sinT[(size_t)i * 16384 + pos] = s;
    }
}

__device__ __forceinline__ void phase_init(const float* __restrict__ xin, bf16_t* xb, float* rowss1, float* rowss2) {
    const int tid = otid(), lane = tid & 63, nw = ogrid() * 8;
    for (int row = blockIdx.x * 8 + (tid >> 6); row < MG; row += nw) {
        const float4* p = (const float4*)(xin + (size_t)row * D); float ss = 0.f;
#pragma unroll
        for (int i = 0; i < 4; ++i) { const float4 v = p[lane + 64 * i]; ss += v.x * v.x + v.y * v.y + v.z * v.z + v.w * v.w;
            u32x2 w; w.x = cvt_pk_bf16(v.x, v.y); w.y = cvt_pk_bf16(v.z, v.w); *(u32x2*)(xb + (size_t)row * D + (lane + 64 * i) * 4) = w; }
        ss = wave_sum(ss, lane);
        if (lane < 16) rowss1[(size_t)row * 16 + lane] = lane == 0 ? ss : 0.f;
    }
}
__device__ __forceinline__ void phase_final(float* xo, const float* rowss1, const float* __restrict__ gfin) {
    const int tid = otid(), lane = tid & 63, nw = ogrid() * 8;
    for (int row = blockIdx.x * 8 + (tid >> 6); row < MG; row += nw) {
        float4* p = (float4*)(xo + (size_t)row * D); const float rs = rsqrtf(sum16(rowss1 + (size_t)row * 16) * (1.0f / 1024.0f) + EPS);
#pragma unroll
        for (int i = 0; i < 4; ++i) { float4 v = p[lane + 64 * i]; const float4 g = ((const float4*)gfin)[lane + 64 * i];
            v.x *= rs * g.x; v.y *= rs * g.y; v.z *= rs * g.z; v.w *= rs * g.w; p[lane + 64 * i] = v; }
    }
}
__device__ __forceinline__ float gelu_tanh(float x) { const float y = 1.5957691216057308f * (x + 0.044715f * x * x * x); return x / (1.0f + __expf(-y)); }
__device__ __forceinline__ void phase_convact(const bf16_t* __restrict__ u, bf16_t* act, const float* __restrict__ cw  , int seqlen, float* rowss2) {
    const int gt = blockIdx.x * NTHREADS + otid(), nth = ogrid() * NTHREADS;
    for (int id = gt; id < 2048 * 352; id += nth) {
        const int tb = id / 352, c = (id % 352) * 8, t0 = tb * 8;
        const u32x4 z = (u32x4){0u, 0u, 0u, 0u};
        u32x4 g[10], v[10];
        const bool has_prev = (t0 % seqlen) != 0, has_next = ((t0 + 8) % seqlen) != 0;
#pragma unroll
        for (int r = 0; r < 10; ++r) { const bool ok = (r == 0) ? has_prev : ((r == 9) ? has_next : true);
            g[r] = z; v[r] = z;
            if (ok) { g[r] = *(const u32x4*)(u + (size_t)(t0 - 1 + r) * DFF2 + c); v[r] = *(const u32x4*)(u + (size_t)(t0 - 1 + r) * DFF2 + DFF + c); } }
        float wg[3][8], wv[3][8];
#pragma unroll
        for (int k = 0; k < 3; ++k) {
            const f32x4 a0 = *(const f32x4*)(cw + k * DFF2 + c), a1 = *(const f32x4*)(cw + k * DFF2 + c + 4);
            const f32x4 b0 = *(const f32x4*)(cw + k * DFF2 + DFF + c), b1 = *(const f32x4*)(cw + k * DFF2 + DFF + c + 4);
#pragma unroll
            for (int j = 0; j < 4; ++j) { wg[k][j] = a0[j]; wg[k][4 + j] = a1[j]; wv[k][j] = b0[j]; wv[k][4 + j] = b1[j]; } }
#pragma unroll
        for (int i = 0; i < 8; ++i) {
            float a[8], b[8], cc[8], r[8], gg[8], vv[8];
            unpack8(g[i], a); unpack8(g[i + 1], b); unpack8(g[i + 2], cc);
#pragma unroll
            for (int j = 0; j < 8; ++j) gg[j] = a[j] * wg[0][j] + b[j] * wg[1][j] + cc[j] * wg[2][j];
            unpack8(v[i], a); unpack8(v[i + 1], b); unpack8(v[i + 2], cc);
#pragma unroll
            for (int j = 0; j < 8; ++j) vv[j] = a[j] * wv[0][j] + b[j] * wv[1][j] + cc[j] * wv[2][j];
#pragma unroll
            for (int j = 0; j < 8; ++j) r[j] = gelu_tanh(gg[j]) * vv[j];
            *(u32x4*)(act + (size_t)(t0 + i) * DFF + c) = pack8(r);
        }
    }
}

constexpr int NA_LDS_WAVE = 12288;
struct NaFrags { bf16x8 k[4]; u32x2 v[2][2][2]; };
__device__ __forceinline__ void na_load(NaFrags& f, const bf16_t* __restrict__ proj, const bf16_t* __restrict__ projT, int ktok, int h, int c, int hh) {
    const bf16_t* kp = proj + (size_t)(ktok + c) * NPROJ + 512 + h * 64 + 8 * hh;
#pragma unroll
    for (int s = 0; s < 4; ++s) f.k[s] = *(const bf16x8*)(kp + 16 * s);
#pragma unroll
    for (int dt = 0; dt < 2; ++dt)
#pragma unroll
        for (int s2 = 0; s2 < 2; ++s2) { const bf16_t* vp = projT + (size_t)(h * 64 + dt * 32 + c) * MG + (ktok + 16 * s2 + 4 * hh);
            f.v[dt][s2][0] = *(const u32x2*)vp; f.v[dt][s2][1] = *(const u32x2*)(vp + 8); }
}
__device__ __forceinline__ void na_item(const bf16_t* __restrict__ proj, const bf16_t* __restrict__ projT, bf16_t* aout, const float* __restrict__ relb  , int item, int seqlen, LAS unsigned char* lds, int w, int lane) {
    const int c = lane & 31, hh = lane >> 5;
    const int R = item >> 3, h = item & 7;
    const int rps = seqlen >> 6, seq = R / rps, r = R % rps;
    int rs = r - 4; rs = rs < 0 ? 0 : rs; rs = rs > rps - 8 ? rps - 8 : rs;
    const int qtok0 = seq * seqlen + r * 64, ktok0 = seq * seqlen + rs * 64;
    LAS float* bias = (LAS float*)(lds + w * NA_LDS_WAVE);
    LAS bf16_t* Otile = (LAS bf16_t*)(lds + w * NA_LDS_WAVE + 2048);
    for (int i = lane; i < 465; i += 64) bias[i] = relb[h * 465 + i];
    bf16x8 qf[2][4];
#pragma unroll
    for (int qh = 0; qh < 2; ++qh) { const bf16_t* qp = proj + (size_t)(qtok0 + 32 * qh + c) * NPROJ + h * 64 + 8 * hh;
#pragma unroll
        for (int s = 0; s < 4; ++s) qf[qh][s] = *(const bf16x8*)(qp + 16 * s); }
    f32x16 O[2][2];
    float mrun[2], lrun[2]; int cs[2];
#pragma unroll
    for (int qh = 0; qh < 2; ++qh) { O[qh][0] = zero16(); O[qh][1] = zero16(); mrun[qh] = -1e30f; lrun[qh] = 0.f;
        int x = 32 * qh + c - 8; x = x < 0 ? 0 : x; x = x > 48 ? 48 : x; cs[qh] = x; }
    NaFrags cur, nxt;
    na_load(cur, proj, projT, ktok0, h, c, hh);
#pragma unroll 1
    for (int t = 0; t < 16; ++t) {
        if (t + 1 < 16) na_load(nxt, proj, projT, ktok0 + 32 * (t + 1), h, c, hh);
        const int kr = rs + (t >> 1), chalf = t & 1, brow = (kr - r + 7) * 31;
#pragma unroll
        for (int qh = 0; qh < 2; ++qh) {
            f32x16 x = zero16();
#pragma unroll
            for (int s = 0; s < 4; ++s) x = mfma32(cur.k[s], qf[qh][s], x);
            const int qc = 32 * qh + c; float mt = -1e30f;
#pragma unroll
            for (int rg = 0; rg < 16; ++rg) { const int kc = 32 * chalf + (rg & 3) + 8 * (rg >> 2) + 4 * hh;
                const bool valid = (kc >= cs[qh]) && (kc < cs[qh] + 16);
                float sv = -1e30f;
                if (valid) sv = x[rg] * 0.125f + bias[brow + kc - qc + 15];
                x[rg] = sv; mt = fmaxf(mt, sv); }
            mt = fmaxf(mt, shx(mt, 32, lane));
            const float mnew = fmaxf(mrun[qh], mt), alpha = __expf(mrun[qh] - mnew);
            mrun[qh] = mnew;
            float ps = 0.f;
#pragma unroll
            for (int rg = 0; rg < 16; ++rg) { const float p = (x[rg] > -1e29f) ? __expf(x[rg] - mnew) : 0.f; x[rg] = p; ps += p; }
            lrun[qh] = lrun[qh] * alpha + ps;
            O[qh][0] *= alpha; O[qh][1] *= alpha;
#pragma unroll
            for (int s2 = 0; s2 < 2; ++s2) {
                u32x4 pw; pw.x = cvt_pk_bf16(x[8 * s2 + 0], x[8 * s2 + 1]); pw.y = cvt_pk_bf16(x[8 * s2 + 2], x[8 * s2 + 3]); pw.z = cvt_pk_bf16(x[8 * s2 + 4], x[8 * s2 + 5]); pw.w = cvt_pk_bf16(x[8 * s2 + 6], x[8 * s2 + 7]);
                const bf16x8 pb = __builtin_bit_cast(bf16x8, pw);
#pragma unroll
                for (int dt = 0; dt < 2; ++dt) { u32x4 aw; aw.x = cur.v[dt][s2][0].x; aw.y = cur.v[dt][s2][0].y; aw.z = cur.v[dt][s2][1].x; aw.w = cur.v[dt][s2][1].y;
                    O[qh][dt] = mfma32(__builtin_bit_cast(bf16x8, aw), pb, O[qh][dt]); } }
        }
        cur = nxt;
    }
#pragma unroll
    for (int qh = 0; qh < 2; ++qh) { const float inv = 1.0f / (lrun[qh] + shx(lrun[qh], 32, lane));
#pragma unroll
        for (int dt = 0; dt < 2; ++dt)
#pragma unroll
            for (int g4 = 0; g4 < 4; ++g4) { u32x2 pw; pw.x = cvt_pk_bf16(O[qh][dt][4 * g4] * inv, O[qh][dt][4 * g4 + 1] * inv); pw.y = cvt_pk_bf16(O[qh][dt][4 * g4 + 2] * inv, O[qh][dt][4 * g4 + 3] * inv);
                *(LAS u32x2*)(Otile + (32 * qh + c) * 72 + dt * 32 + 8 * g4 + 4 * hh) = pw; } }
#pragma unroll
    for (int i = 0; i < 8; ++i) { const int id = lane + 64 * i, q = id >> 3, d8 = (id & 7) * 8;
        *(u32x4*)(aout + (size_t)(qtok0 + q) * 512 + h * 64 + d8) = *(const LAS u32x4*)(Otile + q * 72 + d8); }
}

constexpr int KT_STRIDE = 136;
__device__ __forceinline__ void r1_item(const bf16_t* __restrict__ projT, float* stloc, const float* __restrict__ cosT, const float* __restrict__ sinT, float lgf2, float lgb2, int item, int seqlen, LAS unsigned char* lds) {
    const int tid = otid(), w = __builtin_amdgcn_readfirstlane(tid >> 6), lane = tid & 63, c = lane & 31, hh = lane >> 5;
    const int ch = item >> 2, h = item & 3, tok0 = ch * 128, pos0 = tok0 % seqlen;
    LAS bf16_t* KTf = (LAS bf16_t*)lds; LAS bf16_t* KTb = (LAS bf16_t*)(lds + 128 * KT_STRIDE * 2);
    const float scale = 0.08838834764831845f;
#pragma unroll
    for (int it = 0; it < 2; ++it) {
        const int id = tid + NTHREADS * it, d = id >> 4, t8 = id & 15;
        float k1[8], k2[8];
        unpack8(*(const u32x4*)(projT + (size_t)(512 + h * 128 + d) * MG + tok0 + 8 * t8), k1);
        unpack8(*(const u32x4*)(projT + (size_t)(512 + h * 128 + d + 64) * MG + tok0 + 8 * t8), k2);
        const f32x4 c0 = *(const f32x4*)(cosT + (size_t)d * 16384 + pos0 + 8 * t8), c1 = *(const f32x4*)(cosT + (size_t)d * 16384 + pos0 + 8 * t8 + 4);
        const f32x4 s0 = *(const f32x4*)(sinT + (size_t)d * 16384 + pos0 + 8 * t8), s1 = *(const f32x4*)(sinT + (size_t)d * 16384 + pos0 + 8 * t8 + 4);
        float f1[8], f2[8], b1[8], b2[8];
#pragma unroll
        for (int j = 0; j < 8; ++j) { const float cv = j < 4 ? c0[j & 3] : c1[j & 3], sv = j < 4 ? s0[j & 3] : s1[j & 3];
            const float r1 = (k1[j] * cv - k2[j] * sv) * scale, r2 = (k1[j] * sv + k2[j] * cv) * scale;
            const int tl = 8 * t8 + j; const float df = exp2f((float)(127 - tl) * lgf2), db = exp2f((float)tl * lgb2);
            f1[j] = r1 * df; f2[j] = r2 * df; b1[j] = r1 * db; b2[j] = r2 * db; }
        *(LAS u32x4*)(KTf + d * KT_STRIDE + 8 * t8) = pack8(f1); *(LAS u32x4*)(KTf + (d + 64) * KT_STRIDE + 8 * t8) = pack8(f2);
        *(LAS u32x4*)(KTb + d * KT_STRIDE + 8 * t8) = pack8(b1); *(LAS u32x4*)(KTb + (d + 64) * KT_STRIDE + 8 * t8) = pack8(b2);
    }
    __syncthreads();
    bf16x8 af[8];
    { const bf16_t* vp = projT + (size_t)(1024 + h * 256 + 32 * w + c) * MG + tok0 + 8 * hh;
#pragma unroll
      for (int s = 0; s < 8; ++s) af[s] = *(const bf16x8*)(vp + 16 * s); }
#pragma unroll
    for (int dir = 0; dir < 2; ++dir) {
        LAS bf16_t* KT = dir ? KTb : KTf;
        float* dst = stloc + ((size_t)(ch * 4 + h) * 2 + dir) * 32768;
#pragma unroll
        for (int ct = 0; ct < 4; ++ct) {
            f32x16 acc = zero16();
#pragma unroll
            for (int s = 0; s < 8; ++s) { const bf16x8 bfr = *(const LAS bf16x8*)(KT + (32 * ct + c) * KT_STRIDE + 16 * s + 8 * hh); acc = mfma32(af[s], bfr, acc); }
#pragma unroll
            for (int rg = 0; rg < 16; ++rg) { const int dv = 32 * w + (rg & 3) + 8 * (rg >> 2) + 4 * hh; dst[dv * 128 + 32 * ct + c] = acc[rg]; }
        }
    }
    __syncthreads();
}

__device__ __forceinline__ void phase_scan(const float* __restrict__ stloc, bf16_t* st, const float* __restrict__ decf, const float* __restrict__ decb, int seqlen) {
    const int gt = blockIdx.x * NTHREADS + otid(), nth = ogrid() * NTHREADS;
    if (seqlen == 4096) {
        constexpr int NCH = 32, NTASK = 4 * 4 * 2 * 8192;
        for (int id0 = gt; id0 < NTASK; id0 += 2 * nth) {
            size_t base[2]; int dirs[2]; float cd[2]; bool ok[2];
#pragma unroll
            for (int k = 0; k < 2; ++k) { const int id = id0 + k * nth; ok[k] = id < NTASK; const int idc = ok[k] ? id : id0;
                const int e4 = idc & 8191, dir = (idc >> 13) & 1, h = (idc >> 14) & 3, seq = idc >> 16;
                const float x = dir ? decb[h] : decf[h]; cd[k] = exp2f(-128.0f * log1pf(expf(-x)) * 1.4426950408889634f);
                dirs[k] = dir; base[k] = ((size_t)(seq * NCH * 4 + h) * 2 + dir) * 32768 + (size_t)e4 * 4; }
            float zz = 0.f; asm volatile("" : "+v"(zz));
            f32x4 S[2] = {(f32x4){zz, zz, zz, zz}, (f32x4){zz, zz, zz, zz}};
            for (int i0 = 0; i0 < NCH; i0 += 4) {
                f32x4 loc[2][4];
#pragma unroll
                for (int k = 0; k < 2; ++k)
#pragma unroll
                    for (int j = 0; j < 4; ++j) { const int ci = dirs[k] ? (NCH - 1 - (i0 + j)) : (i0 + j); loc[k][j] = *(const f32x4*)(stloc + base[k] + (size_t)ci * (4 * 2 * 32768)); }
#pragma unroll
                for (int j = 0; j < 4; ++j)
#pragma unroll
                    for (int k = 0; k < 2; ++k) { const int ci = dirs[k] ? (NCH - 1 - (i0 + j)) : (i0 + j);
                        u32x2 wv; wv.x = cvt_pk_bf16(S[k][0], S[k][1]); wv.y = cvt_pk_bf16(S[k][2], S[k][3]);
                        if (ok[k]) *(u32x2*)(st + base[k] + (size_t)ci * (4 * 2 * 32768)) = wv;
                        S[k] = S[k] * cd[k] + loc[k][j]; }
            }
        }
    } else {
        constexpr int NCH = 128, NTASK = 4 * 2 * 16384;
        typedef float f32x2 __attribute__((ext_vector_type(2)));
        for (int id = gt; id < NTASK; id += nth) {
            const int e2 = id & 16383, dir = (id >> 14) & 1, h = (id >> 15) & 3;
            const float x = dir ? decb[h] : decf[h]; const float cd = exp2f(-128.0f * log1pf(expf(-x)) * 1.4426950408889634f);
            const size_t base = ((size_t)h * 2 + dir) * 32768 + (size_t)e2 * 2;
            float zz = 0.f; asm volatile("" : "+v"(zz));
            f32x2 S = (f32x2){zz, zz};
            for (int i0 = 0; i0 < NCH; i0 += 8) {
                f32x2 loc[8];
#pragma unroll
                for (int j = 0; j < 8; ++j) { const int ci = dir ? (NCH - 1 - (i0 + j)) : (i0 + j); loc[j] = *(const f32x2*)(stloc + base + (size_t)ci * (4 * 2 * 32768)); }
#pragma unroll
                for (int j = 0; j < 8; ++j) { const int ci = dir ? (NCH - 1 - (i0 + j)) : (i0 + j);
                    *(unsigned*)(st + base + (size_t)ci * (4 * 2 * 32768)) = cvt_pk_bf16(S[0], S[1]);
                    S = S * cd + loc[j]; }
            }
        }
    }
}

constexpr int OL_STRIDE = 264;
__device__ __forceinline__ void r3_item(const bf16_t* __restrict__ proj, const bf16_t* __restrict__ projT, const bf16_t* __restrict__ st, bf16_t* ro,
                        const float* __restrict__ cosN, const float* __restrict__ sinN, const float* __restrict__ gn  , float lgf2, float lgb2,
                        int item, int seqlen, LAS unsigned char* lds) {
    const int tid = otid(), w = __builtin_amdgcn_readfirstlane(tid >> 6), lane = tid & 63, c = lane & 31, hh = lane >> 5;
    const int ch = item >> 2, h = item & 3, tok0 = ch * 128, pos0 = tok0 % seqlen;
    LAS bf16_t* Ql = (LAS bf16_t*)lds; LAS bf16_t* Kl = (LAS bf16_t*)(lds + 34816); LAS bf16_t* Pl = (LAS bf16_t*)(lds + 69632);
    LAS float* stat = (LAS float*)(lds + 104448);
    LAS bf16_t* Ol = (LAS bf16_t*)lds;
    const float scale = 0.08838834764831845f;
#pragma unroll
    for (int it = 0; it < 2; ++it) {
        const int id = tid + NTHREADS * it, t = id >> 3, d8 = (id & 7) * 8;
        const f32x4 c0 = *(const f32x4*)(cosN + (size_t)(pos0 + t) * 64 + d8), c1 = *(const f32x4*)(cosN + (size_t)(pos0 + t) * 64 + d8 + 4);
        const f32x4 s0 = *(const f32x4*)(sinN + (size_t)(pos0 + t) * 64 + d8), s1 = *(const f32x4*)(sinN + (size_t)(pos0 + t) * 64 + d8 + 4);
        float a[8], b[8], o1[8], o2[8];
        const bf16_t* qp = proj + (size_t)(tok0 + t) * NPROJ + 1024 + h * 128 + d8;
        unpack8(*(const u32x4*)qp, a); unpack8(*(const u32x4*)(qp + 64), b);
#pragma unroll
        for (int j = 0; j < 8; ++j) { const float cv = j < 4 ? c0[j & 3] : c1[j & 3], sv = j < 4 ? s0[j & 3] : s1[j & 3]; o1[j] = a[j] * cv - b[j] * sv; o2[j] = a[j] * sv + b[j] * cv; }
        *(LAS u32x4*)(Ql + t * KT_STRIDE + d8) = pack8(o1); *(LAS u32x4*)(Ql + t * KT_STRIDE + 64 + d8) = pack8(o2);
        const bf16_t* kp = proj + (size_t)(tok0 + t) * NPROJ + 1536 + h * 128 + d8;
        unpack8(*(const u32x4*)kp, a); unpack8(*(const u32x4*)(kp + 64), b);
#pragma unroll
        for (int j = 0; j < 8; ++j) { const float cv = j < 4 ? c0[j & 3] : c1[j & 3], sv = j < 4 ? s0[j & 3] : s1[j & 3]; o1[j] = (a[j] * cv - b[j] * sv) * scale; o2[j] = (a[j] * sv + b[j] * cv) * scale; }
        *(LAS u32x4*)(Kl + t * KT_STRIDE + d8) = pack8(o1); *(LAS u32x4*)(Kl + t * KT_STRIDE + 64 + d8) = pack8(o2);
    }
    __syncthreads();
    { const int kt = w >> 1;
      bf16x8 kf[8];
#pragma unroll
      for (int s = 0; s < 8; ++s) kf[s] = *(const LAS bf16x8*)(Kl + (32 * kt + c) * KT_STRIDE + 16 * s + 8 * hh);
#pragma unroll
      for (int q2 = 0; q2 < 2; ++q2) { const int tqt = 2 * (w & 1) + q2;
          f32x16 x = zero16();
#pragma unroll
          for (int s = 0; s < 8; ++s) { const bf16x8 qf = *(const LAS bf16x8*)(Ql + (32 * tqt + c) * KT_STRIDE + 16 * s + 8 * hh); x = mfma32(kf[s], qf, x); }
          const int n = 32 * tqt + c;
#pragma unroll
          for (int g4 = 0; g4 < 4; ++g4) { float pv[4];
#pragma unroll
              for (int j = 0; j < 4; ++j) { const int mk = 32 * kt + 8 * g4 + 4 * hh + j; const int diff = n - mk;
                  const float dec = diff >= 0 ? exp2f((float)diff * lgf2) : exp2f((float)(-diff) * lgb2); pv[j] = x[4 * g4 + j] * dec; }
              u32x2 pw; pw.x = cvt_pk_bf16(pv[0], pv[1]); pw.y = cvt_pk_bf16(pv[2], pv[3]);
              *(LAS u32x2*)(Pl + n * KT_STRIDE + 32 * kt + 8 * g4 + 4 * hh) = pw; } } }
    __syncthreads();
    f32x16 acc[4];
#pragma unroll
    for (int q = 0; q < 4; ++q) acc[q] = zero16();
    const size_t stb = ((size_t)(ch * 4 + h) * 2) * 32768 + (size_t)(32 * w + c) * 128 + 8 * hh;
#pragma unroll
    for (int s = 0; s < 8; ++s) { const bf16x8 a = *(const bf16x8*)(st + stb + 32768 + 16 * s);
#pragma unroll
        for (int q = 0; q < 4; ++q) { const bf16x8 b = *(const LAS bf16x8*)(Ql + (32 * q + c) * KT_STRIDE + 16 * s + 8 * hh); acc[q] = mfma32(a, b, acc[q]); } }
#pragma unroll
    for (int q = 0; q < 4; ++q) { const int n = 32 * q + c; const float f = exp2f((float)(128 - n) * lgb2 - (float)(n + 1) * lgf2); acc[q] *= f; }
#pragma unroll
    for (int s = 0; s < 8; ++s) { const bf16x8 a = *(const bf16x8*)(st + stb + 16 * s);
#pragma unroll
        for (int q = 0; q < 4; ++q) { const bf16x8 b = *(const LAS bf16x8*)(Ql + (32 * q + c) * KT_STRIDE + 16 * s + 8 * hh); acc[q] = mfma32(a, b, acc[q]); } }
#pragma unroll
    for (int q = 0; q < 4; ++q) { const int n = 32 * q + c; const float f = exp2f((float)(n + 1) * lgf2); acc[q] *= f; }
    { const bf16_t* vp = projT + (size_t)(1024 + h * 256 + 32 * w + c) * MG + tok0 + 8 * hh;
#pragma unroll
      for (int s = 0; s < 8; ++s) { const bf16x8 a = *(const bf16x8*)(vp + 16 * s);
#pragma unroll
          for (int q = 0; q < 4; ++q) { const bf16x8 b = *(const LAS bf16x8*)(Pl + (32 * q + c) * KT_STRIDE + 16 * s + 8 * hh); acc[q] = mfma32(a, b, acc[q]); } } }
#pragma unroll
    for (int q = 0; q < 4; ++q) { float s1 = 0.f, s2 = 0.f;
#pragma unroll
        for (int i = 0; i < 16; ++i) { s1 += acc[q][i]; s2 += acc[q][i] * acc[q][i]; }
        s1 += shx(s1, 32, lane); s2 += shx(s2, 32, lane);
        if (hh == 0) { stat[(w * 128 + 32 * q + c) * 2] = s1; stat[(w * 128 + 32 * q + c) * 2 + 1] = s2; } }
    __syncthreads();
#pragma unroll
    for (int q = 0; q < 4; ++q) { float s1 = 0.f, s2 = 0.f; const int n = 32 * q + c;
#pragma unroll
        for (int k = 0; k < 8; ++k) { s1 += stat[(k * 128 + n) * 2]; s2 += stat[(k * 128 + n) * 2 + 1]; }
        const float mu = s1 * (1.0f / 256.0f); float var = s2 * (1.0f / 256.0f) - mu * mu; var = var < 0.f ? 0.f : var; const float rs = rsqrtf(var + EPS);
#pragma unroll
        for (int g4 = 0; g4 < 4; ++g4) { u32x2 pw; pw.x = cvt_pk_bf16((acc[q][4 * g4] - mu) * rs, (acc[q][4 * g4 + 1] - mu) * rs); pw.y = cvt_pk_bf16((acc[q][4 * g4 + 2] - mu) * rs, (acc[q][4 * g4 + 3] - mu) * rs);
            *(LAS u32x2*)(Ol + n * OL_STRIDE + 32 * w + 8 * g4 + 4 * hh) = pw; } }
    __syncthreads();
#pragma unroll
    for (int it = 0; it < 8; ++it) { const int id = tid + NTHREADS * it, tq = id >> 5, d8 = (id & 31) * 8;
        float y[8], rg[8], o[8]; unpack8(*(const LAS u32x4*)(Ol + tq * OL_STRIDE + d8), y);
        unpack8(*(const u32x4*)(proj + (size_t)(tok0 + tq) * NPROJ + 2048 + h * 256 + d8), rg);
        const f32x4 g0 = *(const f32x4*)(gn + h * 256 + d8), g1 = *(const f32x4*)(gn + h * 256 + d8 + 4);
#pragma unroll
        for (int j = 0; j < 8; ++j) { const float gv = j < 4 ? g0[j & 3] : g1[j & 3]; o[j] = rg[j] * sigmoidf_(rg[j]) * y[j] * gv; }
        *(u32x4*)(ro + (size_t)(tok0 + tq) * D + h * 256 + d8) = pack8(o); }
    __syncthreads();
}


#define XB_TMO      128
#define XB_XCNT(j)  (256  + 64 * (j))
#define XB_XSUB(j)  (1280 + 64 * (j))
#define XB_XGEN(j)  (2304 + 64 * (j))
#define XB_TOP      3328
#define XB_TOPGEN   3392
#define XCD_BAR_WORDS 3456
#define XB_SPIN_CAP (1u << 22)
__device__ __forceinline__ unsigned xb_ld(unsigned* p)              { return __hip_atomic_load(p, __ATOMIC_RELAXED, __HIP_MEMORY_SCOPE_AGENT); }
__device__ __forceinline__ unsigned xb_add(unsigned* p, unsigned v) { return __hip_atomic_fetch_add(p, v, __ATOMIC_RELAXED, __HIP_MEMORY_SCOPE_AGENT); }
__device__ __forceinline__ unsigned xb_xcc_id() { return (unsigned)__builtin_amdgcn_s_getreg((3 << 11) | 20) & 0xFu; }
#define XB_SPIN(cond, bar) do { unsigned _sp = 0; while (cond) { __builtin_amdgcn_s_sleep(1); \
    if ((++_sp & 255u) == 0u) { if (xb_ld(&(bar)[XB_TMO])) break; if (_sp > XB_SPIN_CAP) { atomicAdd(&(bar)[XB_TMO], 1u); break; } } } } while (0)
struct XcdBarrier { unsigned* bar; unsigned x; volatile LAS unsigned* st; };
__device__ __forceinline__ XcdBarrier xcd_barrier_post(unsigned* bar, volatile LAS unsigned* st) {
    XcdBarrier b; b.bar = bar; b.x = xb_xcc_id(); b.st = st;
    if (threadIdx.x == 0) (void)xb_add(&bar[XB_XCNT(b.x)], 1u);
    return b;
}
__device__ __forceinline__ void xcd_barrier_complete(unsigned* bar, unsigned x, unsigned& nloc, unsigned& nx) {
    const unsigned G = gridDim.x * gridDim.y * gridDim.z;
    unsigned sum, cnt, mine, sp = 0u;
    for (;;) {
        sum = 0u; cnt = 0u; mine = 0u;
#pragma unroll
        for (unsigned j = 0; j < 16; ++j) { const unsigned c = xb_ld(&bar[XB_XCNT(j)]); sum += c; cnt += (c > 0u) ? 1u : 0u; mine = (j == x) ? c : mine; }
        if (sum == G) break;
        __builtin_amdgcn_s_sleep(1);
        if ((++sp & 255u) == 0u) { if (xb_ld(&bar[XB_TMO])) break; if (sp > XB_SPIN_CAP) { atomicAdd(&bar[XB_TMO], 1u); break; } }
    }
    nloc = mine > 0u ? mine : 1u; nx = cnt > 0u ? cnt : 1u;
}
__device__ __forceinline__ void xcd_barrier(const XcdBarrier& b) {
    asm volatile("s_waitcnt vmcnt(0)" ::: "memory");
    __syncthreads();
    if (threadIdx.x == 0) {
        unsigned* bar = b.bar;
        __builtin_amdgcn_s_waitcnt(0);
        unsigned nloc = b.st[0], nx = b.st[1];
        if (nloc == 0u) { xcd_barrier_complete(bar, b.x, nloc, nx); b.st[0] = nloc; b.st[1] = nx; }
        const unsigned old = xb_add(&bar[XB_XSUB(b.x)], 1u);
        const unsigned gen = old / nloc;
        if (old + 1u == (gen + 1u) * nloc) {
            __builtin_amdgcn_fence(__ATOMIC_RELEASE, "agent");
            asm volatile("s_waitcnt vmcnt(0)" ::: "memory");
            const unsigned og = xb_add(&bar[XB_TOP], 1u);
            const unsigned tg = og / nx;
            if (og + 1u == (tg + 1u) * nx) xb_add(&bar[XB_TOPGEN], 1u);
            else XB_SPIN(xb_ld(&bar[XB_TOPGEN]) == tg, bar);
            __builtin_amdgcn_fence(__ATOMIC_ACQUIRE, "agent");
            xb_add(&bar[XB_XGEN(b.x)], 1u);
            asm volatile("s_waitcnt vmcnt(0)" ::: "memory");
        } else {
            XB_SPIN(xb_ld(&bar[XB_XGEN(b.x)]) == gen, bar);
            __builtin_amdgcn_fence(__ATOMIC_ACQUIRE, "agent");
            asm volatile("s_waitcnt vmcnt(0)" ::: "memory");
        }
    }
    __syncthreads();
}

__device__ __forceinline__ unsigned char* opq(unsigned char* p) { asm volatile("" : "+s"(p)); return p; }
#define WSP(T, off) ((T*)(opq(P.ws) + (off)))
#define XBAR() do { XcdBarrier _b; _b.bar = (unsigned*)(opq(P.ws) + WS_CTL); _b.x = (unsigned)__builtin_amdgcn_readfirstlane((int)xb_xcc_id()); _b.st = (volatile LAS unsigned*)(lds + 131072); xcd_barrier(_b); } while (0)
__global__ void __launch_bounds__(NTHREADS, 2) fwd_megakernel(Params P) {
    extern __shared__ __attribute__((aligned(16))) unsigned char lds_raw[];
    LAS unsigned char* lds = (LAS unsigned char*)lds_raw;
    cg::grid_group grid = cg::this_grid();
    const int G = ogrid(), bid = blockIdx.x;
    volatile LAS unsigned* xst = (volatile LAS unsigned*)(lds + 131072);
    if (threadIdx.x < 4) xst[threadIdx.x] = 0u;
    __syncthreads();
    (void)xcd_barrier_post((unsigned*)(P.ws + WS_CTL), xst);

    phase_prologue(P, lds);
    grid.sync();
    XBAR();

    for (int grp = 0; grp < NGROUPS; ++grp) {
        const float* xin = grp < 4 ? P.x_prompt + (size_t)grp * MG * D : P.x_sample;
        float* xo = P.out + (size_t)grp * MG * D;
        const int seqlen = grp < 4 ? 4096 : 16384;
        phase_init(xin, WSP(bf16_t, WS_XB), WSP(float, WS_ROWSS1), WSP(float, WS_ROWSS2));
        XBAR();
        for (int l = 0; l < DEPTH; ++l) {
            const size_t wl = WS_W + (size_t)l * W_LAYER;
            { pg8::Gemm g{WSP(bf16_t, WS_XB), WSP(const bf16_t, wl + W_IN_OFF), MG, NPROJ, D}; pg8::StaticOrder S; S.init(MG, NPROJ, G, bid);
              pg8::EpiRowScale E{WSP(bf16_t, WS_PROJ), NPROJ, WSP(float, WS_ROWSS1)}; pg8::gemm_phase(lds, g, S, E); }
            { pg8::Gemm g{WSP(const bf16_t, wl + W_IN_OFF + (size_t)NPROJ * D * 2), WSP(bf16_t, WS_XB), NPT, MG, D}; pg8::StaticOrder S; S.init(NPT, MG, G, bid);
              pg8::EpiColScale E{WSP(bf16_t, WS_PROJT), MG, WSP(float, WS_ROWSS1)}; pg8::gemm_phase(lds, g, S, E); }
            XBAR();
            { { const int tid = otid(), wv = __builtin_amdgcn_readfirstlane(tid >> 6), ln = tid & 63;
                for (int it = bid * 8 + wv; it < 2048; it += G * 8) na_item(WSP(bf16_t, WS_PROJ), WSP(bf16_t, WS_PROJT), WSP(bf16_t, WS_A), P.na_rel_bias + (size_t)l * 8 * 465, it, seqlen, lds, wv, ln);
                __syncthreads(); }
              for (int it = bid; it < 512; it += G) { const int h = it & 3;
                  const float* tab = WSP(const float, WS_LG2) + (l * 4 + h) * 2; const float lgf2 = tab[0], lgb2 = tab[1];
                  r1_item(WSP(bf16_t, WS_PROJT), WSP(float, WS_STLOC), WSP(float, WS_COST), WSP(float, WS_SINT), lgf2, lgb2, it, seqlen, lds); } }
            XBAR();
            phase_scan(WSP(float, WS_STLOC), WSP(bf16_t, WS_ST), P.dec_f + l * 4, P.dec_b + l * 4, seqlen);
            XBAR();
            for (int it = bid; it < 512; it += G) { const int h = it & 3;
                const float* tab = WSP(const float, WS_LG2) + (l * 4 + h) * 2; const float lgf2 = tab[0], lgb2 = tab[1];
                r3_item(WSP(bf16_t, WS_PROJ), WSP(bf16_t, WS_PROJT), WSP(bf16_t, WS_ST), WSP(bf16_t, WS_RO), WSP(float, WS_COSN), WSP(float, WS_SINN), P.ret_norm_g + (size_t)l * 1024, lgf2, lgb2, it, seqlen, lds); }
            XBAR();
            { pg8::Gemm g{WSP(bf16_t, WS_A), WSP(const bf16_t, wl + W_A_OFF), MG, D, 512}; pg8::StaticOrder S; S.init(MG, D, G, bid);
              pg8::EpiGate E{WSP(bf16_t, WS_PROJ) + 3072, nullptr, WSP(bf16_t, WS_TMP)}; pg8::gemm_phase(lds, g, S, E); }
            { pg8::Gemm g{WSP(bf16_t, WS_RO), WSP(const bf16_t, wl + W_R_OFF), MG, D, D}; pg8::StaticOrder S; S.init(MG, D, G, bid);
              pg8::EpiGate E{WSP(bf16_t, WS_PROJ) + 4096, WSP(bf16_t, WS_TMP), WSP(bf16_t, WS_MIXED)}; pg8::gemm_phase(lds, g, S, E); }
            XBAR();
            { pg8::Gemm g{WSP(bf16_t, WS_MIXED), WSP(const bf16_t, wl + W_O_OFF), MG, D, D}; pg8::StaticOrder S; S.init(MG, D, G, bid);
              pg8::EpiResid E{l == 0 ? xin : xo, xo, WSP(bf16_t, WS_XB), WSP(float, WS_ROWSS2)}; pg8::gemm_phase(lds, g, S, E); }
            XBAR();
            { pg8::Gemm g{WSP(bf16_t, WS_XB), WSP(const bf16_t, wl + W_UP_OFF), MG, DFF2, D}; pg8::StaticOrder S; S.init(MG, DFF2, G, bid);
              pg8::EpiRowScale E{WSP(bf16_t, WS_PROJ), DFF2, WSP(float, WS_ROWSS2)}; pg8::gemm_phase(lds, g, S, E); }
            XBAR();
            phase_convact(WSP(bf16_t, WS_PROJ), WSP(bf16_t, WS_STLOC), P.conv_w + (size_t)l * 3 * DFF2, seqlen, WSP(float, WS_ROWSS2));
            XBAR();
            { pg8::Gemm g{WSP(bf16_t, WS_STLOC), WSP(const bf16_t, wl + W_D_OFF), MG, D, DFF}; pg8::StaticOrder S; S.init(MG, D, G, bid);
              pg8::EpiResid E{xo, xo, WSP(bf16_t, WS_XB), WSP(float, WS_ROWSS1)}; pg8::gemm_phase(lds, g, S, E); }
            XBAR();
        }
        phase_final(xo, WSP(float, WS_ROWSS1), P.norm_final_g);
        XBAR();
    }
}

extern "C" void kernel_launch(void* const* d_in, const int* in_sizes, int n_in, void* d_out, int out_size, void* d_ws, size_t ws_size, hipStream_t stream) {
    static int grid_blocks = 0;
    if (grid_blocks == 0) {
        if (n_in != 16 || ws_size < WS_END) { fprintf(stderr, "kernel_launch: unexpected n_in %d or ws_size %zu (< %zu)\n", n_in, ws_size, (size_t)WS_END); grid_blocks = -1; return; }
        int dev = 0, cus = 0, per_cu = 0;
        hipGetDevice(&dev);
        hipDeviceGetAttribute(&cus, hipDeviceAttributeMultiprocessorCount, dev);
        if (hipFuncSetAttribute((const void*)fwd_megakernel, hipFuncAttributeMaxDynamicSharedMemorySize, LDS_BYTES) != hipSuccess) { fprintf(stderr, "kernel_launch: hipFuncSetAttribute failed\n"); grid_blocks = -1; return; }
        hipOccupancyMaxActiveBlocksPerMultiprocessor(&per_cu, (const void*)fwd_megakernel, NTHREADS, LDS_BYTES);
        if (per_cu < 1) { fprintf(stderr, "kernel_launch: occupancy query says %d blocks per CU\n", per_cu); per_cu = 1; }
        (void)hipGetLastError();
        grid_blocks = cus;
    }
    if (grid_blocks < 0) return;
    if (hipMemsetAsync((char*)d_ws + WS_CTL, 0, 16384, stream) != hipSuccess) { fprintf(stderr, "kernel_launch: memset of barrier words failed\n"); return; }
    Params p{};
    p.x_prompt = (const float*)d_in[0]; p.x_sample = (const float*)d_in[1]; p.norm_mix_g = (const float*)d_in[2]; p.w_in = (const float*)d_in[3]; p.na_rel_bias = (const float*)d_in[4];
    p.dec_f = (const float*)d_in[5]; p.dec_b = (const float*)d_in[6]; p.ret_norm_g = (const float*)d_in[7]; p.w_ba = (const float*)d_in[8]; p.w_br = (const float*)d_in[9]; p.w_out = (const float*)d_in[10];
    p.norm_ffn_g = (const float*)d_in[11]; p.w_up = (const float*)d_in[12]; p.conv_w = (const float*)d_in[13]; p.w_down = (const float*)d_in[14]; p.norm_final_g = (const float*)d_in[15];
    p.out = (float*)d_out; p.ws = (unsigned char*)d_ws;
    void* args[] = {&p};
    hipError_t e = hipLaunchCooperativeKernel((const void*)fwd_megakernel, dim3(grid_blocks), dim3(NTHREADS), args, LDS_BYTES, stream);
    if (e != hipSuccess) fprintf(stderr, "kernel_launch: cooperative launch failed: %s (grid %d)\n", hipGetErrorString(e), grid_blocks);
}
```

```cpp
#include <hip/hip_runtime.h>
#include <hip/hip_cooperative_groups.h>
#include <cstdio>
namespace cg = cooperative_groups;

#define LAS __attribute__((address_space(3)))
typedef unsigned short bf16_t;
typedef short bf16x8 __attribute__((ext_vector_type(8)));
typedef short bf16x4 __attribute__((ext_vector_type(4)));
typedef float f32x4 __attribute__((ext_vector_type(4)));
typedef float f32x16 __attribute__((ext_vector_type(16)));
typedef unsigned u32x4 __attribute__((ext_vector_type(4)));
typedef unsigned u32x2 __attribute__((ext_vector_type(2)));

constexpr int D = 1024, MG = 16384, NPROJ = 5120, NPT = 2048, DFF = 2816, DFF2 = 5632, DEPTH = 4, NGROUPS = 5, DIN = 6656;
constexpr float EPS = 1e-6f;
constexpr int NTHREADS = 512;
constexpr int LDS_RSTD_OFF = 131072 + 1024;
constexpr int LDS_BYTES = 131072 + 1024 + 8192;

constexpr size_t WS_CTL = 0;
constexpr size_t WS_LG2 = 32768;
constexpr size_t WS_ROWSS1 = 262144;
constexpr size_t WS_ROWSS2 = WS_ROWSS1 + (size_t)MG * 16 * 4;
constexpr size_t WS_COSN = WS_ROWSS2 + (size_t)MG * 16 * 4;
constexpr size_t TAB_BYTES = (size_t)16384 * 64 * 4;
constexpr size_t WS_SINN = WS_COSN + TAB_BYTES;
constexpr size_t WS_COST = WS_SINN + TAB_BYTES;
constexpr size_t WS_SINT = WS_COST + TAB_BYTES;
constexpr size_t WS_W = WS_SINT + TAB_BYTES;
constexpr size_t W_IN_OFF = 0;
constexpr size_t W_A_OFF = W_IN_OFF + (size_t)7168 * 1024 * 2;
constexpr size_t W_R_OFF = W_A_OFF + (size_t)1024 * 512 * 2;
constexpr size_t W_O_OFF = W_R_OFF + (size_t)1024 * 1024 * 2;
constexpr size_t W_UP_OFF = W_O_OFF + (size_t)1024 * 1024 * 2;
constexpr size_t W_D_OFF = W_UP_OFF + (size_t)5632 * 1024 * 2;
constexpr size_t W_LAYER = W_D_OFF + (size_t)1024 * 2816 * 2;
constexpr size_t WS_XB = WS_W + W_LAYER * DEPTH;
constexpr size_t WS_PROJ = WS_XB + (size_t)MG * D * 2;
constexpr size_t WS_PROJT = WS_PROJ + (size_t)MG * NPROJ * 2;
constexpr size_t WS_A = WS_PROJT + (size_t)NPT * MG * 2;
constexpr size_t WS_RO = WS_A + (size_t)MG * 512 * 2;
constexpr size_t WS_TMP = WS_RO + (size_t)MG * D * 2;
constexpr size_t WS_MIXED = WS_TMP + (size_t)MG * D * 2;
constexpr size_t WS_STLOC = WS_MIXED + (size_t)MG * D * 2;
constexpr size_t WS_ST = WS_STLOC + (size_t)128 * 4 * 2 * 32768 * 4;
constexpr size_t WS_END = WS_ST + (size_t)128 * 4 * 2 * 32768 * 2;
static_assert((size_t)MG * DFF2 * 2 <= (size_t)MG * NPROJ * 2 + (size_t)NPT * MG * 2, "u must fit over proj+projT");
static_assert((size_t)MG * DFF * 2 <= (size_t)128 * 4 * 2 * 32768 * 4, "act must fit over STloc");
static_assert(WS_END <= ((size_t)1 << 30), "workspace over 1 GiB");

struct Params {
    const float* x_prompt; const float* x_sample; const float* norm_mix_g; const float* w_in; const float* na_rel_bias;
    const float* dec_f; const float* dec_b; const float* ret_norm_g; const float* w_ba; const float* w_br; const float* w_out;
    const float* norm_ffn_g; const float* w_up; const float* conv_w; const float* w_down; const float* norm_final_g;
    float* out; unsigned char* ws;
};

typedef __bf16 bf16v2_t __attribute__((ext_vector_type(2)));
typedef float f32v2_t __attribute__((ext_vector_type(2)));
__device__ __forceinline__ unsigned cvt_pk_bf16(float lo, float hi) { const f32v2_t v = {lo, hi}; const bf16v2_t r = __builtin_convertvector(v, bf16v2_t); return __builtin_bit_cast(unsigned, r); }
__device__ __forceinline__ float bf_lo(unsigned w) { return __uint_as_float(w << 16); }
__device__ __forceinline__ float bf_hi(unsigned w) { return __uint_as_float(w & 0xffff0000u); }
__device__ __forceinline__ float bf2f(bf16_t b) { return __uint_as_float(((unsigned)b) << 16); }
__device__ __forceinline__ float sigmoidf_(float x) { return 1.0f / (1.0f + __expf(-x)); }
__device__ __forceinline__ void unpack8(const u32x4 w, float* f) { f[0] = bf_lo(w.x); f[1] = bf_hi(w.x); f[2] = bf_lo(w.y); f[3] = bf_hi(w.y); f[4] = bf_lo(w.z); f[5] = bf_hi(w.z); f[6] = bf_lo(w.w); f[7] = bf_hi(w.w); }
__device__ __forceinline__ u32x4 pack8(const float* f) { u32x4 w; w.x = cvt_pk_bf16(f[0], f[1]); w.y = cvt_pk_bf16(f[2], f[3]); w.z = cvt_pk_bf16(f[4], f[5]); w.w = cvt_pk_bf16(f[6], f[7]); return w; }
__device__ __forceinline__ f32x16 mfma32(bf16x8 a, bf16x8 b, f32x16 c) { return __builtin_amdgcn_mfma_f32_32x32x16_bf16(a, b, c, 0, 0, 0); }
__device__ __forceinline__ int otid() { int t = threadIdx.x; asm volatile("" : "+v"(t)); return t; }
__device__ __forceinline__ int ogrid() { int g = gridDim.x; asm volatile("" : "+s"(g)); return g; }
__device__ __forceinline__ f32x16 zero16() { return (f32x16){0.f, 0.f, 0.f, 0.f, 0.f, 0.f, 0.f, 0.f, 0.f, 0.f, 0.f, 0.f, 0.f, 0.f, 0.f, 0.f}; }
__device__ __forceinline__ float sum16(const float* p) { const f32x4 a = *(const f32x4*)p, b = *(const f32x4*)(p + 4), c = *(const f32x4*)(p + 8), d = *(const f32x4*)(p + 12); const f32x4 t = (a + b) + (c + d); return (t[0] + t[1]) + (t[2] + t[3]); }
__device__ __forceinline__ float shx(float v, int m, int lane) { return __int_as_float(__builtin_amdgcn_ds_bpermute((lane ^ m) << 2, __float_as_int(v))); }
__device__ __forceinline__ float wave_sum(float v, int lane) { v += shx(v, 32, lane); v += shx(v, 16, lane); v += shx(v, 8, lane); v += shx(v, 4, lane); v += shx(v, 2, lane); v += shx(v, 1, lane); return v; }

namespace pg8 {
constexpr int BM = 256, BK = 64, HALF = 128, HTB = HALF * BK * 2, STAGE_BYTES = 8 * HTB, NXCD = 8, WGM = 8;
__host__ __device__ __forceinline__ int lds_byte(int r, int c) { const int st = (r >> 4) * 2 + (c >> 5), rr = r & 15, cc = c & 31, ob = rr * 64 + cc * 2; return st * 1024 + (ob ^ (((ob >> 9) & 1) << 5)); }
__host__ __device__ __forceinline__ void stage_rc(int b, int& R, int& C) { const int st = b / 1024, sb = b % 1024, swz = sb ^ (((sb >> 9) & 1) << 5); R = (st >> 1) * 16 + swz / 64; C = (st & 1) * 32 + (swz % 64) / 2; }
__host__ __device__ __forceinline__ int perm32(int rho) { const int n = rho >> 4, i = rho & 15; return 8 * (i >> 2) + 4 * n + (i & 3); }
struct Unit { int pm, pn, idx; };
struct Gemm { const bf16_t* A; const bf16_t* Bt; int M, N, K; };
struct StaticOrder {
    int nM, nN, nwg, G, c;
    __host__ __device__ void init(int M, int N, int G_, int c_) { nM = M / BM; nN = N / BM; nwg = nM * nN; G = G_; c = c_; }
    __host__ __device__ bool next(int i, Unit& u) const {
        const long L = (long)i * G + c; if (L >= nwg) return false;
        int wgid = (int)L; { const int q = nwg / NXCD, r = nwg % NXCD, xcd = wgid % NXCD, off = wgid / NXCD; wgid = (xcd < r ? xcd * (q + 1) : r * (q + 1) + (xcd - r) * q) + off; }
        const int nig = WGM * nN, gid = wgid / nig, fm = gid * WGM, gsz = (nM - fm) < WGM ? (nM - fm) : WGM;
        u.pm = fm + ((wgid % nig) % gsz); u.pn = (wgid % nig) / gsz; return true;
    }
    __device__ __forceinline__ void a_ready(const Unit&) const {}
    __device__ __forceinline__ void done(const Unit&) const {}
};

template <class Epi, class Sched>
__device__ __forceinline__ void gemm_phase(LAS unsigned char* lds, const Gemm g, const Sched& S, const Epi& E) {
    const int tid = otid(), wid = __builtin_amdgcn_readfirstlane(tid >> 6), lane = tid & 63, wr = wid >> 2, wc = wid & 3, fr = lane & 15, fq = lane >> 4;
    const int K = g.K, nt = K / BK;
    unsigned voffA[2], voffB[2];
#pragma unroll
    for (int i = 0; i < 2; ++i) { int R, C; stage_rc(tid * 16 + i * 8192, R, C); const int Rb = Epi::PERM ? ((R & ~31) + perm32(R & 31)) : R;
        voffA[i] = (unsigned)(R * K + C) * 2u; voffB[i] = (unsigned)(Rb * K + C) * 2u; }
    const size_t kstep = (size_t)(BK * 2);
    const size_t hstep = (size_t)HALF * K * 2;
    const size_t tstep = 2 * hstep;
    const unsigned ldsw = (unsigned)wid * 1024u;
    const int aoff = lds_byte(wr * 64 + fr, fq * 8), boff = lds_byte(wc * 32 + fr, fq * 8);
#define PG8_SA(b, h) (((b) * 2 + (h)) * HTB)
#define PG8_SB(b, h) ((4 + (b) * 2 + (h)) * HTB)
#define PG8_STAGE(bufoff, gbase, voff) do { _Pragma("unroll") for (int _i = 0; _i < 2; ++_i) \
        __builtin_amdgcn_global_load_lds((const unsigned*)((const char*)(gbase) + (voff)[_i]), (LAS unsigned*)(lds + (bufoff) + ldsw + _i * 8192), 16, 0, 0); } while (0)
#define PG8_LDA(dst, b, h) do { _Pragma("unroll") for (int m = 0; m < 4; ++m) _Pragma("unroll") for (int k = 0; k < 2; ++k) dst[m][k] = *(const LAS bf16x8*)(lds + PG8_SA(b, h) + aoff + m * 2048 + k * 1024); } while (0)
#define PG8_LDB(dst, b, h) do { _Pragma("unroll") for (int n = 0; n < 2; ++n) _Pragma("unroll") for (int k = 0; k < 2; ++k) dst[n][k] = *(const LAS bf16x8*)(lds + PG8_SB(b, h) + boff + n * 2048 + k * 1024); } while (0)
#define PG8_MMA(ai, bj, At, Bt) do { __builtin_amdgcn_s_setprio(1); _Pragma("unroll") for (int m = 0; m < 4; ++m) _Pragma("unroll") for (int n = 0; n < 2; ++n) _Pragma("unroll") for (int k = 0; k < 2; ++k) \
        acc[ai][bj][m][n] = __builtin_amdgcn_mfma_f32_16x16x32_bf16(Bt[n][k], At[m][k], acc[ai][bj][m][n], 0, 0, 0); __builtin_amdgcn_s_setprio(0); } while (0)
#define PG8_WAIT_V(n) asm volatile("s_waitcnt vmcnt(" #n ")" ::: "memory")
#define PG8_WAIT_L(n) asm volatile("s_waitcnt lgkmcnt(" #n ")" ::: "memory")
#define PG8_BAR __builtin_amdgcn_s_barrier()
#define PG8_SCHED __builtin_amdgcn_sched_barrier(0)
    Unit cur, nxt; int ui = 0;
    if (!S.next(0, cur)) return;
    cur.idx = 0;
    f32x4 acc[2][2][4][2];
#pragma unroll
    for (int a = 0; a < 2; ++a)
#pragma unroll
        for (int b = 0; b < 2; ++b)
#pragma unroll
            for (int m = 0; m < 4; ++m)
#pragma unroll
                for (int n = 0; n < 2; ++n) acc[a][b][m][n] = (f32x4){0.f, 0.f, 0.f, 0.f};
    bf16x8 At[4][2], B0[2][2], B1[2][2];
    const char* cA = (const char*)g.A + (size_t)cur.pm * tstep; const char* cB = (const char*)g.Bt + (size_t)cur.pn * tstep;
    S.a_ready(cur);
    PG8_STAGE(PG8_SB(0, 0), cB, voffB); PG8_STAGE(PG8_SA(0, 0), cA, voffA); PG8_STAGE(PG8_SB(0, 1), cB + hstep, voffB); PG8_STAGE(PG8_SA(0, 1), cA + hstep, voffA);
    if (wr == 1) PG8_BAR;
    PG8_WAIT_V(4); PG8_BAR;
    PG8_STAGE(PG8_SB(1, 0), cB + kstep, voffB); PG8_STAGE(PG8_SA(1, 0), cA + kstep, voffA); PG8_STAGE(PG8_SB(1, 1), cB + hstep + kstep, voffB);
    PG8_WAIT_V(6); PG8_BAR;
    for (;;) {
        const bool has_next = S.next(ui + 1, nxt); nxt.idx = ui + 1;
        const char* nA = has_next ? (const char*)g.A + (size_t)nxt.pm * tstep : cA; const char* nB = has_next ? (const char*)g.Bt + (size_t)nxt.pn * tstep : cB;
        for (int t = 0; t < nt; t += 2) {
            const bool last = (t == nt - 2);
            const char* a1 = cA + (size_t)(t + 1) * kstep;
            const char* a2 = last ? nA : cA + (size_t)(t + 2) * kstep; const char* b2 = last ? nB : cB + (size_t)(t + 2) * kstep;
            const char* a3 = a2 + kstep; const char* b3 = b2 + kstep;
            if (last && has_next) S.a_ready(nxt);
            PG8_LDB(B0, 0, 0); PG8_SCHED; PG8_LDA(At, 0, 0); PG8_STAGE(PG8_SA(1, 1), a1 + hstep, voffA);
            PG8_WAIT_L(8); PG8_BAR; PG8_WAIT_L(0); PG8_MMA(0, 0, At, B0); PG8_BAR; PG8_SCHED;
            PG8_LDB(B1, 0, 1); PG8_STAGE(PG8_SB(0, 0), b2, voffB);
            PG8_BAR; PG8_WAIT_L(0); PG8_MMA(0, 1, At, B1); PG8_BAR;
            PG8_LDA(At, 0, 1); PG8_STAGE(PG8_SA(0, 0), a2, voffA);
            PG8_BAR; PG8_WAIT_L(0); PG8_MMA(1, 0, At, B0); PG8_BAR; PG8_SCHED;
            PG8_STAGE(PG8_SB(0, 1), b2 + hstep, voffB);
            PG8_WAIT_V(6); PG8_BAR; PG8_MMA(1, 1, At, B1); PG8_BAR;
            PG8_LDB(B0, 1, 0); PG8_SCHED; PG8_LDA(At, 1, 0); PG8_STAGE(PG8_SA(0, 1), a2 + hstep, voffA);
            PG8_WAIT_L(8); PG8_BAR; PG8_WAIT_L(0); PG8_MMA(0, 0, At, B0); PG8_BAR; PG8_SCHED;
            PG8_LDB(B1, 1, 1); PG8_STAGE(PG8_SB(1, 0), b3, voffB);
            PG8_BAR; PG8_WAIT_L(0); PG8_MMA(0, 1, At, B1); PG8_BAR;
            PG8_LDA(At, 1, 1); PG8_STAGE(PG8_SA(1, 0), a3, voffA);
            PG8_BAR; PG8_WAIT_L(0); PG8_MMA(1, 0, At, B0); PG8_BAR; PG8_SCHED;
            PG8_STAGE(PG8_SB(1, 1), b3 + hstep, voffB);
            PG8_WAIT_V(6); PG8_BAR; PG8_MMA(1, 1, At, B1); PG8_BAR;
        }
        E(acc, cur, wr, wc, fr, fq); S.done(cur);
        if (!has_next) break;
#pragma unroll
        for (int a = 0; a < 2; ++a)
#pragma unroll
            for (int b = 0; b < 2; ++b)
#pragma unroll
                for (int m = 0; m < 4; ++m)
#pragma unroll
                    for (int n = 0; n < 2; ++n) acc[a][b][m][n] = (f32x4){0.f, 0.f, 0.f, 0.f};
        cur = nxt; cA = nA; cB = nB; ++ui;
    }
    PG8_WAIT_V(0);
    if (wr == 0) PG8_BAR;
    PG8_BAR;
#undef PG8_SA
#undef PG8_SB
#undef PG8_STAGE
#undef PG8_LDA
#undef PG8_LDB
#undef PG8_MMA
#undef PG8_WAIT_V
#undef PG8_WAIT_L
#undef PG8_BAR
#undef PG8_SCHED
}

struct EpiRowScale {
    static constexpr bool PERM = true;
    bf16_t* O; int ldc; const LAS float* rl;
    __device__ __forceinline__ void operator()(const f32x4 (&acc)[2][2][4][2], const Unit& u, int wr, int wc, int fr, int fq) const {
        const int row0 = u.pm * BM + wr * 64 + fr, col0 = u.pn * BM + wc * 32 + 8 * fq;
#pragma unroll
        for (int ai = 0; ai < 2; ++ai)
#pragma unroll
            for (int m = 0; m < 4; ++m) { const int row = row0 + ai * HALF + m * 16; const float rs = rl[u.idx * 256 + wr * 64 + fr + ai * HALF + m * 16];
                bf16_t* rowp = O + (size_t)row * ldc + col0;
#pragma unroll
                for (int bj = 0; bj < 2; ++bj) { const f32x4 v0 = acc[ai][bj][m][0] * rs, v1 = acc[ai][bj][m][1] * rs;
                    u32x4 w; w.x = cvt_pk_bf16(v0[0], v0[1]); w.y = cvt_pk_bf16(v0[2], v0[3]); w.z = cvt_pk_bf16(v1[0], v1[1]); w.w = cvt_pk_bf16(v1[2], v1[3]);
                    *(u32x4*)(rowp + bj * HALF) = w; } }
    }
};
struct EpiColScale {
    static constexpr bool PERM = true;
    bf16_t* O; int ldc; const LAS float* rl;
    __device__ __forceinline__ void operator()(const f32x4 (&acc)[2][2][4][2], const Unit& u, int wr, int wc, int fr, int fq) const {
        const int row0 = u.pm * BM + wr * 64 + fr, col0 = u.pn * BM + wc * 32 + 8 * fq;
        f32x4 sc[2][2];
#pragma unroll
        for (int bj = 0; bj < 2; ++bj)
#pragma unroll
            for (int n = 0; n < 2; ++n) sc[bj][n] = *(const LAS f32x4*)(rl + u.idx * 256 + wc * 32 + 8 * fq + bj * HALF + 4 * n);
#pragma unroll
        for (int ai = 0; ai < 2; ++ai)
#pragma unroll
            for (int m = 0; m < 4; ++m) { const int row = row0 + ai * HALF + m * 16; bf16_t* rowp = O + (size_t)row * ldc + col0;
#pragma unroll
                for (int bj = 0; bj < 2; ++bj) { const f32x4 v0 = acc[ai][bj][m][0] * sc[bj][0], v1 = acc[ai][bj][m][1] * sc[bj][1];
                    u32x4 w; w.x = cvt_pk_bf16(v0[0], v0[1]); w.y = cvt_pk_bf16(v0[2], v0[3]); w.z = cvt_pk_bf16(v1[0], v1[1]); w.w = cvt_pk_bf16(v1[2], v1[3]);
                    *(u32x4*)(rowp + bj * HALF) = w; } }
    }
};
struct EpiGate {
    static constexpr bool PERM = true;
    const bf16_t* gate; const bf16_t* addsrc; bf16_t* O;
    __device__ __forceinline__ void operator()(const f32x4 (&acc)[2][2][4][2], const Unit& u, int wr, int wc, int fr, int fq) const {
        const int row0 = u.pm * BM + wr * 64 + fr, col0 = u.pn * BM + wc * 32 + 8 * fq;
#pragma unroll
        for (int ai = 0; ai < 2; ++ai)
#pragma unroll
            for (int m = 0; m < 4; ++m) { const int row = row0 + ai * HALF + m * 16;
#pragma unroll
                for (int bj = 0; bj < 2; ++bj) { const int col = col0 + bj * HALF;
                    float gf[8], r[8]; unpack8(*(const u32x4*)(gate + (size_t)row * NPROJ + col), gf);
                    const f32x4 v0 = acc[ai][bj][m][0], v1 = acc[ai][bj][m][1];
#pragma unroll
                    for (int j = 0; j < 4; ++j) { r[j] = v0[j] * sigmoidf_(gf[j]); r[4 + j] = v1[j] * sigmoidf_(gf[4 + j]); }
                    if (addsrc) { float af[8]; unpack8(*(const u32x4*)(addsrc + (size_t)row * D + col), af);
#pragma unroll
                        for (int j = 0; j < 8; ++j) r[j] += af[j]; }
                    *(u32x4*)(O + (size_t)row * D + col) = pack8(r); } }
    }
};
struct EpiResid {
    static constexpr bool PERM = true;
    bf16_t* xb; float* rowss;
    __device__ __forceinline__ void operator()(const f32x4 (&acc)[2][2][4][2], const Unit& u, int wr, int wc, int fr, int fq) const {
        const int row0 = u.pm * BM + wr * 64 + fr, col0 = u.pn * BM + wc * 32 + 8 * fq;
#pragma unroll
        for (int ai = 0; ai < 2; ++ai)
#pragma unroll
            for (int m = 0; m < 4; ++m) { const int row = row0 + ai * HALF + m * 16; float ss = 0.f;
#pragma unroll
                for (int bj = 0; bj < 2; ++bj) { const size_t off = (size_t)row * D + col0 + bj * HALF;
                    float b[8], r[8]; unpack8(*(const u32x4*)(xb + off), b);
                    const f32x4 v0 = acc[ai][bj][m][0], v1 = acc[ai][bj][m][1];
#pragma unroll
                    for (int j = 0; j < 4; ++j) { b[j] += v0[j]; b[4 + j] += v1[j]; }
                    const u32x4 w = pack8(b);
                    *(u32x4*)(xb + off) = w;
                    unpack8(w, r);
#pragma unroll
                    for (int j = 0; j < 8; ++j) ss += r[j] * r[j]; }
                { const int ln = fr + 16 * fq; ss += shx(ss, 16, ln); ss += shx(ss, 32, ln); }
                if (fq == 0) rowss[(size_t)row * 16 + u.pn * 4 + wc] = ss; }
    }
};
}

template <class Sched> __device__ __forceinline__ void fill_rstd(LAS float* rl, const float* rowss, const Sched& S, bool by_col) {
    const int tid = otid();
    for (int e = tid; e < 8 * 256; e += NTHREADS) { pg8::Unit u; const int i = e >> 8;
        if (S.next(i, u)) { const int r = (by_col ? u.pn : u.pm) * 256 + (e & 255); rl[e] = rsqrtf(sum16(rowss + (size_t)r * 16) * (1.0f / 1024.0f) + EPS); } }
    __syncthreads();
}

__device__ __forceinline__ int win_srccol(int nd) {
    if (nd < 1024) return nd;
    if (nd < 1536) return 1536 + (nd - 1024);
    if (nd < 2048) return 2048 + (nd - 1536);
    if (nd < 3072) return 3584 + (nd - 2048);
    if (nd < 4096) return 4608 + (nd - 3072);
    if (nd < 5120) return 5632 + (nd - 4096);
    nd -= 5120;
    if (nd < 512) return 1024 + nd;
    if (nd < 1024) return 2048 + (nd - 512);
    return 2560 + (nd - 1024);
}
__device__ __forceinline__ void conv_tile(const float* __restrict__ src, int ld_src, int k0, int nsrc0, bf16_t* dst, int ldd, int ndst0, const float* gsc, LAS float* tile) {
    const int t = otid();
#pragma unroll
    for (int i = 0; i < 2; ++i) { const int r = (t >> 4) + 32 * i, c = (t & 15) * 4;
        const float4 v = *(const float4*)(src + (size_t)(k0 + r) * ld_src + nsrc0 + c);
        const float s = gsc ? gsc[k0 + r] : 1.0f;
        tile[r * 65 + c] = v.x * s; tile[r * 65 + c + 1] = v.y * s; tile[r * 65 + c + 2] = v.z * s; tile[r * 65 + c + 3] = v.w * s; }
    __syncthreads();
    { const int n = t >> 3, k8 = (t & 7) * 8; float f[8];
#pragma unroll
      for (int j = 0; j < 8; ++j) f[j] = tile[(k8 + j) * 65 + n];
      *(u32x4*)(dst + (size_t)(ndst0 + n) * ldd + k0 + k8) = pack8(f); }
    __syncthreads();
}
__device__ __forceinline__ void phase_prologue(const Params& P, LAS unsigned char* lds) {
    LAS float* tile = (LAS float*)lds;
    constexpr int T_IN = 16 * 112, T_A = 8 * 16, T_R = 16 * 16, T_O = 16 * 16, T_UP = 16 * 88, T_D = 44 * 16, T_L = T_IN + T_A + T_R + T_O + T_UP + T_D;
    for (int job = blockIdx.x; job < T_L * DEPTH; job += ogrid()) {
        const int l = job / T_L; int r = job % T_L;
        unsigned char* wl = P.ws + WS_W + (size_t)l * W_LAYER;
        if (r < T_IN) { const int kt = r / 112, ntile = r % 112; conv_tile(P.w_in + (size_t)l * D * DIN, DIN, kt * 64, win_srccol(ntile * 64), (bf16_t*)(wl + W_IN_OFF), 1024, ntile * 64, P.norm_mix_g + l * D, tile); continue; }
        r -= T_IN;
        if (r < T_A) { const int kt = r / 16, ntile = r % 16; conv_tile(P.w_ba + (size_t)l * 512 * D, D, kt * 64, ntile * 64, (bf16_t*)(wl + W_A_OFF), 512, ntile * 64, nullptr, tile); continue; }
        r -= T_A;
        if (r < T_R) { const int kt = r / 16, ntile = r % 16; conv_tile(P.w_br + (size_t)l * D * D, D, kt * 64, ntile * 64, (bf16_t*)(wl + W_R_OFF), 1024, ntile * 64, nullptr, tile); continue; }
        r -= T_R;
        if (r < T_O) { const int kt = r / 16, ntile = r % 16; conv_tile(P.w_out + (size_t)l * D * D, D, kt * 64, ntile * 64, (bf16_t*)(wl + W_O_OFF), 1024, ntile * 64, nullptr, tile); continue; }
        r -= T_O;
        if (r < T_UP) { const int kt = r / 88, ntile = r % 88; conv_tile(P.w_up + (size_t)l * D * DFF2, DFF2, kt * 64, ntile * 64, (bf16_t*)(wl + W_UP_OFF), 1024, ntile * 64, P.norm_ffn_g + l * D, tile); continue; }
        r -= T_UP;
        { const int kt = r / 16, ntile = r % 16; conv_tile(P.w_down + (size_t)l * DFF * D, D, kt * 64, ntile * 64, (bf16_t*)(wl + W_D_OFF), DFF, ntile * 64, nullptr, tile); }
    }
    if (blockIdx.x == 0 && otid() < DEPTH * 4) { const int i = otid(); float* tab = (float*)(P.ws + WS_LG2);
        tab[2 * i] = -log1pf(expf(-P.dec_f[i])) * 1.4426950408889634f; tab[2 * i + 1] = -log1pf(expf(-P.dec_b[i])) * 1.4426950408889634f; }
    float* cosN = (float*)(P.ws + WS_COSN); float* sinN = (float*)(P.ws + WS_SINN); float* cosT = (float*)(P.ws + WS_COST); float* sinT = (float*)(P.ws + WS_SINT);
    for (int idx = blockIdx.x * NTHREADS + otid(); idx < 16384 * 64; idx += ogrid() * NTHREADS) {
        const int pos = idx >> 6, i = idx & 63;
        const float invf = powf(10000.0f, -(float)i / 64.0f);
        const float ang = (float)pos * invf;
        const float c = cosf(ang), s = sinf(ang);
        cosN[idx] = c; sinN[idx] = s; cosT[(size_t)i * 16384 + pos] = c; sinT[(size_t)i * 16384 + pos] = s;
    }
}

__device__ __forceinline__ void phase_init(const float* __restrict__ xin, bf16_t* xb, float* rowss1, float* rowss2) {
    const int tid = otid(), lane = tid & 63, nw = ogrid() * 8;
    for (int row = blockIdx.x * 8 + (tid >> 6); row < MG; row += nw) {
        const float4* p = (const float4*)(xin + (size_t)row * D); float ss = 0.f;
#pragma unroll
        for (int i = 0; i < 4; ++i) { const float4 v = p[lane + 64 * i];
            u32x2 w; w.x = cvt_pk_bf16(v.x, v.y); w.y = cvt_pk_bf16(v.z, v.w); *(u32x2*)(xb + (size_t)row * D + (lane + 64 * i) * 4) = w;
            const float a0 = bf_lo(w.x), a1 = bf_hi(w.x), a2 = bf_lo(w.y), a3 = bf_hi(w.y); ss += a0 * a0 + a1 * a1 + a2 * a2 + a3 * a3; }
        ss = wave_sum(ss, lane);
        if (lane < 16) rowss1[(size_t)row * 16 + lane] = lane == 0 ? ss : 0.f;
    }
}
__device__ __forceinline__ void phase_final(const bf16_t* __restrict__ xb, float* xo, const float* rowss1, const float* __restrict__ gfin) {
    const int tid = otid(), lane = tid & 63, nw = ogrid() * 8;
    for (int row = blockIdx.x * 8 + (tid >> 6); row < MG; row += nw) {
        const float rs = rsqrtf(sum16(rowss1 + (size_t)row * 16) * (1.0f / 1024.0f) + EPS);
#pragma unroll
        for (int i = 0; i < 2; ++i) { const int c8 = (lane + 64 * i) * 8; float x[8]; unpack8(*(const u32x4*)(xb + (size_t)row * D + c8), x);
            const f32x4 g0 = *(const f32x4*)(gfin + c8), g1 = *(const f32x4*)(gfin + c8 + 4);
            *(f32x4*)(xo + (size_t)row * D + c8) = (f32x4){x[0] * rs * g0[0], x[1] * rs * g0[1], x[2] * rs * g0[2], x[3] * rs * g0[3]};
            *(f32x4*)(xo + (size_t)row * D + c8 + 4) = (f32x4){x[4] * rs * g1[0], x[5] * rs * g1[1], x[6] * rs * g1[2], x[7] * rs * g1[3]}; }
    }
}
__device__ __forceinline__ float gelu_tanh(float x) { const float y = 1.5957691216057308f * (x + 0.044715f * x * x * x); return x / (1.0f + __expf(-y)); }
__device__ __forceinline__ void phase_convact(const bf16_t* __restrict__ u, bf16_t* act, const float* __restrict__ cw  , int seqlen, float* rowss2) {
    const int gt = blockIdx.x * NTHREADS + otid(), nth = ogrid() * NTHREADS;
    for (int id = gt; id < 2048 * 352; id += nth) {
        const int tb = id / 352, c = (id % 352) * 8, t0 = tb * 8;
        const u32x4 z = (u32x4){0u, 0u, 0u, 0u};
        u32x4 g[10], v[10];
        const bool has_prev = (t0 % seqlen) != 0, has_next = ((t0 + 8) % seqlen) != 0;
#pragma unroll
        for (int r = 0; r < 10; ++r) { const bool ok = (r == 0) ? has_prev : ((r == 9) ? has_next : true);
            g[r] = z; v[r] = z;
            if (ok) { g[r] = *(const u32x4*)(u + (size_t)(t0 - 1 + r) * DFF2 + c); v[r] = *(const u32x4*)(u + (size_t)(t0 - 1 + r) * DFF2 + DFF + c); } }
        float wg[3][8], wv[3][8];
#pragma unroll
        for (int k = 0; k < 3; ++k) {
            const f32x4 a0 = *(const f32x4*)(cw + k * DFF2 + c), a1 = *(const f32x4*)(cw + k * DFF2 + c + 4);
            const f32x4 b0 = *(const f32x4*)(cw + k * DFF2 + DFF + c), b1 = *(const f32x4*)(cw + k * DFF2 + DFF + c + 4);
#pragma unroll
            for (int j = 0; j < 4; ++j) { wg[k][j] = a0[j]; wg[k][4 + j] = a1[j]; wv[k][j] = b0[j]; wv[k][4 + j] = b1[j]; } }
#pragma unroll
        for (int i = 0; i < 8; ++i) {
            float a[8], b[8], cc[8], r[8], gg[8], vv[8];
            unpack8(g[i], a); unpack8(g[i + 1], b); unpack8(g[i + 2], cc);
#pragma unroll
            for (int j = 0; j < 8; ++j) gg[j] = a[j] * wg[0][j] + b[j] * wg[1][j] + cc[j] * wg[2][j];
            unpack8(v[i], a); unpack8(v[i + 1], b); unpack8(v[i + 2], cc);
#pragma unroll
            for (int j = 0; j < 8; ++j) vv[j] = a[j] * wv[0][j] + b[j] * wv[1][j] + cc[j] * wv[2][j];
#pragma unroll
            for (int j = 0; j < 8; ++j) r[j] = gelu_tanh(gg[j]) * vv[j];
            *(u32x4*)(act + (size_t)(t0 + i) * DFF + c) = pack8(r);
        }
    }
}

constexpr int NA_LDS_WAVE = 12288;
struct NaFrags { bf16x8 k[4]; u32x2 v[2][2][2]; };
__device__ __forceinline__ void na_load(NaFrags& f, const bf16_t* __restrict__ proj, const bf16_t* __restrict__ projT, int ktok, int h, int c, int hh) {
    const bf16_t* kp = proj + (size_t)(ktok + c) * NPROJ + 512 + h * 64 + 8 * hh;
#pragma unroll
    for (int s = 0; s < 4; ++s) f.k[s] = *(const bf16x8*)(kp + 16 * s);
#pragma unroll
    for (int dt = 0; dt < 2; ++dt)
#pragma unroll
        for (int s2 = 0; s2 < 2; ++s2) { const bf16_t* vp = projT + (size_t)(h * 64 + dt * 32 + c) * MG + (ktok + 16 * s2 + 4 * hh);
            f.v[dt][s2][0] = *(const u32x2*)vp; f.v[dt][s2][1] = *(const u32x2*)(vp + 8); }
}
__device__ __forceinline__ void na_item(const bf16_t* __restrict__ proj, const bf16_t* __restrict__ projT, bf16_t* aout, const float* __restrict__ relb  , int item, int seqlen, LAS unsigned char* lds, int w, int lane) {
    const int c = lane & 31, hh = lane >> 5;
    const int R = item >> 3, h = item & 7;
    const int rps = seqlen >> 6, seq = R / rps, r = R % rps;
    int rs = r - 4; rs = rs < 0 ? 0 : rs; rs = rs > rps - 8 ? rps - 8 : rs;
    const int qtok0 = seq * seqlen + r * 64, ktok0 = seq * seqlen + rs * 64;
    LAS float* bias = (LAS float*)(lds + w * NA_LDS_WAVE);
    LAS bf16_t* Otile = (LAS bf16_t*)(lds + w * NA_LDS_WAVE + 2048);
    for (int i = lane; i < 465; i += 64) bias[i] = relb[h * 465 + i];
    bf16x8 qf[2][4];
#pragma unroll
    for (int qh = 0; qh < 2; ++qh) { const bf16_t* qp = proj + (size_t)(qtok0 + 32 * qh + c) * NPROJ + h * 64 + 8 * hh;
#pragma unroll
        for (int s = 0; s < 4; ++s) qf[qh][s] = *(const bf16x8*)(qp + 16 * s); }
    f32x16 O[2][2];
    float mrun[2], lrun[2]; int cs[2];
#pragma unroll
    for (int qh = 0; qh < 2; ++qh) { O[qh][0] = zero16(); O[qh][1] = zero16(); mrun[qh] = -1e30f; lrun[qh] = 0.f;
        int x = 32 * qh + c - 8; x = x < 0 ? 0 : x; x = x > 48 ? 48 : x; cs[qh] = x; }
    NaFrags cur, nxt;
    na_load(cur, proj, projT, ktok0, h, c, hh);
#pragma unroll 1
    for (int t = 0; t < 16; ++t) {
        if (t + 1 < 16) na_load(nxt, proj, projT, ktok0 + 32 * (t + 1), h, c, hh);
        const int kr = rs + (t >> 1), chalf = t & 1, brow = (kr - r + 7) * 31;
#pragma unroll
        for (int qh = 0; qh < 2; ++qh) {
            f32x16 x = zero16();
#pragma unroll
            for (int s = 0; s < 4; ++s) x = mfma32(cur.k[s], qf[qh][s], x);
            const int qc = 32 * qh + c; float mt = -1e30f;
#pragma unroll
            for (int rg = 0; rg < 16; ++rg) { const int kc = 32 * chalf + (rg & 3) + 8 * (rg >> 2) + 4 * hh;
                const bool valid = (kc >= cs[qh]) && (kc < cs[qh] + 16);
                float sv = -1e30f;
                if (valid) sv = x[rg] * 0.125f + bias[brow + kc - qc + 15];
                x[rg] = sv; mt = fmaxf(mt, sv); }
            mt = fmaxf(mt, shx(mt, 32, lane));
            const float mnew = fmaxf(mrun[qh], mt), alpha = __expf(mrun[qh] - mnew);
            mrun[qh] = mnew;
            float ps = 0.f;
#pragma unroll
            for (int rg = 0; rg < 16; ++rg) { const float p = (x[rg] > -1e29f) ? __expf(x[rg] - mnew) : 0.f; x[rg] = p; ps += p; }
            lrun[qh] = lrun[qh] * alpha + ps;
            O[qh][0] *= alpha; O[qh][1] *= alpha;
#pragma unroll
            for (int s2 = 0; s2 < 2; ++s2) {
                u32x4 pw; pw.x = cvt_pk_bf16(x[8 * s2 + 0], x[8 * s2 + 1]); pw.y = cvt_pk_bf16(x[8 * s2 + 2], x[8 * s2 + 3]); pw.z = cvt_pk_bf16(x[8 * s2 + 4], x[8 * s2 + 5]); pw.w = cvt_pk_bf16(x[8 * s2 + 6], x[8 * s2 + 7]);
                const bf16x8 pb = __builtin_bit_cast(bf16x8, pw);
#pragma unroll
                for (int dt = 0; dt < 2; ++dt) { u32x4 aw; aw.x = cur.v[dt][s2][0].x; aw.y = cur.v[dt][s2][0].y; aw.z = cur.v[dt][s2][1].x; aw.w = cur.v[dt][s2][1].y;
                    O[qh][dt] = mfma32(__builtin_bit_cast(bf16x8, aw), pb, O[qh][dt]); } }
        }
        cur = nxt;
    }
#pragma unroll
    for (int qh = 0; qh < 2; ++qh) { const float inv = 1.0f / (lrun[qh] + shx(lrun[qh], 32, lane));
#pragma unroll
        for (int dt = 0; dt < 2; ++dt)
#pragma unroll
            for (int g4 = 0; g4 < 4; ++g4) { u32x2 pw; pw.x = cvt_pk_bf16(O[qh][dt][4 * g4] * inv, O[qh][dt][4 * g4 + 1] * inv); pw.y = cvt_pk_bf16(O[qh][dt][4 * g4 + 2] * inv, O[qh][dt][4 * g4 + 3] * inv);
                *(LAS u32x2*)(Otile + (32 * qh + c) * 72 + dt * 32 + 8 * g4 + 4 * hh) = pw; } }
#pragma unroll
    for (int i = 0; i < 8; ++i) { const int id = lane + 64 * i, q = id >> 3, d8 = (id & 7) * 8;
        *(u32x4*)(aout + (size_t)(qtok0 + q) * 512 + h * 64 + d8) = *(const LAS u32x4*)(Otile + q * 72 + d8); }
}

constexpr int KT_STRIDE = 136;
__device__ __forceinline__ void r1_item(const bf16_t* __restrict__ projT, bf16_t* stloc, const float* __restrict__ cosT, const float* __restrict__ sinT, float lgf2, float lgb2, int item, int seqlen, LAS unsigned char* lds) {
    const int tid = otid(), w = __builtin_amdgcn_readfirstlane(tid >> 6), lane = tid & 63, c = lane & 31, hh = lane >> 5;
    const int ch = item >> 2, h = item & 3, tok0 = ch * 128, pos0 = tok0 % seqlen;
    LAS bf16_t* KTf = (LAS bf16_t*)lds; LAS bf16_t* KTb = (LAS bf16_t*)(lds + 128 * KT_STRIDE * 2);
    const float scale = 0.08838834764831845f;
    bf16x8 af[8];
    { const bf16_t* vp = projT + (size_t)(1024 + h * 256 + 32 * w + c) * MG + tok0 + 8 * hh;
#pragma unroll
      for (int s = 0; s < 8; ++s) af[s] = *(const bf16x8*)(vp + 16 * s); }
#pragma unroll
    for (int it = 0; it < 2; ++it) {
        const int id = tid + NTHREADS * it, d = id >> 4, t8 = id & 15;
        float k1[8], k2[8];
        unpack8(*(const u32x4*)(projT + (size_t)(512 + h * 128 + d) * MG + tok0 + 8 * t8), k1);
        unpack8(*(const u32x4*)(projT + (size_t)(512 + h * 128 + d + 64) * MG + tok0 + 8 * t8), k2);
        const f32x4 c0 = *(const f32x4*)(cosT + (size_t)d * 16384 + pos0 + 8 * t8), c1 = *(const f32x4*)(cosT + (size_t)d * 16384 + pos0 + 8 * t8 + 4);
        const f32x4 s0 = *(const f32x4*)(sinT + (size_t)d * 16384 + pos0 + 8 * t8), s1 = *(const f32x4*)(sinT + (size_t)d * 16384 + pos0 + 8 * t8 + 4);
        float f1[8], f2[8], b1[8], b2[8];
#pragma unroll
        for (int j = 0; j < 8; ++j) { const float cv = j < 4 ? c0[j & 3] : c1[j & 3], sv = j < 4 ? s0[j & 3] : s1[j & 3];
            const float r1 = (k1[j] * cv - k2[j] * sv) * scale, r2 = (k1[j] * sv + k2[j] * cv) * scale;
            const int tl = 8 * t8 + j; const float df = exp2f((float)(127 - tl) * lgf2), db = exp2f((float)tl * lgb2);
            f1[j] = r1 * df; f2[j] = r2 * df; b1[j] = r1 * db; b2[j] = r2 * db; }
        *(LAS u32x4*)(KTf + d * KT_STRIDE + 8 * t8) = pack8(f1); *(LAS u32x4*)(KTf + (d + 64) * KT_STRIDE + 8 * t8) = pack8(f2);
        *(LAS u32x4*)(KTb + d * KT_STRIDE + 8 * t8) = pack8(b1); *(LAS u32x4*)(KTb + (d + 64) * KT_STRIDE + 8 * t8) = pack8(b2);
    }
    __syncthreads();
#pragma unroll
    for (int dir = 0; dir < 2; ++dir) {
        LAS bf16_t* KT = dir ? KTb : KTf;
        bf16_t* dst = stloc + ((size_t)(ch * 4 + h) * 2 + dir) * 32768;
#pragma unroll
        for (int ct = 0; ct < 4; ++ct) {
            f32x16 acc = zero16();
#pragma unroll
            for (int s = 0; s < 8; ++s) { const bf16x8 bfr = *(const LAS bf16x8*)(KT + (32 * ct + c) * KT_STRIDE + 16 * s + 8 * hh); acc = mfma32(af[s], bfr, acc); }
#pragma unroll
            for (int rg = 0; rg < 16; ++rg) { const int dv = 32 * w + (rg & 3) + 8 * (rg >> 2) + 4 * hh; dst[dv * 128 + 32 * ct + c] = (bf16_t)(cvt_pk_bf16(acc[rg], 0.f) & 0xffffu); }
        }
    }
    __syncthreads();
}

__device__ __forceinline__ void phase_scan(const bf16_t* __restrict__ stloc, bf16_t* st, const float* __restrict__ decf, const float* __restrict__ decb, int seqlen) {
    const int gt = blockIdx.x * NTHREADS + otid(), nth = ogrid() * NTHREADS;
    constexpr size_t CSTR = (size_t)4 * 2 * 32768;
    if (seqlen == 4096) {
        constexpr int NCH = 32, NTASK = 4 * 4 * 2 * 4096;
        for (int id = gt; id < NTASK; id += nth) {
            const int e8 = id & 4095, dir = (id >> 12) & 1, h = (id >> 13) & 3, seq = id >> 15;
            const float x = dir ? decb[h] : decf[h]; const float cd = exp2f(-128.0f * log1pf(expf(-x)) * 1.4426950408889634f);
            const size_t base = ((size_t)(seq * NCH * 4 + h) * 2 + dir) * 32768 + (size_t)e8 * 8;
            float zz = 0.f; asm volatile("" : "+v"(zz));
            float S[8];
#pragma unroll
            for (int j = 0; j < 8; ++j) S[j] = zz;
            for (int i0 = 0; i0 < NCH; i0 += 8) {
                u32x4 loc[8];
#pragma unroll
                for (int j = 0; j < 8; ++j) { const int ci = dir ? (NCH - 1 - (i0 + j)) : (i0 + j); loc[j] = *(const u32x4*)(stloc + base + (size_t)ci * CSTR); }
#pragma unroll
                for (int j = 0; j < 8; ++j) { const int ci = dir ? (NCH - 1 - (i0 + j)) : (i0 + j);
                    *(u32x4*)(st + base + (size_t)ci * CSTR) = pack8(S);
                    float lf[8]; unpack8(loc[j], lf);
#pragma unroll
                    for (int k = 0; k < 8; ++k) S[k] = S[k] * cd + lf[k]; }
            }
        }
    } else {
        constexpr int NCH = 128, NTASK = 4 * 2 * 16384;
        for (int id = gt; id < NTASK; id += nth) {
            const int e2 = id & 16383, dir = (id >> 14) & 1, h = (id >> 15) & 3;
            const float x = dir ? decb[h] : decf[h]; const float cd = exp2f(-128.0f * log1pf(expf(-x)) * 1.4426950408889634f);
            const size_t base = ((size_t)h * 2 + dir) * 32768 + (size_t)e2 * 2;
            float zz = 0.f; asm volatile("" : "+v"(zz));
            float S0 = zz, S1 = zz;
            for (int i0 = 0; i0 < NCH; i0 += 8) {
                unsigned loc[8];
#pragma unroll
                for (int j = 0; j < 8; ++j) { const int ci = dir ? (NCH - 1 - (i0 + j)) : (i0 + j); loc[j] = *(const unsigned*)(stloc + base + (size_t)ci * CSTR); }
#pragma unroll
                for (int j = 0; j < 8; ++j) { const int ci = dir ? (NCH - 1 - (i0 + j)) : (i0 + j);
                    *(unsigned*)(st + base + (size_t)ci * CSTR) = cvt_pk_bf16(S0, S1);
                    S0 = S0 * cd + bf_lo(loc[j]); S1 = S1 * cd + bf_hi(loc[j]); }
            }
        }
    }
}

constexpr int OL_STRIDE = 264;
__device__ __forceinline__ void r3_item(const bf16_t* __restrict__ proj, const bf16_t* __restrict__ projT, const bf16_t* __restrict__ st, bf16_t* ro,
                        const float* __restrict__ cosN, const float* __restrict__ sinN, const float* __restrict__ gn  , float lgf2, float lgb2,
                        int item, int seqlen, LAS unsigned char* lds) {
    const int tid = otid(), w = __builtin_amdgcn_readfirstlane(tid >> 6), lane = tid & 63, c = lane & 31, hh = lane >> 5;
    const int ch = item >> 2, h = item & 3, tok0 = ch * 128, pos0 = tok0 % seqlen;
    LAS bf16_t* Ql = (LAS bf16_t*)lds; LAS bf16_t* Kl = (LAS bf16_t*)(lds + 34816); LAS bf16_t* Pl = (LAS bf16_t*)(lds + 69632);
    LAS float* stat = (LAS float*)(lds + 104448);
    LAS bf16_t* Ol = (LAS bf16_t*)lds;
    const float scale = 0.08838834764831845f;
    bf16x8 asb[8], asf[8], avt[8];
    const size_t stb0 = ((size_t)(ch * 4 + h) * 2) * 32768 + (size_t)(32 * w + c) * 128 + 8 * hh;
#pragma unroll
    for (int s = 0; s < 8; ++s) asb[s] = *(const bf16x8*)(st + stb0 + 32768 + 16 * s);
#pragma unroll
    for (int it = 0; it < 2; ++it) {
        const int id = tid + NTHREADS * it, t = id >> 3, d8 = (id & 7) * 8;
        const f32x4 c0 = *(const f32x4*)(cosN + (size_t)(pos0 + t) * 64 + d8), c1 = *(const f32x4*)(cosN + (size_t)(pos0 + t) * 64 + d8 + 4);
        const f32x4 s0 = *(const f32x4*)(sinN + (size_t)(pos0 + t) * 64 + d8), s1 = *(const f32x4*)(sinN + (size_t)(pos0 + t) * 64 + d8 + 4);
        float a[8], b[8], o1[8], o2[8];
        const bf16_t* qp = proj + (size_t)(tok0 + t) * NPROJ + 1024 + h * 128 + d8;
        unpack8(*(const u32x4*)qp, a); unpack8(*(const u32x4*)(qp + 64), b);
#pragma unroll
        for (int j = 0; j < 8; ++j) { const float cv = j < 4 ? c0[j & 3] : c1[j & 3], sv = j < 4 ? s0[j & 3] : s1[j & 3]; o1[j] = a[j] * cv - b[j] * sv; o2[j] = a[j] * sv + b[j] * cv; }
        *(LAS u32x4*)(Ql + t * KT_STRIDE + d8) = pack8(o1); *(LAS u32x4*)(Ql + t * KT_STRIDE + 64 + d8) = pack8(o2);
        const bf16_t* kp = proj + (size_t)(tok0 + t) * NPROJ + 1536 + h * 128 + d8;
        unpack8(*(const u32x4*)kp, a); unpack8(*(const u32x4*)(kp + 64), b);
#pragma unroll
        for (int j = 0; j < 8; ++j) { const float cv = j < 4 ? c0[j & 3] : c1[j & 3], sv = j < 4 ? s0[j & 3] : s1[j & 3]; o1[j] = (a[j] * cv - b[j] * sv) * scale; o2[j] = (a[j] * sv + b[j] * cv) * scale; }
        *(LAS u32x4*)(Kl + t * KT_STRIDE + d8) = pack8(o1); *(LAS u32x4*)(Kl + t * KT_STRIDE + 64 + d8) = pack8(o2);
    }
    __syncthreads();
    { const int kt = w >> 1;
#pragma unroll
      for (int q2 = 0; q2 < 2; ++q2) { const int tqt = 2 * (w & 1) + q2;
          f32x16 x = zero16();
#pragma unroll
          for (int s = 0; s < 8; ++s) { const bf16x8 kf = *(const LAS bf16x8*)(Kl + (32 * kt + c) * KT_STRIDE + 16 * s + 8 * hh);
              const bf16x8 qf = *(const LAS bf16x8*)(Ql + (32 * tqt + c) * KT_STRIDE + 16 * s + 8 * hh); x = mfma32(kf, qf, x); }
          const int n = 32 * tqt + c;
#pragma unroll
          for (int g4 = 0; g4 < 4; ++g4) { float pv[4];
#pragma unroll
              for (int j = 0; j < 4; ++j) { const int mk = 32 * kt + 8 * g4 + 4 * hh + j; const int diff = n - mk;
                  const float dec = diff >= 0 ? exp2f((float)diff * lgf2) : exp2f((float)(-diff) * lgb2); pv[j] = x[4 * g4 + j] * dec; }
              u32x2 pw; pw.x = cvt_pk_bf16(pv[0], pv[1]); pw.y = cvt_pk_bf16(pv[2], pv[3]);
              *(LAS u32x2*)(Pl + n * KT_STRIDE + 32 * kt + 8 * g4 + 4 * hh) = pw; } } }
    __syncthreads();
    f32x16 acc[4];
#pragma unroll
    for (int q = 0; q < 4; ++q) acc[q] = zero16();
    { const bf16_t* vp0 = projT + (size_t)(1024 + h * 256 + 32 * w + c) * MG + tok0 + 8 * hh;
#pragma unroll
      for (int s = 0; s < 8; ++s) { asf[s] = *(const bf16x8*)(st + stb0 + 16 * s); avt[s] = *(const bf16x8*)(vp0 + 16 * s); } }
#pragma unroll
    for (int s = 0; s < 8; ++s) { const bf16x8 a = asb[s];
#pragma unroll
        for (int q = 0; q < 4; ++q) { const bf16x8 b = *(const LAS bf16x8*)(Ql + (32 * q + c) * KT_STRIDE + 16 * s + 8 * hh); acc[q] = mfma32(a, b, acc[q]); } }
#pragma unroll
    for (int q = 0; q < 4; ++q) { const int n = 32 * q + c; const float f = exp2f((float)(128 - n) * lgb2 - (float)(n + 1) * lgf2); acc[q] *= f; }
#pragma unroll
    for (int s = 0; s < 8; ++s) { const bf16x8 a = asf[s];
#pragma unroll
        for (int q = 0; q < 4; ++q) { const bf16x8 b = *(const LAS bf16x8*)(Ql + (32 * q + c) * KT_STRIDE + 16 * s + 8 * hh); acc[q] = mfma32(a, b, acc[q]); } }
#pragma unroll
    for (int q = 0; q < 4; ++q) { const int n = 32 * q + c; const float f = exp2f((float)(n + 1) * lgf2); acc[q] *= f; }
#pragma unroll
    for (int s = 0; s < 8; ++s) { const bf16x8 a = avt[s];
#pragma unroll
        for (int q = 0; q < 4; ++q) { const bf16x8 b = *(const LAS bf16x8*)(Pl + (32 * q + c) * KT_STRIDE + 16 * s + 8 * hh); acc[q] = mfma32(a, b, acc[q]); } }
#pragma unroll
    for (int q = 0; q < 4; ++q) { float s1 = 0.f, s2 = 0.f;
#pragma unroll
        for (int i = 0; i < 16; ++i) { s1 += acc[q][i]; s2 += acc[q][i] * acc[q][i]; }
        s1 += shx(s1, 32, lane); s2 += shx(s2, 32, lane);
        if (hh == 0) { stat[(w * 128 + 32 * q + c) * 2] = s1; stat[(w * 128 + 32 * q + c) * 2 + 1] = s2; } }
    __syncthreads();
#pragma unroll
    for (int q = 0; q < 4; ++q) { float s1 = 0.f, s2 = 0.f; const int n = 32 * q + c;
#pragma unroll
        for (int k = 0; k < 8; ++k) { s1 += stat[(k * 128 + n) * 2]; s2 += stat[(k * 128 + n) * 2 + 1]; }
        const float mu = s1 * (1.0f / 256.0f); float var = s2 * (1.0f / 256.0f) - mu * mu; var = var < 0.f ? 0.f : var; const float rs = rsqrtf(var + EPS);
#pragma unroll
        for (int g4 = 0; g4 < 4; ++g4) { u32x2 pw; pw.x = cvt_pk_bf16((acc[q][4 * g4] - mu) * rs, (acc[q][4 * g4 + 1] - mu) * rs); pw.y = cvt_pk_bf16((acc[q][4 * g4 + 2] - mu) * rs, (acc[q][4 * g4 + 3] - mu) * rs);
            *(LAS u32x2*)(Ol + n * OL_STRIDE + 32 * w + 8 * g4 + 4 * hh) = pw; } }
    __syncthreads();
#pragma unroll
    for (int it = 0; it < 8; ++it) { const int id = tid + NTHREADS * it, tq = id >> 5, d8 = (id & 31) * 8;
        float y[8], rg[8], o[8]; unpack8(*(const LAS u32x4*)(Ol + tq * OL_STRIDE + d8), y);
        unpack8(*(const u32x4*)(proj + (size_t)(tok0 + tq) * NPROJ + 2048 + h * 256 + d8), rg);
        const f32x4 g0 = *(const f32x4*)(gn + h * 256 + d8), g1 = *(const f32x4*)(gn + h * 256 + d8 + 4);
#pragma unroll
        for (int j = 0; j < 8; ++j) { const float gv = j < 4 ? g0[j & 3] : g1[j & 3]; o[j] = rg[j] * sigmoidf_(rg[j]) * y[j] * gv; }
        *(u32x4*)(ro + (size_t)(tok0 + tq) * D + h * 256 + d8) = pack8(o); }
    __syncthreads();
}


#define XB_TMO      128
#define XB_XCNT(j)  (256  + 64 * (j))
#define XB_XSUB(j)  (1280 + 64 * (j))
#define XB_XGEN(j)  (2304 + 64 * (j))
#define XB_TOP      3328
#define XB_TOPGEN   3392
#define XCD_BAR_WORDS 3456
#define XB_SPIN_CAP (1u << 22)
__device__ __forceinline__ unsigned xb_ld(unsigned* p)              { return __hip_atomic_load(p, __ATOMIC_RELAXED, __HIP_MEMORY_SCOPE_AGENT); }
__device__ __forceinline__ unsigned xb_add(unsigned* p, unsigned v) { return __hip_atomic_fetch_add(p, v, __ATOMIC_RELAXED, __HIP_MEMORY_SCOPE_AGENT); }
__device__ __forceinline__ unsigned xb_xcc_id() { return (unsigned)__builtin_amdgcn_s_getreg((3 << 11) | 20) & 0xFu; }
#define XB_SPIN(cond, bar) do { unsigned _sp = 0; while (cond) { __builtin_amdgcn_s_sleep(1); \
    if ((++_sp & 255u) == 0u) { if (xb_ld(&(bar)[XB_TMO])) break; if (_sp > XB_SPIN_CAP) { atomicAdd(&(bar)[XB_TMO], 1u); break; } } } } while (0)
struct XcdBarrier { unsigned* bar; unsigned x; volatile LAS unsigned* st; };
__device__ __forceinline__ XcdBarrier xcd_barrier_post(unsigned* bar, volatile LAS unsigned* st) {
    XcdBarrier b; b.bar = bar; b.x = xb_xcc_id(); b.st = st;
    if (threadIdx.x == 0) (void)xb_add(&bar[XB_XCNT(b.x)], 1u);
    return b;
}
__device__ __forceinline__ void xcd_barrier_complete(unsigned* bar, unsigned x, unsigned& nloc, unsigned& nx) {
    const unsigned G = gridDim.x * gridDim.y * gridDim.z;
    unsigned sum, cnt, mine, sp = 0u;
    for (;;) {
        sum = 0u; cnt = 0u; mine = 0u;
#pragma unroll
        for (unsigned j = 0; j < 16; ++j) { const unsigned c = xb_ld(&bar[XB_XCNT(j)]); sum += c; cnt += (c > 0u) ? 1u : 0u; mine = (j == x) ? c : mine; }
        if (sum == G) break;
        __builtin_amdgcn_s_sleep(1);
        if ((++sp & 255u) == 0u) { if (xb_ld(&bar[XB_TMO])) break; if (sp > XB_SPIN_CAP) { atomicAdd(&bar[XB_TMO], 1u); break; } }
    }
    nloc = mine > 0u ? mine : 1u; nx = cnt > 0u ? cnt : 1u;
}
__device__ __forceinline__ void xcd_barrier(const XcdBarrier& b) {
    asm volatile("s_waitcnt vmcnt(0)" ::: "memory");
    __syncthreads();
    if (threadIdx.x == 0) {
        unsigned* bar = b.bar;
        __builtin_amdgcn_s_waitcnt(0);
        unsigned nloc = b.st[0], nx = b.st[1];
        if (nloc == 0u) { xcd_barrier_complete(bar, b.x, nloc, nx); b.st[0] = nloc; b.st[1] = nx; }
        const unsigned old = xb_add(&bar[XB_XSUB(b.x)], 1u);
        const unsigned gen = old / nloc;
        if (old + 1u == (gen + 1u) * nloc) {
            __builtin_amdgcn_fence(__ATOMIC_RELEASE, "agent");
            asm volatile("s_waitcnt vmcnt(0)" ::: "memory");
            const unsigned og = xb_add(&bar[XB_TOP], 1u);
            const unsigned tg = og / nx;
            if (og + 1u == (tg + 1u) * nx) xb_add(&bar[XB_TOPGEN], 1u);
            else XB_SPIN(xb_ld(&bar[XB_TOPGEN]) == tg, bar);
            __builtin_amdgcn_fence(__ATOMIC_ACQUIRE, "agent");
            xb_add(&bar[XB_XGEN(b.x)], 1u);
            asm volatile("s_waitcnt vmcnt(0)" ::: "memory");
        } else {
            XB_SPIN(xb_ld(&bar[XB_XGEN(b.x)]) == gen, bar);
            __builtin_amdgcn_fence(__ATOMIC_ACQUIRE, "agent");
            asm volatile("s_waitcnt vmcnt(0)" ::: "memory");
        }
    }
    __syncthreads();
}

__device__ __forceinline__ unsigned char* opq(unsigned char* p) { asm volatile("" : "+s"(p)); return p; }
#define WSP(T, off) ((T*)(opq(P.ws) + (off)))
#define XBAR() do { XcdBarrier _b; _b.bar = (unsigned*)(opq(P.ws) + WS_CTL); _b.x = (unsigned)__builtin_amdgcn_readfirstlane((int)xb_xcc_id()); _b.st = (volatile LAS unsigned*)(lds + 131072); xcd_barrier(_b); } while (0)
__global__ void __launch_bounds__(NTHREADS, 2) fwd_megakernel(Params P) {
    extern __shared__ __attribute__((aligned(16))) unsigned char lds_raw[];
    LAS unsigned char* lds = (LAS unsigned char*)lds_raw;
    cg::grid_group grid = cg::this_grid();
    const int G = ogrid(), bid = blockIdx.x;
    volatile LAS unsigned* xst = (volatile LAS unsigned*)(lds + 131072);
    if (threadIdx.x < 4) xst[threadIdx.x] = 0u;
    __syncthreads();
    (void)xcd_barrier_post((unsigned*)(P.ws + WS_CTL), xst);

    phase_prologue(P, lds);
    grid.sync();
    XBAR();

    for (int grp = 0; grp < NGROUPS; ++grp) {
        const float* xin = grp < 4 ? P.x_prompt + (size_t)grp * MG * D : P.x_sample;
        float* xo = P.out + (size_t)grp * MG * D;
        const int seqlen = grp < 4 ? 4096 : 16384;
        phase_init(xin, WSP(bf16_t, WS_XB), WSP(float, WS_ROWSS1), WSP(float, WS_ROWSS2));
        XBAR();
        for (int l = 0; l < DEPTH; ++l) {
            const size_t wl = WS_W + (size_t)l * W_LAYER;
            { pg8::Gemm g{WSP(bf16_t, WS_XB), WSP(const bf16_t, wl + W_IN_OFF), MG, NPROJ, D}; pg8::StaticOrder S; S.init(MG, NPROJ, G, bid);
              LAS float* rl = (LAS float*)(lds + LDS_RSTD_OFF); fill_rstd(rl, WSP(float, WS_ROWSS1), S, false);
              pg8::EpiRowScale E{WSP(bf16_t, WS_PROJ), NPROJ, rl}; pg8::gemm_phase(lds, g, S, E); }
            { pg8::Gemm g{WSP(const bf16_t, wl + W_IN_OFF + (size_t)NPROJ * D * 2), WSP(bf16_t, WS_XB), NPT, MG, D}; pg8::StaticOrder S; S.init(NPT, MG, G, bid);
              LAS float* rl = (LAS float*)(lds + LDS_RSTD_OFF); fill_rstd(rl, WSP(float, WS_ROWSS1), S, true);
              pg8::EpiColScale E{WSP(bf16_t, WS_PROJT), MG, rl}; pg8::gemm_phase(lds, g, S, E); }
            XBAR();
            { { const int tid = otid(), wv = __builtin_amdgcn_readfirstlane(tid >> 6), ln = tid & 63;
                for (int it = bid * 8 + wv; it < 2048; it += G * 8) na_item(WSP(bf16_t, WS_PROJ), WSP(bf16_t, WS_PROJT), WSP(bf16_t, WS_A), P.na_rel_bias + (size_t)l * 8 * 465, it, seqlen, lds, wv, ln);
                __syncthreads(); }
              for (int it = bid; it < 512; it += G) { const int h = it & 3;
                  const float* tab = WSP(const float, WS_LG2) + (l * 4 + h) * 2; const float lgf2 = tab[0], lgb2 = tab[1];
                  r1_item(WSP(bf16_t, WS_PROJT), WSP(bf16_t, WS_STLOC), WSP(float, WS_COST), WSP(float, WS_SINT), lgf2, lgb2, it, seqlen, lds); } }
            XBAR();
            phase_scan(WSP(bf16_t, WS_STLOC), WSP(bf16_t, WS_ST), P.dec_f + l * 4, P.dec_b + l * 4, seqlen);
            XBAR();
            for (int it = bid; it < 512; it += G) { const int h = it & 3;
                const float* tab = WSP(const float, WS_LG2) + (l * 4 + h) * 2; const float lgf2 = tab[0], lgb2 = tab[1];
                r3_item(WSP(bf16_t, WS_PROJ), WSP(bf16_t, WS_PROJT), WSP(bf16_t, WS_ST), WSP(bf16_t, WS_RO), WSP(float, WS_COSN), WSP(float, WS_SINN), P.ret_norm_g + (size_t)l * 1024, lgf2, lgb2, it, seqlen, lds); }
            XBAR();
            { pg8::Gemm g{WSP(bf16_t, WS_A), WSP(const bf16_t, wl + W_A_OFF), MG, D, 512}; pg8::StaticOrder S; S.init(MG, D, G, bid);
              pg8::EpiGate E{WSP(bf16_t, WS_PROJ) + 3072, nullptr, WSP(bf16_t, WS_TMP)}; pg8::gemm_phase(lds, g, S, E); }
            { pg8::Gemm g{WSP(bf16_t, WS_RO), WSP(const bf16_t, wl + W_R_OFF), MG, D, D}; pg8::StaticOrder S; S.init(MG, D, G, bid);
              pg8::EpiGate E{WSP(bf16_t, WS_PROJ) + 4096, WSP(bf16_t, WS_TMP), WSP(bf16_t, WS_MIXED)}; pg8::gemm_phase(lds, g, S, E); }
            XBAR();
            { pg8::Gemm g{WSP(bf16_t, WS_MIXED), WSP(const bf16_t, wl + W_O_OFF), MG, D, D}; pg8::StaticOrder S; S.init(MG, D, G, bid);
              pg8::EpiResid E{WSP(bf16_t, WS_XB), WSP(float, WS_ROWSS2)}; pg8::gemm_phase(lds, g, S, E); }
            XBAR();
            { pg8::Gemm g{WSP(bf16_t, WS_XB), WSP(const bf16_t, wl + W_UP_OFF), MG, DFF2, D}; pg8::StaticOrder S; S.init(MG, DFF2, G, bid);
              LAS float* rl = (LAS float*)(lds + LDS_RSTD_OFF); fill_rstd(rl, WSP(float, WS_ROWSS2), S, false);
              pg8::EpiRowScale E{WSP(bf16_t, WS_PROJ), DFF2, rl}; pg8::gemm_phase(lds, g, S, E); }
            XBAR();
            phase_convact(WSP(bf16_t, WS_PROJ), WSP(bf16_t, WS_STLOC), P.conv_w + (size_t)l * 3 * DFF2, seqlen, WSP(float, WS_ROWSS2));
            XBAR();
            { pg8::Gemm g{WSP(bf16_t, WS_STLOC), WSP(const bf16_t, wl + W_D_OFF), MG, D, DFF}; pg8::StaticOrder S; S.init(MG, D, G, bid);
              pg8::EpiResid E{WSP(bf16_t, WS_XB), WSP(float, WS_ROWSS1)}; pg8::gemm_phase(lds, g, S, E); }
            XBAR();
        }
        phase_final(WSP(bf16_t, WS_XB), xo, WSP(float, WS_ROWSS1), P.norm_final_g);
        XBAR();
    }
}

extern "C" void kernel_launch(void* const* d_in, const int* in_sizes, int n_in, void* d_out, int out_size, void* d_ws, size_t ws_size, hipStream_t stream) {
    static int grid_blocks = 0;
    if (grid_blocks == 0) {
        if (n_in != 16 || ws_size < WS_END) { fprintf(stderr, "kernel_launch: unexpected n_in %d or ws_size %zu (< %zu)\n", n_in, ws_size, (size_t)WS_END); grid_blocks = -1; return; }
        int dev = 0, cus = 0, per_cu = 0;
        hipGetDevice(&dev);
        hipDeviceGetAttribute(&cus, hipDeviceAttributeMultiprocessorCount, dev);
        if (hipFuncSetAttribute((const void*)fwd_megakernel, hipFuncAttributeMaxDynamicSharedMemorySize, LDS_BYTES) != hipSuccess) { fprintf(stderr, "kernel_launch: hipFuncSetAttribute failed\n"); grid_blocks = -1; return; }
        hipOccupancyMaxActiveBlocksPerMultiprocessor(&per_cu, (const void*)fwd_megakernel, NTHREADS, LDS_BYTES);
        if (per_cu < 1) { fprintf(stderr, "kernel_launch: occupancy query says %d blocks per CU\n", per_cu); per_cu = 1; }
        (void)hipGetLastError();
        grid_blocks = cus;
    }
    if (grid_blocks < 0) return;
    if (hipMemsetAsync((char*)d_ws + WS_CTL, 0, 16384, stream) != hipSuccess) { fprintf(stderr, "kernel_launch: memset of barrier words failed\n"); return; }
    Params p{};
    p.x_prompt = (const float*)d_in[0]; p.x_sample = (const float*)d_in[1]; p.norm_mix_g = (const float*)d_in[2]; p.w_in = (const float*)d_in[3]; p.na_rel_bias = (const float*)d_in[4];
    p.dec_f = (const float*)d_in[5]; p.dec_b = (const float*)d_in[6]; p.ret_norm_g = (const float*)d_in[7]; p.w_ba = (const float*)d_in[8]; p.w_br = (const float*)d_in[9]; p.w_out = (const float*)d_in[10];
    p.norm_ffn_g = (const float*)d_in[11]; p.w_up = (const float*)d_in[12]; p.conv_w = (const float*)d_in[13]; p.w_down = (const float*)d_in[14]; p.norm_final_g = (const float*)d_in[15];
    p.out = (float*)d_out; p.ws = (unsigned char*)d_ws;
    void* args[] = {&p};
    hipError_t e = hipLaunchCooperativeKernel((const void*)fwd_megakernel, dim3(grid_blocks), dim3(NTHREADS), args, LDS_BYTES, stream);
    if (e != hipSuccess) fprintf(stderr, "kernel_launch: cooperative launch failed: %s (grid %d)\n", hipGetErrorString(e), grid_blocks);
}
```

```cpp
#include <hip/hip_runtime.h>
#include <hip/hip_cooperative_groups.h>
#include <cstdio>
namespace cg = cooperative_groups;

#define LAS __attribute__((address_space(3)))
typedef unsigned short bf16_t;
typedef short bf16x8 __attribute__((ext_vector_type(8)));
typedef short bf16x4 __attribute__((ext_vector_type(4)));
typedef float f32x4 __attribute__((ext_vector_type(4)));
typedef float f32x16 __attribute__((ext_vector_type(16)));
typedef unsigned u32x4 __attribute__((ext_vector_type(4)));
typedef unsigned u32x2 __attribute__((ext_vector_type(2)));

constexpr int D = 1024, MG = 16384, NPROJ = 5120, NPT = 2048, DFF = 2816, DFF2 = 5632, DEPTH = 4, NGROUPS = 5, DIN = 6656;
constexpr float EPS = 1e-6f;
constexpr int NTHREADS = 512;
constexpr int LDS_RSTD_OFF = 131072 + 1024;
constexpr int LDS_BYTES = 131072 + 1024 + 8192;

constexpr size_t WS_CTL = 0;
constexpr size_t WS_LG2 = 32768;
constexpr size_t WS_ROWSS1 = 262144;
constexpr size_t WS_ROWSS2 = WS_ROWSS1 + (size_t)MG * 16 * 4;
constexpr size_t WS_COSN = WS_ROWSS2 + (size_t)MG * 16 * 4;
constexpr size_t TAB_BYTES = (size_t)16384 * 64 * 4;
constexpr size_t WS_SINN = WS_COSN + TAB_BYTES;
constexpr size_t WS_COST = WS_SINN + TAB_BYTES;
constexpr size_t WS_SINT = WS_COST + TAB_BYTES;
constexpr size_t WS_W = WS_SINT + TAB_BYTES;
constexpr size_t W_IN_OFF = 0;
constexpr size_t W_A_OFF = W_IN_OFF + (size_t)7168 * 1024 * 2;
constexpr size_t W_R_OFF = W_A_OFF + (size_t)1024 * 512 * 2;
constexpr size_t W_O_OFF = W_R_OFF + (size_t)1024 * 1024 * 2;
constexpr size_t W_UP_OFF = W_O_OFF + (size_t)1024 * 1024 * 2;
constexpr size_t W_D_OFF = W_UP_OFF + (size_t)5632 * 1024 * 2;
constexpr size_t W_LAYER = W_D_OFF + (size_t)1024 * 2816 * 2;
constexpr size_t WS_XB = WS_W + W_LAYER * DEPTH;
constexpr size_t WS_PROJ = WS_XB + (size_t)MG * D * 2;
constexpr size_t WS_PROJT = WS_PROJ + (size_t)MG * NPROJ * 2;
constexpr size_t WS_A = WS_PROJT + (size_t)NPT * MG * 2;
constexpr size_t WS_RO = WS_A + (size_t)MG * 512 * 2;
constexpr size_t WS_TMP = WS_RO + (size_t)MG * D * 2;
constexpr size_t WS_MIXED = WS_TMP + (size_t)MG * D * 2;
constexpr size_t WS_STLOC = WS_MIXED + (size_t)MG * D * 2;
constexpr size_t WS_ST = WS_STLOC + (size_t)128 * 4 * 2 * 32768 * 4;
constexpr size_t WS_END = WS_ST + (size_t)128 * 4 * 2 * 32768 * 2;
static_assert((size_t)MG * DFF2 * 2 <= (size_t)MG * NPROJ * 2 + (size_t)NPT * MG * 2, "u must fit over proj+projT");
static_assert((size_t)MG * DFF * 2 <= (size_t)128 * 4 * 2 * 32768 * 4, "act must fit over STloc");
static_assert(WS_END <= ((size_t)1 << 30), "workspace over 1 GiB");

struct Params {
    const float* x_prompt; const float* x_sample; const float* norm_mix_g; const float* w_in; const float* na_rel_bias;
    const float* dec_f; const float* dec_b; const float* ret_norm_g; const float* w_ba; const float* w_br; const float* w_out;
    const float* norm_ffn_g; const float* w_up; const float* conv_w; const float* w_down; const float* norm_final_g;
    float* out; unsigned char* ws;
};

typedef __bf16 bf16v2_t __attribute__((ext_vector_type(2)));
typedef float f32v2_t __attribute__((ext_vector_type(2)));
__device__ __forceinline__ unsigned cvt_pk_bf16(float lo, float hi) { const f32v2_t v = {lo, hi}; const bf16v2_t r = __builtin_convertvector(v, bf16v2_t); return __builtin_bit_cast(unsigned, r); }
__device__ __forceinline__ float bf_lo(unsigned w) { return __uint_as_float(w << 16); }
__device__ __forceinline__ float bf_hi(unsigned w) { return __uint_as_float(w & 0xffff0000u); }
__device__ __forceinline__ float bf2f(bf16_t b) { return __uint_as_float(((unsigned)b) << 16); }
__device__ __forceinline__ float sigmoidf_(float x) { return __builtin_amdgcn_rcpf(1.0f + __expf(-x)); }
__device__ __forceinline__ void unpack8(const u32x4 w, float* f) { f[0] = bf_lo(w.x); f[1] = bf_hi(w.x); f[2] = bf_lo(w.y); f[3] = bf_hi(w.y); f[4] = bf_lo(w.z); f[5] = bf_hi(w.z); f[6] = bf_lo(w.w); f[7] = bf_hi(w.w); }
__device__ __forceinline__ u32x4 pack8(const float* f) { u32x4 w; w.x = cvt_pk_bf16(f[0], f[1]); w.y = cvt_pk_bf16(f[2], f[3]); w.z = cvt_pk_bf16(f[4], f[5]); w.w = cvt_pk_bf16(f[6], f[7]); return w; }
__device__ __forceinline__ f32x16 mfma32(bf16x8 a, bf16x8 b, f32x16 c) { return __builtin_amdgcn_mfma_f32_32x32x16_bf16(a, b, c, 0, 0, 0); }
__device__ __forceinline__ int otid() { int t = threadIdx.x; asm volatile("" : "+v"(t)); return t; }
__device__ __forceinline__ int ogrid() { int g = gridDim.x; asm volatile("" : "+s"(g)); return g; }
__device__ __forceinline__ f32x16 zero16() { return (f32x16){0.f, 0.f, 0.f, 0.f, 0.f, 0.f, 0.f, 0.f, 0.f, 0.f, 0.f, 0.f, 0.f, 0.f, 0.f, 0.f}; }
__device__ __forceinline__ float sum16(const float* p) { const f32x4 a = *(const f32x4*)p, b = *(const f32x4*)(p + 4), c = *(const f32x4*)(p + 8), d = *(const f32x4*)(p + 12); const f32x4 t = (a + b) + (c + d); return (t[0] + t[1]) + (t[2] + t[3]); }
__device__ __forceinline__ float shx(float v, int m, int lane) { return __int_as_float(__builtin_amdgcn_ds_bpermute((lane ^ m) << 2, __float_as_int(v))); }
__device__ __forceinline__ float wave_sum(float v, int lane) { v += shx(v, 32, lane); v += shx(v, 16, lane); v += shx(v, 8, lane); v += shx(v, 4, lane); v += shx(v, 2, lane); v += shx(v, 1, lane); return v; }

namespace pg8 {
constexpr int BM = 256, BK = 64, HALF = 128, HTB = HALF * BK * 2, STAGE_BYTES = 8 * HTB, NXCD = 8, WGM = 8;
__host__ __device__ __forceinline__ int lds_byte(int r, int c) { const int st = (r >> 4) * 2 + (c >> 5), rr = r & 15, cc = c & 31, ob = rr * 64 + cc * 2; return st * 1024 + (ob ^ (((ob >> 9) & 1) << 5)); }
__host__ __device__ __forceinline__ void stage_rc(int b, int& R, int& C) { const int st = b / 1024, sb = b % 1024, swz = sb ^ (((sb >> 9) & 1) << 5); R = (st >> 1) * 16 + swz / 64; C = (st & 1) * 32 + (swz % 64) / 2; }
__host__ __device__ __forceinline__ int perm32(int rho) { const int n = rho >> 4, i = rho & 15; return 8 * (i >> 2) + 4 * n + (i & 3); }
struct Unit { int pm, pn, idx; };
struct Gemm { const bf16_t* A; const bf16_t* Bt; int M, N, K; };
struct StaticOrder {
    int nM, nN, nwg, G, c;
    __host__ __device__ void init(int M, int N, int G_, int c_) { nM = M / BM; nN = N / BM; nwg = nM * nN; G = G_; c = c_; }
    __host__ __device__ bool next(int i, Unit& u) const {
        const long L = (long)i * G + c; if (L >= nwg) return false;
        int wgid = (int)L; { const int q = nwg / NXCD, r = nwg % NXCD, xcd = wgid % NXCD, off = wgid / NXCD; wgid = (xcd < r ? xcd * (q + 1) : r * (q + 1) + (xcd - r) * q) + off; }
        const int nig = WGM * nN, gid = wgid / nig, fm = gid * WGM, gsz = (nM - fm) < WGM ? (nM - fm) : WGM;
        u.pm = fm + ((wgid % nig) % gsz); u.pn = (wgid % nig) / gsz; return true;
    }
    __device__ __forceinline__ void a_ready(const Unit&) const {}
    __device__ __forceinline__ void done(const Unit&) const {}
};

template <class Epi, class Sched>
__device__ __forceinline__ void gemm_phase(LAS unsigned char* lds, const Gemm g, const Sched& S, const Epi& E) {
    const int tid = otid(), wid = __builtin_amdgcn_readfirstlane(tid >> 6), lane = tid & 63, wr = wid >> 2, wc = wid & 3, fr = lane & 15, fq = lane >> 4;
    const int K = g.K, nt = K / BK;
    unsigned voffA[2], voffB[2];
#pragma unroll
    for (int i = 0; i < 2; ++i) { int R, C; stage_rc(tid * 16 + i * 8192, R, C); const int Rb = Epi::PERM ? ((R & ~31) + perm32(R & 31)) : R;
        voffA[i] = (unsigned)(R * K + C) * 2u; voffB[i] = (unsigned)(Rb * K + C) * 2u; }
    const size_t kstep = (size_t)(BK * 2);
    const size_t hstep = (size_t)HALF * K * 2;
    const size_t tstep = 2 * hstep;
    const unsigned ldsw = (unsigned)wid * 1024u;
    const int aoff = lds_byte(wr * 64 + fr, fq * 8), boff = lds_byte(wc * 32 + fr, fq * 8);
#define PG8_SA(b, h) (((b) * 2 + (h)) * HTB)
#define PG8_SB(b, h) ((4 + (b) * 2 + (h)) * HTB)
#define PG8_STAGE(bufoff, gbase, voff) do { _Pragma("unroll") for (int _i = 0; _i < 2; ++_i) \
        __builtin_amdgcn_global_load_lds((const unsigned*)((const char*)(gbase) + (voff)[_i]), (LAS unsigned*)(lds + (bufoff) + ldsw + _i * 8192), 16, 0, 0); } while (0)
#define PG8_LDA(dst, b, h) do { _Pragma("unroll") for (int m = 0; m < 4; ++m) _Pragma("unroll") for (int k = 0; k < 2; ++k) dst[m][k] = *(const LAS bf16x8*)(lds + PG8_SA(b, h) + aoff + m * 2048 + k * 1024); } while (0)
#define PG8_LDB(dst, b, h) do { _Pragma("unroll") for (int n = 0; n < 2; ++n) _Pragma("unroll") for (int k = 0; k < 2; ++k) dst[n][k] = *(const LAS bf16x8*)(lds + PG8_SB(b, h) + boff + n * 2048 + k * 1024); } while (0)
#define PG8_MMA(ai, bj, At, Bt) do { __builtin_amdgcn_s_setprio(1); _Pragma("unroll") for (int m = 0; m < 4; ++m) _Pragma("unroll") for (int n = 0; n < 2; ++n) _Pragma("unroll") for (int k = 0; k < 2; ++k) \
        acc[ai][bj][m][n] = __builtin_amdgcn_mfma_f32_16x16x32_bf16(Bt[n][k], At[m][k], acc[ai][bj][m][n], 0, 0, 0); __builtin_amdgcn_s_setprio(0); } while (0)
#define PG8_WAIT_V(n) asm volatile("s_waitcnt vmcnt(" #n ")" ::: "memory")
#define PG8_WAIT_L(n) asm volatile("s_waitcnt lgkmcnt(" #n ")" ::: "memory")
#define PG8_BAR __builtin_amdgcn_s_barrier()
#define PG8_SCHED __builtin_amdgcn_sched_barrier(0)
    Unit cur, nxt; int ui = 0;
    if (!S.next(0, cur)) return;
    cur.idx = 0;
    f32x4 acc[2][2][4][2];
#pragma unroll
    for (int a = 0; a < 2; ++a)
#pragma unroll
        for (int b = 0; b < 2; ++b)
#pragma unroll
            for (int m = 0; m < 4; ++m)
#pragma unroll
                for (int n = 0; n < 2; ++n) acc[a][b][m][n] = (f32x4){0.f, 0.f, 0.f, 0.f};
    bf16x8 At[4][2], B0[2][2], B1[2][2];
    const char* cA = (const char*)g.A + (size_t)cur.pm * tstep; const char* cB = (const char*)g.Bt + (size_t)cur.pn * tstep;
    S.a_ready(cur);
    PG8_STAGE(PG8_SB(0, 0), cB, voffB); PG8_STAGE(PG8_SA(0, 0), cA, voffA); PG8_STAGE(PG8_SB(0, 1), cB + hstep, voffB); PG8_STAGE(PG8_SA(0, 1), cA + hstep, voffA);
    if (wr == 1) PG8_BAR;
    PG8_WAIT_V(4); PG8_BAR;
    PG8_STAGE(PG8_SB(1, 0), cB + kstep, voffB); PG8_STAGE(PG8_SA(1, 0), cA + kstep, voffA); PG8_STAGE(PG8_SB(1, 1), cB + hstep + kstep, voffB);
    PG8_WAIT_V(6); PG8_BAR;
    for (;;) {
        const bool has_next = S.next(ui + 1, nxt); nxt.idx = ui + 1;
        const char* nA = has_next ? (const char*)g.A + (size_t)nxt.pm * tstep : cA; const char* nB = has_next ? (const char*)g.Bt + (size_t)nxt.pn * tstep : cB;
        for (int t = 0; t < nt; t += 2) {
            const bool last = (t == nt - 2);
            const char* a1 = cA + (size_t)(t + 1) * kstep;
            const char* a2 = last ? nA : cA + (size_t)(t + 2) * kstep; const char* b2 = last ? nB : cB + (size_t)(t + 2) * kstep;
            const char* a3 = a2 + kstep; const char* b3 = b2 + kstep;
            if (last && has_next) S.a_ready(nxt);
            PG8_LDB(B0, 0, 0); PG8_SCHED; PG8_LDA(At, 0, 0); PG8_STAGE(PG8_SA(1, 1), a1 + hstep, voffA);
            PG8_WAIT_L(8); PG8_BAR; PG8_WAIT_L(0); PG8_MMA(0, 0, At, B0); PG8_BAR; PG8_SCHED;
            PG8_LDB(B1, 0, 1); PG8_STAGE(PG8_SB(0, 0), b2, voffB);
            PG8_BAR; PG8_WAIT_L(0); PG8_MMA(0, 1, At, B1); PG8_BAR;
            PG8_LDA(At, 0, 1); PG8_STAGE(PG8_SA(0, 0), a2, voffA);
            PG8_BAR; PG8_WAIT_L(0); PG8_MMA(1, 0, At, B0); PG8_BAR; PG8_SCHED;
            PG8_STAGE(PG8_SB(0, 1), b2 + hstep, voffB);
            PG8_WAIT_V(6); PG8_BAR; PG8_MMA(1, 1, At, B1); PG8_BAR;
            PG8_LDB(B0, 1, 0); PG8_SCHED; PG8_LDA(At, 1, 0); PG8_STAGE(PG8_SA(0, 1), a2 + hstep, voffA);
            PG8_WAIT_L(8); PG8_BAR; PG8_WAIT_L(0); PG8_MMA(0, 0, At, B0); PG8_BAR; PG8_SCHED;
            PG8_LDB(B1, 1, 1); PG8_STAGE(PG8_SB(1, 0), b3, voffB);
            PG8_BAR; PG8_WAIT_L(0); PG8_MMA(0, 1, At, B1); PG8_BAR;
            PG8_LDA(At, 1, 1); PG8_STAGE(PG8_SA(1, 0), a3, voffA);
            PG8_BAR; PG8_WAIT_L(0); PG8_MMA(1, 0, At, B0); PG8_BAR; PG8_SCHED;
            PG8_STAGE(PG8_SB(1, 1), b3 + hstep, voffB);
            PG8_WAIT_V(6); PG8_BAR; PG8_MMA(1, 1, At, B1); PG8_BAR;
        }
        E(acc, cur, wr, wc, fr, fq); S.done(cur);
        if (!has_next) break;
#pragma unroll
        for (int a = 0; a < 2; ++a)
#pragma unroll
            for (int b = 0; b < 2; ++b)
#pragma unroll
                for (int m = 0; m < 4; ++m)
#pragma unroll
                    for (int n = 0; n < 2; ++n) acc[a][b][m][n] = (f32x4){0.f, 0.f, 0.f, 0.f};
        cur = nxt; cA = nA; cB = nB; ++ui;
    }
    PG8_WAIT_V(0);
    if (wr == 0) PG8_BAR;
    PG8_BAR;
#undef PG8_SA
#undef PG8_SB
#undef PG8_STAGE
#undef PG8_LDA
#undef PG8_LDB
#undef PG8_MMA
#undef PG8_WAIT_V
#undef PG8_WAIT_L
#undef PG8_BAR
#undef PG8_SCHED
}

struct EpiRowScale {
    static constexpr bool PERM = true;
    bf16_t* O; int ldc; const LAS float* rl;
    __device__ __forceinline__ void operator()(const f32x4 (&acc)[2][2][4][2], const Unit& u, int wr, int wc, int fr, int fq) const {
        const int row0 = u.pm * BM + wr * 64 + fr, col0 = u.pn * BM + wc * 32 + 8 * fq;
#pragma unroll
        for (int ai = 0; ai < 2; ++ai)
#pragma unroll
            for (int m = 0; m < 4; ++m) { const int row = row0 + ai * HALF + m * 16; const float rs = rl[u.idx * 256 + wr * 64 + fr + ai * HALF + m * 16];
                bf16_t* rowp = O + (size_t)row * ldc + col0;
#pragma unroll
                for (int bj = 0; bj < 2; ++bj) { const f32x4 v0 = acc[ai][bj][m][0] * rs, v1 = acc[ai][bj][m][1] * rs;
                    u32x4 w; w.x = cvt_pk_bf16(v0[0], v0[1]); w.y = cvt_pk_bf16(v0[2], v0[3]); w.z = cvt_pk_bf16(v1[0], v1[1]); w.w = cvt_pk_bf16(v1[2], v1[3]);
                    *(u32x4*)(rowp + bj * HALF) = w; } }
    }
};
struct EpiColScale {
    static constexpr bool PERM = true;
    bf16_t* O; int ldc; const LAS float* rl;
    __device__ __forceinline__ void operator()(const f32x4 (&acc)[2][2][4][2], const Unit& u, int wr, int wc, int fr, int fq) const {
        const int row0 = u.pm * BM + wr * 64 + fr, col0 = u.pn * BM + wc * 32 + 8 * fq;
        f32x4 sc[2][2];
#pragma unroll
        for (int bj = 0; bj < 2; ++bj)
#pragma unroll
            for (int n = 0; n < 2; ++n) sc[bj][n] = *(const LAS f32x4*)(rl + u.idx * 256 + wc * 32 + 8 * fq + bj * HALF + 4 * n);
#pragma unroll
        for (int ai = 0; ai < 2; ++ai)
#pragma unroll
            for (int m = 0; m < 4; ++m) { const int row = row0 + ai * HALF + m * 16; bf16_t* rowp = O + (size_t)row * ldc + col0;
#pragma unroll
                for (int bj = 0; bj < 2; ++bj) { const f32x4 v0 = acc[ai][bj][m][0] * sc[bj][0], v1 = acc[ai][bj][m][1] * sc[bj][1];
                    u32x4 w; w.x = cvt_pk_bf16(v0[0], v0[1]); w.y = cvt_pk_bf16(v0[2], v0[3]); w.z = cvt_pk_bf16(v1[0], v1[1]); w.w = cvt_pk_bf16(v1[2], v1[3]);
                    *(u32x4*)(rowp + bj * HALF) = w; } }
    }
};
struct EpiGate {
    static constexpr bool PERM = true;
    const bf16_t* gate; const bf16_t* addsrc; bf16_t* O;
    __device__ __forceinline__ void operator()(const f32x4 (&acc)[2][2][4][2], const Unit& u, int wr, int wc, int fr, int fq) const {
        const int row0 = u.pm * BM + wr * 64 + fr, col0 = u.pn * BM + wc * 32 + 8 * fq;
#pragma unroll
        for (int ai = 0; ai < 2; ++ai)
#pragma unroll
            for (int m = 0; m < 4; ++m) { const int row = row0 + ai * HALF + m * 16;
#pragma unroll
                for (int bj = 0; bj < 2; ++bj) { const int col = col0 + bj * HALF;
                    float gf[8], r[8]; unpack8(*(const u32x4*)(gate + (size_t)row * NPROJ + col), gf);
                    const f32x4 v0 = acc[ai][bj][m][0], v1 = acc[ai][bj][m][1];
#pragma unroll
                    for (int j = 0; j < 4; ++j) { r[j] = v0[j] * sigmoidf_(gf[j]); r[4 + j] = v1[j] * sigmoidf_(gf[4 + j]); }
                    if (addsrc) { float af[8]; unpack8(*(const u32x4*)(addsrc + (size_t)row * D + col), af);
#pragma unroll
                        for (int j = 0; j < 8; ++j) r[j] += af[j]; }
                    *(u32x4*)(O + (size_t)row * D + col) = pack8(r); } }
    }
};
struct EpiResid {
    static constexpr bool PERM = true;
    bf16_t* xb; float* rowss;
    __device__ __forceinline__ void operator()(const f32x4 (&acc)[2][2][4][2], const Unit& u, int wr, int wc, int fr, int fq) const {
        const int row0 = u.pm * BM + wr * 64 + fr, col0 = u.pn * BM + wc * 32 + 8 * fq;
#pragma unroll
        for (int ai = 0; ai < 2; ++ai)
#pragma unroll
            for (int m = 0; m < 4; ++m) { const int row = row0 + ai * HALF + m * 16; float ss = 0.f;
#pragma unroll
                for (int bj = 0; bj < 2; ++bj) { const size_t off = (size_t)row * D + col0 + bj * HALF;
                    float b[8], r[8]; unpack8(*(const u32x4*)(xb + off), b);
                    const f32x4 v0 = acc[ai][bj][m][0], v1 = acc[ai][bj][m][1];
#pragma unroll
                    for (int j = 0; j < 4; ++j) { b[j] += v0[j]; b[4 + j] += v1[j]; }
                    const u32x4 w = pack8(b);
                    *(u32x4*)(xb + off) = w;
                    unpack8(w, r);
#pragma unroll
                    for (int j = 0; j < 8; ++j) ss += r[j] * r[j]; }
                { const int ln = fr + 16 * fq; ss += shx(ss, 16, ln); ss += shx(ss, 32, ln); }
                if (fq == 0) rowss[(size_t)row * 16 + u.pn * 4 + wc] = ss; }
    }
};
}

template <class Sched> __device__ __forceinline__ void fill_rstd(LAS float* rl, const float* rowss, const Sched& S, bool by_col) {
    const int tid = otid();
    for (int e = tid; e < 8 * 256; e += NTHREADS) { pg8::Unit u; const int i = e >> 8;
        if (S.next(i, u)) { const int r = (by_col ? u.pn : u.pm) * 256 + (e & 255); rl[e] = rsqrtf(sum16(rowss + (size_t)r * 16) * (1.0f / 1024.0f) + EPS); } }
    __syncthreads();
}

__device__ __forceinline__ int win_srccol(int nd) {
    if (nd < 1024) return nd;
    if (nd < 1536) return 1536 + (nd - 1024);
    if (nd < 2048) return 2048 + (nd - 1536);
    if (nd < 3072) return 3584 + (nd - 2048);
    if (nd < 4096) return 4608 + (nd - 3072);
    if (nd < 5120) return 5632 + (nd - 4096);
    nd -= 5120;
    if (nd < 512) return 1024 + nd;
    if (nd < 1024) return 2048 + (nd - 512);
    return 2560 + (nd - 1024);
}
__device__ __forceinline__ void conv_tile(const float* __restrict__ src, int ld_src, int k0, int nsrc0, bf16_t* dst, int ldd, int ndst0, const float* gsc, LAS float* tile) {
    const int t = otid();
#pragma unroll
    for (int i = 0; i < 2; ++i) { const int r = (t >> 4) + 32 * i, c = (t & 15) * 4;
        const float4 v = *(const float4*)(src + (size_t)(k0 + r) * ld_src + nsrc0 + c);
        const float s = gsc ? gsc[k0 + r] : 1.0f;
        tile[r * 65 + c] = v.x * s; tile[r * 65 + c + 1] = v.y * s; tile[r * 65 + c + 2] = v.z * s; tile[r * 65 + c + 3] = v.w * s; }
    __syncthreads();
    { const int n = t >> 3, k8 = (t & 7) * 8; float f[8];
#pragma unroll
      for (int j = 0; j < 8; ++j) f[j] = tile[(k8 + j) * 65 + n];
      *(u32x4*)(dst + (size_t)(ndst0 + n) * ldd + k0 + k8) = pack8(f); }
    __syncthreads();
}
__device__ __forceinline__ void phase_prologue(const Params& P, LAS unsigned char* lds) {
    LAS float* tile = (LAS float*)lds;
    constexpr int T_IN = 16 * 112, T_A = 8 * 16, T_R = 16 * 16, T_O = 16 * 16, T_UP = 16 * 88, T_D = 44 * 16, T_L = T_IN + T_A + T_R + T_O + T_UP + T_D;
    for (int job = blockIdx.x; job < T_L * DEPTH; job += ogrid()) {
        const int l = job / T_L; int r = job % T_L;
        unsigned char* wl = P.ws + WS_W + (size_t)l * W_LAYER;
        if (r < T_IN) { const int kt = r / 112, ntile = r % 112; conv_tile(P.w_in + (size_t)l * D * DIN, DIN, kt * 64, win_srccol(ntile * 64), (bf16_t*)(wl + W_IN_OFF), 1024, ntile * 64, P.norm_mix_g + l * D, tile); continue; }
        r -= T_IN;
        if (r < T_A) { const int kt = r / 16, ntile = r % 16; conv_tile(P.w_ba + (size_t)l * 512 * D, D, kt * 64, ntile * 64, (bf16_t*)(wl + W_A_OFF), 512, ntile * 64, nullptr, tile); continue; }
        r -= T_A;
        if (r < T_R) { const int kt = r / 16, ntile = r % 16; conv_tile(P.w_br + (size_t)l * D * D, D, kt * 64, ntile * 64, (bf16_t*)(wl + W_R_OFF), 1024, ntile * 64, nullptr, tile); continue; }
        r -= T_R;
        if (r < T_O) { const int kt = r / 16, ntile = r % 16; conv_tile(P.w_out + (size_t)l * D * D, D, kt * 64, ntile * 64, (bf16_t*)(wl + W_O_OFF), 1024, ntile * 64, nullptr, tile); continue; }
        r -= T_O;
        if (r < T_UP) { const int kt = r / 88, ntile = r % 88; conv_tile(P.w_up + (size_t)l * D * DFF2, DFF2, kt * 64, ntile * 64, (bf16_t*)(wl + W_UP_OFF), 1024, ntile * 64, P.norm_ffn_g + l * D, tile); continue; }
        r -= T_UP;
        { const int kt = r / 16, ntile = r % 16; conv_tile(P.w_down + (size_t)l * DFF * D, D, kt * 64, ntile * 64, (bf16_t*)(wl + W_D_OFF), DFF, ntile * 64, nullptr, tile); }
    }
    if (blockIdx.x == 0 && otid() < DEPTH * 4) { const int i = otid(); float* tab = (float*)(P.ws + WS_LG2);
        tab[2 * i] = -log1pf(expf(-P.dec_f[i])) * 1.4426950408889634f; tab[2 * i + 1] = -log1pf(expf(-P.dec_b[i])) * 1.4426950408889634f; }
    float* cosN = (float*)(P.ws + WS_COSN); float* sinN = (float*)(P.ws + WS_SINN); float* cosT = (float*)(P.ws + WS_COST); float* sinT = (float*)(P.ws + WS_SINT);
    for (int idx = blockIdx.x * NTHREADS + otid(); idx < 16384 * 64; idx += ogrid() * NTHREADS) {
        const int pos = idx >> 6, i = idx & 63;
        const float invf = powf(10000.0f, -(float)i / 64.0f);
        const float ang = (float)pos * invf;
        const float c = cosf(ang), s = sinf(ang);
        cosN[idx] = c; sinN[idx] = s; cosT[(size_t)i * 16384 + pos] = c; sinT[(size_t)i * 16384 + pos] = s;
    }
}

__device__ __forceinline__ void phase_init(const float* __restrict__ xin, bf16_t* xb, float* rowss1, float* rowss2) {
    const int tid = otid(), lane = tid & 63, nw = ogrid() * 8;
    for (int row = blockIdx.x * 8 + (tid >> 6); row < MG; row += nw) {
        const float4* p = (const float4*)(xin + (size_t)row * D); float ss = 0.f;
#pragma unroll
        for (int i = 0; i < 4; ++i) { const float4 v = p[lane + 64 * i];
            u32x2 w; w.x = cvt_pk_bf16(v.x, v.y); w.y = cvt_pk_bf16(v.z, v.w); *(u32x2*)(xb + (size_t)row * D + (lane + 64 * i) * 4) = w;
            const float a0 = bf_lo(w.x), a1 = bf_hi(w.x), a2 = bf_lo(w.y), a3 = bf_hi(w.y); ss += a0 * a0 + a1 * a1 + a2 * a2 + a3 * a3; }
        ss = wave_sum(ss, lane);
        if (lane < 16) rowss1[(size_t)row * 16 + lane] = lane == 0 ? ss : 0.f;
    }
}
__device__ __forceinline__ void phase_final(const bf16_t* __restrict__ xb, float* xo, const float* rowss1, const float* __restrict__ gfin) {
    const int tid = otid(), lane = tid & 63, nw = ogrid() * 8;
    for (int row = blockIdx.x * 8 + (tid >> 6); row < MG; row += nw) {
        const float rs = rsqrtf(sum16(rowss1 + (size_t)row * 16) * (1.0f / 1024.0f) + EPS);
#pragma unroll
        for (int i = 0; i < 2; ++i) { const int c8 = (lane + 64 * i) * 8; float x[8]; unpack8(*(const u32x4*)(xb + (size_t)row * D + c8), x);
            const f32x4 g0 = *(const f32x4*)(gfin + c8), g1 = *(const f32x4*)(gfin + c8 + 4);
            *(f32x4*)(xo + (size_t)row * D + c8) = (f32x4){x[0] * rs * g0[0], x[1] * rs * g0[1], x[2] * rs * g0[2], x[3] * rs * g0[3]};
            *(f32x4*)(xo + (size_t)row * D + c8 + 4) = (f32x4){x[4] * rs * g1[0], x[5] * rs * g1[1], x[6] * rs * g1[2], x[7] * rs * g1[3]}; }
    }
}
__device__ __forceinline__ float gelu_tanh(float x) { const float t = fmaf(x * x, -0.10294324f, -2.30220819f);
    return x * __builtin_amdgcn_rcpf(1.0f + __builtin_amdgcn_exp2f(x * t)); }
__device__ __forceinline__ void phase_convact(const bf16_t* __restrict__ u, bf16_t* act, const float* __restrict__ cw  , int seqlen, float* rowss2) {
    const int gt = blockIdx.x * NTHREADS + otid(), nth = ogrid() * NTHREADS;
    for (int id = gt; id < 2048 * 352; id += nth) {
        const int tb = id / 352, c = (id % 352) * 8, t0 = tb * 8;
        const u32x4 z = (u32x4){0u, 0u, 0u, 0u};
        u32x4 g[10], v[10];
        const bool has_prev = (t0 & (seqlen - 1)) != 0, has_next = ((t0 + 8) & (seqlen - 1)) != 0;
#pragma unroll
        for (int r = 0; r < 10; ++r) { const bool ok = (r == 0) ? has_prev : ((r == 9) ? has_next : true);
            g[r] = z; v[r] = z;
            if (ok) { g[r] = *(const u32x4*)(u + (size_t)(t0 - 1 + r) * DFF2 + c); v[r] = *(const u32x4*)(u + (size_t)(t0 - 1 + r) * DFF2 + DFF + c); } }
        float wg[3][8], wv[3][8];
#pragma unroll
        for (int k = 0; k < 3; ++k) {
            const f32x4 a0 = *(const f32x4*)(cw + k * DFF2 + c), a1 = *(const f32x4*)(cw + k * DFF2 + c + 4);
            const f32x4 b0 = *(const f32x4*)(cw + k * DFF2 + DFF + c), b1 = *(const f32x4*)(cw + k * DFF2 + DFF + c + 4);
#pragma unroll
            for (int j = 0; j < 4; ++j) { wg[k][j] = a0[j]; wg[k][4 + j] = a1[j]; wv[k][j] = b0[j]; wv[k][4 + j] = b1[j]; } }
#pragma unroll
        for (int i = 0; i < 8; ++i) {
            float a[8], b[8], cc[8], r[8], gg[8], vv[8];
            unpack8(g[i], a); unpack8(g[i + 1], b); unpack8(g[i + 2], cc);
#pragma unroll
            for (int j = 0; j < 8; ++j) gg[j] = a[j] * wg[0][j] + b[j] * wg[1][j] + cc[j] * wg[2][j];
            unpack8(v[i], a); unpack8(v[i + 1], b); unpack8(v[i + 2], cc);
#pragma unroll
            for (int j = 0; j < 8; ++j) vv[j] = a[j] * wv[0][j] + b[j] * wv[1][j] + cc[j] * wv[2][j];
#pragma unroll
            for (int j = 0; j < 8; ++j) r[j] = gelu_tanh(gg[j]) * vv[j];
            *(u32x4*)(act + (size_t)(t0 + i) * DFF + c) = pack8(r);
        }
    }
}

constexpr int NA_LDS_WAVE = 12288;
struct NaFrags { bf16x8 k[4]; u32x2 v[2][2][2]; };
__device__ __forceinline__ void na_load(NaFrags& f, const bf16_t* __restrict__ proj, const bf16_t* __restrict__ projT, int ktok, int h, int c, int hh) {
    const bf16_t* kp = proj + (size_t)(ktok + c) * NPROJ + 512 + h * 64 + 8 * hh;
#pragma unroll
    for (int s = 0; s < 4; ++s) f.k[s] = *(const bf16x8*)(kp + 16 * s);
#pragma unroll
    for (int dt = 0; dt < 2; ++dt)
#pragma unroll
        for (int s2 = 0; s2 < 2; ++s2) { const bf16_t* vp = projT + (size_t)(h * 64 + dt * 32 + c) * MG + (ktok + 16 * s2 + 4 * hh);
            f.v[dt][s2][0] = *(const u32x2*)vp; f.v[dt][s2][1] = *(const u32x2*)(vp + 8); }
}
__device__ __forceinline__ void na_item(const bf16_t* __restrict__ proj, const bf16_t* __restrict__ projT, bf16_t* aout, const float* __restrict__ relb  , int item, int seqlen, LAS unsigned char* lds, int w, int lane) {
    const int c = lane & 31, hh = lane >> 5;
    const int R = item >> 3, h = item & 7;
    const int rps = seqlen >> 6, seq = R / rps, r = R % rps;
    int rs = r - 4; rs = rs < 0 ? 0 : rs; rs = rs > rps - 8 ? rps - 8 : rs;
    const int qtok0 = seq * seqlen + r * 64, ktok0 = seq * seqlen + rs * 64;
    LAS float* bias = (LAS float*)(lds + w * NA_LDS_WAVE) + 64;
    LAS bf16_t* Otile = (LAS bf16_t*)(lds + w * NA_LDS_WAVE + 3072);
    for (int i = lane; i < 768; i += 64) { const int j = i - 64; bias[j] = (j >= 0 && j < 465) ? relb[h * 465 + j] * 1.4426950408889634f : 0.f; }
    bf16x8 qf[2][4];
#pragma unroll
    for (int qh = 0; qh < 2; ++qh) { const bf16_t* qp = proj + (size_t)(qtok0 + 32 * qh + c) * NPROJ + h * 64 + 8 * hh;
#pragma unroll
        for (int s = 0; s < 4; ++s) qf[qh][s] = *(const bf16x8*)(qp + 16 * s); }
    f32x16 O[2][2];
    float mrun[2], lrun[2]; int cs[2];
#pragma unroll
    for (int qh = 0; qh < 2; ++qh) { O[qh][0] = zero16(); O[qh][1] = zero16(); mrun[qh] = -1e30f; lrun[qh] = 0.f;
        int x = 32 * qh + c - 8; x = x < 0 ? 0 : x; x = x > 48 ? 48 : x; cs[qh] = x; }
    NaFrags cur, nxt;
    na_load(cur, proj, projT, ktok0, h, c, hh);
#pragma unroll 1
    for (int t = 0; t < 16; ++t) {
        if (t + 1 < 16) na_load(nxt, proj, projT, ktok0 + 32 * (t + 1), h, c, hh);
        const int kr = rs + (t >> 1), chalf = t & 1, brow = (kr - r + 7) * 31;
#pragma unroll
        for (int qh = 0; qh < 2; ++qh) {
            f32x16 x = zero16();
#pragma unroll
            for (int s = 0; s < 4; ++s) x = mfma32(cur.k[s], qf[qh][s], x);
            const int qc = 32 * qh + c; float mt = -1e30f;
#pragma unroll
            for (int rg = 0; rg < 16; ++rg) { const int kc = 32 * chalf + (rg & 3) + 8 * (rg >> 2) + 4 * hh;
                const bool valid = (kc >= cs[qh]) && (kc < cs[qh] + 16);
                const float sv = fmaf(x[rg], 0.18033688011112042f, bias[brow + kc - qc + 15]) + (valid ? 0.f : -__builtin_inff());
                x[rg] = sv; mt = fmaxf(mt, sv); }
            mt = fmaxf(mt, shx(mt, 32, lane));
            const float mnew = fmaxf(mrun[qh], mt), alpha = __builtin_amdgcn_exp2f(mrun[qh] - mnew);
            const bool grew = mnew > mrun[qh];
            mrun[qh] = mnew;
            float ps = 0.f;
#pragma unroll
            for (int rg = 0; rg < 16; ++rg) { const float p = __builtin_amdgcn_exp2f(x[rg] - mnew); x[rg] = p; ps += p; }
            lrun[qh] = lrun[qh] * alpha + ps;
            if (__builtin_amdgcn_ballot_w64(grew) != 0ull) { O[qh][0] *= alpha; O[qh][1] *= alpha; }
#pragma unroll
            for (int s2 = 0; s2 < 2; ++s2) {
                u32x4 pw; pw.x = cvt_pk_bf16(x[8 * s2 + 0], x[8 * s2 + 1]); pw.y = cvt_pk_bf16(x[8 * s2 + 2], x[8 * s2 + 3]); pw.z = cvt_pk_bf16(x[8 * s2 + 4], x[8 * s2 + 5]); pw.w = cvt_pk_bf16(x[8 * s2 + 6], x[8 * s2 + 7]);
                const bf16x8 pb = __builtin_bit_cast(bf16x8, pw);
#pragma unroll
                for (int dt = 0; dt < 2; ++dt) { u32x4 aw; aw.x = cur.v[dt][s2][0].x; aw.y = cur.v[dt][s2][0].y; aw.z = cur.v[dt][s2][1].x; aw.w = cur.v[dt][s2][1].y;
                    O[qh][dt] = mfma32(__builtin_bit_cast(bf16x8, aw), pb, O[qh][dt]); } }
        }
        cur = nxt;
    }
#pragma unroll
    for (int qh = 0; qh < 2; ++qh) { const float inv = 1.0f / (lrun[qh] + shx(lrun[qh], 32, lane));
#pragma unroll
        for (int dt = 0; dt < 2; ++dt)
#pragma unroll
            for (int g4 = 0; g4 < 4; ++g4) { u32x2 pw; pw.x = cvt_pk_bf16(O[qh][dt][4 * g4] * inv, O[qh][dt][4 * g4 + 1] * inv); pw.y = cvt_pk_bf16(O[qh][dt][4 * g4 + 2] * inv, O[qh][dt][4 * g4 + 3] * inv);
                *(LAS u32x2*)(Otile + (32 * qh + c) * 72 + dt * 32 + 8 * g4 + 4 * hh) = pw; } }
#pragma unroll
    for (int i = 0; i < 8; ++i) { const int id = lane + 64 * i, q = id >> 3, d8 = (id & 7) * 8;
        *(u32x4*)(aout + (size_t)(qtok0 + q) * 512 + h * 64 + d8) = *(const LAS u32x4*)(Otile + q * 72 + d8); }
}

constexpr int KT_STRIDE = 136;
__device__ __forceinline__ void r1_item(const bf16_t* __restrict__ projT, bf16_t* stloc, const float* __restrict__ cosT, const float* __restrict__ sinT, float lgf2, float lgb2, int item, int seqlen, LAS unsigned char* lds) {
    const int tid = otid(), w = __builtin_amdgcn_readfirstlane(tid >> 6), lane = tid & 63, c = lane & 31, hh = lane >> 5;
    const int ch = item >> 2, h = item & 3, tok0 = ch * 128, pos0 = tok0 % seqlen;
    LAS bf16_t* KTf = (LAS bf16_t*)lds; LAS bf16_t* KTb = (LAS bf16_t*)(lds + 128 * KT_STRIDE * 2);
    const float scale = 0.08838834764831845f;
    bf16x8 af[8];
    { const bf16_t* vp = projT + (size_t)(1024 + h * 256 + 32 * w + c) * MG + tok0 + 8 * hh;
#pragma unroll
      for (int s = 0; s < 8; ++s) af[s] = *(const bf16x8*)(vp + 16 * s); }
#pragma unroll
    for (int it = 0; it < 2; ++it) {
        const int id = tid + NTHREADS * it, d = id >> 4, t8 = id & 15;
        float k1[8], k2[8];
        unpack8(*(const u32x4*)(projT + (size_t)(512 + h * 128 + d) * MG + tok0 + 8 * t8), k1);
        unpack8(*(const u32x4*)(projT + (size_t)(512 + h * 128 + d + 64) * MG + tok0 + 8 * t8), k2);
        const f32x4 c0 = *(const f32x4*)(cosT + (size_t)d * 16384 + pos0 + 8 * t8), c1 = *(const f32x4*)(cosT + (size_t)d * 16384 + pos0 + 8 * t8 + 4);
        const f32x4 s0 = *(const f32x4*)(sinT + (size_t)d * 16384 + pos0 + 8 * t8), s1 = *(const f32x4*)(sinT + (size_t)d * 16384 + pos0 + 8 * t8 + 4);
        float f1[8], f2[8], b1[8], b2[8];
#pragma unroll
        for (int j = 0; j < 8; ++j) { const float cv = j < 4 ? c0[j & 3] : c1[j & 3], sv = j < 4 ? s0[j & 3] : s1[j & 3];
            const float r1 = (k1[j] * cv - k2[j] * sv) * scale, r2 = (k1[j] * sv + k2[j] * cv) * scale;
            const int tl = 8 * t8 + j; const float df = __builtin_amdgcn_exp2f((float)(127 - tl) * lgf2), db = __builtin_amdgcn_exp2f((float)tl * lgb2);
            f1[j] = r1 * df; f2[j] = r2 * df; b1[j] = r1 * db; b2[j] = r2 * db; }
        *(LAS u32x4*)(KTf + d * KT_STRIDE + 8 * t8) = pack8(f1); *(LAS u32x4*)(KTf + (d + 64) * KT_STRIDE + 8 * t8) = pack8(f2);
        *(LAS u32x4*)(KTb + d * KT_STRIDE + 8 * t8) = pack8(b1); *(LAS u32x4*)(KTb + (d + 64) * KT_STRIDE + 8 * t8) = pack8(b2);
    }
    __syncthreads();
#pragma unroll
    for (int dir = 0; dir < 2; ++dir) {
        LAS bf16_t* KT = dir ? KTb : KTf;
        bf16_t* dst = stloc + ((size_t)(ch * 4 + h) * 2 + dir) * 32768;
#pragma unroll
        for (int ct = 0; ct < 4; ++ct) {
            f32x16 acc = zero16();
#pragma unroll
            for (int s = 0; s < 8; ++s) { const bf16x8 bfr = *(const LAS bf16x8*)(KT + (32 * ct + c) * KT_STRIDE + 16 * s + 8 * hh); acc = mfma32(af[s], bfr, acc); }
#pragma unroll
            for (int rg = 0; rg < 16; ++rg) { const int dv = 32 * w + (rg & 3) + 8 * (rg >> 2) + 4 * hh; dst[dv * 128 + 32 * ct + c] = (bf16_t)(cvt_pk_bf16(acc[rg], 0.f) & 0xffffu); }
        }
    }
    __syncthreads();
}

__device__ __forceinline__ void phase_scan(const bf16_t* __restrict__ stloc, bf16_t* st, const float* __restrict__ decf, const float* __restrict__ decb, int seqlen) {
    const int gt = blockIdx.x * NTHREADS + otid(), nth = ogrid() * NTHREADS;
    constexpr size_t CSTR = (size_t)4 * 2 * 32768;
    if (seqlen == 4096) {
        constexpr int NCH = 32, NTASK = 4 * 4 * 2 * 4096;
        for (int id = gt; id < NTASK; id += nth) {
            const int e8 = id & 4095, dir = (id >> 12) & 1, h = (id >> 13) & 3, seq = id >> 15;
            const float x = dir ? decb[h] : decf[h]; const float cd = exp2f(-128.0f * log1pf(expf(-x)) * 1.4426950408889634f);
            const size_t base = ((size_t)(seq * NCH * 4 + h) * 2 + dir) * 32768 + (size_t)e8 * 8;
            float zz = 0.f; asm volatile("" : "+v"(zz));
            float S[8];
#pragma unroll
            for (int j = 0; j < 8; ++j) S[j] = zz;
            for (int i0 = 0; i0 < NCH; i0 += 8) {
                u32x4 loc[8];
#pragma unroll
                for (int j = 0; j < 8; ++j) { const int ci = dir ? (NCH - 1 - (i0 + j)) : (i0 + j); loc[j] = *(const u32x4*)(stloc + base + (size_t)ci * CSTR); }
#pragma unroll
                for (int j = 0; j < 8; ++j) { const int ci = dir ? (NCH - 1 - (i0 + j)) : (i0 + j);
                    *(u32x4*)(st + base + (size_t)ci * CSTR) = pack8(S);
                    float lf[8]; unpack8(loc[j], lf);
#pragma unroll
                    for (int k = 0; k < 8; ++k) S[k] = S[k] * cd + lf[k]; }
            }
        }
    } else {
        constexpr int NCH = 128, NTASK = 4 * 2 * 16384;
        for (int id = gt; id < NTASK; id += nth) {
            const int e2 = id & 16383, dir = (id >> 14) & 1, h = (id >> 15) & 3;
            const float x = dir ? decb[h] : decf[h]; const float cd = exp2f(-128.0f * log1pf(expf(-x)) * 1.4426950408889634f);
            const size_t base = ((size_t)h * 2 + dir) * 32768 + (size_t)e2 * 2;
            float zz = 0.f; asm volatile("" : "+v"(zz));
            float S0 = zz, S1 = zz;
            for (int i0 = 0; i0 < NCH; i0 += 8) {
                unsigned loc[8];
#pragma unroll
                for (int j = 0; j < 8; ++j) { const int ci = dir ? (NCH - 1 - (i0 + j)) : (i0 + j); loc[j] = *(const unsigned*)(stloc + base + (size_t)ci * CSTR); }
#pragma unroll
                for (int j = 0; j < 8; ++j) { const int ci = dir ? (NCH - 1 - (i0 + j)) : (i0 + j);
                    *(unsigned*)(st + base + (size_t)ci * CSTR) = cvt_pk_bf16(S0, S1);
                    S0 = S0 * cd + bf_lo(loc[j]); S1 = S1 * cd + bf_hi(loc[j]); }
            }
        }
    }
}

constexpr int OL_STRIDE = 264;
__device__ __forceinline__ void r3_item(const bf16_t* __restrict__ proj, const bf16_t* __restrict__ projT, const bf16_t* __restrict__ st, bf16_t* ro,
                        const float* __restrict__ cosN, const float* __restrict__ sinN, const float* __restrict__ gn  , float lgf2, float lgb2,
                        int item, int seqlen, LAS unsigned char* lds) {
    const int tid = otid(), w = __builtin_amdgcn_readfirstlane(tid >> 6), lane = tid & 63, c = lane & 31, hh = lane >> 5;
    const int ch = item >> 2, h = item & 3, tok0 = ch * 128, pos0 = tok0 % seqlen;
    LAS bf16_t* Ql = (LAS bf16_t*)lds; LAS bf16_t* Kl = (LAS bf16_t*)(lds + 34816); LAS bf16_t* Pl = (LAS bf16_t*)(lds + 69632);
    LAS float* stat = (LAS float*)(lds + 104448);
    LAS bf16_t* Ol = (LAS bf16_t*)lds;
    const float scale = 0.08838834764831845f;
    bf16x8 asb[8], asf[8], avt[8];
    const size_t stb0 = ((size_t)(ch * 4 + h) * 2) * 32768 + (size_t)(32 * w + c) * 128 + 8 * hh;
#pragma unroll
    for (int s = 0; s < 8; ++s) asb[s] = *(const bf16x8*)(st + stb0 + 32768 + 16 * s);
#pragma unroll
    for (int it = 0; it < 2; ++it) {
        const int id = tid + NTHREADS * it, t = id >> 3, d8 = (id & 7) * 8;
        const f32x4 c0 = *(const f32x4*)(cosN + (size_t)(pos0 + t) * 64 + d8), c1 = *(const f32x4*)(cosN + (size_t)(pos0 + t) * 64 + d8 + 4);
        const f32x4 s0 = *(const f32x4*)(sinN + (size_t)(pos0 + t) * 64 + d8), s1 = *(const f32x4*)(sinN + (size_t)(pos0 + t) * 64 + d8 + 4);
        float a[8], b[8], o1[8], o2[8];
        const bf16_t* qp = proj + (size_t)(tok0 + t) * NPROJ + 1024 + h * 128 + d8;
        unpack8(*(const u32x4*)qp, a); unpack8(*(const u32x4*)(qp + 64), b);
#pragma unroll
        for (int j = 0; j < 8; ++j) { const float cv = j < 4 ? c0[j & 3] : c1[j & 3], sv = j < 4 ? s0[j & 3] : s1[j & 3]; o1[j] = a[j] * cv - b[j] * sv; o2[j] = a[j] * sv + b[j] * cv; }
        *(LAS u32x4*)(Ql + t * KT_STRIDE + d8) = pack8(o1); *(LAS u32x4*)(Ql + t * KT_STRIDE + 64 + d8) = pack8(o2);
        const bf16_t* kp = proj + (size_t)(tok0 + t) * NPROJ + 1536 + h * 128 + d8;
        unpack8(*(const u32x4*)kp, a); unpack8(*(const u32x4*)(kp + 64), b);
#pragma unroll
        for (int j = 0; j < 8; ++j) { const float cv = j < 4 ? c0[j & 3] : c1[j & 3], sv = j < 4 ? s0[j & 3] : s1[j & 3]; o1[j] = (a[j] * cv - b[j] * sv) * scale; o2[j] = (a[j] * sv + b[j] * cv) * scale; }
        *(LAS u32x4*)(Kl + t * KT_STRIDE + d8) = pack8(o1); *(LAS u32x4*)(Kl + t * KT_STRIDE + 64 + d8) = pack8(o2);
    }
    __syncthreads();
    { const int kt = w >> 1;
#pragma unroll
      for (int q2 = 0; q2 < 2; ++q2) { const int tqt = 2 * (w & 1) + q2;
          f32x16 x = zero16();
#pragma unroll
          for (int s = 0; s < 8; ++s) { const bf16x8 kf = *(const LAS bf16x8*)(Kl + (32 * kt + c) * KT_STRIDE + 16 * s + 8 * hh);
              const bf16x8 qf = *(const LAS bf16x8*)(Ql + (32 * tqt + c) * KT_STRIDE + 16 * s + 8 * hh); x = mfma32(kf, qf, x); }
          const int n = 32 * tqt + c;
#pragma unroll
          for (int g4 = 0; g4 < 4; ++g4) { float pv[4];
#pragma unroll
              for (int j = 0; j < 4; ++j) { const int mk = 32 * kt + 8 * g4 + 4 * hh + j; const int diff = n - mk;
                  const float dec = __builtin_amdgcn_exp2f(diff >= 0 ? (float)diff * lgf2 : (float)(-diff) * lgb2); pv[j] = x[4 * g4 + j] * dec; }
              u32x2 pw; pw.x = cvt_pk_bf16(pv[0], pv[1]); pw.y = cvt_pk_bf16(pv[2], pv[3]);
              *(LAS u32x2*)(Pl + n * KT_STRIDE + 32 * kt + 8 * g4 + 4 * hh) = pw; } } }
    __syncthreads();
    f32x16 acc[4];
#pragma unroll
    for (int q = 0; q < 4; ++q) acc[q] = zero16();
    { const bf16_t* vp0 = projT + (size_t)(1024 + h * 256 + 32 * w + c) * MG + tok0 + 8 * hh;
#pragma unroll
      for (int s = 0; s < 8; ++s) { asf[s] = *(const bf16x8*)(st + stb0 + 16 * s); avt[s] = *(const bf16x8*)(vp0 + 16 * s); } }
#pragma unroll
    for (int s = 0; s < 8; ++s) { const bf16x8 a = asb[s];
#pragma unroll
        for (int q = 0; q < 4; ++q) { const bf16x8 b = *(const LAS bf16x8*)(Ql + (32 * q + c) * KT_STRIDE + 16 * s + 8 * hh); acc[q] = mfma32(a, b, acc[q]); } }
#pragma unroll
    for (int q = 0; q < 4; ++q) { const int n = 32 * q + c; const float f = __builtin_amdgcn_exp2f((float)(128 - n) * lgb2 - (float)(n + 1) * lgf2); acc[q] *= f; }
#pragma unroll
    for (int s = 0; s < 8; ++s) { const bf16x8 a = asf[s];
#pragma unroll
        for (int q = 0; q < 4; ++q) { const bf16x8 b = *(const LAS bf16x8*)(Ql + (32 * q + c) * KT_STRIDE + 16 * s + 8 * hh); acc[q] = mfma32(a, b, acc[q]); } }
#pragma unroll
    for (int q = 0; q < 4; ++q) { const int n = 32 * q + c; const float f = __builtin_amdgcn_exp2f((float)(n + 1) * lgf2); acc[q] *= f; }
#pragma unroll
    for (int s = 0; s < 8; ++s) { const bf16x8 a = avt[s];
#pragma unroll
        for (int q = 0; q < 4; ++q) { const bf16x8 b = *(const LAS bf16x8*)(Pl + (32 * q + c) * KT_STRIDE + 16 * s + 8 * hh); acc[q] = mfma32(a, b, acc[q]); } }
#pragma unroll
    for (int q = 0; q < 4; ++q) { float s1 = 0.f, s2 = 0.f;
#pragma unroll
        for (int i = 0; i < 16; ++i) { s1 += acc[q][i]; s2 += acc[q][i] * acc[q][i]; }
        s1 += shx(s1, 32, lane); s2 += shx(s2, 32, lane);
        if (hh == 0) { stat[(w * 128 + 32 * q + c) * 2] = s1; stat[(w * 128 + 32 * q + c) * 2 + 1] = s2; } }
    __syncthreads();
#pragma unroll
    for (int q = 0; q < 4; ++q) { float s1 = 0.f, s2 = 0.f; const int n = 32 * q + c;
#pragma unroll
        for (int k = 0; k < 8; ++k) { s1 += stat[(k * 128 + n) * 2]; s2 += stat[(k * 128 + n) * 2 + 1]; }
        const float mu = s1 * (1.0f / 256.0f); float var = s2 * (1.0f / 256.0f) - mu * mu; var = var < 0.f ? 0.f : var; const float rs = rsqrtf(var + EPS);
#pragma unroll
        for (int g4 = 0; g4 < 4; ++g4) { u32x2 pw; pw.x = cvt_pk_bf16((acc[q][4 * g4] - mu) * rs, (acc[q][4 * g4 + 1] - mu) * rs); pw.y = cvt_pk_bf16((acc[q][4 * g4 + 2] - mu) * rs, (acc[q][4 * g4 + 3] - mu) * rs);
            *(LAS u32x2*)(Ol + n * OL_STRIDE + 32 * w + 8 * g4 + 4 * hh) = pw; } }
    __syncthreads();
#pragma unroll
    for (int it = 0; it < 8; ++it) { const int id = tid + NTHREADS * it, tq = id >> 5, d8 = (id & 31) * 8;
        float y[8], rg[8], o[8]; unpack8(*(const LAS u32x4*)(Ol + tq * OL_STRIDE + d8), y);
        unpack8(*(const u32x4*)(proj + (size_t)(tok0 + tq) * NPROJ + 2048 + h * 256 + d8), rg);
        const f32x4 g0 = *(const f32x4*)(gn + h * 256 + d8), g1 = *(const f32x4*)(gn + h * 256 + d8 + 4);
#pragma unroll
        for (int j = 0; j < 8; ++j) { const float gv = j < 4 ? g0[j & 3] : g1[j & 3]; o[j] = rg[j] * sigmoidf_(rg[j]) * y[j] * gv; }
        *(u32x4*)(ro + (size_t)(tok0 + tq) * D + h * 256 + d8) = pack8(o); }
    __syncthreads();
}


#define XB_TMO      128
#define XB_XCNT(j)  (256  + 64 * (j))
#define XB_XSUB(j)  (1280 + 64 * (j))
#define XB_XGEN(j)  (2304 + 64 * (j))
#define XB_TOP      3328
#define XB_TOPGEN   3392
#define XCD_BAR_WORDS 3456
#define XB_SPIN_CAP (1u << 22)
__device__ __forceinline__ unsigned xb_ld(unsigned* p)              { return __hip_atomic_load(p, __ATOMIC_RELAXED, __HIP_MEMORY_SCOPE_AGENT); }
__device__ __forceinline__ unsigned xb_add(unsigned* p, unsigned v) { return __hip_atomic_fetch_add(p, v, __ATOMIC_RELAXED, __HIP_MEMORY_SCOPE_AGENT); }
__device__ __forceinline__ unsigned xb_xcc_id() { return (unsigned)__builtin_amdgcn_s_getreg((3 << 11) | 20) & 0xFu; }
#define XB_SPIN(cond, bar) do { unsigned _sp = 0; while (cond) { __builtin_amdgcn_s_sleep(1); \
    if ((++_sp & 255u) == 0u) { if (xb_ld(&(bar)[XB_TMO])) break; if (_sp > XB_SPIN_CAP) { atomicAdd(&(bar)[XB_TMO], 1u); break; } } } } while (0)
struct XcdBarrier { unsigned* bar; unsigned x; volatile LAS unsigned* st; };
__device__ __forceinline__ XcdBarrier xcd_barrier_post(unsigned* bar, volatile LAS unsigned* st) {
    XcdBarrier b; b.bar = bar; b.x = xb_xcc_id(); b.st = st;
    if (threadIdx.x == 0) (void)xb_add(&bar[XB_XCNT(b.x)], 1u);
    return b;
}
__device__ __forceinline__ void xcd_barrier_complete(unsigned* bar, unsigned x, unsigned& nloc, unsigned& nx) {
    const unsigned G = gridDim.x * gridDim.y * gridDim.z;
    unsigned sum, cnt, mine, sp = 0u;
    for (;;) {
        sum = 0u; cnt = 0u; mine = 0u;
#pragma unroll
        for (unsigned j = 0; j < 16; ++j) { const unsigned c = xb_ld(&bar[XB_XCNT(j)]); sum += c; cnt += (c > 0u) ? 1u : 0u; mine = (j == x) ? c : mine; }
        if (sum == G) break;
        __builtin_amdgcn_s_sleep(1);
        if ((++sp & 255u) == 0u) { if (xb_ld(&bar[XB_TMO])) break; if (sp > XB_SPIN_CAP) { atomicAdd(&bar[XB_TMO], 1u); break; } }
    }
    nloc = mine > 0u ? mine : 1u; nx = cnt > 0u ? cnt : 1u;
}
__device__ __forceinline__ void xcd_barrier(const XcdBarrier& b) {
    asm volatile("s_waitcnt vmcnt(0)" ::: "memory");
    __syncthreads();
    if (threadIdx.x == 0) {
        unsigned* bar = b.bar;
        __builtin_amdgcn_s_waitcnt(0);
        unsigned nloc = b.st[0], nx = b.st[1];
        if (nloc == 0u) { xcd_barrier_complete(bar, b.x, nloc, nx); b.st[0] = nloc; b.st[1] = nx; }
        const unsigned old = xb_add(&bar[XB_XSUB(b.x)], 1u);
        const unsigned gen = old / nloc;
        if (old + 1u == (gen + 1u) * nloc) {
            __builtin_amdgcn_fence(__ATOMIC_RELEASE, "agent");
            asm volatile("s_waitcnt vmcnt(0)" ::: "memory");
            const unsigned og = xb_add(&bar[XB_TOP], 1u);
            const unsigned tg = og / nx;
            if (og + 1u == (tg + 1u) * nx) xb_add(&bar[XB_TOPGEN], 1u);
            else XB_SPIN(xb_ld(&bar[XB_TOPGEN]) == tg, bar);
            __builtin_amdgcn_fence(__ATOMIC_ACQUIRE, "agent");
            xb_add(&bar[XB_XGEN(b.x)], 1u);
            asm volatile("s_waitcnt vmcnt(0)" ::: "memory");
        } else {
            XB_SPIN(xb_ld(&bar[XB_XGEN(b.x)]) == gen, bar);
            __builtin_amdgcn_fence(__ATOMIC_ACQUIRE, "agent");
            asm volatile("s_waitcnt vmcnt(0)" ::: "memory");
        }
    }
    __syncthreads();
}

__device__ __forceinline__ unsigned char* opq(unsigned char* p) { asm volatile("" : "+s"(p)); return p; }
#define WSP(T, off) ((T*)(opq(P.ws) + (off)))
#define XBAR() do { XcdBarrier _b; _b.bar = (unsigned*)(opq(P.ws) + WS_CTL); _b.x = (unsigned)__builtin_amdgcn_readfirstlane((int)xb_xcc_id()); _b.st = (volatile LAS unsigned*)(lds + 131072); xcd_barrier(_b); } while (0)
__global__ void __launch_bounds__(NTHREADS, 2) fwd_megakernel(Params P) {
    extern __shared__ __attribute__((aligned(16))) unsigned char lds_raw[];
    LAS unsigned char* lds = (LAS unsigned char*)lds_raw;
    cg::grid_group grid = cg::this_grid();
    const int G = ogrid(), bid = blockIdx.x;
    volatile LAS unsigned* xst = (volatile LAS unsigned*)(lds + 131072);
    if (threadIdx.x < 4) xst[threadIdx.x] = 0u;
    __syncthreads();
    (void)xcd_barrier_post((unsigned*)(P.ws + WS_CTL), xst);

    phase_prologue(P, lds);
    grid.sync();
    XBAR();

    for (int grp = 0; grp < NGROUPS; ++grp) {
        const float* xin = grp < 4 ? P.x_prompt + (size_t)grp * MG * D : P.x_sample;
        float* xo = P.out + (size_t)grp * MG * D;
        const int seqlen = grp < 4 ? 4096 : 16384;
        phase_init(xin, WSP(bf16_t, WS_XB), WSP(float, WS_ROWSS1), WSP(float, WS_ROWSS2));
        XBAR();
        for (int l = 0; l < DEPTH; ++l) {
            const size_t wl = WS_W + (size_t)l * W_LAYER;
            { pg8::Gemm g{WSP(bf16_t, WS_XB), WSP(const bf16_t, wl + W_IN_OFF), MG, NPROJ, D}; pg8::StaticOrder S; S.init(MG, NPROJ, G, bid);
              LAS float* rl = (LAS float*)(lds + LDS_RSTD_OFF); fill_rstd(rl, WSP(float, WS_ROWSS1), S, false);
              pg8::EpiRowScale E{WSP(bf16_t, WS_PROJ), NPROJ, rl}; pg8::gemm_phase(lds, g, S, E); }
            { pg8::Gemm g{WSP(const bf16_t, wl + W_IN_OFF + (size_t)NPROJ * D * 2), WSP(bf16_t, WS_XB), NPT, MG, D}; pg8::StaticOrder S; S.init(NPT, MG, G, bid);
              LAS float* rl = (LAS float*)(lds + LDS_RSTD_OFF); fill_rstd(rl, WSP(float, WS_ROWSS1), S, true);
              pg8::EpiColScale E{WSP(bf16_t, WS_PROJT), MG, rl}; pg8::gemm_phase(lds, g, S, E); }
            XBAR();
            { { const int tid = otid(), wv = __builtin_amdgcn_readfirstlane(tid >> 6), ln = tid & 63;
                for (int it = bid * 8 + wv; it < 2048; it += G * 8) na_item(WSP(bf16_t, WS_PROJ), WSP(bf16_t, WS_PROJT), WSP(bf16_t, WS_A), P.na_rel_bias + (size_t)l * 8 * 465, it, seqlen, lds, wv, ln);
                __syncthreads(); }
              for (int it = bid; it < 512; it += G) { const int h = it & 3;
                  const float* tab = WSP(const float, WS_LG2) + (l * 4 + h) * 2; const float lgf2 = tab[0], lgb2 = tab[1];
                  r1_item(WSP(bf16_t, WS_PROJT), WSP(bf16_t, WS_STLOC), WSP(float, WS_COST), WSP(float, WS_SINT), lgf2, lgb2, it, seqlen, lds); } }
            XBAR();
            phase_scan(WSP(bf16_t, WS_STLOC), WSP(bf16_t, WS_ST), P.dec_f + l * 4, P.dec_b + l * 4, seqlen);
            XBAR();
            for (int it = bid; it < 512; it += G) { const int h = it & 3;
                const float* tab = WSP(const float, WS_LG2) + (l * 4 + h) * 2; const float lgf2 = tab[0], lgb2 = tab[1];
                r3_item(WSP(bf16_t, WS_PROJ), WSP(bf16_t, WS_PROJT), WSP(bf16_t, WS_ST), WSP(bf16_t, WS_RO), WSP(float, WS_COSN), WSP(float, WS_SINN), P.ret_norm_g + (size_t)l * 1024, lgf2, lgb2, it, seqlen, lds); }
            XBAR();
            { pg8::Gemm g{WSP(bf16_t, WS_A), WSP(const bf16_t, wl + W_A_OFF), MG, D, 512}; pg8::StaticOrder S; S.init(MG, D, G, bid);
              pg8::EpiGate E{WSP(bf16_t, WS_PROJ) + 3072, nullptr, WSP(bf16_t, WS_TMP)}; pg8::gemm_phase(lds, g, S, E); }
            { pg8::Gemm g{WSP(bf16_t, WS_RO), WSP(const bf16_t, wl + W_R_OFF), MG, D, D}; pg8::StaticOrder S; S.init(MG, D, G, bid);
              pg8::EpiGate E{WSP(bf16_t, WS_PROJ) + 4096, WSP(bf16_t, WS_TMP), WSP(bf16_t, WS_MIXED)}; pg8::gemm_phase(lds, g, S, E); }
            XBAR();
            { pg8::Gemm g{WSP(bf16_t, WS_MIXED), WSP(const bf16_t, wl + W_O_OFF), MG, D, D}; pg8::StaticOrder S; S.init(MG, D, G, bid);
              pg8::EpiResid E{WSP(bf16_t, WS_XB), WSP(float, WS_ROWSS2)}; pg8::gemm_phase(lds, g, S, E); }
            XBAR();
            { pg8::Gemm g{WSP(bf16_t, WS_XB), WSP(const bf16_t, wl + W_UP_OFF), MG, DFF2, D}; pg8::StaticOrder S; S.init(MG, DFF2, G, bid);
              LAS float* rl = (LAS float*)(lds + LDS_RSTD_OFF); fill_rstd(rl, WSP(float, WS_ROWSS2), S, false);
              pg8::EpiRowScale E{WSP(bf16_t, WS_PROJ), DFF2, rl}; pg8::gemm_phase(lds, g, S, E); }
            XBAR();
            phase_convact(WSP(bf16_t, WS_PROJ), WSP(bf16_t, WS_STLOC), P.conv_w + (size_t)l * 3 * DFF2, seqlen, WSP(float, WS_ROWSS2));
            XBAR();
            { pg8::Gemm g{WSP(bf16_t, WS_STLOC), WSP(const bf16_t, wl + W_D_OFF), MG, D, DFF}; pg8::StaticOrder S; S.init(MG, D, G, bid);
              pg8::EpiResid E{WSP(bf16_t, WS_XB), WSP(float, WS_ROWSS1)}; pg8::gemm_phase(lds, g, S, E); }
            XBAR();
        }
        phase_final(WSP(bf16_t, WS_XB), xo, WSP(float, WS_ROWSS1), P.norm_final_g);
        XBAR();
    }
}

extern "C" void kernel_launch(void* const* d_in, const int* in_sizes, int n_in, void* d_out, int out_size, void* d_ws, size_t ws_size, hipStream_t stream) {
    static int grid_blocks = 0;
    if (grid_blocks == 0) {
        if (n_in != 16 || ws_size < WS_END) { fprintf(stderr, "kernel_launch: unexpected n_in %d or ws_size %zu (< %zu)\n", n_in, ws_size, (size_t)WS_END); grid_blocks = -1; return; }
        int dev = 0, cus = 0, per_cu = 0;
        hipGetDevice(&dev);
        hipDeviceGetAttribute(&cus, hipDeviceAttributeMultiprocessorCount, dev);
        if (hipFuncSetAttribute((const void*)fwd_megakernel, hipFuncAttributeMaxDynamicSharedMemorySize, LDS_BYTES) != hipSuccess) { fprintf(stderr, "kernel_launch: hipFuncSetAttribute failed\n"); grid_blocks = -1; return; }
        hipOccupancyMaxActiveBlocksPerMultiprocessor(&per_cu, (const void*)fwd_megakernel, NTHREADS, LDS_BYTES);
        if (per_cu < 1) { fprintf(stderr, "kernel_launch: occupancy query says %d blocks per CU\n", per_cu); per_cu = 1; }
        (void)hipGetLastError();
        grid_blocks = cus;
    }
    if (grid_blocks < 0) return;
    if (hipMemsetAsync((char*)d_ws + WS_CTL, 0, 16384, stream) != hipSuccess) { fprintf(stderr, "kernel_launch: memset of barrier words failed\n"); return; }
    Params p{};
    p.x_prompt = (const float*)d_in[0]; p.x_sample = (const float*)d_in[1]; p.norm_mix_g = (const float*)d_in[2]; p.w_in = (const float*)d_in[3]; p.na_rel_bias = (const float*)d_in[4];
    p.dec_f = (const float*)d_in[5]; p.dec_b = (const float*)d_in[6]; p.ret_norm_g = (const float*)d_in[7]; p.w_ba = (const float*)d_in[8]; p.w_br = (const float*)d_in[9]; p.w_out = (const float*)d_in[10];
    p.norm_ffn_g = (const float*)d_in[11]; p.w_up = (const float*)d_in[12]; p.conv_w = (const float*)d_in[13]; p.w_down = (const float*)d_in[14]; p.norm_final_g = (const float*)d_in[15];
    p.out = (float*)d_out; p.ws = (unsigned char*)d_ws;
    void* args[] = {&p};
    hipError_t e = hipLaunchCooperativeKernel((const void*)fwd_megakernel, dim3(grid_blocks), dim3(NTHREADS), args, LDS_BYTES, stream);
    if (e != hipSuccess) fprintf(stderr, "kernel_launch: cooperative launch failed: %s (grid %d)\n", hipGetErrorString(e), grid_blocks);
}
```

```cpp
#include <hip/hip_runtime.h>
#include <hip/hip_cooperative_groups.h>
#include <cstdio>
namespace cg = cooperative_groups;

#define LAS __attribute__((address_space(3)))
typedef unsigned short bf16_t;
typedef short bf16x8 __attribute__((ext_vector_type(8)));
typedef short bf16x4 __attribute__((ext_vector_type(4)));
typedef float f32x4 __attribute__((ext_vector_type(4)));
typedef float f32x16 __attribute__((ext_vector_type(16)));
typedef unsigned u32x4 __attribute__((ext_vector_type(4)));
typedef unsigned u32x2 __attribute__((ext_vector_type(2)));

constexpr int D = 1024, MG = 16384, NPROJ = 5120, NPT = 2048, DFF = 2816, DFF2 = 5632, DEPTH = 4, NGROUPS = 5, DIN = 6656;
constexpr float EPS = 1e-6f;
constexpr int NTHREADS = 512;
constexpr int LDS_RSTD_OFF = 131072 + 1024;
constexpr int LDS_BYTES = 131072 + 1024 + 8192;

constexpr size_t WS_CTL = 0;
constexpr size_t WS_LG2 = 32768;
constexpr size_t WS_ROWSS1 = 262144;
constexpr size_t WS_ROWSS2 = WS_ROWSS1 + (size_t)MG * 16 * 4;
constexpr size_t WS_COSN = WS_ROWSS2 + (size_t)MG * 16 * 4;
constexpr size_t TAB_BYTES = (size_t)16384 * 64 * 4;
constexpr size_t WS_SINN = WS_COSN + TAB_BYTES;
constexpr size_t WS_COST = WS_SINN + TAB_BYTES;
constexpr size_t WS_SINT = WS_COST + TAB_BYTES;
constexpr size_t WS_W = WS_SINT + TAB_BYTES;
constexpr size_t W_IN_OFF = 0;
constexpr size_t W_A_OFF = W_IN_OFF + (size_t)7168 * 1024 * 2;
constexpr size_t W_R_OFF = W_A_OFF + (size_t)1024 * 512 * 2;
constexpr size_t W_O_OFF = W_R_OFF + (size_t)1024 * 1024 * 2;
constexpr size_t W_UP_OFF = W_O_OFF + (size_t)1024 * 1024 * 2;
constexpr size_t W_D_OFF = W_UP_OFF + (size_t)5632 * 1024 * 2;
constexpr size_t W_LAYER = W_D_OFF + (size_t)1024 * 2816 * 2;
constexpr size_t WS_XB = WS_W + W_LAYER * DEPTH;
constexpr size_t WS_PROJ = WS_XB + (size_t)MG * D * 2;
constexpr size_t WS_PROJT = WS_PROJ + (size_t)MG * NPROJ * 2;
constexpr size_t WS_A = WS_PROJT + (size_t)NPT * MG * 2;
constexpr size_t WS_RO = WS_A + (size_t)MG * 512 * 2;
constexpr size_t WS_TMP = WS_RO + (size_t)MG * D * 2;
constexpr size_t WS_MIXED = WS_TMP + (size_t)MG * D * 2;
constexpr size_t WS_STLOC = WS_MIXED + (size_t)MG * D * 2;
constexpr size_t WS_ST = WS_STLOC + (size_t)128 * 4 * 2 * 32768 * 4;
constexpr size_t WS_END = WS_ST + (size_t)128 * 4 * 2 * 32768 * 2;
static_assert((size_t)MG * DFF2 * 2 <= (size_t)MG * NPROJ * 2 + (size_t)NPT * MG * 2, "u must fit over proj+projT");
static_assert((size_t)MG * DFF * 2 <= (size_t)128 * 4 * 2 * 32768 * 4, "act must fit over STloc");
static_assert(WS_END <= ((size_t)1 << 30), "workspace over 1 GiB");

struct Params {
    const float* x_prompt; const float* x_sample; const float* norm_mix_g; const float* w_in; const float* na_rel_bias;
    const float* dec_f; const float* dec_b; const float* ret_norm_g; const float* w_ba; const float* w_br; const float* w_out;
    const float* norm_ffn_g; const float* w_up; const float* conv_w; const float* w_down; const float* norm_final_g;
    float* out; unsigned char* ws;
};

typedef __bf16 bf16v2_t __attribute__((ext_vector_type(2)));
typedef float f32v2_t __attribute__((ext_vector_type(2)));
__device__ __forceinline__ unsigned cvt_pk_bf16(float lo, float hi) { const f32v2_t v = {lo, hi}; const bf16v2_t r = __builtin_convertvector(v, bf16v2_t); return __builtin_bit_cast(unsigned, r); }
__device__ __forceinline__ float bf_lo(unsigned w) { return __uint_as_float(w << 16); }
__device__ __forceinline__ float bf_hi(unsigned w) { return __uint_as_float(w & 0xffff0000u); }
__device__ __forceinline__ float bf2f(bf16_t b) { return __uint_as_float(((unsigned)b) << 16); }
__device__ __forceinline__ float sigmoidf_(float x) { return __builtin_amdgcn_rcpf(1.0f + __expf(-x)); }
__device__ __forceinline__ void unpack8(const u32x4 w, float* f) { f[0] = bf_lo(w.x); f[1] = bf_hi(w.x); f[2] = bf_lo(w.y); f[3] = bf_hi(w.y); f[4] = bf_lo(w.z); f[5] = bf_hi(w.z); f[6] = bf_lo(w.w); f[7] = bf_hi(w.w); }
__device__ __forceinline__ u32x4 pack8(const float* f) { u32x4 w; w.x = cvt_pk_bf16(f[0], f[1]); w.y = cvt_pk_bf16(f[2], f[3]); w.z = cvt_pk_bf16(f[4], f[5]); w.w = cvt_pk_bf16(f[6], f[7]); return w; }
__device__ __forceinline__ f32x16 mfma32(bf16x8 a, bf16x8 b, f32x16 c) { return __builtin_amdgcn_mfma_f32_32x32x16_bf16(a, b, c, 0, 0, 0); }
__device__ __forceinline__ int otid() { int t = threadIdx.x; asm volatile("" : "+v"(t)); return t; }
__device__ __forceinline__ int ogrid() { int g = gridDim.x; asm volatile("" : "+s"(g)); return g; }
__device__ __forceinline__ f32x16 zero16() { return (f32x16){0.f, 0.f, 0.f, 0.f, 0.f, 0.f, 0.f, 0.f, 0.f, 0.f, 0.f, 0.f, 0.f, 0.f, 0.f, 0.f}; }
__device__ __forceinline__ float sum16(const float* p) { const f32x4 a = *(const f32x4*)p, b = *(const f32x4*)(p + 4), c = *(const f32x4*)(p + 8), d = *(const f32x4*)(p + 12); const f32x4 t = (a + b) + (c + d); return (t[0] + t[1]) + (t[2] + t[3]); }
__device__ __forceinline__ float shx(float v, int m, int lane) { return __int_as_float(__builtin_amdgcn_ds_bpermute((lane ^ m) << 2, __float_as_int(v))); }
__device__ __forceinline__ float wave_sum(float v, int lane) { v += shx(v, 32, lane); v += shx(v, 16, lane); v += shx(v, 8, lane); v += shx(v, 4, lane); v += shx(v, 2, lane); v += shx(v, 1, lane); return v; }

namespace pg8 {
constexpr int BM = 256, BK = 64, HALF = 128, HTB = HALF * BK * 2, STAGE_BYTES = 8 * HTB, NXCD = 8, WGM = 8;
__host__ __device__ __forceinline__ int lds_byte(int r, int c) { const int st = (r >> 4) * 2 + (c >> 5), rr = r & 15, cc = c & 31, ob = rr * 64 + cc * 2; return st * 1024 + (ob ^ (((ob >> 9) & 1) << 5)); }
__host__ __device__ __forceinline__ void stage_rc(int b, int& R, int& C) { const int st = b / 1024, sb = b % 1024, swz = sb ^ (((sb >> 9) & 1) << 5); R = (st >> 1) * 16 + swz / 64; C = (st & 1) * 32 + (swz % 64) / 2; }
__host__ __device__ __forceinline__ int perm32(int rho) { const int n = rho >> 4, i = rho & 15; return 8 * (i >> 2) + 4 * n + (i & 3); }
struct Unit { int pm, pn, idx; };
struct Gemm { const bf16_t* A; const bf16_t* Bt; int M, N, K; };
struct StaticOrder {
    int nM, nN, nwg, G, c;
    __host__ __device__ void init(int M, int N, int G_, int c_) { nM = M / BM; nN = N / BM; nwg = nM * nN; G = G_; c = c_; }
    __host__ __device__ bool next(int i, Unit& u) const {
        const long L = (long)i * G + c; if (L >= nwg) return false;
        int wgid = (int)L; { const int q = nwg / NXCD, r = nwg % NXCD, xcd = wgid % NXCD, off = wgid / NXCD; wgid = (xcd < r ? xcd * (q + 1) : r * (q + 1) + (xcd - r) * q) + off; }
        const int nig = WGM * nN, gid = wgid / nig, fm = gid * WGM, gsz = (nM - fm) < WGM ? (nM - fm) : WGM;
        u.pm = fm + ((wgid % nig) % gsz); u.pn = (wgid % nig) / gsz; return true;
    }
    __device__ __forceinline__ void a_ready(const Unit&) const {}
    __device__ __forceinline__ void done(const Unit&) const {}
};

template <class Epi, class Sched>
__device__ __forceinline__ void gemm_phase(LAS unsigned char* lds, const Gemm g, const Sched& S, const Epi& E) {
    const int tid = otid(), wid = __builtin_amdgcn_readfirstlane(tid >> 6), lane = tid & 63, wr = wid >> 2, wc = wid & 3, fr = lane & 15, fq = lane >> 4;
    const int K = g.K, nt = K / BK;
    unsigned voffA[2], voffB[2];
#pragma unroll
    for (int i = 0; i < 2; ++i) { int R, C; stage_rc(tid * 16 + i * 8192, R, C); const int Rb = Epi::PERM ? ((R & ~31) + perm32(R & 31)) : R;
        voffA[i] = (unsigned)(R * K + C) * 2u; voffB[i] = (unsigned)(Rb * K + C) * 2u; }
    const size_t kstep = (size_t)(BK * 2);
    const size_t hstep = (size_t)HALF * K * 2;
    const size_t tstep = 2 * hstep;
    const unsigned ldsw = (unsigned)wid * 1024u;
    const int aoff = lds_byte(wr * 64 + fr, fq * 8), boff = lds_byte(wc * 32 + fr, fq * 8);
#define PG8_SA(b, h) (((b) * 2 + (h)) * HTB)
#define PG8_SB(b, h) ((4 + (b) * 2 + (h)) * HTB)
#define PG8_STAGE(bufoff, gbase, voff) do { _Pragma("unroll") for (int _i = 0; _i < 2; ++_i) \
        __builtin_amdgcn_global_load_lds((const unsigned*)((const char*)(gbase) + (voff)[_i]), (LAS unsigned*)(lds + (bufoff) + ldsw + _i * 8192), 16, 0, 0); } while (0)
#define PG8_LDA(dst, b, h) do { _Pragma("unroll") for (int m = 0; m < 4; ++m) _Pragma("unroll") for (int k = 0; k < 2; ++k) dst[m][k] = *(const LAS bf16x8*)(lds + PG8_SA(b, h) + aoff + m * 2048 + k * 1024); } while (0)
#define PG8_LDB(dst, b, h) do { _Pragma("unroll") for (int n = 0; n < 2; ++n) _Pragma("unroll") for (int k = 0; k < 2; ++k) dst[n][k] = *(const LAS bf16x8*)(lds + PG8_SB(b, h) + boff + n * 2048 + k * 1024); } while (0)
#define PG8_MMA(ai, bj, At, Bt) do { __builtin_amdgcn_s_setprio(1); _Pragma("unroll") for (int m = 0; m < 4; ++m) _Pragma("unroll") for (int n = 0; n < 2; ++n) _Pragma("unroll") for (int k = 0; k < 2; ++k) \
        acc[ai][bj][m][n] = __builtin_amdgcn_mfma_f32_16x16x32_bf16(Bt[n][k], At[m][k], acc[ai][bj][m][n], 0, 0, 0); __builtin_amdgcn_s_setprio(0); } while (0)
#define PG8_WAIT_V(n) asm volatile("s_waitcnt vmcnt(" #n ")" ::: "memory")
#define PG8_WAIT_L(n) asm volatile("s_waitcnt lgkmcnt(" #n ")" ::: "memory")
#define PG8_BAR __builtin_amdgcn_s_barrier()
#define PG8_SCHED __builtin_amdgcn_sched_barrier(0)
    Unit cur, nxt; int ui = 0;
    if (!S.next(0, cur)) return;
    cur.idx = 0;
    f32x4 acc[2][2][4][2];
#pragma unroll
    for (int a = 0; a < 2; ++a)
#pragma unroll
        for (int b = 0; b < 2; ++b)
#pragma unroll
            for (int m = 0; m < 4; ++m)
#pragma unroll
                for (int n = 0; n < 2; ++n) acc[a][b][m][n] = (f32x4){0.f, 0.f, 0.f, 0.f};
    bf16x8 At[4][2], B0[2][2], B1[2][2];
    const char* cA = (const char*)g.A + (size_t)cur.pm * tstep; const char* cB = (const char*)g.Bt + (size_t)cur.pn * tstep;
    S.a_ready(cur);
    PG8_STAGE(PG8_SB(0, 0), cB, voffB); PG8_STAGE(PG8_SA(0, 0), cA, voffA); PG8_STAGE(PG8_SB(0, 1), cB + hstep, voffB); PG8_STAGE(PG8_SA(0, 1), cA + hstep, voffA);
    if (wr == 1) PG8_BAR;
    PG8_WAIT_V(4); PG8_BAR;
    PG8_STAGE(PG8_SB(1, 0), cB + kstep, voffB); PG8_STAGE(PG8_SA(1, 0), cA + kstep, voffA); PG8_STAGE(PG8_SB(1, 1), cB + hstep + kstep, voffB);
    PG8_WAIT_V(6); PG8_BAR;
    for (;;) {
        const bool has_next = S.next(ui + 1, nxt); nxt.idx = ui + 1;
        const char* nA = has_next ? (const char*)g.A + (size_t)nxt.pm * tstep : cA; const char* nB = has_next ? (const char*)g.Bt + (size_t)nxt.pn * tstep : cB;
        for (int t = 0; t < nt; t += 2) {
            const bool last = (t == nt - 2);
            const char* a1 = cA + (size_t)(t + 1) * kstep;
            const char* a2 = last ? nA : cA + (size_t)(t + 2) * kstep; const char* b2 = last ? nB : cB + (size_t)(t + 2) * kstep;
            const char* a3 = a2 + kstep; const char* b3 = b2 + kstep;
            if (last && has_next) S.a_ready(nxt);
            if constexpr (Epi::MID > 0) { if (t == Epi::MID) E.mid(acc, cur, wr, wc, fr, fq); }
            PG8_LDB(B0, 0, 0); PG8_SCHED; PG8_LDA(At, 0, 0); PG8_STAGE(PG8_SA(1, 1), a1 + hstep, voffA);
            PG8_WAIT_L(8); PG8_BAR; PG8_WAIT_L(0); PG8_MMA(0, 0, At, B0); PG8_BAR; PG8_SCHED;
            PG8_LDB(B1, 0, 1); PG8_STAGE(PG8_SB(0, 0), b2, voffB);
            PG8_BAR; PG8_WAIT_L(0); PG8_MMA(0, 1, At, B1); PG8_BAR;
            PG8_LDA(At, 0, 1); PG8_STAGE(PG8_SA(0, 0), a2, voffA);
            PG8_BAR; PG8_WAIT_L(0); PG8_MMA(1, 0, At, B0); PG8_BAR; PG8_SCHED;
            PG8_STAGE(PG8_SB(0, 1), b2 + hstep, voffB);
            PG8_WAIT_V(6); PG8_BAR; PG8_MMA(1, 1, At, B1); PG8_BAR;
            PG8_LDB(B0, 1, 0); PG8_SCHED; PG8_LDA(At, 1, 0); PG8_STAGE(PG8_SA(0, 1), a2 + hstep, voffA);
            PG8_WAIT_L(8); PG8_BAR; PG8_WAIT_L(0); PG8_MMA(0, 0, At, B0); PG8_BAR; PG8_SCHED;
            PG8_LDB(B1, 1, 1); PG8_STAGE(PG8_SB(1, 0), b3, voffB);
            PG8_BAR; PG8_WAIT_L(0); PG8_MMA(0, 1, At, B1); PG8_BAR;
            PG8_LDA(At, 1, 1); PG8_STAGE(PG8_SA(1, 0), a3, voffA);
            PG8_BAR; PG8_WAIT_L(0); PG8_MMA(1, 0, At, B0); PG8_BAR; PG8_SCHED;
            PG8_STAGE(PG8_SB(1, 1), b3 + hstep, voffB);
            PG8_WAIT_V(6); PG8_BAR; PG8_MMA(1, 1, At, B1); PG8_BAR;
        }
        E(acc, cur, wr, wc, fr, fq); S.done(cur);
        if (!has_next) break;
#pragma unroll
        for (int a = 0; a < 2; ++a)
#pragma unroll
            for (int b = 0; b < 2; ++b)
#pragma unroll
                for (int m = 0; m < 4; ++m)
#pragma unroll
                    for (int n = 0; n < 2; ++n) acc[a][b][m][n] = (f32x4){0.f, 0.f, 0.f, 0.f};
        cur = nxt; cA = nA; cB = nB; ++ui;
    }
    PG8_WAIT_V(0);
    if (wr == 0) PG8_BAR;
    PG8_BAR;
#undef PG8_SA
#undef PG8_SB
#undef PG8_STAGE
#undef PG8_LDA
#undef PG8_LDB
#undef PG8_MMA
#undef PG8_WAIT_V
#undef PG8_WAIT_L
#undef PG8_BAR
#undef PG8_SCHED
}

struct EpiRowScale {
    static constexpr bool PERM = true; static constexpr int MID = 0;
    bf16_t* O; int ldc; const LAS float* rl;
    __device__ __forceinline__ void operator()(const f32x4 (&acc)[2][2][4][2], const Unit& u, int wr, int wc, int fr, int fq) const {
        const int row0 = u.pm * BM + wr * 64 + fr, col0 = u.pn * BM + wc * 32 + 8 * fq;
#pragma unroll
        for (int ai = 0; ai < 2; ++ai)
#pragma unroll
            for (int m = 0; m < 4; ++m) { const int row = row0 + ai * HALF + m * 16; const float rs = rl[u.idx * 256 + wr * 64 + fr + ai * HALF + m * 16];
                bf16_t* rowp = O + (size_t)row * ldc + col0;
#pragma unroll
                for (int bj = 0; bj < 2; ++bj) { const f32x4 v0 = acc[ai][bj][m][0] * rs, v1 = acc[ai][bj][m][1] * rs;
                    u32x4 w; w.x = cvt_pk_bf16(v0[0], v0[1]); w.y = cvt_pk_bf16(v0[2], v0[3]); w.z = cvt_pk_bf16(v1[0], v1[1]); w.w = cvt_pk_bf16(v1[2], v1[3]);
                    *(u32x4*)(rowp + bj * HALF) = w; } }
    }
};
struct EpiColScale {
    static constexpr bool PERM = true; static constexpr int MID = 0;
    bf16_t* O; int ldc; const LAS float* rl;
    __device__ __forceinline__ void operator()(const f32x4 (&acc)[2][2][4][2], const Unit& u, int wr, int wc, int fr, int fq) const {
        const int row0 = u.pm * BM + wr * 64 + fr, col0 = u.pn * BM + wc * 32 + 8 * fq;
        f32x4 sc[2][2];
#pragma unroll
        for (int bj = 0; bj < 2; ++bj)
#pragma unroll
            for (int n = 0; n < 2; ++n) sc[bj][n] = *(const LAS f32x4*)(rl + u.idx * 256 + wc * 32 + 8 * fq + bj * HALF + 4 * n);
#pragma unroll
        for (int ai = 0; ai < 2; ++ai)
#pragma unroll
            for (int m = 0; m < 4; ++m) { const int row = row0 + ai * HALF + m * 16; bf16_t* rowp = O + (size_t)row * ldc + col0;
#pragma unroll
                for (int bj = 0; bj < 2; ++bj) { const f32x4 v0 = acc[ai][bj][m][0] * sc[bj][0], v1 = acc[ai][bj][m][1] * sc[bj][1];
                    u32x4 w; w.x = cvt_pk_bf16(v0[0], v0[1]); w.y = cvt_pk_bf16(v0[2], v0[3]); w.z = cvt_pk_bf16(v1[0], v1[1]); w.w = cvt_pk_bf16(v1[2], v1[3]);
                    *(u32x4*)(rowp + bj * HALF) = w; } }
    }
};
struct EpiGate {
    static constexpr bool PERM = true; static constexpr int MID = 0;
    const bf16_t* gate; const bf16_t* addsrc; bf16_t* O;
    __device__ __forceinline__ void operator()(const f32x4 (&acc)[2][2][4][2], const Unit& u, int wr, int wc, int fr, int fq) const {
        const int row0 = u.pm * BM + wr * 64 + fr, col0 = u.pn * BM + wc * 32 + 8 * fq;
#pragma unroll
        for (int ai = 0; ai < 2; ++ai)
#pragma unroll
            for (int m = 0; m < 4; ++m) { const int row = row0 + ai * HALF + m * 16;
#pragma unroll
                for (int bj = 0; bj < 2; ++bj) { const int col = col0 + bj * HALF;
                    float gf[8], r[8]; unpack8(*(const u32x4*)(gate + (size_t)row * NPROJ + col), gf);
                    const f32x4 v0 = acc[ai][bj][m][0], v1 = acc[ai][bj][m][1];
#pragma unroll
                    for (int j = 0; j < 4; ++j) { r[j] = v0[j] * sigmoidf_(gf[j]); r[4 + j] = v1[j] * sigmoidf_(gf[4 + j]); }
                    if (addsrc) { float af[8]; unpack8(*(const u32x4*)(addsrc + (size_t)row * D + col), af);
#pragma unroll
                        for (int j = 0; j < 8; ++j) r[j] += af[j]; }
                    *(u32x4*)(O + (size_t)row * D + col) = pack8(r); } }
    }
};
struct EpiMerge {
    static constexpr bool PERM = true; static constexpr int MID = 8;
    const bf16_t* ga; const bf16_t* gr; bf16_t* O;
    __device__ __forceinline__ void mid(f32x4 (&acc)[2][2][4][2], const Unit& u, int wr, int wc, int fr, int fq) const {
        const int row0 = u.pm * BM + wr * 64 + fr, col0 = u.pn * BM + wc * 32 + 8 * fq;
#pragma unroll
        for (int ai = 0; ai < 2; ++ai)
#pragma unroll
            for (int m = 0; m < 4; ++m) { int row = row0 + ai * HALF + m * 16; asm volatile("" : "+v"(row));
#pragma unroll
                for (int bj = 0; bj < 2; ++bj) { const size_t off = (size_t)row * NPROJ + col0 + bj * HALF;
                    float fa[8], fb[8]; unpack8(*(const u32x4*)(ga + off), fa); unpack8(*(const u32x4*)(gr + off), fb);
#pragma unroll
                    for (int j = 0; j < 8; ++j) { const float rt = (1.0f + __builtin_amdgcn_exp2f(fb[j] * -1.4426950408889634f)) * __builtin_amdgcn_rcpf(1.0f + __builtin_amdgcn_exp2f(fa[j] * -1.4426950408889634f));
                        if (j < 4) acc[ai][bj][m][0][j] *= rt; else acc[ai][bj][m][1][j - 4] *= rt; } }
                asm volatile("" ::: "memory"); }
    }
    __device__ __forceinline__ void operator()(const f32x4 (&acc)[2][2][4][2], const Unit& u, int wr, int wc, int fr, int fq) const {
        const int row0 = u.pm * BM + wr * 64 + fr, col0 = u.pn * BM + wc * 32 + 8 * fq;
#pragma unroll
        for (int ai = 0; ai < 2; ++ai)
#pragma unroll
            for (int m = 0; m < 4; ++m) { const int row = row0 + ai * HALF + m * 16;
#pragma unroll
                for (int bj = 0; bj < 2; ++bj) { const int col = col0 + bj * HALF;
                    float gf[8], r[8]; unpack8(*(const u32x4*)(gr + (size_t)row * NPROJ + col), gf);
                    const f32x4 v0 = acc[ai][bj][m][0], v1 = acc[ai][bj][m][1];
#pragma unroll
                    for (int j = 0; j < 4; ++j) { r[j] = v0[j] * sigmoidf_(gf[j]); r[4 + j] = v1[j] * sigmoidf_(gf[4 + j]); }
                    *(u32x4*)(O + (size_t)row * D + col) = pack8(r); } }
    }
};
struct EpiResid {
    static constexpr bool PERM = true; static constexpr int MID = 0;
    bf16_t* xb; float* rowss;
    __device__ __forceinline__ void operator()(const f32x4 (&acc)[2][2][4][2], const Unit& u, int wr, int wc, int fr, int fq) const {
        const int row0 = u.pm * BM + wr * 64 + fr, col0 = u.pn * BM + wc * 32 + 8 * fq;
#pragma unroll
        for (int ai = 0; ai < 2; ++ai)
#pragma unroll
            for (int m = 0; m < 4; ++m) { const int row = row0 + ai * HALF + m * 16; float ss = 0.f;
#pragma unroll
                for (int bj = 0; bj < 2; ++bj) { const size_t off = (size_t)row * D + col0 + bj * HALF;
                    float b[8], r[8]; unpack8(*(const u32x4*)(xb + off), b);
                    const f32x4 v0 = acc[ai][bj][m][0], v1 = acc[ai][bj][m][1];
#pragma unroll
                    for (int j = 0; j < 4; ++j) { b[j] += v0[j]; b[4 + j] += v1[j]; }
                    const u32x4 w = pack8(b);
                    *(u32x4*)(xb + off) = w;
                    unpack8(w, r);
#pragma unroll
                    for (int j = 0; j < 8; ++j) ss += r[j] * r[j]; }
                { const int ln = fr + 16 * fq; ss += shx(ss, 16, ln); ss += shx(ss, 32, ln); }
                if (fq == 0) rowss[(size_t)row * 16 + u.pn * 4 + wc] = ss; }
    }
};
}

template <class Sched> __device__ __forceinline__ void fill_rstd(LAS float* rl, const float* rowss, const Sched& S, bool by_col) {
    const int tid = otid();
    for (int e = tid; e < 8 * 256; e += NTHREADS) { pg8::Unit u; const int i = e >> 8;
        if (S.next(i, u)) { const int r = (by_col ? u.pn : u.pm) * 256 + (e & 255); rl[e] = rsqrtf(sum16(rowss + (size_t)r * 16) * (1.0f / 1024.0f) + EPS); } }
    __syncthreads();
}

__device__ __forceinline__ int win_srccol(int nd) {
    if (nd < 1024) return nd;
    if (nd < 1536) return 1536 + (nd - 1024);
    if (nd < 2048) return 2048 + (nd - 1536);
    if (nd < 3072) return 3584 + (nd - 2048);
    if (nd < 4096) return 4608 + (nd - 3072);
    if (nd < 5120) return 5632 + (nd - 4096);
    nd -= 5120;
    if (nd < 512) return 1024 + nd;
    if (nd < 1024) return 2048 + (nd - 512);
    return 2560 + (nd - 1024);
}
__device__ __forceinline__ void conv_tile(const float* __restrict__ src, int ld_src, int k0, int nsrc0, bf16_t* dst, int ldd, int ndst0, const float* gsc, LAS float* tile, int kdst0 = 0) {
    const int t = otid();
#pragma unroll
    for (int i = 0; i < 2; ++i) { const int r = (t >> 4) + 32 * i, c = (t & 15) * 4;
        const float4 v = *(const float4*)(src + (size_t)(k0 + r) * ld_src + nsrc0 + c);
        const float s = gsc ? gsc[k0 + r] : 1.0f;
        tile[r * 65 + c] = v.x * s; tile[r * 65 + c + 1] = v.y * s; tile[r * 65 + c + 2] = v.z * s; tile[r * 65 + c + 3] = v.w * s; }
    __syncthreads();
    { const int n = t >> 3, k8 = (t & 7) * 8; float f[8];
#pragma unroll
      for (int j = 0; j < 8; ++j) f[j] = tile[(k8 + j) * 65 + n];
      *(u32x4*)(dst + (size_t)(ndst0 + n) * ldd + kdst0 + k0 + k8) = pack8(f); }
    __syncthreads();
}
__device__ __forceinline__ void phase_prologue(const Params& P, LAS unsigned char* lds) {
    LAS float* tile = (LAS float*)lds;
    constexpr int T_IN = 16 * 112, T_A = 8 * 16, T_R = 16 * 16, T_O = 16 * 16, T_UP = 16 * 88, T_D = 44 * 16, T_L = T_IN + T_A + T_R + T_O + T_UP + T_D;
    for (int job = blockIdx.x; job < T_L * DEPTH; job += ogrid()) {
        const int l = job / T_L; int r = job % T_L;
        unsigned char* wl = P.ws + WS_W + (size_t)l * W_LAYER;
        if (r < T_IN) { const int kt = r / 112, ntile = r % 112; conv_tile(P.w_in + (size_t)l * D * DIN, DIN, kt * 64, win_srccol(ntile * 64), (bf16_t*)(wl + W_IN_OFF), 1024, ntile * 64, P.norm_mix_g + l * D, tile); continue; }
        r -= T_IN;
        if (r < T_A) { const int kt = r / 16, ntile = r % 16; conv_tile(P.w_ba + (size_t)l * 512 * D, D, kt * 64, ntile * 64, (bf16_t*)(wl + W_A_OFF), 1536, ntile * 64, nullptr, tile, 0); continue; }
        r -= T_A;
        if (r < T_R) { const int kt = r / 16, ntile = r % 16; conv_tile(P.w_br + (size_t)l * D * D, D, kt * 64, ntile * 64, (bf16_t*)(wl + W_A_OFF), 1536, ntile * 64, nullptr, tile, 512); continue; }
        r -= T_R;
        if (r < T_O) { const int kt = r / 16, ntile = r % 16; conv_tile(P.w_out + (size_t)l * D * D, D, kt * 64, ntile * 64, (bf16_t*)(wl + W_O_OFF), 1024, ntile * 64, nullptr, tile); continue; }
        r -= T_O;
        if (r < T_UP) { const int kt = r / 88, ntile = r % 88; conv_tile(P.w_up + (size_t)l * D * DFF2, DFF2, kt * 64, ntile * 64, (bf16_t*)(wl + W_UP_OFF), 1024, ntile * 64, P.norm_ffn_g + l * D, tile); continue; }
        r -= T_UP;
        { const int kt = r / 16, ntile = r % 16; conv_tile(P.w_down + (size_t)l * DFF * D, D, kt * 64, ntile * 64, (bf16_t*)(wl + W_D_OFF), DFF, ntile * 64, nullptr, tile); }
    }
    if (blockIdx.x == 0 && otid() < DEPTH * 4) { const int i = otid(); float* tab = (float*)(P.ws + WS_LG2);
        tab[2 * i] = -log1pf(expf(-P.dec_f[i])) * 1.4426950408889634f; tab[2 * i + 1] = -log1pf(expf(-P.dec_b[i])) * 1.4426950408889634f; }
    float* cosN = (float*)(P.ws + WS_COSN); float* sinN = (float*)(P.ws + WS_SINN); float* cosT = (float*)(P.ws + WS_COST); float* sinT = (float*)(P.ws + WS_SINT);
    for (int idx = blockIdx.x * NTHREADS + otid(); idx < 16384 * 64; idx += ogrid() * NTHREADS) {
        const int pos = idx >> 6, i = idx & 63;
        const float invf = powf(10000.0f, -(float)i / 64.0f);
        const float ang = (float)pos * invf;
        const float c = cosf(ang), s = sinf(ang);
        cosN[idx] = c; sinN[idx] = s; cosT[(size_t)i * 16384 + pos] = c; sinT[(size_t)i * 16384 + pos] = s;
    }
}

__device__ __forceinline__ void phase_init(const float* __restrict__ xin, bf16_t* xb, float* rowss1, float* rowss2) {
    const int tid = otid(), lane = tid & 63, nw = ogrid() * 8;
    for (int row = blockIdx.x * 8 + (tid >> 6); row < MG; row += nw) {
        const float4* p = (const float4*)(xin + (size_t)row * D); float ss = 0.f;
#pragma unroll
        for (int i = 0; i < 4; ++i) { const float4 v = p[lane + 64 * i];
            u32x2 w; w.x = cvt_pk_bf16(v.x, v.y); w.y = cvt_pk_bf16(v.z, v.w); *(u32x2*)(xb + (size_t)row * D + (lane + 64 * i) * 4) = w;
            const float a0 = bf_lo(w.x), a1 = bf_hi(w.x), a2 = bf_lo(w.y), a3 = bf_hi(w.y); ss += a0 * a0 + a1 * a1 + a2 * a2 + a3 * a3; }
        ss = wave_sum(ss, lane);
        if (lane < 16) rowss1[(size_t)row * 16 + lane] = lane == 0 ? ss : 0.f;
    }
}
__device__ __forceinline__ void phase_final(const bf16_t* __restrict__ xb, float* xo, const float* rowss1, const float* __restrict__ gfin) {
    const int tid = otid(), lane = tid & 63, nw = ogrid() * 8;
    for (int row = blockIdx.x * 8 + (tid >> 6); row < MG; row += nw) {
        const float rs = rsqrtf(sum16(rowss1 + (size_t)row * 16) * (1.0f / 1024.0f) + EPS);
#pragma unroll
        for (int i = 0; i < 2; ++i) { const int c8 = (lane + 64 * i) * 8; float x[8]; unpack8(*(const u32x4*)(xb + (size_t)row * D + c8), x);
            const f32x4 g0 = *(const f32x4*)(gfin + c8), g1 = *(const f32x4*)(gfin + c8 + 4);
            *(f32x4*)(xo + (size_t)row * D + c8) = (f32x4){x[0] * rs * g0[0], x[1] * rs * g0[1], x[2] * rs * g0[2], x[3] * rs * g0[3]};
            *(f32x4*)(xo + (size_t)row * D + c8 + 4) = (f32x4){x[4] * rs * g1[0], x[5] * rs * g1[1], x[6] * rs * g1[2], x[7] * rs * g1[3]}; }
    }
}
__device__ __forceinline__ float gelu_tanh(float x) { const float t = fmaf(x * x, -0.10294324f, -2.30220819f);
    return x * __builtin_amdgcn_rcpf(1.0f + __builtin_amdgcn_exp2f(x * t)); }
__device__ __forceinline__ void phase_convact(const bf16_t* __restrict__ u, bf16_t* act, const float* __restrict__ cw  , int seqlen, float* rowss2) {
    const int gt = blockIdx.x * NTHREADS + otid(), nth = ogrid() * NTHREADS;
    for (int id = gt; id < 2048 * 352; id += nth) {
        const int tb = id / 352, c = (id % 352) * 8, t0 = tb * 8;
        const u32x4 z = (u32x4){0u, 0u, 0u, 0u};
        u32x4 g[10], v[10];
        const bool has_prev = (t0 & (seqlen - 1)) != 0, has_next = ((t0 + 8) & (seqlen - 1)) != 0;
#pragma unroll
        for (int r = 0; r < 10; ++r) { const bool ok = (r == 0) ? has_prev : ((r == 9) ? has_next : true);
            g[r] = z; v[r] = z;
            if (ok) { g[r] = *(const u32x4*)(u + (size_t)(t0 - 1 + r) * DFF2 + c); v[r] = *(const u32x4*)(u + (size_t)(t0 - 1 + r) * DFF2 + DFF + c); } }
        float wg[3][8], wv[3][8];
#pragma unroll
        for (int k = 0; k < 3; ++k) {
            const f32x4 a0 = *(const f32x4*)(cw + k * DFF2 + c), a1 = *(const f32x4*)(cw + k * DFF2 + c + 4);
            const f32x4 b0 = *(const f32x4*)(cw + k * DFF2 + DFF + c), b1 = *(const f32x4*)(cw + k * DFF2 + DFF + c + 4);
#pragma unroll
            for (int j = 0; j < 4; ++j) { wg[k][j] = a0[j]; wg[k][4 + j] = a1[j]; wv[k][j] = b0[j]; wv[k][4 + j] = b1[j]; } }
#pragma unroll
        for (int i = 0; i < 8; ++i) {
            float a[8], b[8], cc[8], r[8], gg[8], vv[8];
            unpack8(g[i], a); unpack8(g[i + 1], b); unpack8(g[i + 2], cc);
#pragma unroll
            for (int j = 0; j < 8; ++j) gg[j] = a[j] * wg[0][j] + b[j] * wg[1][j] + cc[j] * wg[2][j];
            unpack8(v[i], a); unpack8(v[i + 1], b); unpack8(v[i + 2], cc);
#pragma unroll
            for (int j = 0; j < 8; ++j) vv[j] = a[j] * wv[0][j] + b[j] * wv[1][j] + cc[j] * wv[2][j];
#pragma unroll
            for (int j = 0; j < 8; ++j) r[j] = gelu_tanh(gg[j]) * vv[j];
            *(u32x4*)(act + (size_t)(t0 + i) * DFF + c) = pack8(r);
        }
    }
}

constexpr int NA_LDS_WAVE = 12288;
struct NaFrags { bf16x8 k[4]; u32x2 v[2][2][2]; };
__device__ __forceinline__ void na_load(NaFrags& f, const bf16_t* __restrict__ proj, const bf16_t* __restrict__ projT, int ktok, int h, int c, int hh) {
    const bf16_t* kp = proj + (size_t)(ktok + c) * NPROJ + 512 + h * 64 + 8 * hh;
#pragma unroll
    for (int s = 0; s < 4; ++s) f.k[s] = *(const bf16x8*)(kp + 16 * s);
#pragma unroll
    for (int dt = 0; dt < 2; ++dt)
#pragma unroll
        for (int s2 = 0; s2 < 2; ++s2) { const bf16_t* vp = projT + (size_t)(h * 64 + dt * 32 + c) * MG + (ktok + 16 * s2 + 4 * hh);
            f.v[dt][s2][0] = *(const u32x2*)vp; f.v[dt][s2][1] = *(const u32x2*)(vp + 8); }
}
__device__ __forceinline__ void na_item(const bf16_t* __restrict__ proj, const bf16_t* __restrict__ projT, bf16_t* aout, const float* __restrict__ relb  , int item, int seqlen, LAS unsigned char* lds, int w, int lane) {
    const int c = lane & 31, hh = lane >> 5;
    const int R = item >> 3, h = item & 7;
    const int rps = seqlen >> 6, seq = R / rps, r = R % rps;
    int rs = r - 4; rs = rs < 0 ? 0 : rs; rs = rs > rps - 8 ? rps - 8 : rs;
    const int qtok0 = seq * seqlen + r * 64, ktok0 = seq * seqlen + rs * 64;
    LAS float* bias = (LAS float*)(lds + w * NA_LDS_WAVE) + 64;
    LAS bf16_t* Otile = (LAS bf16_t*)(lds + w * NA_LDS_WAVE + 3072);
    for (int i = lane; i < 768; i += 64) { const int j = i - 64; bias[j] = (j >= 0 && j < 465) ? relb[h * 465 + j] * 1.4426950408889634f : 0.f; }
    bf16x8 qf[2][4];
#pragma unroll
    for (int qh = 0; qh < 2; ++qh) { const bf16_t* qp = proj + (size_t)(qtok0 + 32 * qh + c) * NPROJ + h * 64 + 8 * hh;
#pragma unroll
        for (int s = 0; s < 4; ++s) qf[qh][s] = *(const bf16x8*)(qp + 16 * s); }
    f32x16 O[2][2];
    float mrun[2], lrun[2]; int cs[2];
#pragma unroll
    for (int qh = 0; qh < 2; ++qh) { O[qh][0] = zero16(); O[qh][1] = zero16(); mrun[qh] = -1e30f; lrun[qh] = 0.f;
        int x = 32 * qh + c - 8; x = x < 0 ? 0 : x; x = x > 48 ? 48 : x; cs[qh] = x; }
    NaFrags cur, nxt;
    na_load(cur, proj, projT, ktok0, h, c, hh);
#pragma unroll 1
    for (int t = 0; t < 16; ++t) {
        if (t + 1 < 16) na_load(nxt, proj, projT, ktok0 + 32 * (t + 1), h, c, hh);
        const int kr = rs + (t >> 1), chalf = t & 1, brow = (kr - r + 7) * 31;
#pragma unroll
        for (int qh = 0; qh < 2; ++qh) {
            f32x16 x = zero16();
#pragma unroll
            for (int s = 0; s < 4; ++s) x = mfma32(cur.k[s], qf[qh][s], x);
            const int qc = 32 * qh + c; float mt = -1e30f;
#pragma unroll
            for (int rg = 0; rg < 16; ++rg) { const int kc = 32 * chalf + (rg & 3) + 8 * (rg >> 2) + 4 * hh;
                const bool valid = (kc >= cs[qh]) && (kc < cs[qh] + 16);
                const float sv = fmaf(x[rg], 0.18033688011112042f, bias[brow + kc - qc + 15]) + (valid ? 0.f : -__builtin_inff());
                x[rg] = sv; mt = fmaxf(mt, sv); }
            mt = fmaxf(mt, shx(mt, 32, lane));
            const float mnew = fmaxf(mrun[qh], mt), alpha = __builtin_amdgcn_exp2f(mrun[qh] - mnew);
            const bool grew = mnew > mrun[qh];
            mrun[qh] = mnew;
            float ps = 0.f;
#pragma unroll
            for (int rg = 0; rg < 16; ++rg) { const float p = __builtin_amdgcn_exp2f(x[rg] - mnew); x[rg] = p; ps += p; }
            lrun[qh] = lrun[qh] * alpha + ps;
            if (__builtin_amdgcn_ballot_w64(grew) != 0ull) { O[qh][0] *= alpha; O[qh][1] *= alpha; }
#pragma unroll
            for (int s2 = 0; s2 < 2; ++s2) {
                u32x4 pw; pw.x = cvt_pk_bf16(x[8 * s2 + 0], x[8 * s2 + 1]); pw.y = cvt_pk_bf16(x[8 * s2 + 2], x[8 * s2 + 3]); pw.z = cvt_pk_bf16(x[8 * s2 + 4], x[8 * s2 + 5]); pw.w = cvt_pk_bf16(x[8 * s2 + 6], x[8 * s2 + 7]);
                const bf16x8 pb = __builtin_bit_cast(bf16x8, pw);
#pragma unroll
                for (int dt = 0; dt < 2; ++dt) { u32x4 aw; aw.x = cur.v[dt][s2][0].x; aw.y = cur.v[dt][s2][0].y; aw.z = cur.v[dt][s2][1].x; aw.w = cur.v[dt][s2][1].y;
                    O[qh][dt] = mfma32(__builtin_bit_cast(bf16x8, aw), pb, O[qh][dt]); } }
        }
        cur = nxt;
    }
#pragma unroll
    for (int qh = 0; qh < 2; ++qh) { const float inv = 1.0f / (lrun[qh] + shx(lrun[qh], 32, lane));
#pragma unroll
        for (int dt = 0; dt < 2; ++dt)
#pragma unroll
            for (int g4 = 0; g4 < 4; ++g4) { u32x2 pw; pw.x = cvt_pk_bf16(O[qh][dt][4 * g4] * inv, O[qh][dt][4 * g4 + 1] * inv); pw.y = cvt_pk_bf16(O[qh][dt][4 * g4 + 2] * inv, O[qh][dt][4 * g4 + 3] * inv);
                *(LAS u32x2*)(Otile + (32 * qh + c) * 72 + dt * 32 + 8 * g4 + 4 * hh) = pw; } }
#pragma unroll
    for (int i = 0; i < 8; ++i) { const int id = lane + 64 * i, q = id >> 3, d8 = (id & 7) * 8;
        *(u32x4*)(aout + (size_t)(qtok0 + q) * 1536 + h * 64 + d8) = *(const LAS u32x4*)(Otile + q * 72 + d8); }
}

constexpr int KT_STRIDE = 136;
__device__ __forceinline__ void r1_item(const bf16_t* __restrict__ projT, bf16_t* stloc, const float* __restrict__ cosT, const float* __restrict__ sinT, float lgf2, float lgb2, int item, int seqlen, LAS unsigned char* lds) {
    const int tid = otid(), w = __builtin_amdgcn_readfirstlane(tid >> 6), lane = tid & 63, c = lane & 31, hh = lane >> 5;
    const int ch = item >> 2, h = item & 3, tok0 = ch * 128, pos0 = tok0 % seqlen;
    LAS bf16_t* KTf = (LAS bf16_t*)lds; LAS bf16_t* KTb = (LAS bf16_t*)(lds + 128 * KT_STRIDE * 2);
    const float scale = 0.08838834764831845f;
    bf16x8 af[8];
    { const bf16_t* vp = projT + (size_t)(1024 + h * 256 + 32 * w + c) * MG + tok0 + 8 * hh;
#pragma unroll
      for (int s = 0; s < 8; ++s) af[s] = *(const bf16x8*)(vp + 16 * s); }
#pragma unroll
    for (int it = 0; it < 2; ++it) {
        const int id = tid + NTHREADS * it, d = id >> 4, t8 = id & 15;
        float k1[8], k2[8];
        unpack8(*(const u32x4*)(projT + (size_t)(512 + h * 128 + d) * MG + tok0 + 8 * t8), k1);
        unpack8(*(const u32x4*)(projT + (size_t)(512 + h * 128 + d + 64) * MG + tok0 + 8 * t8), k2);
        const f32x4 c0 = *(const f32x4*)(cosT + (size_t)d * 16384 + pos0 + 8 * t8), c1 = *(const f32x4*)(cosT + (size_t)d * 16384 + pos0 + 8 * t8 + 4);
        const f32x4 s0 = *(const f32x4*)(sinT + (size_t)d * 16384 + pos0 + 8 * t8), s1 = *(const f32x4*)(sinT + (size_t)d * 16384 + pos0 + 8 * t8 + 4);
        float f1[8], f2[8], b1[8], b2[8];
#pragma unroll
        for (int j = 0; j < 8; ++j) { const float cv = j < 4 ? c0[j & 3] : c1[j & 3], sv = j < 4 ? s0[j & 3] : s1[j & 3];
            const float r1 = (k1[j] * cv - k2[j] * sv) * scale, r2 = (k1[j] * sv + k2[j] * cv) * scale;
            const int tl = 8 * t8 + j; const float df = __builtin_amdgcn_exp2f((float)(127 - tl) * lgf2), db = __builtin_amdgcn_exp2f((float)tl * lgb2);
            f1[j] = r1 * df; f2[j] = r2 * df; b1[j] = r1 * db; b2[j] = r2 * db; }
        *(LAS u32x4*)(KTf + d * KT_STRIDE + 8 * t8) = pack8(f1); *(LAS u32x4*)(KTf + (d + 64) * KT_STRIDE + 8 * t8) = pack8(f2);
        *(LAS u32x4*)(KTb + d * KT_STRIDE + 8 * t8) = pack8(b1); *(LAS u32x4*)(KTb + (d + 64) * KT_STRIDE + 8 * t8) = pack8(b2);
    }
    __syncthreads();
#pragma unroll
    for (int dir = 0; dir < 2; ++dir) {
        LAS bf16_t* KT = dir ? KTb : KTf;
        bf16_t* dst = stloc + ((size_t)(ch * 4 + h) * 2 + dir) * 32768;
#pragma unroll
        for (int ct = 0; ct < 4; ++ct) {
            f32x16 acc = zero16();
#pragma unroll
            for (int s = 0; s < 8; ++s) { const bf16x8 bfr = *(const LAS bf16x8*)(KT + (32 * ct + c) * KT_STRIDE + 16 * s + 8 * hh); acc = mfma32(af[s], bfr, acc); }
#pragma unroll
            for (int rg = 0; rg < 16; ++rg) { const int dv = 32 * w + (rg & 3) + 8 * (rg >> 2) + 4 * hh; dst[dv * 128 + 32 * ct + c] = (bf16_t)(cvt_pk_bf16(acc[rg], 0.f) & 0xffffu); }
        }
    }
    __syncthreads();
}

__device__ __forceinline__ void phase_scan(const bf16_t* __restrict__ stloc, bf16_t* st, const float* __restrict__ decf, const float* __restrict__ decb, int seqlen) {
    const int gt = blockIdx.x * NTHREADS + otid(), nth = ogrid() * NTHREADS;
    constexpr size_t CSTR = (size_t)4 * 2 * 32768;
    if (seqlen == 4096) {
        constexpr int NCH = 32, NTASK = 4 * 4 * 2 * 4096;
        for (int id = gt; id < NTASK; id += nth) {
            const int e8 = id & 4095, dir = (id >> 12) & 1, h = (id >> 13) & 3, seq = id >> 15;
            const float x = dir ? decb[h] : decf[h]; const float cd = exp2f(-128.0f * log1pf(expf(-x)) * 1.4426950408889634f);
            const size_t base = ((size_t)(seq * NCH * 4 + h) * 2 + dir) * 32768 + (size_t)e8 * 8;
            float zz = 0.f; asm volatile("" : "+v"(zz));
            float S[8];
#pragma unroll
            for (int j = 0; j < 8; ++j) S[j] = zz;
            for (int i0 = 0; i0 < NCH; i0 += 8) {
                u32x4 loc[8];
#pragma unroll
                for (int j = 0; j < 8; ++j) { const int ci = dir ? (NCH - 1 - (i0 + j)) : (i0 + j); loc[j] = *(const u32x4*)(stloc + base + (size_t)ci * CSTR); }
#pragma unroll
                for (int j = 0; j < 8; ++j) { const int ci = dir ? (NCH - 1 - (i0 + j)) : (i0 + j);
                    *(u32x4*)(st + base + (size_t)ci * CSTR) = pack8(S);
                    float lf[8]; unpack8(loc[j], lf);
#pragma unroll
                    for (int k = 0; k < 8; ++k) S[k] = S[k] * cd + lf[k]; }
            }
        }
    } else {
        constexpr int NCH = 128, NTASK = 4 * 2 * 16384;
        for (int id = gt; id < NTASK; id += nth) {
            const int e2 = id & 16383, dir = (id >> 14) & 1, h = (id >> 15) & 3;
            const float x = dir ? decb[h] : decf[h]; const float cd = exp2f(-128.0f * log1pf(expf(-x)) * 1.4426950408889634f);
            const size_t base = ((size_t)h * 2 + dir) * 32768 + (size_t)e2 * 2;
            float zz = 0.f; asm volatile("" : "+v"(zz));
            float S0 = zz, S1 = zz;
            for (int i0 = 0; i0 < NCH; i0 += 8) {
                unsigned loc[8];
#pragma unroll
                for (int j = 0; j < 8; ++j) { const int ci = dir ? (NCH - 1 - (i0 + j)) : (i0 + j); loc[j] = *(const unsigned*)(stloc + base + (size_t)ci * CSTR); }
#pragma unroll
                for (int j = 0; j < 8; ++j) { const int ci = dir ? (NCH - 1 - (i0 + j)) : (i0 + j);
                    *(unsigned*)(st + base + (size_t)ci * CSTR) = cvt_pk_bf16(S0, S1);
                    S0 = S0 * cd + bf_lo(loc[j]); S1 = S1 * cd + bf_hi(loc[j]); }
            }
        }
    }
}

constexpr int OL_STRIDE = 264;
__device__ __forceinline__ void r3_item(const bf16_t* __restrict__ proj, const bf16_t* __restrict__ projT, const bf16_t* __restrict__ st, bf16_t* ro,
                        const float* __restrict__ cosN, const float* __restrict__ sinN, const float* __restrict__ gn  , float lgf2, float lgb2,
                        int item, int seqlen, LAS unsigned char* lds) {
    const int tid = otid(), w = __builtin_amdgcn_readfirstlane(tid >> 6), lane = tid & 63, c = lane & 31, hh = lane >> 5;
    const int ch = item >> 2, h = item & 3, tok0 = ch * 128, pos0 = tok0 % seqlen;
    LAS bf16_t* Ql = (LAS bf16_t*)lds; LAS bf16_t* Kl = (LAS bf16_t*)(lds + 34816); LAS bf16_t* Pl = (LAS bf16_t*)(lds + 69632);
    LAS float* stat = (LAS float*)(lds + 104448);
    LAS bf16_t* Ol = (LAS bf16_t*)lds;
    const float scale = 0.08838834764831845f;
    bf16x8 asb[8], asf[8], avt[8];
    const size_t stb0 = ((size_t)(ch * 4 + h) * 2) * 32768 + (size_t)(32 * w + c) * 128 + 8 * hh;
#pragma unroll
    for (int s = 0; s < 8; ++s) asb[s] = *(const bf16x8*)(st + stb0 + 32768 + 16 * s);
#pragma unroll
    for (int it = 0; it < 2; ++it) {
        const int id = tid + NTHREADS * it, t = id >> 3, d8 = (id & 7) * 8;
        const f32x4 c0 = *(const f32x4*)(cosN + (size_t)(pos0 + t) * 64 + d8), c1 = *(const f32x4*)(cosN + (size_t)(pos0 + t) * 64 + d8 + 4);
        const f32x4 s0 = *(const f32x4*)(sinN + (size_t)(pos0 + t) * 64 + d8), s1 = *(const f32x4*)(sinN + (size_t)(pos0 + t) * 64 + d8 + 4);
        float a[8], b[8], o1[8], o2[8];
        const bf16_t* qp = proj + (size_t)(tok0 + t) * NPROJ + 1024 + h * 128 + d8;
        unpack8(*(const u32x4*)qp, a); unpack8(*(const u32x4*)(qp + 64), b);
#pragma unroll
        for (int j = 0; j < 8; ++j) { const float cv = j < 4 ? c0[j & 3] : c1[j & 3], sv = j < 4 ? s0[j & 3] : s1[j & 3]; o1[j] = a[j] * cv - b[j] * sv; o2[j] = a[j] * sv + b[j] * cv; }
        *(LAS u32x4*)(Ql + t * KT_STRIDE + d8) = pack8(o1); *(LAS u32x4*)(Ql + t * KT_STRIDE + 64 + d8) = pack8(o2);
        const bf16_t* kp = proj + (size_t)(tok0 + t) * NPROJ + 1536 + h * 128 + d8;
        unpack8(*(const u32x4*)kp, a); unpack8(*(const u32x4*)(kp + 64), b);
#pragma unroll
        for (int j = 0; j < 8; ++j) { const float cv = j < 4 ? c0[j & 3] : c1[j & 3], sv = j < 4 ? s0[j & 3] : s1[j & 3]; o1[j] = (a[j] * cv - b[j] * sv) * scale; o2[j] = (a[j] * sv + b[j] * cv) * scale; }
        *(LAS u32x4*)(Kl + t * KT_STRIDE + d8) = pack8(o1); *(LAS u32x4*)(Kl + t * KT_STRIDE + 64 + d8) = pack8(o2);
    }
    __syncthreads();
    { const int kt = w >> 1;
#pragma unroll
      for (int q2 = 0; q2 < 2; ++q2) { const int tqt = 2 * (w & 1) + q2;
          f32x16 x = zero16();
#pragma unroll
          for (int s = 0; s < 8; ++s) { const bf16x8 kf = *(const LAS bf16x8*)(Kl + (32 * kt + c) * KT_STRIDE + 16 * s + 8 * hh);
              const bf16x8 qf = *(const LAS bf16x8*)(Ql + (32 * tqt + c) * KT_STRIDE + 16 * s + 8 * hh); x = mfma32(kf, qf, x); }
          const int n = 32 * tqt + c;
#pragma unroll
          for (int g4 = 0; g4 < 4; ++g4) { float pv[4];
#pragma unroll
              for (int j = 0; j < 4; ++j) { const int mk = 32 * kt + 8 * g4 + 4 * hh + j; const int diff = n - mk;
                  const float dec = __builtin_amdgcn_exp2f(diff >= 0 ? (float)diff * lgf2 : (float)(-diff) * lgb2); pv[j] = x[4 * g4 + j] * dec; }
              u32x2 pw; pw.x = cvt_pk_bf16(pv[0], pv[1]); pw.y = cvt_pk_bf16(pv[2], pv[3]);
              *(LAS u32x2*)(Pl + n * KT_STRIDE + 32 * kt + 8 * g4 + 4 * hh) = pw; } } }
    __syncthreads();
    f32x16 acc[4];
#pragma unroll
    for (int q = 0; q < 4; ++q) acc[q] = zero16();
    { const bf16_t* vp0 = projT + (size_t)(1024 + h * 256 + 32 * w + c) * MG + tok0 + 8 * hh;
#pragma unroll
      for (int s = 0; s < 8; ++s) { asf[s] = *(const bf16x8*)(st + stb0 + 16 * s); avt[s] = *(const bf16x8*)(vp0 + 16 * s); } }
#pragma unroll
    for (int s = 0; s < 8; ++s) { const bf16x8 a = asb[s];
#pragma unroll
        for (int q = 0; q < 4; ++q) { const bf16x8 b = *(const LAS bf16x8*)(Ql + (32 * q + c) * KT_STRIDE + 16 * s + 8 * hh); acc[q] = mfma32(a, b, acc[q]); } }
#pragma unroll
    for (int q = 0; q < 4; ++q) { const int n = 32 * q + c; const float f = __builtin_amdgcn_exp2f((float)(128 - n) * lgb2 - (float)(n + 1) * lgf2); acc[q] *= f; }
#pragma unroll
    for (int s = 0; s < 8; ++s) { const bf16x8 a = asf[s];
#pragma unroll
        for (int q = 0; q < 4; ++q) { const bf16x8 b = *(const LAS bf16x8*)(Ql + (32 * q + c) * KT_STRIDE + 16 * s + 8 * hh); acc[q] = mfma32(a, b, acc[q]); } }
#pragma unroll
    for (int q = 0; q < 4; ++q) { const int n = 32 * q + c; const float f = __builtin_amdgcn_exp2f((float)(n + 1) * lgf2); acc[q] *= f; }
#pragma unroll
    for (int s = 0; s < 8; ++s) { const bf16x8 a = avt[s];
#pragma unroll
        for (int q = 0; q < 4; ++q) { const bf16x8 b = *(const LAS bf16x8*)(Pl + (32 * q + c) * KT_STRIDE + 16 * s + 8 * hh); acc[q] = mfma32(a, b, acc[q]); } }
#pragma unroll
    for (int q = 0; q < 4; ++q) { float s1 = 0.f, s2 = 0.f;
#pragma unroll
        for (int i = 0; i < 16; ++i) { s1 += acc[q][i]; s2 += acc[q][i] * acc[q][i]; }
        s1 += shx(s1, 32, lane); s2 += shx(s2, 32, lane);
        if (hh == 0) { stat[(w * 128 + 32 * q + c) * 2] = s1; stat[(w * 128 + 32 * q + c) * 2 + 1] = s2; } }
    __syncthreads();
#pragma unroll
    for (int q = 0; q < 4; ++q) { float s1 = 0.f, s2 = 0.f; const int n = 32 * q + c;
#pragma unroll
        for (int k = 0; k < 8; ++k) { s1 += stat[(k * 128 + n) * 2]; s2 += stat[(k * 128 + n) * 2 + 1]; }
        const float mu = s1 * (1.0f / 256.0f); float var = s2 * (1.0f / 256.0f) - mu * mu; var = var < 0.f ? 0.f : var; const float rs = rsqrtf(var + EPS);
#pragma unroll
        for (int g4 = 0; g4 < 4; ++g4) { u32x2 pw; pw.x = cvt_pk_bf16((acc[q][4 * g4] - mu) * rs, (acc[q][4 * g4 + 1] - mu) * rs); pw.y = cvt_pk_bf16((acc[q][4 * g4 + 2] - mu) * rs, (acc[q][4 * g4 + 3] - mu) * rs);
            *(LAS u32x2*)(Ol + n * OL_STRIDE + 32 * w + 8 * g4 + 4 * hh) = pw; } }
    __syncthreads();
#pragma unroll
    for (int it = 0; it < 8; ++it) { const int id = tid + NTHREADS * it, tq = id >> 5, d8 = (id & 31) * 8;
        float y[8], rg[8], o[8]; unpack8(*(const LAS u32x4*)(Ol + tq * OL_STRIDE + d8), y);
        unpack8(*(const u32x4*)(proj + (size_t)(tok0 + tq) * NPROJ + 2048 + h * 256 + d8), rg);
        const f32x4 g0 = *(const f32x4*)(gn + h * 256 + d8), g1 = *(const f32x4*)(gn + h * 256 + d8 + 4);
#pragma unroll
        for (int j = 0; j < 8; ++j) { const float gv = j < 4 ? g0[j & 3] : g1[j & 3]; o[j] = rg[j] * sigmoidf_(rg[j]) * y[j] * gv; }
        *(u32x4*)(ro + (size_t)(tok0 + tq) * 1536 + 512 + h * 256 + d8) = pack8(o); }
    __syncthreads();
}


#define XB_TMO      128
#define XB_XCNT(j)  (256  + 64 * (j))
#define XB_XSUB(j)  (1280 + 64 * (j))
#define XB_XGEN(j)  (2304 + 64 * (j))
#define XB_TOP      3328
#define XB_TOPGEN   3392
#define XCD_BAR_WORDS 3456
#define XB_SPIN_CAP (1u << 22)
__device__ __forceinline__ unsigned xb_ld(unsigned* p)              { return __hip_atomic_load(p, __ATOMIC_RELAXED, __HIP_MEMORY_SCOPE_AGENT); }
__device__ __forceinline__ unsigned xb_add(unsigned* p, unsigned v) { return __hip_atomic_fetch_add(p, v, __ATOMIC_RELAXED, __HIP_MEMORY_SCOPE_AGENT); }
__device__ __forceinline__ unsigned xb_xcc_id() { return (unsigned)__builtin_amdgcn_s_getreg((3 << 11) | 20) & 0xFu; }
#define XB_SPIN(cond, bar) do { unsigned _sp = 0; while (cond) { __builtin_amdgcn_s_sleep(1); \
    if ((++_sp & 255u) == 0u) { if (xb_ld(&(bar)[XB_TMO])) break; if (_sp > XB_SPIN_CAP) { atomicAdd(&(bar)[XB_TMO], 1u); break; } } } } while (0)
struct XcdBarrier { unsigned* bar; unsigned x; volatile LAS unsigned* st; };
__device__ __forceinline__ XcdBarrier xcd_barrier_post(unsigned* bar, volatile LAS unsigned* st) {
    XcdBarrier b; b.bar = bar; b.x = xb_xcc_id(); b.st = st;
    if (threadIdx.x == 0) (void)xb_add(&bar[XB_XCNT(b.x)], 1u);
    return b;
}
__device__ __forceinline__ void xcd_barrier_complete(unsigned* bar, unsigned x, unsigned& nloc, unsigned& nx) {
    const unsigned G = gridDim.x * gridDim.y * gridDim.z;
    unsigned sum, cnt, mine, sp = 0u;
    for (;;) {
        sum = 0u; cnt = 0u; mine = 0u;
#pragma unroll
        for (unsigned j = 0; j < 16; ++j) { const unsigned c = xb_ld(&bar[XB_XCNT(j)]); sum += c; cnt += (c > 0u) ? 1u : 0u; mine = (j == x) ? c : mine; }
        if (sum == G) break;
        __builtin_amdgcn_s_sleep(1);
        if ((++sp & 255u) == 0u) { if (xb_ld(&bar[XB_TMO])) break; if (sp > XB_SPIN_CAP) { atomicAdd(&bar[XB_TMO], 1u); break; } }
    }
    nloc = mine > 0u ? mine : 1u; nx = cnt > 0u ? cnt : 1u;
}
__device__ __forceinline__ void xcd_barrier(const XcdBarrier& b) {
    asm volatile("s_waitcnt vmcnt(0)" ::: "memory");
    __syncthreads();
    if (threadIdx.x == 0) {
        unsigned* bar = b.bar;
        __builtin_amdgcn_s_waitcnt(0);
        unsigned nloc = b.st[0], nx = b.st[1];
        if (nloc == 0u) { xcd_barrier_complete(bar, b.x, nloc, nx); b.st[0] = nloc; b.st[1] = nx; }
        const unsigned old = xb_add(&bar[XB_XSUB(b.x)], 1u);
        const unsigned gen = old / nloc;
        if (old + 1u == (gen + 1u) * nloc) {
            __builtin_amdgcn_fence(__ATOMIC_RELEASE, "agent");
            asm volatile("s_waitcnt vmcnt(0)" ::: "memory");
            const unsigned og = xb_add(&bar[XB_TOP], 1u);
            const unsigned tg = og / nx;
            if (og + 1u == (tg + 1u) * nx) xb_add(&bar[XB_TOPGEN], 1u);
            else XB_SPIN(xb_ld(&bar[XB_TOPGEN]) == tg, bar);
            __builtin_amdgcn_fence(__ATOMIC_ACQUIRE, "agent");
            xb_add(&bar[XB_XGEN(b.x)], 1u);
            asm volatile("s_waitcnt vmcnt(0)" ::: "memory");
        } else {
            XB_SPIN(xb_ld(&bar[XB_XGEN(b.x)]) == gen, bar);
            __builtin_amdgcn_fence(__ATOMIC_ACQUIRE, "agent");
            asm volatile("s_waitcnt vmcnt(0)" ::: "memory");
        }
    }
    __syncthreads();
}

__device__ __forceinline__ unsigned char* opq(unsigned char* p) { asm volatile("" : "+s"(p)); return p; }
#define WSP(T, off) ((T*)(opq(P.ws) + (off)))
#define XBAR() do { XcdBarrier _b; _b.bar = (unsigned*)(opq(P.ws) + WS_CTL); _b.x = (unsigned)__builtin_amdgcn_readfirstlane((int)xb_xcc_id()); _b.st = (volatile LAS unsigned*)(lds + 131072); xcd_barrier(_b); } while (0)
__global__ void __launch_bounds__(NTHREADS, 2) fwd_megakernel(Params P) {
    extern __shared__ __attribute__((aligned(16))) unsigned char lds_raw[];
    LAS unsigned char* lds = (LAS unsigned char*)lds_raw;
    cg::grid_group grid = cg::this_grid();
    const int G = ogrid(), bid = blockIdx.x;
    volatile LAS unsigned* xst = (volatile LAS unsigned*)(lds + 131072);
    if (threadIdx.x < 4) xst[threadIdx.x] = 0u;
    __syncthreads();
    (void)xcd_barrier_post((unsigned*)(P.ws + WS_CTL), xst);

    phase_prologue(P, lds);
    grid.sync();
    XBAR();

    for (int grp = 0; grp < NGROUPS; ++grp) {
        const float* xin = grp < 4 ? P.x_prompt + (size_t)grp * MG * D : P.x_sample;
        float* xo = P.out + (size_t)grp * MG * D;
        const int seqlen = grp < 4 ? 4096 : 16384;
        phase_init(xin, WSP(bf16_t, WS_XB), WSP(float, WS_ROWSS1), WSP(float, WS_ROWSS2));
        XBAR();
        for (int l = 0; l < DEPTH; ++l) {
            const size_t wl = WS_W + (size_t)l * W_LAYER;
            { pg8::Gemm g{WSP(bf16_t, WS_XB), WSP(const bf16_t, wl + W_IN_OFF), MG, NPROJ, D}; pg8::StaticOrder S; S.init(MG, NPROJ, G, bid);
              LAS float* rl = (LAS float*)(lds + LDS_RSTD_OFF); fill_rstd(rl, WSP(float, WS_ROWSS1), S, false);
              pg8::EpiRowScale E{WSP(bf16_t, WS_PROJ), NPROJ, rl}; pg8::gemm_phase(lds, g, S, E); }
            { pg8::Gemm g{WSP(const bf16_t, wl + W_IN_OFF + (size_t)NPROJ * D * 2), WSP(bf16_t, WS_XB), NPT, MG, D}; pg8::StaticOrder S; S.init(NPT, MG, G, bid);
              LAS float* rl = (LAS float*)(lds + LDS_RSTD_OFF); fill_rstd(rl, WSP(float, WS_ROWSS1), S, true);
              pg8::EpiColScale E{WSP(bf16_t, WS_PROJT), MG, rl}; pg8::gemm_phase(lds, g, S, E); }
            XBAR();
            { { const int tid = otid(), wv = __builtin_amdgcn_readfirstlane(tid >> 6), ln = tid & 63;
                for (int it = bid * 8 + wv; it < 2048; it += G * 8) na_item(WSP(bf16_t, WS_PROJ), WSP(bf16_t, WS_PROJT), WSP(bf16_t, WS_A), P.na_rel_bias + (size_t)l * 8 * 465, it, seqlen, lds, wv, ln);
                __syncthreads(); }
              for (int it = bid; it < 512; it += G) { const int h = it & 3;
                  const float* tab = WSP(const float, WS_LG2) + (l * 4 + h) * 2; const float lgf2 = tab[0], lgb2 = tab[1];
                  r1_item(WSP(bf16_t, WS_PROJT), WSP(bf16_t, WS_STLOC), WSP(float, WS_COST), WSP(float, WS_SINT), lgf2, lgb2, it, seqlen, lds); } }
            XBAR();
            phase_scan(WSP(bf16_t, WS_STLOC), WSP(bf16_t, WS_ST), P.dec_f + l * 4, P.dec_b + l * 4, seqlen);
            XBAR();
            for (int it = bid; it < 512; it += G) { const int h = it & 3;
                const float* tab = WSP(const float, WS_LG2) + (l * 4 + h) * 2; const float lgf2 = tab[0], lgb2 = tab[1];
                r3_item(WSP(bf16_t, WS_PROJ), WSP(bf16_t, WS_PROJT), WSP(bf16_t, WS_ST), WSP(bf16_t, WS_A), WSP(float, WS_COSN), WSP(float, WS_SINN), P.ret_norm_g + (size_t)l * 1024, lgf2, lgb2, it, seqlen, lds); }
            XBAR();
            { pg8::Gemm g{WSP(bf16_t, WS_A), WSP(const bf16_t, wl + W_A_OFF), MG, D, 1536}; pg8::StaticOrder S; S.init(MG, D, G, bid);
              pg8::EpiMerge E{WSP(bf16_t, WS_PROJ) + 3072, WSP(bf16_t, WS_PROJ) + 4096, WSP(bf16_t, WS_MIXED)}; pg8::gemm_phase(lds, g, S, E); }
            XBAR();
            { pg8::Gemm g{WSP(bf16_t, WS_MIXED), WSP(const bf16_t, wl + W_O_OFF), MG, D, D}; pg8::StaticOrder S; S.init(MG, D, G, bid);
              pg8::EpiResid E{WSP(bf16_t, WS_XB), WSP(float, WS_ROWSS2)}; pg8::gemm_phase(lds, g, S, E); }
            XBAR();
            { pg8::Gemm g{WSP(bf16_t, WS_XB), WSP(const bf16_t, wl + W_UP_OFF), MG, DFF2, D}; pg8::StaticOrder S; S.init(MG, DFF2, G, bid);
              LAS float* rl = (LAS float*)(lds + LDS_RSTD_OFF); fill_rstd(rl, WSP(float, WS_ROWSS2), S, false);
              pg8::EpiRowScale E{WSP(bf16_t, WS_PROJ), DFF2, rl}; pg8::gemm_phase(lds, g, S, E); }
            XBAR();
            phase_convact(WSP(bf16_t, WS_PROJ), WSP(bf16_t, WS_STLOC), P.conv_w + (size_t)l * 3 * DFF2, seqlen, WSP(float, WS_ROWSS2));
            XBAR();
            { pg8::Gemm g{WSP(bf16_t, WS_STLOC), WSP(const bf16_t, wl + W_D_OFF), MG, D, DFF}; pg8::StaticOrder S; S.init(MG, D, G, bid);
              pg8::EpiResid E{WSP(bf16_t, WS_XB), WSP(float, WS_ROWSS1)}; pg8::gemm_phase(lds, g, S, E); }
            XBAR();
        }
        phase_final(WSP(bf16_t, WS_XB), xo, WSP(float, WS_ROWSS1), P.norm_final_g);
        XBAR();
    }
}

extern "C" void kernel_launch(void* const* d_in, const int* in_sizes, int n_in, void* d_out, int out_size, void* d_ws, size_t ws_size, hipStream_t stream) {
    static int grid_blocks = 0;
    if (grid_blocks == 0) {
        if (n_in != 16 || ws_size < WS_END) { fprintf(stderr, "kernel_launch: unexpected n_in %d or ws_size %zu (< %zu)\n", n_in, ws_size, (size_t)WS_END); grid_blocks = -1; return; }
        int dev = 0, cus = 0, per_cu = 0;
        hipGetDevice(&dev);
        hipDeviceGetAttribute(&cus, hipDeviceAttributeMultiprocessorCount, dev);
        if (hipFuncSetAttribute((const void*)fwd_megakernel, hipFuncAttributeMaxDynamicSharedMemorySize, LDS_BYTES) != hipSuccess) { fprintf(stderr, "kernel_launch: hipFuncSetAttribute failed\n"); grid_blocks = -1; return; }
        hipOccupancyMaxActiveBlocksPerMultiprocessor(&per_cu, (const void*)fwd_megakernel, NTHREADS, LDS_BYTES);
        if (per_cu < 1) { fprintf(stderr, "kernel_launch: occupancy query says %d blocks per CU\n", per_cu); per_cu = 1; }
        (void)hipGetLastError();
        grid_blocks = cus;
    }
    if (grid_blocks < 0) return;
    if (hipMemsetAsync((char*)d_ws + WS_CTL, 0, 16384, stream) != hipSuccess) { fprintf(stderr, "kernel_launch: memset of barrier words failed\n"); return; }
    Params p{};
    p.x_prompt = (const float*)d_in[0]; p.x_sample = (const float*)d_in[1]; p.norm_mix_g = (const float*)d_in[2]; p.w_in = (const float*)d_in[3]; p.na_rel_bias = (const float*)d_in[4];
    p.dec_f = (const float*)d_in[5]; p.dec_b = (const float*)d_in[6]; p.ret_norm_g = (const float*)d_in[7]; p.w_ba = (const float*)d_in[8]; p.w_br = (const float*)d_in[9]; p.w_out = (const float*)d_in[10];
    p.norm_ffn_g = (const float*)d_in[11]; p.w_up = (const float*)d_in[12]; p.conv_w = (const float*)d_in[13]; p.w_down = (const float*)d_in[14]; p.norm_final_g = (const float*)d_in[15];
    p.out = (float*)d_out; p.ws = (unsigned char*)d_ws;
    void* args[] = {&p};
    hipError_t e = hipLaunchCooperativeKernel((const void*)fwd_megakernel, dim3(grid_blocks), dim3(NTHREADS), args, LDS_BYTES, stream);
    if (e != hipSuccess) fprintf(stderr, "kernel_launch: cooperative launch failed: %s (grid %d)\n", hipGetErrorString(e), grid_blocks);
}
```

```cpp
#include <hip/hip_runtime.h>
#include <hip/hip_cooperative_groups.h>
#include <cstdio>
namespace cg = cooperative_groups;

#define LAS __attribute__((address_space(3)))
typedef unsigned short bf16_t;
typedef short bf16x8 __attribute__((ext_vector_type(8)));
typedef short bf16x4 __attribute__((ext_vector_type(4)));
typedef float f32x4 __attribute__((ext_vector_type(4)));
typedef float f32x16 __attribute__((ext_vector_type(16)));
typedef unsigned u32x4 __attribute__((ext_vector_type(4)));
typedef unsigned u32x2 __attribute__((ext_vector_type(2)));

constexpr int D = 1024, MG = 16384, NPROJ = 5120, NPT = 2048, DFF = 2816, DFF2 = 5632, DEPTH = 4, NGROUPS = 5, DIN = 6656;
constexpr float EPS = 1e-6f;
constexpr int NTHREADS = 512;
constexpr int LDS_RSTD_OFF = 131072 + 1024;
constexpr int LDS_BYTES = 131072 + 1024 + 12288;

constexpr size_t WS_CTL = 0;
constexpr size_t WS_LG2 = 32768;
constexpr size_t WS_ROWSS1 = 262144;
constexpr size_t WS_ROWSS2 = WS_ROWSS1 + (size_t)2 * MG * 16 * 4;
constexpr size_t WS_COSN = WS_ROWSS2 + (size_t)2 * MG * 16 * 4;
constexpr size_t TAB_BYTES = (size_t)16384 * 64 * 4;
constexpr size_t WS_SINN = WS_COSN + TAB_BYTES;
constexpr size_t WS_COST = WS_SINN + TAB_BYTES;
constexpr size_t WS_SINT = WS_COST + TAB_BYTES;
constexpr size_t WS_W = WS_SINT + TAB_BYTES;
constexpr size_t W_IN_OFF = 0;
constexpr size_t W_A_OFF = W_IN_OFF + (size_t)7168 * 1024 * 2;
constexpr size_t W_R_OFF = W_A_OFF + (size_t)1024 * 512 * 2;
constexpr size_t W_O_OFF = W_R_OFF + (size_t)1024 * 1024 * 2;
constexpr size_t W_UP_OFF = W_O_OFF + (size_t)1024 * 1024 * 2;
constexpr size_t W_D_OFF = W_UP_OFF + (size_t)5632 * 1024 * 2;
constexpr size_t W_LAYER = W_D_OFF + (size_t)1024 * 2816 * 2;
constexpr size_t WS_XB = WS_W + W_LAYER * DEPTH;
constexpr size_t WS_S = WS_XB + (size_t)2 * MG * D * 2;
constexpr size_t WS_PROJ = WS_S;
constexpr size_t WS_PROJT = WS_PROJ + (size_t)MG * NPROJ * 2;
constexpr size_t WS_A = WS_PROJT + (size_t)NPT * MG * 2;
constexpr size_t WS_MIXED = WS_A + (size_t)MG * 1536 * 2;
constexpr size_t WS_STLOC = WS_MIXED + (size_t)MG * D * 2;
constexpr size_t WS_ST = WS_STLOC + (size_t)128 * 4 * 2 * 32768 * 2;
constexpr size_t WS_MIX_END = WS_ST + (size_t)128 * 4 * 2 * 32768 * 2;
constexpr size_t WS_U = WS_S;
constexpr size_t WS_ACT = WS_U + (size_t)2 * MG * DFF2 * 2;
constexpr size_t WS_FFN_END = WS_ACT + (size_t)2 * MG * DFF * 2;
constexpr size_t WS_END = WS_MIX_END > WS_FFN_END ? WS_MIX_END : WS_FFN_END;
static_assert(WS_END <= ((size_t)1 << 30), "workspace over 1 GiB");

struct Params {
    const float* x_prompt; const float* x_sample; const float* norm_mix_g; const float* w_in; const float* na_rel_bias;
    const float* dec_f; const float* dec_b; const float* ret_norm_g; const float* w_ba; const float* w_br; const float* w_out;
    const float* norm_ffn_g; const float* w_up; const float* conv_w; const float* w_down; const float* norm_final_g;
    float* out; unsigned char* ws;
};

typedef __bf16 bf16v2_t __attribute__((ext_vector_type(2)));
typedef float f32v2_t __attribute__((ext_vector_type(2)));
__device__ __forceinline__ unsigned cvt_pk_bf16(float lo, float hi) { const f32v2_t v = {lo, hi}; const bf16v2_t r = __builtin_convertvector(v, bf16v2_t); return __builtin_bit_cast(unsigned, r); }
__device__ __forceinline__ float bf_lo(unsigned w) { return __uint_as_float(w << 16); }
__device__ __forceinline__ float bf_hi(unsigned w) { return __uint_as_float(w & 0xffff0000u); }
__device__ __forceinline__ float bf2f(bf16_t b) { return __uint_as_float(((unsigned)b) << 16); }
__device__ __forceinline__ float sigmoidf_(float x) { return __builtin_amdgcn_rcpf(1.0f + __expf(-x)); }
__device__ __forceinline__ void unpack8(const u32x4 w, float* f) { f[0] = bf_lo(w.x); f[1] = bf_hi(w.x); f[2] = bf_lo(w.y); f[3] = bf_hi(w.y); f[4] = bf_lo(w.z); f[5] = bf_hi(w.z); f[6] = bf_lo(w.w); f[7] = bf_hi(w.w); }
__device__ __forceinline__ u32x4 pack8(const float* f) { u32x4 w; w.x = cvt_pk_bf16(f[0], f[1]); w.y = cvt_pk_bf16(f[2], f[3]); w.z = cvt_pk_bf16(f[4], f[5]); w.w = cvt_pk_bf16(f[6], f[7]); return w; }
__device__ __forceinline__ f32x16 mfma32(bf16x8 a, bf16x8 b, f32x16 c) { return __builtin_amdgcn_mfma_f32_32x32x16_bf16(a, b, c, 0, 0, 0); }
__device__ __forceinline__ int otid() { int t = threadIdx.x; asm volatile("" : "+v"(t)); return t; }
__device__ __forceinline__ int ogrid() { int g = gridDim.x; asm volatile("" : "+s"(g)); return g; }
__device__ __forceinline__ f32x16 zero16() { return (f32x16){0.f, 0.f, 0.f, 0.f, 0.f, 0.f, 0.f, 0.f, 0.f, 0.f, 0.f, 0.f, 0.f, 0.f, 0.f, 0.f}; }
__device__ __forceinline__ float sum16(const float* p) { const f32x4 a = *(const f32x4*)p, b = *(const f32x4*)(p + 4), c = *(const f32x4*)(p + 8), d = *(const f32x4*)(p + 12); const f32x4 t = (a + b) + (c + d); return (t[0] + t[1]) + (t[2] + t[3]); }
__device__ __forceinline__ float shx(float v, int m, int lane) { return __int_as_float(__builtin_amdgcn_ds_bpermute((lane ^ m) << 2, __float_as_int(v))); }
__device__ __forceinline__ float wave_sum(float v, int lane) { v += shx(v, 32, lane); v += shx(v, 16, lane); v += shx(v, 8, lane); v += shx(v, 4, lane); v += shx(v, 2, lane); v += shx(v, 1, lane); return v; }

namespace pg8 {
constexpr int BM = 256, BK = 64, HALF = 128, HTB = HALF * BK * 2, STAGE_BYTES = 8 * HTB, NXCD = 8, WGM = 8;
__host__ __device__ __forceinline__ int lds_byte(int r, int c) { const int st = (r >> 4) * 2 + (c >> 5), rr = r & 15, cc = c & 31, ob = rr * 64 + cc * 2; return st * 1024 + (ob ^ (((ob >> 9) & 1) << 5)); }
__host__ __device__ __forceinline__ void stage_rc(int b, int& R, int& C) { const int st = b / 1024, sb = b % 1024, swz = sb ^ (((sb >> 9) & 1) << 5); R = (st >> 1) * 16 + swz / 64; C = (st & 1) * 32 + (swz % 64) / 2; }
__host__ __device__ __forceinline__ int perm32(int rho) { const int n = rho >> 4, i = rho & 15; return 8 * (i >> 2) + 4 * n + (i & 3); }
struct Unit { int pm, pn, idx, kind; };
struct Gemm { const bf16_t* A; const bf16_t* Bt; int M, N, K; };
struct StaticOrder {
    int nM, nN, nwg, G, c;
    __host__ __device__ void init(int M, int N, int G_, int c_) { nM = M / BM; nN = N / BM; nwg = nM * nN; G = G_; c = c_; }
    __host__ __device__ bool next(int i, Unit& u) const { return at((long)i * G + c, u); }
    __host__ __device__ bool at(long L, Unit& u) const {
        if (L >= nwg) return false;
        u.kind = 0;
        int wgid = (int)L; { const int q = nwg / NXCD, r = nwg % NXCD, xcd = wgid % NXCD, off = wgid / NXCD; wgid = (xcd < r ? xcd * (q + 1) : r * (q + 1) + (xcd - r) * q) + off; }
        const int nig = WGM * nN, gid = wgid / nig, fm = gid * WGM, gsz = (nM - fm) < WGM ? (nM - fm) : WGM;
        u.pm = fm + ((wgid % nig) % gsz); u.pn = (wgid % nig) / gsz; return true;
    }
    __device__ __forceinline__ void a_ready(const Unit&) const {}
    __device__ __forceinline__ void done(const Unit&) const {}
    __device__ __forceinline__ const char* abase(const Gemm& g, const Unit& u, size_t tstep) const { return (const char*)g.A + (size_t)u.pm * tstep; }
    __device__ __forceinline__ const char* bbase(const Gemm& g, const Unit& u, size_t tstep) const { return (const char*)g.Bt + (size_t)u.pn * tstep; }
};
struct P1Order {
    StaticOrder s0, s1; int G, c; const bf16_t* wt2;
    __device__ void init(int G_, int c_, const bf16_t* wt2_) { s0.init(MG, NPROJ, G_, c_); s1.init(NPT, MG, G_, c_); G = G_; c = c_; wt2 = wt2_; }
    __device__ bool next(int i, Unit& u) const { const long L = (long)i * G + c; if (L < 1280) return s0.at(L, u); if (!s1.at(L - 1280, u)) return false; u.kind = 1; return true; }
    __device__ __forceinline__ void a_ready(const Unit&) const {}
    __device__ __forceinline__ void done(const Unit&) const {}
    __device__ __forceinline__ const char* abase(const Gemm& g, const Unit& u, size_t tstep) const { return (u.kind ? (const char*)wt2 : (const char*)g.A) + (size_t)u.pm * tstep; }
    __device__ __forceinline__ const char* bbase(const Gemm& g, const Unit& u, size_t tstep) const { return (u.kind ? (const char*)g.A : (const char*)g.Bt) + (size_t)u.pn * tstep; }
};

template <class Epi, class Sched>
__device__ __forceinline__ void gemm_phase(LAS unsigned char* lds, const Gemm g, const Sched& S, const Epi& E) {
    const int tid = otid(), wid = __builtin_amdgcn_readfirstlane(tid >> 6), lane = tid & 63, wr = wid >> 2, wc = wid & 3, fr = lane & 15, fq = lane >> 4;
    const int K = g.K, nt = K / BK;
    unsigned voffA[2], voffB[2];
#pragma unroll
    for (int i = 0; i < 2; ++i) { int R, C; stage_rc(tid * 16 + i * 8192, R, C); const int Rb = Epi::PERM ? ((R & ~31) + perm32(R & 31)) : R;
        voffA[i] = (unsigned)(R * K + C) * 2u; voffB[i] = (unsigned)(Rb * K + C) * 2u; }
    const size_t kstep = (size_t)(BK * 2);
    const size_t hstep = (size_t)HALF * K * 2;
    const size_t tstep = 2 * hstep;
    const unsigned ldsw = (unsigned)wid * 1024u;
    const int aoff = lds_byte(wr * 64 + fr, fq * 8), boff = lds_byte(wc * 32 + fr, fq * 8);
#define PG8_SA(b, h) (((b) * 2 + (h)) * HTB)
#define PG8_SB(b, h) ((4 + (b) * 2 + (h)) * HTB)
#define PG8_STAGE(bufoff, gbase, voff) do { _Pragma("unroll") for (int _i = 0; _i < 2; ++_i) \
        __builtin_amdgcn_global_load_lds((const unsigned*)((const char*)(gbase) + (voff)[_i]), (LAS unsigned*)(lds + (bufoff) + ldsw + _i * 8192), 16, 0, 0); } while (0)
#define PG8_LDA(dst, b, h) do { _Pragma("unroll") for (int m = 0; m < 4; ++m) _Pragma("unroll") for (int k = 0; k < 2; ++k) dst[m][k] = *(const LAS bf16x8*)(lds + PG8_SA(b, h) + aoff + m * 2048 + k * 1024); } while (0)
#define PG8_LDB(dst, b, h) do { _Pragma("unroll") for (int n = 0; n < 2; ++n) _Pragma("unroll") for (int k = 0; k < 2; ++k) dst[n][k] = *(const LAS bf16x8*)(lds + PG8_SB(b, h) + boff + n * 2048 + k * 1024); } while (0)
#define PG8_MMA(ai, bj, At, Bt) do { __builtin_amdgcn_s_setprio(1); _Pragma("unroll") for (int m = 0; m < 4; ++m) _Pragma("unroll") for (int n = 0; n < 2; ++n) _Pragma("unroll") for (int k = 0; k < 2; ++k) \
        acc[ai][bj][m][n] = __builtin_amdgcn_mfma_f32_16x16x32_bf16(Bt[n][k], At[m][k], acc[ai][bj][m][n], 0, 0, 0); __builtin_amdgcn_s_setprio(0); } while (0)
#define PG8_WAIT_V(n) asm volatile("s_waitcnt vmcnt(" #n ")" ::: "memory")
#define PG8_WAIT_L(n) asm volatile("s_waitcnt lgkmcnt(" #n ")" ::: "memory")
#define PG8_BAR __builtin_amdgcn_s_barrier()
#define PG8_SCHED __builtin_amdgcn_sched_barrier(0)
    Unit cur, nxt; int ui = 0;
    if (!S.next(0, cur)) return;
    cur.idx = 0;
    f32x4 acc[2][2][4][2];
#pragma unroll
    for (int a = 0; a < 2; ++a)
#pragma unroll
        for (int b = 0; b < 2; ++b)
#pragma unroll
            for (int m = 0; m < 4; ++m)
#pragma unroll
                for (int n = 0; n < 2; ++n) acc[a][b][m][n] = (f32x4){0.f, 0.f, 0.f, 0.f};
    bf16x8 At[4][2], B0[2][2], B1[2][2];
    const char* cA = S.abase(g, cur, tstep); const char* cB = S.bbase(g, cur, tstep);
    S.a_ready(cur);
    PG8_STAGE(PG8_SB(0, 0), cB, voffB); PG8_STAGE(PG8_SA(0, 0), cA, voffA); PG8_STAGE(PG8_SB(0, 1), cB + hstep, voffB); PG8_STAGE(PG8_SA(0, 1), cA + hstep, voffA);
    if (wr == 1) PG8_BAR;
    PG8_WAIT_V(4); PG8_BAR;
    PG8_STAGE(PG8_SB(1, 0), cB + kstep, voffB); PG8_STAGE(PG8_SA(1, 0), cA + kstep, voffA); PG8_STAGE(PG8_SB(1, 1), cB + hstep + kstep, voffB);
    PG8_WAIT_V(6); PG8_BAR;
    for (;;) {
        const bool has_next = S.next(ui + 1, nxt); nxt.idx = ui + 1;
        const char* nA = has_next ? S.abase(g, nxt, tstep) : cA; const char* nB = has_next ? S.bbase(g, nxt, tstep) : cB;
        for (int t = 0; t < nt; t += 2) {
            const bool last = (t == nt - 2);
            const char* a1 = cA + (size_t)(t + 1) * kstep;
            const char* a2 = last ? nA : cA + (size_t)(t + 2) * kstep; const char* b2 = last ? nB : cB + (size_t)(t + 2) * kstep;
            const char* a3 = a2 + kstep; const char* b3 = b2 + kstep;
            if (last && has_next) S.a_ready(nxt);
            if constexpr (Epi::MID > 0) { if (t == Epi::MID) E.mid(acc, cur, wr, wc, fr, fq); }
            PG8_LDB(B0, 0, 0); PG8_SCHED; PG8_LDA(At, 0, 0); PG8_STAGE(PG8_SA(1, 1), a1 + hstep, voffA);
            PG8_WAIT_L(8); PG8_BAR; PG8_WAIT_L(0); PG8_MMA(0, 0, At, B0); PG8_BAR; PG8_SCHED;
            PG8_LDB(B1, 0, 1); PG8_STAGE(PG8_SB(0, 0), b2, voffB);
            PG8_BAR; PG8_WAIT_L(0); PG8_MMA(0, 1, At, B1); PG8_BAR;
            PG8_LDA(At, 0, 1); PG8_STAGE(PG8_SA(0, 0), a2, voffA);
            PG8_BAR; PG8_WAIT_L(0); PG8_MMA(1, 0, At, B0); PG8_BAR; PG8_SCHED;
            PG8_STAGE(PG8_SB(0, 1), b2 + hstep, voffB);
            PG8_WAIT_V(6); PG8_BAR; PG8_MMA(1, 1, At, B1); PG8_BAR;
            PG8_LDB(B0, 1, 0); PG8_SCHED; PG8_LDA(At, 1, 0); PG8_STAGE(PG8_SA(0, 1), a2 + hstep, voffA);
            PG8_WAIT_L(8); PG8_BAR; PG8_WAIT_L(0); PG8_MMA(0, 0, At, B0); PG8_BAR; PG8_SCHED;
            PG8_LDB(B1, 1, 1); PG8_STAGE(PG8_SB(1, 0), b3, voffB);
            PG8_BAR; PG8_WAIT_L(0); PG8_MMA(0, 1, At, B1); PG8_BAR;
            PG8_LDA(At, 1, 1); PG8_STAGE(PG8_SA(1, 0), a3, voffA);
            PG8_BAR; PG8_WAIT_L(0); PG8_MMA(1, 0, At, B0); PG8_BAR; PG8_SCHED;
            PG8_STAGE(PG8_SB(1, 1), b3 + hstep, voffB);
            PG8_WAIT_V(6); PG8_BAR; PG8_MMA(1, 1, At, B1); PG8_BAR;
        }
        E(acc, cur, wr, wc, fr, fq); S.done(cur);
        if (!has_next) break;
#pragma unroll
        for (int a = 0; a < 2; ++a)
#pragma unroll
            for (int b = 0; b < 2; ++b)
#pragma unroll
                for (int m = 0; m < 4; ++m)
#pragma unroll
                    for (int n = 0; n < 2; ++n) acc[a][b][m][n] = (f32x4){0.f, 0.f, 0.f, 0.f};
        cur = nxt; cA = nA; cB = nB; ++ui;
    }
    PG8_WAIT_V(0);
    if (wr == 0) PG8_BAR;
    PG8_BAR;
#undef PG8_SA
#undef PG8_SB
#undef PG8_STAGE
#undef PG8_LDA
#undef PG8_LDB
#undef PG8_MMA
#undef PG8_WAIT_V
#undef PG8_WAIT_L
#undef PG8_BAR
#undef PG8_SCHED
}

struct EpiRowScale {
    static constexpr bool PERM = true; static constexpr int MID = 0;
    bf16_t* O; int ldc; const LAS float* rl;
    __device__ __forceinline__ void operator()(const f32x4 (&acc)[2][2][4][2], const Unit& u, int wr, int wc, int fr, int fq) const {
        const int row0 = u.pm * BM + wr * 64 + fr, col0 = u.pn * BM + wc * 32 + 8 * fq;
#pragma unroll
        for (int ai = 0; ai < 2; ++ai)
#pragma unroll
            for (int m = 0; m < 4; ++m) { const int row = row0 + ai * HALF + m * 16; const float rs = rl[u.idx * 256 + wr * 64 + fr + ai * HALF + m * 16];
                bf16_t* rowp = O + (size_t)row * ldc + col0;
#pragma unroll
                for (int bj = 0; bj < 2; ++bj) { const f32x4 v0 = acc[ai][bj][m][0] * rs, v1 = acc[ai][bj][m][1] * rs;
                    u32x4 w; w.x = cvt_pk_bf16(v0[0], v0[1]); w.y = cvt_pk_bf16(v0[2], v0[3]); w.z = cvt_pk_bf16(v1[0], v1[1]); w.w = cvt_pk_bf16(v1[2], v1[3]);
                    *(u32x4*)(rowp + bj * HALF) = w; } }
    }
};
struct EpiColScale {
    static constexpr bool PERM = true; static constexpr int MID = 0;
    bf16_t* O; int ldc; const LAS float* rl;
    __device__ __forceinline__ void operator()(const f32x4 (&acc)[2][2][4][2], const Unit& u, int wr, int wc, int fr, int fq) const {
        const int row0 = u.pm * BM + wr * 64 + fr, col0 = u.pn * BM + wc * 32 + 8 * fq;
        f32x4 sc[2][2];
#pragma unroll
        for (int bj = 0; bj < 2; ++bj)
#pragma unroll
            for (int n = 0; n < 2; ++n) sc[bj][n] = *(const LAS f32x4*)(rl + u.idx * 256 + wc * 32 + 8 * fq + bj * HALF + 4 * n);
#pragma unroll
        for (int ai = 0; ai < 2; ++ai)
#pragma unroll
            for (int m = 0; m < 4; ++m) { const int row = row0 + ai * HALF + m * 16; bf16_t* rowp = O + (size_t)row * ldc + col0;
#pragma unroll
                for (int bj = 0; bj < 2; ++bj) { const f32x4 v0 = acc[ai][bj][m][0] * sc[bj][0], v1 = acc[ai][bj][m][1] * sc[bj][1];
                    u32x4 w; w.x = cvt_pk_bf16(v0[0], v0[1]); w.y = cvt_pk_bf16(v0[2], v0[3]); w.z = cvt_pk_bf16(v1[0], v1[1]); w.w = cvt_pk_bf16(v1[2], v1[3]);
                    *(u32x4*)(rowp + bj * HALF) = w; } }
    }
};
struct EpiP1 {
    static constexpr bool PERM = true; static constexpr int MID = 0;
    EpiRowScale e0; EpiColScale e1;
    __device__ __forceinline__ void operator()(const f32x4 (&acc)[2][2][4][2], const Unit& u, int wr, int wc, int fr, int fq) const { if (u.kind == 0) e0(acc, u, wr, wc, fr, fq); else e1(acc, u, wr, wc, fr, fq); }
};
struct EpiGate {
    static constexpr bool PERM = true; static constexpr int MID = 0;
    const bf16_t* gate; const bf16_t* addsrc; bf16_t* O;
    __device__ __forceinline__ void operator()(const f32x4 (&acc)[2][2][4][2], const Unit& u, int wr, int wc, int fr, int fq) const {
        const int row0 = u.pm * BM + wr * 64 + fr, col0 = u.pn * BM + wc * 32 + 8 * fq;
#pragma unroll
        for (int ai = 0; ai < 2; ++ai)
#pragma unroll
            for (int m = 0; m < 4; ++m) { const int row = row0 + ai * HALF + m * 16;
#pragma unroll
                for (int bj = 0; bj < 2; ++bj) { const int col = col0 + bj * HALF;
                    float gf[8], r[8]; unpack8(*(const u32x4*)(gate + (size_t)row * NPROJ + col), gf);
                    const f32x4 v0 = acc[ai][bj][m][0], v1 = acc[ai][bj][m][1];
#pragma unroll
                    for (int j = 0; j < 4; ++j) { r[j] = v0[j] * sigmoidf_(gf[j]); r[4 + j] = v1[j] * sigmoidf_(gf[4 + j]); }
                    if (addsrc) { float af[8]; unpack8(*(const u32x4*)(addsrc + (size_t)row * D + col), af);
#pragma unroll
                        for (int j = 0; j < 8; ++j) r[j] += af[j]; }
                    *(u32x4*)(O + (size_t)row * D + col) = pack8(r); } }
    }
};
struct EpiMerge {
    static constexpr bool PERM = true; static constexpr int MID = 8;
    const bf16_t* ga; const bf16_t* gr; bf16_t* O;
    __device__ __forceinline__ void mid(f32x4 (&acc)[2][2][4][2], const Unit& u, int wr, int wc, int fr, int fq) const {
        const int row0 = u.pm * BM + wr * 64 + fr, col0 = u.pn * BM + wc * 32 + 8 * fq;
#pragma unroll
        for (int ai = 0; ai < 2; ++ai)
#pragma unroll
            for (int m = 0; m < 4; ++m) { int row = row0 + ai * HALF + m * 16; asm volatile("" : "+v"(row));
#pragma unroll
                for (int bj = 0; bj < 2; ++bj) { const size_t off = (size_t)row * NPROJ + col0 + bj * HALF;
                    float fa[8], fb[8]; unpack8(*(const u32x4*)(ga + off), fa); unpack8(*(const u32x4*)(gr + off), fb);
#pragma unroll
                    for (int j = 0; j < 8; ++j) { const float rt = (1.0f + __builtin_amdgcn_exp2f(fb[j] * -1.4426950408889634f)) * __builtin_amdgcn_rcpf(1.0f + __builtin_amdgcn_exp2f(fa[j] * -1.4426950408889634f));
                        if (j < 4) acc[ai][bj][m][0][j] *= rt; else acc[ai][bj][m][1][j - 4] *= rt; } }
                asm volatile("" ::: "memory"); }
    }
    __device__ __forceinline__ void operator()(const f32x4 (&acc)[2][2][4][2], const Unit& u, int wr, int wc, int fr, int fq) const {
        const int row0 = u.pm * BM + wr * 64 + fr, col0 = u.pn * BM + wc * 32 + 8 * fq;
#pragma unroll
        for (int ai = 0; ai < 2; ++ai)
#pragma unroll
            for (int m = 0; m < 4; ++m) { const int row = row0 + ai * HALF + m * 16;
#pragma unroll
                for (int bj = 0; bj < 2; ++bj) { const int col = col0 + bj * HALF;
                    float gf[8], r[8]; unpack8(*(const u32x4*)(gr + (size_t)row * NPROJ + col), gf);
                    const f32x4 v0 = acc[ai][bj][m][0], v1 = acc[ai][bj][m][1];
#pragma unroll
                    for (int j = 0; j < 4; ++j) { r[j] = v0[j] * sigmoidf_(gf[j]); r[4 + j] = v1[j] * sigmoidf_(gf[4 + j]); }
                    *(u32x4*)(O + (size_t)row * D + col) = pack8(r); } }
    }
};
struct EpiResid {
    static constexpr bool PERM = true; static constexpr int MID = 0;
    bf16_t* xb; float* rowss;
    __device__ __forceinline__ void operator()(const f32x4 (&acc)[2][2][4][2], const Unit& u, int wr, int wc, int fr, int fq) const {
        const int row0 = u.pm * BM + wr * 64 + fr, col0 = u.pn * BM + wc * 32 + 8 * fq;
#pragma unroll
        for (int ai = 0; ai < 2; ++ai)
#pragma unroll
            for (int m = 0; m < 4; ++m) { const int row = row0 + ai * HALF + m * 16; float ss = 0.f;
#pragma unroll
                for (int bj = 0; bj < 2; ++bj) { const size_t off = (size_t)row * D + col0 + bj * HALF;
                    float b[8], r[8]; unpack8(*(const u32x4*)(xb + off), b);
                    const f32x4 v0 = acc[ai][bj][m][0], v1 = acc[ai][bj][m][1];
#pragma unroll
                    for (int j = 0; j < 4; ++j) { b[j] += v0[j]; b[4 + j] += v1[j]; }
                    const u32x4 w = pack8(b);
                    *(u32x4*)(xb + off) = w;
                    unpack8(w, r);
#pragma unroll
                    for (int j = 0; j < 8; ++j) ss += r[j] * r[j]; }
                { const int ln = fr + 16 * fq; ss += shx(ss, 16, ln); ss += shx(ss, 32, ln); }
                if (fq == 0) rowss[(size_t)row * 16 + u.pn * 4 + wc] = ss; }
    }
};
}

template <class Sched> __device__ __forceinline__ void fill_rstd(LAS float* rl, const float* rowss, const Sched& S, int by_col  ) {
    const int tid = otid();
    for (int e = tid; e < 12 * 256; e += NTHREADS) { pg8::Unit u; const int i = e >> 8;
        if (S.next(i, u)) { const bool bc = by_col < 0 ? (u.kind != 0) : (by_col != 0); const int r = (bc ? u.pn : u.pm) * 256 + (e & 255); rl[e] = rsqrtf(sum16(rowss + (size_t)r * 16) * (1.0f / 1024.0f) + EPS); } }
    __syncthreads();
}

__device__ __forceinline__ int win_srccol(int nd) {
    if (nd < 1024) return nd;
    if (nd < 1536) return 1536 + (nd - 1024);
    if (nd < 2048) return 2048 + (nd - 1536);
    if (nd < 3072) return 3584 + (nd - 2048);
    if (nd < 4096) return 4608 + (nd - 3072);
    if (nd < 5120) return 5632 + (nd - 4096);
    nd -= 5120;
    if (nd < 512) return 1024 + nd;
    if (nd < 1024) return 2048 + (nd - 512);
    return 2560 + (nd - 1024);
}
__device__ __forceinline__ void conv_tile(const float* __restrict__ src, int ld_src, int k0, int nsrc0, bf16_t* dst, int ldd, int ndst0, const float* gsc, LAS float* tile, int kdst0 = 0) {
    const int t = otid();
#pragma unroll
    for (int i = 0; i < 2; ++i) { const int r = (t >> 4) + 32 * i, c = (t & 15) * 4;
        const float4 v = *(const float4*)(src + (size_t)(k0 + r) * ld_src + nsrc0 + c);
        const float s = gsc ? gsc[k0 + r] : 1.0f;
        tile[r * 65 + c] = v.x * s; tile[r * 65 + c + 1] = v.y * s; tile[r * 65 + c + 2] = v.z * s; tile[r * 65 + c + 3] = v.w * s; }
    __syncthreads();
    { const int n = t >> 3, k8 = (t & 7) * 8; float f[8];
#pragma unroll
      for (int j = 0; j < 8; ++j) f[j] = tile[(k8 + j) * 65 + n];
      *(u32x4*)(dst + (size_t)(ndst0 + n) * ldd + kdst0 + k0 + k8) = pack8(f); }
    __syncthreads();
}
__device__ __forceinline__ void phase_prologue(const Params& P, LAS unsigned char* lds) {
    LAS float* tile = (LAS float*)lds;
    constexpr int T_IN = 16 * 112, T_A = 8 * 16, T_R = 16 * 16, T_O = 16 * 16, T_UP = 16 * 88, T_D = 44 * 16, T_L = T_IN + T_A + T_R + T_O + T_UP + T_D;
    for (int job = blockIdx.x; job < T_L * DEPTH; job += ogrid()) {
        const int l = job / T_L; int r = job % T_L;
        unsigned char* wl = P.ws + WS_W + (size_t)l * W_LAYER;
        if (r < T_IN) { const int kt = r / 112, ntile = r % 112; conv_tile(P.w_in + (size_t)l * D * DIN, DIN, kt * 64, win_srccol(ntile * 64), (bf16_t*)(wl + W_IN_OFF), 1024, ntile * 64, P.norm_mix_g + l * D, tile); continue; }
        r -= T_IN;
        if (r < T_A) { const int kt = r / 16, ntile = r % 16; conv_tile(P.w_ba + (size_t)l * 512 * D, D, kt * 64, ntile * 64, (bf16_t*)(wl + W_A_OFF), 1536, ntile * 64, nullptr, tile, 0); continue; }
        r -= T_A;
        if (r < T_R) { const int kt = r / 16, ntile = r % 16; conv_tile(P.w_br + (size_t)l * D * D, D, kt * 64, ntile * 64, (bf16_t*)(wl + W_A_OFF), 1536, ntile * 64, nullptr, tile, 512); continue; }
        r -= T_R;
        if (r < T_O) { const int kt = r / 16, ntile = r % 16; conv_tile(P.w_out + (size_t)l * D * D, D, kt * 64, ntile * 64, (bf16_t*)(wl + W_O_OFF), 1024, ntile * 64, nullptr, tile); continue; }
        r -= T_O;
        if (r < T_UP) { const int kt = r / 88, ntile = r % 88; conv_tile(P.w_up + (size_t)l * D * DFF2, DFF2, kt * 64, ntile * 64, (bf16_t*)(wl + W_UP_OFF), 1024, ntile * 64, P.norm_ffn_g + l * D, tile); continue; }
        r -= T_UP;
        { const int kt = r / 16, ntile = r % 16; conv_tile(P.w_down + (size_t)l * DFF * D, D, kt * 64, ntile * 64, (bf16_t*)(wl + W_D_OFF), DFF, ntile * 64, nullptr, tile); }
    }
    if (blockIdx.x == 0 && otid() < DEPTH * 4) { const int i = otid(); float* tab = (float*)(P.ws + WS_LG2);
        tab[2 * i] = -log1pf(expf(-P.dec_f[i])) * 1.4426950408889634f; tab[2 * i + 1] = -log1pf(expf(-P.dec_b[i])) * 1.4426950408889634f; }
    float* cosN = (float*)(P.ws + WS_COSN); float* sinN = (float*)(P.ws + WS_SINN); float* cosT = (float*)(P.ws + WS_COST); float* sinT = (float*)(P.ws + WS_SINT);
    for (int idx = blockIdx.x * NTHREADS + otid(); idx < 16384 * 64; idx += ogrid() * NTHREADS) {
        const int pos = idx >> 6, i = idx & 63;
        const float invf = powf(10000.0f, -(float)i / 64.0f);
        const float ang = (float)pos * invf;
        const float c = cosf(ang), s = sinf(ang);
        cosN[idx] = c; sinN[idx] = s; cosT[(size_t)i * 16384 + pos] = c; sinT[(size_t)i * 16384 + pos] = s;
    }
}

__device__ __forceinline__ void phase_init(const float* __restrict__ xin, bf16_t* xb, float* rowss1, float* rowss2) {
    const int tid = otid(), lane = tid & 63, nw = ogrid() * 8;
    for (int row = blockIdx.x * 8 + (tid >> 6); row < MG; row += nw) {
        const float4* p = (const float4*)(xin + (size_t)row * D); float ss = 0.f;
#pragma unroll
        for (int i = 0; i < 4; ++i) { const float4 v = p[lane + 64 * i];
            u32x2 w; w.x = cvt_pk_bf16(v.x, v.y); w.y = cvt_pk_bf16(v.z, v.w); *(u32x2*)(xb + (size_t)row * D + (lane + 64 * i) * 4) = w;
            const float a0 = bf_lo(w.x), a1 = bf_hi(w.x), a2 = bf_lo(w.y), a3 = bf_hi(w.y); ss += a0 * a0 + a1 * a1 + a2 * a2 + a3 * a3; }
        ss = wave_sum(ss, lane);
        if (lane < 16) rowss1[(size_t)row * 16 + lane] = lane == 0 ? ss : 0.f;
    }
}
__device__ __forceinline__ void phase_final(const bf16_t* __restrict__ xb, float* xo, const float* rowss1, const float* __restrict__ gfin) {
    const int tid = otid(), lane = tid & 63, nw = ogrid() * 8;
    for (int row = blockIdx.x * 8 + (tid >> 6); row < MG; row += nw) {
        const float rs = rsqrtf(sum16(rowss1 + (size_t)row * 16) * (1.0f / 1024.0f) + EPS);
#pragma unroll
        for (int i = 0; i < 2; ++i) { const int c8 = (lane + 64 * i) * 8; float x[8]; unpack8(*(const u32x4*)(xb + (size_t)row * D + c8), x);
            const f32x4 g0 = *(const f32x4*)(gfin + c8), g1 = *(const f32x4*)(gfin + c8 + 4);
            *(f32x4*)(xo + (size_t)row * D + c8) = (f32x4){x[0] * rs * g0[0], x[1] * rs * g0[1], x[2] * rs * g0[2], x[3] * rs * g0[3]};
            *(f32x4*)(xo + (size_t)row * D + c8 + 4) = (f32x4){x[4] * rs * g1[0], x[5] * rs * g1[1], x[6] * rs * g1[2], x[7] * rs * g1[3]}; }
    }
}
__device__ __forceinline__ float gelu_tanh(float x) { const float t = fmaf(x * x, -0.10294324f, -2.30220819f);
    return x * __builtin_amdgcn_rcpf(1.0f + __builtin_amdgcn_exp2f(x * t)); }
__device__ __forceinline__ void phase_convact(const bf16_t* __restrict__ u, bf16_t* act, const float* __restrict__ cw  , int seqlen, int nrows) {
    const int gt = blockIdx.x * NTHREADS + otid(), nth = ogrid() * NTHREADS;
    int nr = nrows; asm volatile("" : "+s"(nr));
    const int ntask = (nr >> 3) * 352;
    for (int id = gt; id < ntask; id += nth) {
        const int tb = id / 352, c = (id % 352) * 8, t0 = tb * 8;
        const u32x4 z = (u32x4){0u, 0u, 0u, 0u};
        u32x4 g[10], v[10];
        const bool has_prev = (t0 & (seqlen - 1)) != 0, has_next = ((t0 + 8) & (seqlen - 1)) != 0;
#pragma unroll
        for (int r = 0; r < 10; ++r) { const bool ok = (r == 0) ? has_prev : ((r == 9) ? has_next : true);
            g[r] = z; v[r] = z;
            if (ok) { g[r] = *(const u32x4*)(u + (size_t)(t0 - 1 + r) * DFF2 + c); v[r] = *(const u32x4*)(u + (size_t)(t0 - 1 + r) * DFF2 + DFF + c); } }
        float wg[3][8], wv[3][8];
#pragma unroll
        for (int k = 0; k < 3; ++k) {
            const f32x4 a0 = *(const f32x4*)(cw + k * DFF2 + c), a1 = *(const f32x4*)(cw + k * DFF2 + c + 4);
            const f32x4 b0 = *(const f32x4*)(cw + k * DFF2 + DFF + c), b1 = *(const f32x4*)(cw + k * DFF2 + DFF + c + 4);
#pragma unroll
            for (int j = 0; j < 4; ++j) { wg[k][j] = a0[j]; wg[k][4 + j] = a1[j]; wv[k][j] = b0[j]; wv[k][4 + j] = b1[j]; } }
#pragma unroll
        for (int i = 0; i < 8; ++i) {
            float a[8], b[8], cc[8], r[8], gg[8], vv[8];
            unpack8(g[i], a); unpack8(g[i + 1], b); unpack8(g[i + 2], cc);
#pragma unroll
            for (int j = 0; j < 8; ++j) gg[j] = a[j] * wg[0][j] + b[j] * wg[1][j] + cc[j] * wg[2][j];
            unpack8(v[i], a); unpack8(v[i + 1], b); unpack8(v[i + 2], cc);
#pragma unroll
            for (int j = 0; j < 8; ++j) vv[j] = a[j] * wv[0][j] + b[j] * wv[1][j] + cc[j] * wv[2][j];
#pragma unroll
            for (int j = 0; j < 8; ++j) r[j] = gelu_tanh(gg[j]) * vv[j];
            *(u32x4*)(act + (size_t)(t0 + i) * DFF + c) = pack8(r);
        }
    }
}

constexpr int NA_LDS_WAVE = 12288;
struct NaFrags { bf16x8 k[4]; u32x2 v[2][2][2]; };
__device__ __forceinline__ void na_load(NaFrags& f, const bf16_t* __restrict__ proj, const bf16_t* __restrict__ projT, int ktok, int h, int c, int hh) {
    const bf16_t* kp = proj + (size_t)(ktok + c) * NPROJ + 512 + h * 64 + 8 * hh;
#pragma unroll
    for (int s = 0; s < 4; ++s) f.k[s] = *(const bf16x8*)(kp + 16 * s);
#pragma unroll
    for (int dt = 0; dt < 2; ++dt)
#pragma unroll
        for (int s2 = 0; s2 < 2; ++s2) { const bf16_t* vp = projT + (size_t)(h * 64 + dt * 32 + c) * MG + (ktok + 16 * s2 + 4 * hh);
            f.v[dt][s2][0] = *(const u32x2*)vp; f.v[dt][s2][1] = *(const u32x2*)(vp + 8); }
}
__device__ __forceinline__ void na_item(const bf16_t* __restrict__ proj, const bf16_t* __restrict__ projT, bf16_t* aout, const float* __restrict__ relb  , int item, int seqlen, LAS unsigned char* lds, int w, int lane) {
    const int c = lane & 31, hh = lane >> 5;
    const int R = item >> 3, h = item & 7;
    const int rps = seqlen >> 6, seq = R / rps, r = R % rps;
    int rs = r - 4; rs = rs < 0 ? 0 : rs; rs = rs > rps - 8 ? rps - 8 : rs;
    const int qtok0 = seq * seqlen + r * 64, ktok0 = seq * seqlen + rs * 64;
    LAS float* bias = (LAS float*)(lds + w * NA_LDS_WAVE) + 64;
    LAS bf16_t* Otile = (LAS bf16_t*)(lds + w * NA_LDS_WAVE + 3072);
    for (int i = lane; i < 768; i += 64) { const int j = i - 64; bias[j] = (j >= 0 && j < 465) ? relb[h * 465 + j] * 1.4426950408889634f : 0.f; }
    bf16x8 qf[2][4];
#pragma unroll
    for (int qh = 0; qh < 2; ++qh) { const bf16_t* qp = proj + (size_t)(qtok0 + 32 * qh + c) * NPROJ + h * 64 + 8 * hh;
#pragma unroll
        for (int s = 0; s < 4; ++s) qf[qh][s] = *(const bf16x8*)(qp + 16 * s); }
    f32x16 O[2][2];
    float mrun[2], lrun[2]; int cs[2];
#pragma unroll
    for (int qh = 0; qh < 2; ++qh) { O[qh][0] = zero16(); O[qh][1] = zero16(); mrun[qh] = -1e30f; lrun[qh] = 0.f;
        int x = 32 * qh + c - 8; x = x < 0 ? 0 : x; x = x > 48 ? 48 : x; cs[qh] = x; }
    NaFrags cur, nxt;
    na_load(cur, proj, projT, ktok0, h, c, hh);
#pragma unroll 1
    for (int t = 0; t < 16; ++t) {
        if (t + 1 < 16) na_load(nxt, proj, projT, ktok0 + 32 * (t + 1), h, c, hh);
        const int kr = rs + (t >> 1), chalf = t & 1, brow = (kr - r + 7) * 31;
#pragma unroll
        for (int qh = 0; qh < 2; ++qh) {
            f32x16 x = zero16();
#pragma unroll
            for (int s = 0; s < 4; ++s) x = mfma32(cur.k[s], qf[qh][s], x);
            const int qc = 32 * qh + c; float mt = -1e30f;
#pragma unroll
            for (int rg = 0; rg < 16; ++rg) { const int kc = 32 * chalf + (rg & 3) + 8 * (rg >> 2) + 4 * hh;
                const bool valid = (kc >= cs[qh]) && (kc < cs[qh] + 16);
                const float sv = fmaf(x[rg], 0.18033688011112042f, bias[brow + kc - qc + 15]) + (valid ? 0.f : -__builtin_inff());
                x[rg] = sv; mt = fmaxf(mt, sv); }
            mt = fmaxf(mt, shx(mt, 32, lane));
            const float mnew = fmaxf(mrun[qh], mt), alpha = __builtin_amdgcn_exp2f(mrun[qh] - mnew);
            const bool grew = mnew > mrun[qh];
            mrun[qh] = mnew;
            float ps = 0.f;
#pragma unroll
            for (int rg = 0; rg < 16; ++rg) { const float p = __builtin_amdgcn_exp2f(x[rg] - mnew); x[rg] = p; ps += p; }
            lrun[qh] = lrun[qh] * alpha + ps;
            if (__builtin_amdgcn_ballot_w64(grew) != 0ull) { O[qh][0] *= alpha; O[qh][1] *= alpha; }
#pragma unroll
            for (int s2 = 0; s2 < 2; ++s2) {
                u32x4 pw; pw.x = cvt_pk_bf16(x[8 * s2 + 0], x[8 * s2 + 1]); pw.y = cvt_pk_bf16(x[8 * s2 + 2], x[8 * s2 + 3]); pw.z = cvt_pk_bf16(x[8 * s2 + 4], x[8 * s2 + 5]); pw.w = cvt_pk_bf16(x[8 * s2 + 6], x[8 * s2 + 7]);
                const bf16x8 pb = __builtin_bit_cast(bf16x8, pw);
#pragma unroll
                for (int dt = 0; dt < 2; ++dt) { u32x4 aw; aw.x = cur.v[dt][s2][0].x; aw.y = cur.v[dt][s2][0].y; aw.z = cur.v[dt][s2][1].x; aw.w = cur.v[dt][s2][1].y;
                    O[qh][dt] = mfma32(__builtin_bit_cast(bf16x8, aw), pb, O[qh][dt]); } }
        }
        cur = nxt;
    }
#pragma unroll
    for (int qh = 0; qh < 2; ++qh) { const float inv = 1.0f / (lrun[qh] + shx(lrun[qh], 32, lane));
#pragma unroll
        for (int dt = 0; dt < 2; ++dt)
#pragma unroll
            for (int g4 = 0; g4 < 4; ++g4) { u32x2 pw; pw.x = cvt_pk_bf16(O[qh][dt][4 * g4] * inv, O[qh][dt][4 * g4 + 1] * inv); pw.y = cvt_pk_bf16(O[qh][dt][4 * g4 + 2] * inv, O[qh][dt][4 * g4 + 3] * inv);
                *(LAS u32x2*)(Otile + (32 * qh + c) * 72 + dt * 32 + 8 * g4 + 4 * hh) = pw; } }
#pragma unroll
    for (int i = 0; i < 8; ++i) { const int id = lane + 64 * i, q = id >> 3, d8 = (id & 7) * 8;
        *(u32x4*)(aout + (size_t)(qtok0 + q) * 1536 + h * 64 + d8) = *(const LAS u32x4*)(Otile + q * 72 + d8); }
}

constexpr int KT_STRIDE = 136;
__device__ __forceinline__ void r1_item(const bf16_t* __restrict__ projT, bf16_t* stloc, const float* __restrict__ cosT, const float* __restrict__ sinT, float lgf2, float lgb2, int item, int seqlen, LAS unsigned char* lds) {
    const int tid = otid(), w = __builtin_amdgcn_readfirstlane(tid >> 6), lane = tid & 63, c = lane & 31, hh = lane >> 5;
    const int ch = item >> 2, h = item & 3, tok0 = ch * 128, pos0 = tok0 % seqlen;
    LAS bf16_t* KTf = (LAS bf16_t*)lds; LAS bf16_t* KTb = (LAS bf16_t*)(lds + 128 * KT_STRIDE * 2);
    const float scale = 0.08838834764831845f;
    bf16x8 af[8];
    { const bf16_t* vp = projT + (size_t)(1024 + h * 256 + 32 * w + c) * MG + tok0 + 8 * hh;
#pragma unroll
      for (int s = 0; s < 8; ++s) af[s] = *(const bf16x8*)(vp + 16 * s); }
#pragma unroll
    for (int it = 0; it < 2; ++it) {
        const int id = tid + NTHREADS * it, d = id >> 4, t8 = id & 15;
        float k1[8], k2[8];
        unpack8(*(const u32x4*)(projT + (size_t)(512 + h * 128 + d) * MG + tok0 + 8 * t8), k1);
        unpack8(*(const u32x4*)(projT + (size_t)(512 + h * 128 + d + 64) * MG + tok0 + 8 * t8), k2);
        const f32x4 c0 = *(const f32x4*)(cosT + (size_t)d * 16384 + pos0 + 8 * t8), c1 = *(const f32x4*)(cosT + (size_t)d * 16384 + pos0 + 8 * t8 + 4);
        const f32x4 s0 = *(const f32x4*)(sinT + (size_t)d * 16384 + pos0 + 8 * t8), s1 = *(const f32x4*)(sinT + (size_t)d * 16384 + pos0 + 8 * t8 + 4);
        float f1[8], f2[8], b1[8], b2[8];
#pragma unroll
        for (int j = 0; j < 8; ++j) { const float cv = j < 4 ? c0[j & 3] : c1[j & 3], sv = j < 4 ? s0[j & 3] : s1[j & 3];
            const float r1 = (k1[j] * cv - k2[j] * sv) * scale, r2 = (k1[j] * sv + k2[j] * cv) * scale;
            const int tl = 8 * t8 + j; const float df = __builtin_amdgcn_exp2f((float)(127 - tl) * lgf2), db = __builtin_amdgcn_exp2f((float)tl * lgb2);
            f1[j] = r1 * df; f2[j] = r2 * df; b1[j] = r1 * db; b2[j] = r2 * db; }
        *(LAS u32x4*)(KTf + d * KT_STRIDE + 8 * t8) = pack8(f1); *(LAS u32x4*)(KTf + (d + 64) * KT_STRIDE + 8 * t8) = pack8(f2);
        *(LAS u32x4*)(KTb + d * KT_STRIDE + 8 * t8) = pack8(b1); *(LAS u32x4*)(KTb + (d + 64) * KT_STRIDE + 8 * t8) = pack8(b2);
    }
    __syncthreads();
#pragma unroll
    for (int dir = 0; dir < 2; ++dir) {
        LAS bf16_t* KT = dir ? KTb : KTf;
        bf16_t* dst = stloc + ((size_t)(ch * 4 + h) * 2 + dir) * 32768;
#pragma unroll
        for (int ct = 0; ct < 4; ++ct) {
            f32x16 acc = zero16();
#pragma unroll
            for (int s = 0; s < 8; ++s) { const bf16x8 bfr = *(const LAS bf16x8*)(KT + (32 * ct + c) * KT_STRIDE + 16 * s + 8 * hh); acc = mfma32(af[s], bfr, acc); }
#pragma unroll
            for (int rg = 0; rg < 16; ++rg) { const int dv = 32 * w + (rg & 3) + 8 * (rg >> 2) + 4 * hh; dst[dv * 128 + 32 * ct + c] = (bf16_t)(cvt_pk_bf16(acc[rg], 0.f) & 0xffffu); }
        }
    }
    __syncthreads();
}

__device__ __forceinline__ void phase_scan(const bf16_t* __restrict__ stloc, bf16_t* st, const float* __restrict__ decf, const float* __restrict__ decb, int seqlen) {
    const int gt = blockIdx.x * NTHREADS + otid(), nth = ogrid() * NTHREADS;
    constexpr size_t CSTR = (size_t)4 * 2 * 32768;
    if (seqlen == 4096) {
        constexpr int NCH = 32, NTASK = 4 * 4 * 2 * 4096;
        for (int id = gt; id < NTASK; id += nth) {
            const int e8 = id & 4095, dir = (id >> 12) & 1, h = (id >> 13) & 3, seq = id >> 15;
            const float x = dir ? decb[h] : decf[h]; const float cd = exp2f(-128.0f * log1pf(expf(-x)) * 1.4426950408889634f);
            const size_t base = ((size_t)(seq * NCH * 4 + h) * 2 + dir) * 32768 + (size_t)e8 * 8;
            float zz = 0.f; asm volatile("" : "+v"(zz));
            float S[8];
#pragma unroll
            for (int j = 0; j < 8; ++j) S[j] = zz;
            for (int i0 = 0; i0 < NCH; i0 += 8) {
                u32x4 loc[8];
#pragma unroll
                for (int j = 0; j < 8; ++j) { const int ci = dir ? (NCH - 1 - (i0 + j)) : (i0 + j); loc[j] = *(const u32x4*)(stloc + base + (size_t)ci * CSTR); }
#pragma unroll
                for (int j = 0; j < 8; ++j) { const int ci = dir ? (NCH - 1 - (i0 + j)) : (i0 + j);
                    *(u32x4*)(st + base + (size_t)ci * CSTR) = pack8(S);
                    float lf[8]; unpack8(loc[j], lf);
#pragma unroll
                    for (int k = 0; k < 8; ++k) S[k] = S[k] * cd + lf[k]; }
            }
        }
    } else {
        constexpr int NCH = 128, NTASK = 4 * 2 * 16384;
        for (int id = gt; id < NTASK; id += nth) {
            const int e2 = id & 16383, dir = (id >> 14) & 1, h = (id >> 15) & 3;
            const float x = dir ? decb[h] : decf[h]; const float cd = exp2f(-128.0f * log1pf(expf(-x)) * 1.4426950408889634f);
            const size_t base = ((size_t)h * 2 + dir) * 32768 + (size_t)e2 * 2;
            float zz = 0.f; asm volatile("" : "+v"(zz));
            float S0 = zz, S1 = zz;
            for (int i0 = 0; i0 < NCH; i0 += 8) {
                unsigned loc[8];
#pragma unroll
                for (int j = 0; j < 8; ++j) { const int ci = dir ? (NCH - 1 - (i0 + j)) : (i0 + j); loc[j] = *(const unsigned*)(stloc + base + (size_t)ci * CSTR); }
#pragma unroll
                for (int j = 0; j < 8; ++j) { const int ci = dir ? (NCH - 1 - (i0 + j)) : (i0 + j);
                    *(unsigned*)(st + base + (size_t)ci * CSTR) = cvt_pk_bf16(S0, S1);
                    S0 = S0 * cd + bf_lo(loc[j]); S1 = S1 * cd + bf_hi(loc[j]); }
            }
        }
    }
}

constexpr int OL_STRIDE = 264;
__device__ __forceinline__ void r3_item(const bf16_t* __restrict__ proj, const bf16_t* __restrict__ projT, const bf16_t* __restrict__ st, bf16_t* ro,
                        const float* __restrict__ cosN, const float* __restrict__ sinN, const float* __restrict__ gn  , float lgf2, float lgb2,
                        int item, int seqlen, LAS unsigned char* lds) {
    const int tid = otid(), w = __builtin_amdgcn_readfirstlane(tid >> 6), lane = tid & 63, c = lane & 31, hh = lane >> 5;
    const int ch = item >> 2, h = item & 3, tok0 = ch * 128, pos0 = tok0 % seqlen;
    LAS bf16_t* Ql = (LAS bf16_t*)lds; LAS bf16_t* Kl = (LAS bf16_t*)(lds + 34816); LAS bf16_t* Pl = (LAS bf16_t*)(lds + 69632);
    LAS float* stat = (LAS float*)(lds + 104448);
    LAS bf16_t* Ol = (LAS bf16_t*)lds;
    const float scale = 0.08838834764831845f;
    bf16x8 asb[8], asf[8], avt[8];
    const size_t stb0 = ((size_t)(ch * 4 + h) * 2) * 32768 + (size_t)(32 * w + c) * 128 + 8 * hh;
#pragma unroll
    for (int s = 0; s < 8; ++s) asb[s] = *(const bf16x8*)(st + stb0 + 32768 + 16 * s);
#pragma unroll
    for (int it = 0; it < 2; ++it) {
        const int id = tid + NTHREADS * it, t = id >> 3, d8 = (id & 7) * 8;
        const f32x4 c0 = *(const f32x4*)(cosN + (size_t)(pos0 + t) * 64 + d8), c1 = *(const f32x4*)(cosN + (size_t)(pos0 + t) * 64 + d8 + 4);
        const f32x4 s0 = *(const f32x4*)(sinN + (size_t)(pos0 + t) * 64 + d8), s1 = *(const f32x4*)(sinN + (size_t)(pos0 + t) * 64 + d8 + 4);
        float a[8], b[8], o1[8], o2[8];
        const bf16_t* qp = proj + (size_t)(tok0 + t) * NPROJ + 1024 + h * 128 + d8;
        unpack8(*(const u32x4*)qp, a); unpack8(*(const u32x4*)(qp + 64), b);
#pragma unroll
        for (int j = 0; j < 8; ++j) { const float cv = j < 4 ? c0[j & 3] : c1[j & 3], sv = j < 4 ? s0[j & 3] : s1[j & 3]; o1[j] = a[j] * cv - b[j] * sv; o2[j] = a[j] * sv + b[j] * cv; }
        *(LAS u32x4*)(Ql + t * KT_STRIDE + d8) = pack8(o1); *(LAS u32x4*)(Ql + t * KT_STRIDE + 64 + d8) = pack8(o2);
        const bf16_t* kp = proj + (size_t)(tok0 + t) * NPROJ + 1536 + h * 128 + d8;
        unpack8(*(const u32x4*)kp, a); unpack8(*(const u32x4*)(kp + 64), b);
#pragma unroll
        for (int j = 0; j < 8; ++j) { const float cv = j < 4 ? c0[j & 3] : c1[j & 3], sv = j < 4 ? s0[j & 3] : s1[j & 3]; o1[j] = (a[j] * cv - b[j] * sv) * scale; o2[j] = (a[j] * sv + b[j] * cv) * scale; }
        *(LAS u32x4*)(Kl + t * KT_STRIDE + d8) = pack8(o1); *(LAS u32x4*)(Kl + t * KT_STRIDE + 64 + d8) = pack8(o2);
    }
    __syncthreads();
    { const int kt = w >> 1;
#pragma unroll
      for (int q2 = 0; q2 < 2; ++q2) { const int tqt = 2 * (w & 1) + q2;
          f32x16 x = zero16();
#pragma unroll
          for (int s = 0; s < 8; ++s) { const bf16x8 kf = *(const LAS bf16x8*)(Kl + (32 * kt + c) * KT_STRIDE + 16 * s + 8 * hh);
              const bf16x8 qf = *(const LAS bf16x8*)(Ql + (32 * tqt + c) * KT_STRIDE + 16 * s + 8 * hh); x = mfma32(kf, qf, x); }
          const int n = 32 * tqt + c;
#pragma unroll
          for (int g4 = 0; g4 < 4; ++g4) { float pv[4];
#pragma unroll
              for (int j = 0; j < 4; ++j) { const int mk = 32 * kt + 8 * g4 + 4 * hh + j; const int diff = n - mk;
                  const float dec = __builtin_amdgcn_exp2f(diff >= 0 ? (float)diff * lgf2 : (float)(-diff) * lgb2); pv[j] = x[4 * g4 + j] * dec; }
              u32x2 pw; pw.x = cvt_pk_bf16(pv[0], pv[1]); pw.y = cvt_pk_bf16(pv[2], pv[3]);
              *(LAS u32x2*)(Pl + n * KT_STRIDE + 32 * kt + 8 * g4 + 4 * hh) = pw; } } }
    __syncthreads();
    f32x16 acc[4];
#pragma unroll
    for (int q = 0; q < 4; ++q) acc[q] = zero16();
    { const bf16_t* vp0 = projT + (size_t)(1024 + h * 256 + 32 * w + c) * MG + tok0 + 8 * hh;
#pragma unroll
      for (int s = 0; s < 8; ++s) { asf[s] = *(const bf16x8*)(st + stb0 + 16 * s); avt[s] = *(const bf16x8*)(vp0 + 16 * s); } }
#pragma unroll
    for (int s = 0; s < 8; ++s) { const bf16x8 a = asb[s];
#pragma unroll
        for (int q = 0; q < 4; ++q) { const bf16x8 b = *(const LAS bf16x8*)(Ql + (32 * q + c) * KT_STRIDE + 16 * s + 8 * hh); acc[q] = mfma32(a, b, acc[q]); } }
#pragma unroll
    for (int q = 0; q < 4; ++q) { const int n = 32 * q + c; const float f = __builtin_amdgcn_exp2f((float)(128 - n) * lgb2 - (float)(n + 1) * lgf2); acc[q] *= f; }
#pragma unroll
    for (int s = 0; s < 8; ++s) { const bf16x8 a = asf[s];
#pragma unroll
        for (int q = 0; q < 4; ++q) { const bf16x8 b = *(const LAS bf16x8*)(Ql + (32 * q + c) * KT_STRIDE + 16 * s + 8 * hh); acc[q] = mfma32(a, b, acc[q]); } }
#pragma unroll
    for (int q = 0; q < 4; ++q) { const int n = 32 * q + c; const float f = __builtin_amdgcn_exp2f((float)(n + 1) * lgf2); acc[q] *= f; }
#pragma unroll
    for (int s = 0; s < 8; ++s) { const bf16x8 a = avt[s];
#pragma unroll
        for (int q = 0; q < 4; ++q) { const bf16x8 b = *(const LAS bf16x8*)(Pl + (32 * q + c) * KT_STRIDE + 16 * s + 8 * hh); acc[q] = mfma32(a, b, acc[q]); } }
#pragma unroll
    for (int q = 0; q < 4; ++q) { float s1 = 0.f, s2 = 0.f;
#pragma unroll
        for (int i = 0; i < 16; ++i) { s1 += acc[q][i]; s2 += acc[q][i] * acc[q][i]; }
        s1 += shx(s1, 32, lane); s2 += shx(s2, 32, lane);
        if (hh == 0) { stat[(w * 128 + 32 * q + c) * 2] = s1; stat[(w * 128 + 32 * q + c) * 2 + 1] = s2; } }
    __syncthreads();
#pragma unroll
    for (int q = 0; q < 4; ++q) { float s1 = 0.f, s2 = 0.f; const int n = 32 * q + c;
#pragma unroll
        for (int k = 0; k < 8; ++k) { s1 += stat[(k * 128 + n) * 2]; s2 += stat[(k * 128 + n) * 2 + 1]; }
        const float mu = s1 * (1.0f / 256.0f); float var = s2 * (1.0f / 256.0f) - mu * mu; var = var < 0.f ? 0.f : var; const float rs = rsqrtf(var + EPS);
#pragma unroll
        for (int g4 = 0; g4 < 4; ++g4) { u32x2 pw; pw.x = cvt_pk_bf16((acc[q][4 * g4] - mu) * rs, (acc[q][4 * g4 + 1] - mu) * rs); pw.y = cvt_pk_bf16((acc[q][4 * g4 + 2] - mu) * rs, (acc[q][4 * g4 + 3] - mu) * rs);
            *(LAS u32x2*)(Ol + n * OL_STRIDE + 32 * w + 8 * g4 + 4 * hh) = pw; } }
    __syncthreads();
#pragma unroll
    for (int it = 0; it < 8; ++it) { const int id = tid + NTHREADS * it, tq = id >> 5, d8 = (id & 31) * 8;
        float y[8], rg[8], o[8]; unpack8(*(const LAS u32x4*)(Ol + tq * OL_STRIDE + d8), y);
        unpack8(*(const u32x4*)(proj + (size_t)(tok0 + tq) * NPROJ + 2048 + h * 256 + d8), rg);
        const f32x4 g0 = *(const f32x4*)(gn + h * 256 + d8), g1 = *(const f32x4*)(gn + h * 256 + d8 + 4);
#pragma unroll
        for (int j = 0; j < 8; ++j) { const float gv = j < 4 ? g0[j & 3] : g1[j & 3]; o[j] = rg[j] * sigmoidf_(rg[j]) * y[j] * gv; }
        *(u32x4*)(ro + (size_t)(tok0 + tq) * 1536 + 512 + h * 256 + d8) = pack8(o); }
    __syncthreads();
}


#define XB_TMO      128
#define XB_XCNT(j)  (256  + 64 * (j))
#define XB_XSUB(j)  (1280 + 64 * (j))
#define XB_XGEN(j)  (2304 + 64 * (j))
#define XB_TOP      3328
#define XB_TOPGEN   3392
#define XCD_BAR_WORDS 3456
#define XB_SPIN_CAP (1u << 22)
__device__ __forceinline__ unsigned xb_ld(unsigned* p)              { return __hip_atomic_load(p, __ATOMIC_RELAXED, __HIP_MEMORY_SCOPE_AGENT); }
__device__ __forceinline__ unsigned xb_add(unsigned* p, unsigned v) { return __hip_atomic_fetch_add(p, v, __ATOMIC_RELAXED, __HIP_MEMORY_SCOPE_AGENT); }
__device__ __forceinline__ unsigned xb_xcc_id() { return (unsigned)__builtin_amdgcn_s_getreg((3 << 11) | 20) & 0xFu; }
#define XB_SPIN(cond, bar) do { unsigned _sp = 0; while (cond) { __builtin_amdgcn_s_sleep(1); \
    if ((++_sp & 255u) == 0u) { if (xb_ld(&(bar)[XB_TMO])) break; if (_sp > XB_SPIN_CAP) { atomicAdd(&(bar)[XB_TMO], 1u); break; } } } } while (0)
struct XcdBarrier { unsigned* bar; unsigned x; volatile LAS unsigned* st; };
__device__ __forceinline__ XcdBarrier xcd_barrier_post(unsigned* bar, volatile LAS unsigned* st) {
    XcdBarrier b; b.bar = bar; b.x = xb_xcc_id(); b.st = st;
    if (threadIdx.x == 0) (void)xb_add(&bar[XB_XCNT(b.x)], 1u);
    return b;
}
__device__ __forceinline__ void xcd_barrier_complete(unsigned* bar, unsigned x, unsigned& nloc, unsigned& nx) {
    const unsigned G = gridDim.x * gridDim.y * gridDim.z;
    unsigned sum, cnt, mine, sp = 0u;
    for (;;) {
        sum = 0u; cnt = 0u; mine = 0u;
#pragma unroll
        for (unsigned j = 0; j < 16; ++j) { const unsigned c = xb_ld(&bar[XB_XCNT(j)]); sum += c; cnt += (c > 0u) ? 1u : 0u; mine = (j == x) ? c : mine; }
        if (sum == G) break;
        __builtin_amdgcn_s_sleep(1);
        if ((++sp & 255u) == 0u) { if (xb_ld(&bar[XB_TMO])) break; if (sp > XB_SPIN_CAP) { atomicAdd(&bar[XB_TMO], 1u); break; } }
    }
    nloc = mine > 0u ? mine : 1u; nx = cnt > 0u ? cnt : 1u;
}
__device__ __forceinline__ void xcd_barrier(const XcdBarrier& b) {
    asm volatile("s_waitcnt vmcnt(0)" ::: "memory");
    __syncthreads();
    if (threadIdx.x == 0) {
        unsigned* bar = b.bar;
        __builtin_amdgcn_s_waitcnt(0);
        unsigned nloc = b.st[0], nx = b.st[1];
        if (nloc == 0u) { xcd_barrier_complete(bar, b.x, nloc, nx); b.st[0] = nloc; b.st[1] = nx; }
        const unsigned old = xb_add(&bar[XB_XSUB(b.x)], 1u);
        const unsigned gen = old / nloc;
        if (old + 1u == (gen + 1u) * nloc) {
            __builtin_amdgcn_fence(__ATOMIC_RELEASE, "agent");
            asm volatile("s_waitcnt vmcnt(0)" ::: "memory");
            const unsigned og = xb_add(&bar[XB_TOP], 1u);
            const unsigned tg = og / nx;
            if (og + 1u == (tg + 1u) * nx) xb_add(&bar[XB_TOPGEN], 1u);
            else XB_SPIN(xb_ld(&bar[XB_TOPGEN]) == tg, bar);
            __builtin_amdgcn_fence(__ATOMIC_ACQUIRE, "agent");
            xb_add(&bar[XB_XGEN(b.x)], 1u);
            asm volatile("s_waitcnt vmcnt(0)" ::: "memory");
        } else {
            XB_SPIN(xb_ld(&bar[XB_XGEN(b.x)]) == gen, bar);
            __builtin_amdgcn_fence(__ATOMIC_ACQUIRE, "agent");
            asm volatile("s_waitcnt vmcnt(0)" ::: "memory");
        }
    }
    __syncthreads();
}

__device__ __forceinline__ unsigned char* opq(unsigned char* p) { asm volatile("" : "+s"(p)); return p; }
#define WSP(T, off) ((T*)(opq(P.ws) + (off)))
#define XBAR() do { XcdBarrier _b; _b.bar = (unsigned*)(opq(P.ws) + WS_CTL); _b.x = (unsigned)__builtin_amdgcn_readfirstlane((int)xb_xcc_id()); _b.st = (volatile LAS unsigned*)(lds + 131072); xcd_barrier(_b); } while (0)
__global__ void __launch_bounds__(NTHREADS, 2) fwd_megakernel(Params P) {
    extern __shared__ __attribute__((aligned(16))) unsigned char lds_raw[];
    LAS unsigned char* lds = (LAS unsigned char*)lds_raw;
    cg::grid_group grid = cg::this_grid();
    const int G = ogrid(), bid = blockIdx.x;
    volatile LAS unsigned* xst = (volatile LAS unsigned*)(lds + 131072);
    if (threadIdx.x < 4) xst[threadIdx.x] = 0u;
    __syncthreads();
    (void)xcd_barrier_post((unsigned*)(P.ws + WS_CTL), xst);

    phase_prologue(P, lds);
    grid.sync();
    XBAR();

    for (int pr = 0; pr < 3; ++pr) {
        const int ngr = pr < 2 ? 2 : 1, g0 = 2 * pr, seqlen = pr < 2 ? 4096 : 16384, MM = ngr * MG;
        for (int gi = 0; gi < ngr; ++gi) { const int grp = g0 + gi;
            const float* xin = grp < 4 ? P.x_prompt + (size_t)grp * MG * D : P.x_sample;
            phase_init(xin, WSP(bf16_t, WS_XB) + (size_t)gi * MG * D, WSP(float, WS_ROWSS1) + (size_t)gi * MG * 16, WSP(float, WS_ROWSS2)); }
        XBAR();
        for (int l = 0; l < DEPTH; ++l) {
            const size_t wl = WS_W + (size_t)l * W_LAYER;
            for (int gi = 0; gi < ngr; ++gi) {
                const size_t xoff = (size_t)gi * MG * D, roff = (size_t)gi * MG * 16;
                { pg8::Gemm g{WSP(bf16_t, WS_XB) + xoff, WSP(const bf16_t, wl + W_IN_OFF), MG, NPROJ, D};
                  pg8::P1Order S; S.init(G, bid, WSP(const bf16_t, wl + W_IN_OFF + (size_t)NPROJ * D * 2));
                  LAS float* rl = (LAS float*)(lds + LDS_RSTD_OFF); fill_rstd(rl, WSP(float, WS_ROWSS1) + roff, S, -1);
                  pg8::EpiP1 E{pg8::EpiRowScale{WSP(bf16_t, WS_PROJ), NPROJ, rl}, pg8::EpiColScale{WSP(bf16_t, WS_PROJT), MG, rl}}; pg8::gemm_phase(lds, g, S, E); }
                XBAR();
                { { const int tid = otid(), wv = __builtin_amdgcn_readfirstlane(tid >> 6), ln = tid & 63;
                    for (int it = bid * 8 + wv; it < 2048; it += G * 8) na_item(WSP(bf16_t, WS_PROJ), WSP(bf16_t, WS_PROJT), WSP(bf16_t, WS_A), P.na_rel_bias + (size_t)l * 8 * 465, it, seqlen, lds, wv, ln);
                    __syncthreads(); }
                  for (int it = bid; it < 512; it += G) { const int h = it & 3;
                      const float* tab = WSP(const float, WS_LG2) + (l * 4 + h) * 2; const float lgf2 = tab[0], lgb2 = tab[1];
                      r1_item(WSP(bf16_t, WS_PROJT), WSP(bf16_t, WS_STLOC), WSP(float, WS_COST), WSP(float, WS_SINT), lgf2, lgb2, it, seqlen, lds); } }
                XBAR();
                phase_scan(WSP(bf16_t, WS_STLOC), WSP(bf16_t, WS_ST), P.dec_f + l * 4, P.dec_b + l * 4, seqlen);
                XBAR();
                for (int it = bid; it < 512; it += G) { const int h = it & 3;
                    const float* tab = WSP(const float, WS_LG2) + (l * 4 + h) * 2; const float lgf2 = tab[0], lgb2 = tab[1];
                    r3_item(WSP(bf16_t, WS_PROJ), WSP(bf16_t, WS_PROJT), WSP(bf16_t, WS_ST), WSP(bf16_t, WS_A), WSP(float, WS_COSN), WSP(float, WS_SINN), P.ret_norm_g + (size_t)l * 1024, lgf2, lgb2, it, seqlen, lds); }
                XBAR();
                { pg8::Gemm g{WSP(bf16_t, WS_A), WSP(const bf16_t, wl + W_A_OFF), MG, D, 1536}; pg8::StaticOrder S; S.init(MG, D, G, bid);
                  pg8::EpiMerge E{WSP(bf16_t, WS_PROJ) + 3072, WSP(bf16_t, WS_PROJ) + 4096, WSP(bf16_t, WS_MIXED)}; pg8::gemm_phase(lds, g, S, E); }
                XBAR();
                { pg8::Gemm g{WSP(bf16_t, WS_MIXED), WSP(const bf16_t, wl + W_O_OFF), MG, D, D}; pg8::StaticOrder S; S.init(MG, D, G, bid);
                  pg8::EpiResid E{WSP(bf16_t, WS_XB) + xoff, WSP(float, WS_ROWSS2) + roff}; pg8::gemm_phase(lds, g, S, E); }
                XBAR();
            }
            { pg8::Gemm g{WSP(bf16_t, WS_XB), WSP(const bf16_t, wl + W_UP_OFF), MM, DFF2, D}; pg8::StaticOrder S; S.init(MM, DFF2, G, bid);
              LAS float* rl = (LAS float*)(lds + LDS_RSTD_OFF); fill_rstd(rl, WSP(float, WS_ROWSS2), S, 0);
              pg8::EpiRowScale E{WSP(bf16_t, WS_U), DFF2, rl}; pg8::gemm_phase(lds, g, S, E); }
            XBAR();
            phase_convact(WSP(bf16_t, WS_U), WSP(bf16_t, WS_ACT), P.conv_w + (size_t)l * 3 * DFF2, seqlen, MM);
            XBAR();
            { pg8::Gemm g{WSP(bf16_t, WS_ACT), WSP(const bf16_t, wl + W_D_OFF), MM, D, DFF}; pg8::StaticOrder S; S.init(MM, D, G, bid);
              pg8::EpiResid E{WSP(bf16_t, WS_XB), WSP(float, WS_ROWSS1)}; pg8::gemm_phase(lds, g, S, E); }
            XBAR();
        }
        for (int gi = 0; gi < ngr; ++gi) { const int grp = g0 + gi;
            phase_final(WSP(bf16_t, WS_XB) + (size_t)gi * MG * D, P.out + (size_t)grp * MG * D, WSP(float, WS_ROWSS1) + (size_t)gi * MG * 16, P.norm_final_g); }
        XBAR();
    }
}

extern "C" void kernel_launch(void* const* d_in, const int* in_sizes, int n_in, void* d_out, int out_size, void* d_ws, size_t ws_size, hipStream_t stream) {
    static int grid_blocks = 0;
    if (grid_blocks == 0) {
        if (n_in != 16 || ws_size < WS_END) { fprintf(stderr, "kernel_launch: unexpected n_in %d or ws_size %zu (< %zu)\n", n_in, ws_size, (size_t)WS_END); grid_blocks = -1; return; }
        int dev = 0, cus = 0, per_cu = 0;
        hipGetDevice(&dev);
        hipDeviceGetAttribute(&cus, hipDeviceAttributeMultiprocessorCount, dev);
        if (hipFuncSetAttribute((const void*)fwd_megakernel, hipFuncAttributeMaxDynamicSharedMemorySize, LDS_BYTES) != hipSuccess) { fprintf(stderr, "kernel_launch: hipFuncSetAttribute failed\n"); grid_blocks = -1; return; }
        hipOccupancyMaxActiveBlocksPerMultiprocessor(&per_cu, (const void*)fwd_megakernel, NTHREADS, LDS_BYTES);
        if (per_cu < 1) { fprintf(stderr, "kernel_launch: occupancy query says %d blocks per CU\n", per_cu); per_cu = 1; }
        (void)hipGetLastError();
        grid_blocks = cus;
    }
    if (grid_blocks < 0) return;
    if (hipMemsetAsync((char*)d_ws + WS_CTL, 0, 16384, stream) != hipSuccess) { fprintf(stderr, "kernel_launch: memset of barrier words failed\n"); return; }
    Params p{};
    p.x_prompt = (const float*)d_in[0]; p.x_sample = (const float*)d_in[1]; p.norm_mix_g = (const float*)d_in[2]; p.w_in = (const float*)d_in[3]; p.na_rel_bias = (const float*)d_in[4];
    p.dec_f = (const float*)d_in[5]; p.dec_b = (const float*)d_in[6]; p.ret_norm_g = (const float*)d_in[7]; p.w_ba = (const float*)d_in[8]; p.w_br = (const float*)d_in[9]; p.w_out = (const float*)d_in[10];
    p.norm_ffn_g = (const float*)d_in[11]; p.w_up = (const float*)d_in[12]; p.conv_w = (const float*)d_in[13]; p.w_down = (const float*)d_in[14]; p.norm_final_g = (const float*)d_in[15];
    p.out = (float*)d_out; p.ws = (unsigned char*)d_ws;
    void* args[] = {&p};
    hipError_t e = hipLaunchCooperativeKernel((const void*)fwd_megakernel, dim3(grid_blocks), dim3(NTHREADS), args, LDS_BYTES, stream);
    if (e != hipSuccess) fprintf(stderr, "kernel_launch: cooperative launch failed: %s (grid %d)\n", hipGetErrorString(e), grid_blocks);
}
```

```cpp
#include <hip/hip_runtime.h>
#include <hip/hip_cooperative_groups.h>
#include <cstdio>
namespace cg = cooperative_groups;

#define LAS __attribute__((address_space(3)))
typedef unsigned short bf16_t;
typedef short bf16x8 __attribute__((ext_vector_type(8)));
typedef short bf16x4 __attribute__((ext_vector_type(4)));
typedef float f32x4 __attribute__((ext_vector_type(4)));
typedef float f32x16 __attribute__((ext_vector_type(16)));
typedef unsigned u32x4 __attribute__((ext_vector_type(4)));
typedef unsigned u32x2 __attribute__((ext_vector_type(2)));

constexpr int D = 1024, MG = 16384, NPROJ = 5120, NPT = 2048, DFF = 2816, DFF2 = 5632, DEPTH = 4, NGROUPS = 5, DIN = 6656;
constexpr float EPS = 1e-6f;
constexpr int NTHREADS = 512;
constexpr int LDS_RSTD_OFF = 131072 + 1024;
constexpr int LDS_BYTES = 131072 + 1024 + 12288;

constexpr size_t WS_CTL = 0;
constexpr size_t WS_LG2 = 32768;
constexpr size_t WS_ROWSS1 = 262144;
constexpr size_t WS_ROWSS2 = WS_ROWSS1 + (size_t)2 * MG * 16 * 4;
constexpr size_t WS_COSN = WS_ROWSS2 + (size_t)2 * MG * 16 * 4;
constexpr size_t TAB_BYTES = (size_t)16384 * 64 * 4;
constexpr size_t WS_SINN = WS_COSN + TAB_BYTES;
constexpr size_t WS_COST = WS_SINN + TAB_BYTES;
constexpr size_t WS_SINT = WS_COST + TAB_BYTES;
constexpr size_t WS_W = WS_SINT + TAB_BYTES;
constexpr size_t W_IN_OFF = 0;
constexpr size_t W_A_OFF = W_IN_OFF + (size_t)7168 * 1024 * 2;
constexpr size_t W_R_OFF = W_A_OFF + (size_t)1024 * 512 * 2;
constexpr size_t W_O_OFF = W_R_OFF + (size_t)1024 * 1024 * 2;
constexpr size_t W_UP_OFF = W_O_OFF + (size_t)1024 * 1024 * 2;
constexpr size_t W_D_OFF = W_UP_OFF + (size_t)5632 * 1024 * 2;
constexpr size_t W_LAYER = W_D_OFF + (size_t)1024 * 2816 * 2;
constexpr size_t WS_XB = WS_W + W_LAYER * DEPTH;
constexpr size_t WS_S = WS_XB + (size_t)2 * MG * D * 2;
constexpr size_t WS_PROJ = WS_S;
constexpr size_t WS_PROJT = WS_PROJ + (size_t)MG * NPROJ * 2;
constexpr size_t WS_A = WS_PROJT + (size_t)NPT * MG * 2;
constexpr size_t WS_MIXED = WS_A + (size_t)MG * 1536 * 2;
constexpr size_t WS_STLOC = WS_MIXED + (size_t)MG * D * 2;
constexpr size_t WS_ST = WS_STLOC + (size_t)128 * 4 * 2 * 32768 * 2;
constexpr size_t WS_MIX_END = WS_ST + (size_t)128 * 4 * 2 * 32768 * 2;
constexpr size_t WS_U = WS_S;
constexpr size_t WS_ACT = WS_U + (size_t)2 * MG * DFF2 * 2;
constexpr size_t WS_FFN_END = WS_ACT + (size_t)2 * MG * DFF * 2;
constexpr size_t WS_MIXED2 = WS_MIX_END > WS_FFN_END ? WS_MIX_END : WS_FFN_END;
constexpr size_t WS_END = WS_MIXED2 + (size_t)2 * MG * D * 2;
static_assert(WS_END <= ((size_t)1 << 30), "workspace over 1 GiB");

struct Params {
    const float* x_prompt; const float* x_sample; const float* norm_mix_g; const float* w_in; const float* na_rel_bias;
    const float* dec_f; const float* dec_b; const float* ret_norm_g; const float* w_ba; const float* w_br; const float* w_out;
    const float* norm_ffn_g; const float* w_up; const float* conv_w; const float* w_down; const float* norm_final_g;
    float* out; unsigned char* ws;
};

typedef __bf16 bf16v2_t __attribute__((ext_vector_type(2)));
typedef float f32v2_t __attribute__((ext_vector_type(2)));
__device__ __forceinline__ unsigned cvt_pk_bf16(float lo, float hi) { const f32v2_t v = {lo, hi}; const bf16v2_t r = __builtin_convertvector(v, bf16v2_t); return __builtin_bit_cast(unsigned, r); }
__device__ __forceinline__ float bf_lo(unsigned w) { return __uint_as_float(w << 16); }
__device__ __forceinline__ float bf_hi(unsigned w) { return __uint_as_float(w & 0xffff0000u); }
__device__ __forceinline__ float bf2f(bf16_t b) { return __uint_as_float(((unsigned)b) << 16); }
__device__ __forceinline__ float sigmoidf_(float x) { return __builtin_amdgcn_rcpf(1.0f + __expf(-x)); }
__device__ __forceinline__ void unpack8(const u32x4 w, float* f) { f[0] = bf_lo(w.x); f[1] = bf_hi(w.x); f[2] = bf_lo(w.y); f[3] = bf_hi(w.y); f[4] = bf_lo(w.z); f[5] = bf_hi(w.z); f[6] = bf_lo(w.w); f[7] = bf_hi(w.w); }
__device__ __forceinline__ u32x4 pack8(const float* f) { u32x4 w; w.x = cvt_pk_bf16(f[0], f[1]); w.y = cvt_pk_bf16(f[2], f[3]); w.z = cvt_pk_bf16(f[4], f[5]); w.w = cvt_pk_bf16(f[6], f[7]); return w; }
__device__ __forceinline__ f32x16 mfma32(bf16x8 a, bf16x8 b, f32x16 c) { return __builtin_amdgcn_mfma_f32_32x32x16_bf16(a, b, c, 0, 0, 0); }
__device__ __forceinline__ int otid() { int t = threadIdx.x; asm volatile("" : "+v"(t)); return t; }
__device__ __forceinline__ int ogrid() { int g = gridDim.x; asm volatile("" : "+s"(g)); return g; }
__device__ __forceinline__ f32x16 zero16() { return (f32x16){0.f, 0.f, 0.f, 0.f, 0.f, 0.f, 0.f, 0.f, 0.f, 0.f, 0.f, 0.f, 0.f, 0.f, 0.f, 0.f}; }
__device__ __forceinline__ float sum16(const float* p) { const f32x4 a = *(const f32x4*)p, b = *(const f32x4*)(p + 4), c = *(const f32x4*)(p + 8), d = *(const f32x4*)(p + 12); const f32x4 t = (a + b) + (c + d); return (t[0] + t[1]) + (t[2] + t[3]); }
__device__ __forceinline__ float shx(float v, int m, int lane) { return __int_as_float(__builtin_amdgcn_ds_bpermute((lane ^ m) << 2, __float_as_int(v))); }
__device__ __forceinline__ float wave_sum(float v, int lane) { v += shx(v, 32, lane); v += shx(v, 16, lane); v += shx(v, 8, lane); v += shx(v, 4, lane); v += shx(v, 2, lane); v += shx(v, 1, lane); return v; }

namespace pg8 {
constexpr int BM = 256, BK = 64, HALF = 128, HTB = HALF * BK * 2, STAGE_BYTES = 8 * HTB, NXCD = 8, WGM = 8;
__host__ __device__ __forceinline__ int lds_byte(int r, int c) { const int st = (r >> 4) * 2 + (c >> 5), rr = r & 15, cc = c & 31, ob = rr * 64 + cc * 2; return st * 1024 + (ob ^ (((ob >> 9) & 1) << 5)); }
__host__ __device__ __forceinline__ void stage_rc(int b, int& R, int& C) { const int st = b / 1024, sb = b % 1024, swz = sb ^ (((sb >> 9) & 1) << 5); R = (st >> 1) * 16 + swz / 64; C = (st & 1) * 32 + (swz % 64) / 2; }
__host__ __device__ __forceinline__ int perm32(int rho) { const int n = rho >> 4, i = rho & 15; return 8 * (i >> 2) + 4 * n + (i & 3); }
struct Unit { int pm, pn, idx, kind; };
struct Gemm { const bf16_t* A; const bf16_t* Bt; int M, N, K; };
struct StaticOrder {
    int nM, nN, nwg, G, c;
    __host__ __device__ void init(int M, int N, int G_, int c_) { nM = M / BM; nN = N / BM; nwg = nM * nN; G = G_; c = c_; }
    __host__ __device__ bool next(int i, Unit& u) const { return at((long)i * G + c, u); }
    __host__ __device__ bool at(long L, Unit& u) const {
        if (L >= nwg) return false;
        u.kind = 0;
        int wgid = (int)L; { const int q = nwg / NXCD, r = nwg % NXCD, xcd = wgid % NXCD, off = wgid / NXCD; wgid = (xcd < r ? xcd * (q + 1) : r * (q + 1) + (xcd - r) * q) + off; }
        const int nig = WGM * nN, gid = wgid / nig, fm = gid * WGM, gsz = (nM - fm) < WGM ? (nM - fm) : WGM;
        u.pm = fm + ((wgid % nig) % gsz); u.pn = (wgid % nig) / gsz; return true;
    }
    __device__ __forceinline__ void a_ready(const Unit&) const {}
    __device__ __forceinline__ void done(const Unit&) const {}
    __device__ __forceinline__ const char* abase(const Gemm& g, const Unit& u, size_t tstep) const { return (const char*)g.A + (size_t)u.pm * tstep; }
    __device__ __forceinline__ const char* bbase(const Gemm& g, const Unit& u, size_t tstep) const { return (const char*)g.Bt + (size_t)u.pn * tstep; }
};
struct P1Order {
    StaticOrder s0, s1; int G, c; const bf16_t* wt2;
    __device__ void init(int G_, int c_, const bf16_t* wt2_) { s0.init(MG, NPROJ, G_, c_); s1.init(NPT, MG, G_, c_); G = G_; c = c_; wt2 = wt2_; }
    __device__ bool next(int i, Unit& u) const { const long L = (long)i * G + c; if (L < 1280) return s0.at(L, u); if (!s1.at(L - 1280, u)) return false; u.kind = 1; return true; }
    __device__ __forceinline__ void a_ready(const Unit&) const {}
    __device__ __forceinline__ void done(const Unit&) const {}
    __device__ __forceinline__ const char* abase(const Gemm& g, const Unit& u, size_t tstep) const { return (u.kind ? (const char*)wt2 : (const char*)g.A) + (size_t)u.pm * tstep; }
    __device__ __forceinline__ const char* bbase(const Gemm& g, const Unit& u, size_t tstep) const { return (u.kind ? (const char*)g.A : (const char*)g.Bt) + (size_t)u.pn * tstep; }
};

template <class Epi, class Sched>
__device__ __forceinline__ void gemm_phase(LAS unsigned char* lds, const Gemm g, const Sched& S, const Epi& E) {
    const int tid = otid(), wid = __builtin_amdgcn_readfirstlane(tid >> 6), lane = tid & 63, wr = wid >> 2, wc = wid & 3, fr = lane & 15, fq = lane >> 4;
    const int K = g.K, nt = K / BK;
    unsigned voffA[2], voffB[2];
#pragma unroll
    for (int i = 0; i < 2; ++i) { int R, C; stage_rc(tid * 16 + i * 8192, R, C); const int Rb = Epi::PERM ? ((R & ~31) + perm32(R & 31)) : R;
        voffA[i] = (unsigned)(R * K + C) * 2u; voffB[i] = (unsigned)(Rb * K + C) * 2u; }
    const size_t kstep = (size_t)(BK * 2);
    const size_t hstep = (size_t)HALF * K * 2;
    const size_t tstep = 2 * hstep;
    const unsigned ldsw = (unsigned)wid * 1024u;
    const int aoff = lds_byte(wr * 64 + fr, fq * 8), boff = lds_byte(wc * 32 + fr, fq * 8);
#define PG8_SA(b, h) (((b) * 2 + (h)) * HTB)
#define PG8_SB(b, h) ((4 + (b) * 2 + (h)) * HTB)
#define PG8_STAGE(bufoff, gbase, voff) do { _Pragma("unroll") for (int _i = 0; _i < 2; ++_i) \
        __builtin_amdgcn_global_load_lds((const unsigned*)((const char*)(gbase) + (voff)[_i]), (LAS unsigned*)(lds + (bufoff) + ldsw + _i * 8192), 16, 0, 0); } while (0)
#define PG8_LDA(dst, b, h) do { _Pragma("unroll") for (int m = 0; m < 4; ++m) _Pragma("unroll") for (int k = 0; k < 2; ++k) dst[m][k] = *(const LAS bf16x8*)(lds + PG8_SA(b, h) + aoff + m * 2048 + k * 1024); } while (0)
#define PG8_LDB(dst, b, h) do { _Pragma("unroll") for (int n = 0; n < 2; ++n) _Pragma("unroll") for (int k = 0; k < 2; ++k) dst[n][k] = *(const LAS bf16x8*)(lds + PG8_SB(b, h) + boff + n * 2048 + k * 1024); } while (0)
#define PG8_MMA(ai, bj, At, Bt) do { __builtin_amdgcn_s_setprio(1); _Pragma("unroll") for (int m = 0; m < 4; ++m) _Pragma("unroll") for (int n = 0; n < 2; ++n) _Pragma("unroll") for (int k = 0; k < 2; ++k) \
        acc[ai][bj][m][n] = __builtin_amdgcn_mfma_f32_16x16x32_bf16(Bt[n][k], At[m][k], acc[ai][bj][m][n], 0, 0, 0); __builtin_amdgcn_s_setprio(0); } while (0)
#define PG8_WAIT_V(n) asm volatile("s_waitcnt vmcnt(" #n ")" ::: "memory")
#define PG8_WAIT_L(n) asm volatile("s_waitcnt lgkmcnt(" #n ")" ::: "memory")
#define PG8_BAR __builtin_amdgcn_s_barrier()
#define PG8_SCHED __builtin_amdgcn_sched_barrier(0)
    Unit cur, nxt; int ui = 0;
    if (!S.next(0, cur)) return;
    cur.idx = 0;
    f32x4 acc[2][2][4][2];
#pragma unroll
    for (int a = 0; a < 2; ++a)
#pragma unroll
        for (int b = 0; b < 2; ++b)
#pragma unroll
            for (int m = 0; m < 4; ++m)
#pragma unroll
                for (int n = 0; n < 2; ++n) acc[a][b][m][n] = (f32x4){0.f, 0.f, 0.f, 0.f};
    bf16x8 At[4][2], B0[2][2], B1[2][2];
    const char* cA = S.abase(g, cur, tstep); const char* cB = S.bbase(g, cur, tstep);
    S.a_ready(cur);
    PG8_STAGE(PG8_SB(0, 0), cB, voffB); PG8_STAGE(PG8_SA(0, 0), cA, voffA); PG8_STAGE(PG8_SB(0, 1), cB + hstep, voffB); PG8_STAGE(PG8_SA(0, 1), cA + hstep, voffA);
    if (wr == 1) PG8_BAR;
    PG8_WAIT_V(4); PG8_BAR;
    PG8_STAGE(PG8_SB(1, 0), cB + kstep, voffB); PG8_STAGE(PG8_SA(1, 0), cA + kstep, voffA); PG8_STAGE(PG8_SB(1, 1), cB + hstep + kstep, voffB);
    PG8_WAIT_V(6); PG8_BAR;
    for (;;) {
        const bool has_next = S.next(ui + 1, nxt); nxt.idx = ui + 1;
        const char* nA = has_next ? S.abase(g, nxt, tstep) : cA; const char* nB = has_next ? S.bbase(g, nxt, tstep) : cB;
        for (int t = 0; t < nt; t += 2) {
            const bool last = (t == nt - 2);
            const char* a1 = cA + (size_t)(t + 1) * kstep;
            const char* a2 = last ? nA : cA + (size_t)(t + 2) * kstep; const char* b2 = last ? nB : cB + (size_t)(t + 2) * kstep;
            const char* a3 = a2 + kstep; const char* b3 = b2 + kstep;
            if (last && has_next) S.a_ready(nxt);
            if constexpr (Epi::MID > 0) { if (t == Epi::MID) E.mid(acc, cur, wr, wc, fr, fq); }
            PG8_LDB(B0, 0, 0); PG8_SCHED; PG8_LDA(At, 0, 0); PG8_STAGE(PG8_SA(1, 1), a1 + hstep, voffA);
            PG8_WAIT_L(8); PG8_BAR; PG8_WAIT_L(0); PG8_MMA(0, 0, At, B0); PG8_BAR; PG8_SCHED;
            PG8_LDB(B1, 0, 1); PG8_STAGE(PG8_SB(0, 0), b2, voffB);
            PG8_BAR; PG8_WAIT_L(0); PG8_MMA(0, 1, At, B1); PG8_BAR;
            PG8_LDA(At, 0, 1); PG8_STAGE(PG8_SA(0, 0), a2, voffA);
            PG8_BAR; PG8_WAIT_L(0); PG8_MMA(1, 0, At, B0); PG8_BAR; PG8_SCHED;
            PG8_STAGE(PG8_SB(0, 1), b2 + hstep, voffB);
            PG8_WAIT_V(6); PG8_BAR; PG8_MMA(1, 1, At, B1); PG8_BAR;
            PG8_LDB(B0, 1, 0); PG8_SCHED; PG8_LDA(At, 1, 0); PG8_STAGE(PG8_SA(0, 1), a2 + hstep, voffA);
            PG8_WAIT_L(8); PG8_BAR; PG8_WAIT_L(0); PG8_MMA(0, 0, At, B0); PG8_BAR; PG8_SCHED;
            PG8_LDB(B1, 1, 1); PG8_STAGE(PG8_SB(1, 0), b3, voffB);
            PG8_BAR; PG8_WAIT_L(0); PG8_MMA(0, 1, At, B1); PG8_BAR;
            PG8_LDA(At, 1, 1); PG8_STAGE(PG8_SA(1, 0), a3, voffA);
            PG8_BAR; PG8_WAIT_L(0); PG8_MMA(1, 0, At, B0); PG8_BAR; PG8_SCHED;
            PG8_STAGE(PG8_SB(1, 1), b3 + hstep, voffB);
            PG8_WAIT_V(6); PG8_BAR; PG8_MMA(1, 1, At, B1); PG8_BAR;
        }
        E(acc, cur, wr, wc, fr, fq); S.done(cur);
        if (!has_next) break;
#pragma unroll
        for (int a = 0; a < 2; ++a)
#pragma unroll
            for (int b = 0; b < 2; ++b)
#pragma unroll
                for (int m = 0; m < 4; ++m)
#pragma unroll
                    for (int n = 0; n < 2; ++n) acc[a][b][m][n] = (f32x4){0.f, 0.f, 0.f, 0.f};
        cur = nxt; cA = nA; cB = nB; ++ui;
    }
    PG8_WAIT_V(0);
    if (wr == 0) PG8_BAR;
    PG8_BAR;
#undef PG8_SA
#undef PG8_SB
#undef PG8_STAGE
#undef PG8_LDA
#undef PG8_LDB
#undef PG8_MMA
#undef PG8_WAIT_V
#undef PG8_WAIT_L
#undef PG8_BAR
#undef PG8_SCHED
}

struct EpiRowScale {
    static constexpr bool PERM = true; static constexpr int MID = 0;
    bf16_t* O; int ldc; const LAS float* rl;
    __device__ __forceinline__ void operator()(const f32x4 (&acc)[2][2][4][2], const Unit& u, int wr, int wc, int fr, int fq) const {
        const int row0 = u.pm * BM + wr * 64 + fr, col0 = u.pn * BM + wc * 32 + 8 * fq;
#pragma unroll
        for (int ai = 0; ai < 2; ++ai)
#pragma unroll
            for (int m = 0; m < 4; ++m) { const int row = row0 + ai * HALF + m * 16; const float rs = rl[u.idx * 256 + wr * 64 + fr + ai * HALF + m * 16];
                bf16_t* rowp = O + (size_t)row * ldc + col0;
#pragma unroll
                for (int bj = 0; bj < 2; ++bj) { const f32x4 v0 = acc[ai][bj][m][0] * rs, v1 = acc[ai][bj][m][1] * rs;
                    u32x4 w; w.x = cvt_pk_bf16(v0[0], v0[1]); w.y = cvt_pk_bf16(v0[2], v0[3]); w.z = cvt_pk_bf16(v1[0], v1[1]); w.w = cvt_pk_bf16(v1[2], v1[3]);
                    *(u32x4*)(rowp + bj * HALF) = w; } }
    }
};
struct EpiColScale {
    static constexpr bool PERM = true; static constexpr int MID = 0;
    bf16_t* O; int ldc; const LAS float* rl;
    __device__ __forceinline__ void operator()(const f32x4 (&acc)[2][2][4][2], const Unit& u, int wr, int wc, int fr, int fq) const {
        const int row0 = u.pm * BM + wr * 64 + fr, col0 = u.pn * BM + wc * 32 + 8 * fq;
        f32x4 sc[2][2];
#pragma unroll
        for (int bj = 0; bj < 2; ++bj)
#pragma unroll
            for (int n = 0; n < 2; ++n) sc[bj][n] = *(const LAS f32x4*)(rl + u.idx * 256 + wc * 32 + 8 * fq + bj * HALF + 4 * n);
#pragma unroll
        for (int ai = 0; ai < 2; ++ai)
#pragma unroll
            for (int m = 0; m < 4; ++m) { const int row = row0 + ai * HALF + m * 16; bf16_t* rowp = O + (size_t)row * ldc + col0;
#pragma unroll
                for (int bj = 0; bj < 2; ++bj) { const f32x4 v0 = acc[ai][bj][m][0] * sc[bj][0], v1 = acc[ai][bj][m][1] * sc[bj][1];
                    u32x4 w; w.x = cvt_pk_bf16(v0[0], v0[1]); w.y = cvt_pk_bf16(v0[2], v0[3]); w.z = cvt_pk_bf16(v1[0], v1[1]); w.w = cvt_pk_bf16(v1[2], v1[3]);
                    *(u32x4*)(rowp + bj * HALF) = w; } }
    }
};
struct EpiP1 {
    static constexpr bool PERM = true; static constexpr int MID = 0;
    EpiRowScale e0; EpiColScale e1;
    __device__ __forceinline__ void operator()(const f32x4 (&acc)[2][2][4][2], const Unit& u, int wr, int wc, int fr, int fq) const { if (u.kind == 0) e0(acc, u, wr, wc, fr, fq); else e1(acc, u, wr, wc, fr, fq); }
};
struct EpiGate {
    static constexpr bool PERM = true; static constexpr int MID = 0;
    const bf16_t* gate; const bf16_t* addsrc; bf16_t* O;
    __device__ __forceinline__ void operator()(const f32x4 (&acc)[2][2][4][2], const Unit& u, int wr, int wc, int fr, int fq) const {
        const int row0 = u.pm * BM + wr * 64 + fr, col0 = u.pn * BM + wc * 32 + 8 * fq;
#pragma unroll
        for (int ai = 0; ai < 2; ++ai)
#pragma unroll
            for (int m = 0; m < 4; ++m) { const int row = row0 + ai * HALF + m * 16;
#pragma unroll
                for (int bj = 0; bj < 2; ++bj) { const int col = col0 + bj * HALF;
                    float gf[8], r[8]; unpack8(*(const u32x4*)(gate + (size_t)row * NPROJ + col), gf);
                    const f32x4 v0 = acc[ai][bj][m][0], v1 = acc[ai][bj][m][1];
#pragma unroll
                    for (int j = 0; j < 4; ++j) { r[j] = v0[j] * sigmoidf_(gf[j]); r[4 + j] = v1[j] * sigmoidf_(gf[4 + j]); }
                    if (addsrc) { float af[8]; unpack8(*(const u32x4*)(addsrc + (size_t)row * D + col), af);
#pragma unroll
                        for (int j = 0; j < 8; ++j) r[j] += af[j]; }
                    *(u32x4*)(O + (size_t)row * D + col) = pack8(r); } }
    }
};
struct EpiMerge {
    static constexpr bool PERM = true; static constexpr int MID = 8;
    const bf16_t* ga; const bf16_t* gr; bf16_t* O;
    __device__ __forceinline__ void mid(f32x4 (&acc)[2][2][4][2], const Unit& u, int wr, int wc, int fr, int fq) const {
        const int row0 = u.pm * BM + wr * 64 + fr, col0 = u.pn * BM + wc * 32 + 8 * fq;
#pragma unroll
        for (int ai = 0; ai < 2; ++ai)
#pragma unroll
            for (int m = 0; m < 4; ++m) { int row = row0 + ai * HALF + m * 16; asm volatile("" : "+v"(row));
#pragma unroll
                for (int bj = 0; bj < 2; ++bj) { const size_t off = (size_t)row * NPROJ + col0 + bj * HALF;
                    float fa[8], fb[8]; unpack8(*(const u32x4*)(ga + off), fa); unpack8(*(const u32x4*)(gr + off), fb);
#pragma unroll
                    for (int j = 0; j < 8; ++j) { const float rt = (1.0f + __builtin_amdgcn_exp2f(fb[j] * -1.4426950408889634f)) * __builtin_amdgcn_rcpf(1.0f + __builtin_amdgcn_exp2f(fa[j] * -1.4426950408889634f));
                        if (j < 4) acc[ai][bj][m][0][j] *= rt; else acc[ai][bj][m][1][j - 4] *= rt; } }
                asm volatile("" ::: "memory"); }
    }
    __device__ __forceinline__ void operator()(const f32x4 (&acc)[2][2][4][2], const Unit& u, int wr, int wc, int fr, int fq) const {
        const int row0 = u.pm * BM + wr * 64 + fr, col0 = u.pn * BM + wc * 32 + 8 * fq;
#pragma unroll
        for (int ai = 0; ai < 2; ++ai)
#pragma unroll
            for (int m = 0; m < 4; ++m) { const int row = row0 + ai * HALF + m * 16;
#pragma unroll
                for (int bj = 0; bj < 2; ++bj) { const int col = col0 + bj * HALF;
                    float gf[8], r[8]; unpack8(*(const u32x4*)(gr + (size_t)row * NPROJ + col), gf);
                    const f32x4 v0 = acc[ai][bj][m][0], v1 = acc[ai][bj][m][1];
#pragma unroll
                    for (int j = 0; j < 4; ++j) { r[j] = v0[j] * sigmoidf_(gf[j]); r[4 + j] = v1[j] * sigmoidf_(gf[4 + j]); }
                    *(u32x4*)(O + (size_t)row * D + col) = pack8(r); } }
    }
};
struct EpiResid {
    static constexpr bool PERM = true; static constexpr int MID = 0;
    bf16_t* xb; float* rowss;
    __device__ __forceinline__ void operator()(const f32x4 (&acc)[2][2][4][2], const Unit& u, int wr, int wc, int fr, int fq) const {
        const int row0 = u.pm * BM + wr * 64 + fr, col0 = u.pn * BM + wc * 32 + 8 * fq;
#pragma unroll
        for (int ai = 0; ai < 2; ++ai)
#pragma unroll
            for (int m = 0; m < 4; ++m) { const int row = row0 + ai * HALF + m * 16; float ss = 0.f;
#pragma unroll
                for (int bj = 0; bj < 2; ++bj) { const size_t off = (size_t)row * D + col0 + bj * HALF;
                    float b[8], r[8]; unpack8(*(const u32x4*)(xb + off), b);
                    const f32x4 v0 = acc[ai][bj][m][0], v1 = acc[ai][bj][m][1];
#pragma unroll
                    for (int j = 0; j < 4; ++j) { b[j] += v0[j]; b[4 + j] += v1[j]; }
                    const u32x4 w = pack8(b);
                    *(u32x4*)(xb + off) = w;
                    unpack8(w, r);
#pragma unroll
                    for (int j = 0; j < 8; ++j) ss += r[j] * r[j]; }
                { const int ln = fr + 16 * fq; ss += shx(ss, 16, ln); ss += shx(ss, 32, ln); }
                if (fq == 0) rowss[(size_t)row * 16 + u.pn * 4 + wc] = ss; }
    }
};
}

template <class Sched> __device__ __forceinline__ void fill_rstd(LAS float* rl, const float* rowss, const Sched& S, int by_col  ) {
    const int tid = otid();
    for (int e = tid; e < 12 * 256; e += NTHREADS) { pg8::Unit u; const int i = e >> 8;
        if (S.next(i, u)) { const bool bc = by_col < 0 ? (u.kind != 0) : (by_col != 0); const int r = (bc ? u.pn : u.pm) * 256 + (e & 255); rl[e] = rsqrtf(sum16(rowss + (size_t)r * 16) * (1.0f / 1024.0f) + EPS); } }
    __syncthreads();
}

__device__ __forceinline__ int win_srccol(int nd) {
    if (nd < 1024) return nd;
    if (nd < 1536) return 1536 + (nd - 1024);
    if (nd < 2048) return 2048 + (nd - 1536);
    if (nd < 3072) return 3584 + (nd - 2048);
    if (nd < 4096) return 4608 + (nd - 3072);
    if (nd < 5120) return 5632 + (nd - 4096);
    nd -= 5120;
    if (nd < 512) return 1024 + nd;
    if (nd < 1024) return 2048 + (nd - 512);
    return 2560 + (nd - 1024);
}
struct TileJob { const float* src; const float* gsc; bf16_t* dst; int ld_src, k0, nsrc0, ldd, ndst0, kdst0; };
__device__ __forceinline__ TileJob tile_job(const Params& P, int job) {
    constexpr int T_IN = 16 * 112, T_A = 8 * 16, T_R = 16 * 16, T_O = 16 * 16, T_UP = 16 * 88, T_D = 44 * 16, T_L = T_IN + T_A + T_R + T_O + T_UP + T_D;
    const int l = job / T_L; int r = job % T_L;
    unsigned char* wl = P.ws + WS_W + (size_t)l * W_LAYER;
    TileJob j;
    if (r < T_IN) { const int kt = r / 112, nt = r % 112; j = TileJob{P.w_in + (size_t)l * D * DIN, P.norm_mix_g + l * D, (bf16_t*)(wl + W_IN_OFF), DIN, kt * 64, win_srccol(nt * 64), 1024, nt * 64, 0}; return j; }
    r -= T_IN;
    if (r < T_A) { const int kt = r / 16, nt = r % 16; j = TileJob{P.w_ba + (size_t)l * 512 * D, nullptr, (bf16_t*)(wl + W_A_OFF), D, kt * 64, nt * 64, 1536, nt * 64, 0}; return j; }
    r -= T_A;
    if (r < T_R) { const int kt = r / 16, nt = r % 16; j = TileJob{P.w_br + (size_t)l * D * D, nullptr, (bf16_t*)(wl + W_A_OFF), D, kt * 64, nt * 64, 1536, nt * 64, 512}; return j; }
    r -= T_R;
    if (r < T_O) { const int kt = r / 16, nt = r % 16; j = TileJob{P.w_out + (size_t)l * D * D, nullptr, (bf16_t*)(wl + W_O_OFF), D, kt * 64, nt * 64, 1024, nt * 64, 0}; return j; }
    r -= T_O;
    if (r < T_UP) { const int kt = r / 88, nt = r % 88; j = TileJob{P.w_up + (size_t)l * D * DFF2, P.norm_ffn_g + l * D, (bf16_t*)(wl + W_UP_OFF), DFF2, kt * 64, nt * 64, 1024, nt * 64, 0}; return j; }
    r -= T_UP;
    { const int kt = r / 16, nt = r % 16; j = TileJob{P.w_down + (size_t)l * DFF * D, nullptr, (bf16_t*)(wl + W_D_OFF), D, kt * 64, nt * 64, DFF, nt * 64, 0}; return j; }
}
struct TileRegs { float4 v[2]; float s[2]; };
__device__ __forceinline__ void tile_load(TileRegs& tr, const TileJob& j, int t) {
#pragma unroll
    for (int i = 0; i < 2; ++i) { const int r = (t >> 4) + 32 * i, c = (t & 15) * 4;
        tr.v[i] = *(const float4*)(j.src + (size_t)(j.k0 + r) * j.ld_src + j.nsrc0 + c);
        tr.s[i] = j.gsc ? j.gsc[j.k0 + r] : 1.0f; }
}
__device__ __forceinline__ void tile_store(const TileRegs& tr, const TileJob& j, int t, LAS float* tile) {
#pragma unroll
    for (int i = 0; i < 2; ++i) { const int r = (t >> 4) + 32 * i, c = (t & 15) * 4; const float sc = tr.s[i];
        tile[r * 65 + c] = tr.v[i].x * sc; tile[r * 65 + c + 1] = tr.v[i].y * sc; tile[r * 65 + c + 2] = tr.v[i].z * sc; tile[r * 65 + c + 3] = tr.v[i].w * sc; }
    __syncthreads();
    { const int n = t >> 3, k8 = (t & 7) * 8; float f[8];
#pragma unroll
      for (int jj = 0; jj < 8; ++jj) f[jj] = tile[(k8 + jj) * 65 + n];
      *(u32x4*)(j.dst + (size_t)(j.ndst0 + n) * j.ldd + j.kdst0 + j.k0 + k8) = pack8(f); }
    __syncthreads();
}
__device__ __forceinline__ void phase_prologue(const Params& P, LAS unsigned char* lds) {
    LAS float* tile = (LAS float*)lds;
    constexpr int NJOBS = (16 * 112 + 8 * 16 + 16 * 16 + 16 * 16 + 16 * 88 + 44 * 16) * DEPTH;
    { const int t = otid(), G = ogrid();
      int job = blockIdx.x;
      if (job < NJOBS) { TileJob jc = tile_job(P, job); TileRegs rc; tile_load(rc, jc, t);
          while (true) { const int jn = job + G; const bool more = jn < NJOBS;
              TileJob jx = jc; TileRegs rx = rc; if (more) { jx = tile_job(P, jn); tile_load(rx, jx, t); }
              tile_store(rc, jc, t, tile);
              if (!more) break; jc = jx; rc = rx; job = jn; } } }
    if (blockIdx.x == 0 && otid() < DEPTH * 4) { const int i = otid(); float* tab = (float*)(P.ws + WS_LG2);
        tab[2 * i] = -log1pf(expf(-P.dec_f[i])) * 1.4426950408889634f; tab[2 * i + 1] = -log1pf(expf(-P.dec_b[i])) * 1.4426950408889634f; }
    float* cosN = (float*)(P.ws + WS_COSN); float* sinN = (float*)(P.ws + WS_SINN); float* cosT = (float*)(P.ws + WS_COST); float* sinT = (float*)(P.ws + WS_SINT);
    for (int idx = blockIdx.x * NTHREADS + otid(); idx < 16384 * 64; idx += ogrid() * NTHREADS) {
        const int pos = idx >> 6, i = idx & 63;
        const float invf = powf(10000.0f, -(float)i / 64.0f);
        const float ang = (float)pos * invf;
        const float c = cosf(ang), s = sinf(ang);
        cosN[idx] = c; sinN[idx] = s; cosT[(size_t)i * 16384 + pos] = c; sinT[(size_t)i * 16384 + pos] = s;
    }
}

__device__ __forceinline__ void phase_init(const float* __restrict__ xin, bf16_t* xb, float* rowss1, float* rowss2) {
    const int tid = otid(), lane = tid & 63, nw = ogrid() * 8;
    for (int row = blockIdx.x * 8 + (tid >> 6); row < MG; row += nw) {
        const float4* p = (const float4*)(xin + (size_t)row * D); float ss = 0.f;
#pragma unroll
        for (int i = 0; i < 4; ++i) { const float4 v = p[lane + 64 * i];
            u32x2 w; w.x = cvt_pk_bf16(v.x, v.y); w.y = cvt_pk_bf16(v.z, v.w); *(u32x2*)(xb + (size_t)row * D + (lane + 64 * i) * 4) = w;
            const float a0 = bf_lo(w.x), a1 = bf_hi(w.x), a2 = bf_lo(w.y), a3 = bf_hi(w.y); ss += a0 * a0 + a1 * a1 + a2 * a2 + a3 * a3; }
        ss = wave_sum(ss, lane);
        if (lane < 16) rowss1[(size_t)row * 16 + lane] = lane == 0 ? ss : 0.f;
    }
}
__device__ __forceinline__ void phase_final(const bf16_t* __restrict__ xb, float* xo, const float* rowss1, const float* __restrict__ gfin) {
    const int tid = otid(), lane = tid & 63, nw = ogrid() * 8;
    for (int row = blockIdx.x * 8 + (tid >> 6); row < MG; row += nw) {
        const float rs = rsqrtf(sum16(rowss1 + (size_t)row * 16) * (1.0f / 1024.0f) + EPS);
#pragma unroll
        for (int i = 0; i < 2; ++i) { const int c8 = (lane + 64 * i) * 8; float x[8]; unpack8(*(const u32x4*)(xb + (size_t)row * D + c8), x);
            const f32x4 g0 = *(const f32x4*)(gfin + c8), g1 = *(const f32x4*)(gfin + c8 + 4);
            *(f32x4*)(xo + (size_t)row * D + c8) = (f32x4){x[0] * rs * g0[0], x[1] * rs * g0[1], x[2] * rs * g0[2], x[3] * rs * g0[3]};
            *(f32x4*)(xo + (size_t)row * D + c8 + 4) = (f32x4){x[4] * rs * g1[0], x[5] * rs * g1[1], x[6] * rs * g1[2], x[7] * rs * g1[3]}; }
    }
}
__device__ __forceinline__ float gelu_tanh(float x) { const float t = fmaf(x * x, -0.10294324f, -2.30220819f);
    return x * __builtin_amdgcn_rcpf(1.0f + __builtin_amdgcn_exp2f(x * t)); }
__device__ __forceinline__ void phase_convact(const bf16_t* __restrict__ u, bf16_t* act, const float* __restrict__ cw  , int seqlen, int nrows) {
    const int gt = blockIdx.x * NTHREADS + otid(), nth = ogrid() * NTHREADS;
    int nr = nrows; asm volatile("" : "+s"(nr));
    const int ntask = (nr >> 3) * 352;
    for (int id = gt; id < ntask; id += nth) {
        const int tb = id / 352, c = (id % 352) * 8, t0 = tb * 8;
        const u32x4 z = (u32x4){0u, 0u, 0u, 0u};
        u32x4 g[10], v[10];
        const bool has_prev = (t0 & (seqlen - 1)) != 0, has_next = ((t0 + 8) & (seqlen - 1)) != 0;
#pragma unroll
        for (int r = 0; r < 10; ++r) { const bool ok = (r == 0) ? has_prev : ((r == 9) ? has_next : true);
            g[r] = z; v[r] = z;
            if (ok) { g[r] = *(const u32x4*)(u + (size_t)(t0 - 1 + r) * DFF2 + c); v[r] = *(const u32x4*)(u + (size_t)(t0 - 1 + r) * DFF2 + DFF + c); } }
        float wg[3][8], wv[3][8];
#pragma unroll
        for (int k = 0; k < 3; ++k) {
            const f32x4 a0 = *(const f32x4*)(cw + k * DFF2 + c), a1 = *(const f32x4*)(cw + k * DFF2 + c + 4);
            const f32x4 b0 = *(const f32x4*)(cw + k * DFF2 + DFF + c), b1 = *(const f32x4*)(cw + k * DFF2 + DFF + c + 4);
#pragma unroll
            for (int j = 0; j < 4; ++j) { wg[k][j] = a0[j]; wg[k][4 + j] = a1[j]; wv[k][j] = b0[j]; wv[k][4 + j] = b1[j]; } }
#pragma unroll
        for (int i = 0; i < 8; ++i) {
            float a[8], b[8], cc[8], r[8], gg[8], vv[8];
            unpack8(g[i], a); unpack8(g[i + 1], b); unpack8(g[i + 2], cc);
#pragma unroll
            for (int j = 0; j < 8; ++j) gg[j] = a[j] * wg[0][j] + b[j] * wg[1][j] + cc[j] * wg[2][j];
            unpack8(v[i], a); unpack8(v[i + 1], b); unpack8(v[i + 2], cc);
#pragma unroll
            for (int j = 0; j < 8; ++j) vv[j] = a[j] * wv[0][j] + b[j] * wv[1][j] + cc[j] * wv[2][j];
#pragma unroll
            for (int j = 0; j < 8; ++j) r[j] = gelu_tanh(gg[j]) * vv[j];
            *(u32x4*)(act + (size_t)(t0 + i) * DFF + c) = pack8(r);
        }
    }
}

constexpr int NA_LDS_WAVE = 12288;
struct NaFrags { bf16x8 k[4]; u32x2 v[2][2][2]; };
__device__ __forceinline__ void na_load(NaFrags& f, const bf16_t* __restrict__ proj, const bf16_t* __restrict__ projT, int ktok, int h, int c, int hh) {
    const bf16_t* kp = proj + (size_t)(ktok + c) * NPROJ + 512 + h * 64 + 8 * hh;
#pragma unroll
    for (int s = 0; s < 4; ++s) f.k[s] = *(const bf16x8*)(kp + 16 * s);
#pragma unroll
    for (int dt = 0; dt < 2; ++dt)
#pragma unroll
        for (int s2 = 0; s2 < 2; ++s2) { const bf16_t* vp = projT + (size_t)(h * 64 + dt * 32 + c) * MG + (ktok + 16 * s2 + 4 * hh);
            f.v[dt][s2][0] = *(const u32x2*)vp; f.v[dt][s2][1] = *(const u32x2*)(vp + 8); }
}
__device__ __forceinline__ void na_item(const bf16_t* __restrict__ proj, const bf16_t* __restrict__ projT, bf16_t* aout, const float* __restrict__ relb  , int item, int seqlen, LAS unsigned char* lds, int w, int lane) {
    const int c = lane & 31, hh = lane >> 5;
    const int R = item >> 3, h = item & 7;
    const int rps = seqlen >> 6, seq = R / rps, r = R % rps;
    int rs = r - 4; rs = rs < 0 ? 0 : rs; rs = rs > rps - 8 ? rps - 8 : rs;
    const int qtok0 = seq * seqlen + r * 64, ktok0 = seq * seqlen + rs * 64;
    LAS float* bias = (LAS float*)(lds + w * NA_LDS_WAVE) + 64;
    LAS bf16_t* Otile = (LAS bf16_t*)(lds + w * NA_LDS_WAVE + 3072);
    for (int i = lane; i < 768; i += 64) { const int j = i - 64; bias[j] = (j >= 0 && j < 465) ? relb[h * 465 + j] * 1.4426950408889634f : 0.f; }
    bf16x8 qf[2][4];
#pragma unroll
    for (int qh = 0; qh < 2; ++qh) { const bf16_t* qp = proj + (size_t)(qtok0 + 32 * qh + c) * NPROJ + h * 64 + 8 * hh;
#pragma unroll
        for (int s = 0; s < 4; ++s) qf[qh][s] = *(const bf16x8*)(qp + 16 * s); }
    f32x16 O[2][2];
    float mrun[2], lrun[2]; int cs[2];
#pragma unroll
    for (int qh = 0; qh < 2; ++qh) { O[qh][0] = zero16(); O[qh][1] = zero16(); mrun[qh] = -1e30f; lrun[qh] = 0.f;
        int x = 32 * qh + c - 8; x = x < 0 ? 0 : x; x = x > 48 ? 48 : x; cs[qh] = x; }
    NaFrags cur, nxt;
    na_load(cur, proj, projT, ktok0, h, c, hh);
#pragma unroll 1
    for (int t = 0; t < 16; ++t) {
        if (t + 1 < 16) na_load(nxt, proj, projT, ktok0 + 32 * (t + 1), h, c, hh);
        const int kr = rs + (t >> 1), chalf = t & 1, brow = (kr - r + 7) * 31;
#pragma unroll
        for (int qh = 0; qh < 2; ++qh) {
            f32x16 x = zero16();
#pragma unroll
            for (int s = 0; s < 4; ++s) x = mfma32(cur.k[s], qf[qh][s], x);
            const int qc = 32 * qh + c; float mt = -1e30f;
#pragma unroll
            for (int rg = 0; rg < 16; ++rg) { const int kc = 32 * chalf + (rg & 3) + 8 * (rg >> 2) + 4 * hh;
                const bool valid = (kc >= cs[qh]) && (kc < cs[qh] + 16);
                const float sv = fmaf(x[rg], 0.18033688011112042f, bias[brow + kc - qc + 15]) + (valid ? 0.f : -__builtin_inff());
                x[rg] = sv; mt = fmaxf(mt, sv); }
            mt = fmaxf(mt, shx(mt, 32, lane));
            const float mnew = fmaxf(mrun[qh], mt), alpha = __builtin_amdgcn_exp2f(mrun[qh] - mnew);
            const bool grew = mnew > mrun[qh];
            mrun[qh] = mnew;
            float ps = 0.f;
#pragma unroll
            for (int rg = 0; rg < 16; ++rg) { const float p = __builtin_amdgcn_exp2f(x[rg] - mnew); x[rg] = p; ps += p; }
            lrun[qh] = lrun[qh] * alpha + ps;
            if (__builtin_amdgcn_ballot_w64(grew) != 0ull) { O[qh][0] *= alpha; O[qh][1] *= alpha; }
#pragma unroll
            for (int s2 = 0; s2 < 2; ++s2) {
                u32x4 pw; pw.x = cvt_pk_bf16(x[8 * s2 + 0], x[8 * s2 + 1]); pw.y = cvt_pk_bf16(x[8 * s2 + 2], x[8 * s2 + 3]); pw.z = cvt_pk_bf16(x[8 * s2 + 4], x[8 * s2 + 5]); pw.w = cvt_pk_bf16(x[8 * s2 + 6], x[8 * s2 + 7]);
                const bf16x8 pb = __builtin_bit_cast(bf16x8, pw);
#pragma unroll
                for (int dt = 0; dt < 2; ++dt) { u32x4 aw; aw.x = cur.v[dt][s2][0].x; aw.y = cur.v[dt][s2][0].y; aw.z = cur.v[dt][s2][1].x; aw.w = cur.v[dt][s2][1].y;
                    O[qh][dt] = mfma32(__builtin_bit_cast(bf16x8, aw), pb, O[qh][dt]); } }
        }
        cur = nxt;
    }
#pragma unroll
    for (int qh = 0; qh < 2; ++qh) { const float inv = 1.0f / (lrun[qh] + shx(lrun[qh], 32, lane));
#pragma unroll
        for (int dt = 0; dt < 2; ++dt)
#pragma unroll
            for (int g4 = 0; g4 < 4; ++g4) { u32x2 pw; pw.x = cvt_pk_bf16(O[qh][dt][4 * g4] * inv, O[qh][dt][4 * g4 + 1] * inv); pw.y = cvt_pk_bf16(O[qh][dt][4 * g4 + 2] * inv, O[qh][dt][4 * g4 + 3] * inv);
                *(LAS u32x2*)(Otile + (32 * qh + c) * 72 + dt * 32 + 8 * g4 + 4 * hh) = pw; } }
#pragma unroll
    for (int i = 0; i < 8; ++i) { const int id = lane + 64 * i, q = id >> 3, d8 = (id & 7) * 8;
        *(u32x4*)(aout + (size_t)(qtok0 + q) * 1536 + h * 64 + d8) = *(const LAS u32x4*)(Otile + q * 72 + d8); }
}

constexpr int KT_STRIDE = 136;
__device__ __forceinline__ void r1_item(const bf16_t* __restrict__ projT, bf16_t* stloc, const float* __restrict__ cosT, const float* __restrict__ sinT, float lgf2, float lgb2, int item, int seqlen, LAS unsigned char* lds) {
    const int tid = otid(), w = __builtin_amdgcn_readfirstlane(tid >> 6), lane = tid & 63, c = lane & 31, hh = lane >> 5;
    const int ch = item >> 2, h = item & 3, tok0 = ch * 128, pos0 = tok0 % seqlen;
    LAS bf16_t* KTf = (LAS bf16_t*)lds; LAS bf16_t* KTb = (LAS bf16_t*)(lds + 128 * KT_STRIDE * 2);
    const float scale = 0.08838834764831845f;
    bf16x8 af[8];
    { const bf16_t* vp = projT + (size_t)(1024 + h * 256 + 32 * w + c) * MG + tok0 + 8 * hh;
#pragma unroll
      for (int s = 0; s < 8; ++s) af[s] = *(const bf16x8*)(vp + 16 * s); }
#pragma unroll
    for (int it = 0; it < 2; ++it) {
        const int id = tid + NTHREADS * it, d = id >> 4, t8 = id & 15;
        float k1[8], k2[8];
        unpack8(*(const u32x4*)(projT + (size_t)(512 + h * 128 + d) * MG + tok0 + 8 * t8), k1);
        unpack8(*(const u32x4*)(projT + (size_t)(512 + h * 128 + d + 64) * MG + tok0 + 8 * t8), k2);
        const f32x4 c0 = *(const f32x4*)(cosT + (size_t)d * 16384 + pos0 + 8 * t8), c1 = *(const f32x4*)(cosT + (size_t)d * 16384 + pos0 + 8 * t8 + 4);
        const f32x4 s0 = *(const f32x4*)(sinT + (size_t)d * 16384 + pos0 + 8 * t8), s1 = *(const f32x4*)(sinT + (size_t)d * 16384 + pos0 + 8 * t8 + 4);
        float f1[8], f2[8], b1[8], b2[8];
#pragma unroll
        for (int j = 0; j < 8; ++j) { const float cv = j < 4 ? c0[j & 3] : c1[j & 3], sv = j < 4 ? s0[j & 3] : s1[j & 3];
            const float r1 = (k1[j] * cv - k2[j] * sv) * scale, r2 = (k1[j] * sv + k2[j] * cv) * scale;
            const int tl = 8 * t8 + j; const float df = __builtin_amdgcn_exp2f((float)(127 - tl) * lgf2), db = __builtin_amdgcn_exp2f((float)tl * lgb2);
            f1[j] = r1 * df; f2[j] = r2 * df; b1[j] = r1 * db; b2[j] = r2 * db; }
        *(LAS u32x4*)(KTf + d * KT_STRIDE + 8 * t8) = pack8(f1); *(LAS u32x4*)(KTf + (d + 64) * KT_STRIDE + 8 * t8) = pack8(f2);
        *(LAS u32x4*)(KTb + d * KT_STRIDE + 8 * t8) = pack8(b1); *(LAS u32x4*)(KTb + (d + 64) * KT_STRIDE + 8 * t8) = pack8(b2);
    }
    __syncthreads();
#pragma unroll
    for (int dir = 0; dir < 2; ++dir) {
        LAS bf16_t* KT = dir ? KTb : KTf;
        bf16_t* dst = stloc + ((size_t)(ch * 4 + h) * 2 + dir) * 32768;
#pragma unroll
        for (int ct = 0; ct < 4; ++ct) {
            f32x16 acc = zero16();
#pragma unroll
            for (int s = 0; s < 8; ++s) { const bf16x8 bfr = *(const LAS bf16x8*)(KT + (32 * ct + c) * KT_STRIDE + 16 * s + 8 * hh); acc = mfma32(af[s], bfr, acc); }
#pragma unroll
            for (int rg = 0; rg < 16; ++rg) { const int dv = 32 * w + (rg & 3) + 8 * (rg >> 2) + 4 * hh; dst[dv * 128 + 32 * ct + c] = (bf16_t)(cvt_pk_bf16(acc[rg], 0.f) & 0xffffu); }
        }
    }
    __syncthreads();
}

__device__ __forceinline__ void phase_scan(const bf16_t* __restrict__ stloc, bf16_t* st, const float* __restrict__ decf, const float* __restrict__ decb, int seqlen) {
    const int gt = blockIdx.x * NTHREADS + otid(), nth = ogrid() * NTHREADS;
    constexpr size_t CSTR = (size_t)4 * 2 * 32768;
    if (seqlen == 4096) {
        constexpr int NCH = 32, NTASK = 4 * 4 * 2 * 4096;
        for (int id = gt; id < NTASK; id += nth) {
            const int e8 = id & 4095, dir = (id >> 12) & 1, h = (id >> 13) & 3, seq = id >> 15;
            const float x = dir ? decb[h] : decf[h]; const float cd = exp2f(-128.0f * log1pf(expf(-x)) * 1.4426950408889634f);
            const size_t base = ((size_t)(seq * NCH * 4 + h) * 2 + dir) * 32768 + (size_t)e8 * 8;
            float zz = 0.f; asm volatile("" : "+v"(zz));
            float S[8];
#pragma unroll
            for (int j = 0; j < 8; ++j) S[j] = zz;
            for (int i0 = 0; i0 < NCH; i0 += 8) {
                u32x4 loc[8];
#pragma unroll
                for (int j = 0; j < 8; ++j) { const int ci = dir ? (NCH - 1 - (i0 + j)) : (i0 + j); loc[j] = *(const u32x4*)(stloc + base + (size_t)ci * CSTR); }
#pragma unroll
                for (int j = 0; j < 8; ++j) { const int ci = dir ? (NCH - 1 - (i0 + j)) : (i0 + j);
                    *(u32x4*)(st + base + (size_t)ci * CSTR) = pack8(S);
                    float lf[8]; unpack8(loc[j], lf);
#pragma unroll
                    for (int k = 0; k < 8; ++k) S[k] = S[k] * cd + lf[k]; }
            }
        }
    } else {
        constexpr int NCH = 128, NTASK = 4 * 2 * 16384;
        for (int id = gt; id < NTASK; id += nth) {
            const int e2 = id & 16383, dir = (id >> 14) & 1, h = (id >> 15) & 3;
            const float x = dir ? decb[h] : decf[h]; const float cd = exp2f(-128.0f * log1pf(expf(-x)) * 1.4426950408889634f);
            const size_t base = ((size_t)h * 2 + dir) * 32768 + (size_t)e2 * 2;
            float zz = 0.f; asm volatile("" : "+v"(zz));
            float S0 = zz, S1 = zz;
            for (int i0 = 0; i0 < NCH; i0 += 8) {
                unsigned loc[8];
#pragma unroll
                for (int j = 0; j < 8; ++j) { const int ci = dir ? (NCH - 1 - (i0 + j)) : (i0 + j); loc[j] = *(const unsigned*)(stloc + base + (size_t)ci * CSTR); }
#pragma unroll
                for (int j = 0; j < 8; ++j) { const int ci = dir ? (NCH - 1 - (i0 + j)) : (i0 + j);
                    *(unsigned*)(st + base + (size_t)ci * CSTR) = cvt_pk_bf16(S0, S1);
                    S0 = S0 * cd + bf_lo(loc[j]); S1 = S1 * cd + bf_hi(loc[j]); }
            }
        }
    }
}

constexpr int OL_STRIDE = 264;
__device__ __forceinline__ void r3_item(const bf16_t* __restrict__ proj, const bf16_t* __restrict__ projT, const bf16_t* __restrict__ st, bf16_t* ro,
                        const float* __restrict__ cosN, const float* __restrict__ sinN, const float* __restrict__ gn  , float lgf2, float lgb2,
                        int item, int seqlen, LAS unsigned char* lds) {
    const int tid = otid(), w = __builtin_amdgcn_readfirstlane(tid >> 6), lane = tid & 63, c = lane & 31, hh = lane >> 5;
    const int ch = item >> 2, h = item & 3, tok0 = ch * 128, pos0 = tok0 % seqlen;
    LAS bf16_t* Ql = (LAS bf16_t*)lds; LAS bf16_t* Kl = (LAS bf16_t*)(lds + 34816); LAS bf16_t* Pl = (LAS bf16_t*)(lds + 69632);
    LAS float* stat = (LAS float*)(lds + 104448);
    LAS bf16_t* Ol = (LAS bf16_t*)lds;
    const float scale = 0.08838834764831845f;
    bf16x8 asb[8], asf[8], avt[8];
    const size_t stb0 = ((size_t)(ch * 4 + h) * 2) * 32768 + (size_t)(32 * w + c) * 128 + 8 * hh;
#pragma unroll
    for (int s = 0; s < 8; ++s) asb[s] = *(const bf16x8*)(st + stb0 + 32768 + 16 * s);
#pragma unroll
    for (int it = 0; it < 2; ++it) {
        const int id = tid + NTHREADS * it, t = id >> 3, d8 = (id & 7) * 8;
        const f32x4 c0 = *(const f32x4*)(cosN + (size_t)(pos0 + t) * 64 + d8), c1 = *(const f32x4*)(cosN + (size_t)(pos0 + t) * 64 + d8 + 4);
        const f32x4 s0 = *(const f32x4*)(sinN + (size_t)(pos0 + t) * 64 + d8), s1 = *(const f32x4*)(sinN + (size_t)(pos0 + t) * 64 + d8 + 4);
        float a[8], b[8], o1[8], o2[8];
        const bf16_t* qp = proj + (size_t)(tok0 + t) * NPROJ + 1024 + h * 128 + d8;
        unpack8(*(const u32x4*)qp, a); unpack8(*(const u32x4*)(qp + 64), b);
#pragma unroll
        for (int j = 0; j < 8; ++j) { const float cv = j < 4 ? c0[j & 3] : c1[j & 3], sv = j < 4 ? s0[j & 3] : s1[j & 3]; o1[j] = a[j] * cv - b[j] * sv; o2[j] = a[j] * sv + b[j] * cv; }
        *(LAS u32x4*)(Ql + t * KT_STRIDE + d8) = pack8(o1); *(LAS u32x4*)(Ql + t * KT_STRIDE + 64 + d8) = pack8(o2);
        const bf16_t* kp = proj + (size_t)(tok0 + t) * NPROJ + 1536 + h * 128 + d8;
        unpack8(*(const u32x4*)kp, a); unpack8(*(const u32x4*)(kp + 64), b);
#pragma unroll
        for (int j = 0; j < 8; ++j) { const float cv = j < 4 ? c0[j & 3] : c1[j & 3], sv = j < 4 ? s0[j & 3] : s1[j & 3]; o1[j] = (a[j] * cv - b[j] * sv) * scale; o2[j] = (a[j] * sv + b[j] * cv) * scale; }
        *(LAS u32x4*)(Kl + t * KT_STRIDE + d8) = pack8(o1); *(LAS u32x4*)(Kl + t * KT_STRIDE + 64 + d8) = pack8(o2);
    }
    __syncthreads();
    { const int kt = w >> 1;
#pragma unroll
      for (int q2 = 0; q2 < 2; ++q2) { const int tqt = 2 * (w & 1) + q2;
          f32x16 x = zero16();
#pragma unroll
          for (int s = 0; s < 8; ++s) { const bf16x8 kf = *(const LAS bf16x8*)(Kl + (32 * kt + c) * KT_STRIDE + 16 * s + 8 * hh);
              const bf16x8 qf = *(const LAS bf16x8*)(Ql + (32 * tqt + c) * KT_STRIDE + 16 * s + 8 * hh); x = mfma32(kf, qf, x); }
          const int n = 32 * tqt + c;
#pragma unroll
          for (int g4 = 0; g4 < 4; ++g4) { float pv[4];
#pragma unroll
              for (int j = 0; j < 4; ++j) { const int mk = 32 * kt + 8 * g4 + 4 * hh + j; const int diff = n - mk;
                  const float dec = __builtin_amdgcn_exp2f(diff >= 0 ? (float)diff * lgf2 : (float)(-diff) * lgb2); pv[j] = x[4 * g4 + j] * dec; }
              u32x2 pw; pw.x = cvt_pk_bf16(pv[0], pv[1]); pw.y = cvt_pk_bf16(pv[2], pv[3]);
              *(LAS u32x2*)(Pl + n * KT_STRIDE + 32 * kt + 8 * g4 + 4 * hh) = pw; } } }
    __syncthreads();
    f32x16 acc[4];
#pragma unroll
    for (int q = 0; q < 4; ++q) acc[q] = zero16();
    { const bf16_t* vp0 = projT + (size_t)(1024 + h * 256 + 32 * w + c) * MG + tok0 + 8 * hh;
#pragma unroll
      for (int s = 0; s < 8; ++s) { asf[s] = *(const bf16x8*)(st + stb0 + 16 * s); avt[s] = *(const bf16x8*)(vp0 + 16 * s); } }
#pragma unroll
    for (int s = 0; s < 8; ++s) { const bf16x8 a = asb[s];
#pragma unroll
        for (int q = 0; q < 4; ++q) { const bf16x8 b = *(const LAS bf16x8*)(Ql + (32 * q + c) * KT_STRIDE + 16 * s + 8 * hh); acc[q] = mfma32(a, b, acc[q]); } }
#pragma unroll
    for (int q = 0; q < 4; ++q) { const int n = 32 * q + c; const float f = __builtin_amdgcn_exp2f((float)(128 - n) * lgb2 - (float)(n + 1) * lgf2); acc[q] *= f; }
#pragma unroll
    for (int s = 0; s < 8; ++s) { const bf16x8 a = asf[s];
#pragma unroll
        for (int q = 0; q < 4; ++q) { const bf16x8 b = *(const LAS bf16x8*)(Ql + (32 * q + c) * KT_STRIDE + 16 * s + 8 * hh); acc[q] = mfma32(a, b, acc[q]); } }
#pragma unroll
    for (int q = 0; q < 4; ++q) { const int n = 32 * q + c; const float f = __builtin_amdgcn_exp2f((float)(n + 1) * lgf2); acc[q] *= f; }
#pragma unroll
    for (int s = 0; s < 8; ++s) { const bf16x8 a = avt[s];
#pragma unroll
        for (int q = 0; q < 4; ++q) { const bf16x8 b = *(const LAS bf16x8*)(Pl + (32 * q + c) * KT_STRIDE + 16 * s + 8 * hh); acc[q] = mfma32(a, b, acc[q]); } }
#pragma unroll
    for (int q = 0; q < 4; ++q) { float s1 = 0.f, s2 = 0.f;
#pragma unroll
        for (int i = 0; i < 16; ++i) { s1 += acc[q][i]; s2 += acc[q][i] * acc[q][i]; }
        s1 += shx(s1, 32, lane); s2 += shx(s2, 32, lane);
        if (hh == 0) { stat[(w * 128 + 32 * q + c) * 2] = s1; stat[(w * 128 + 32 * q + c) * 2 + 1] = s2; } }
    __syncthreads();
#pragma unroll
    for (int q = 0; q < 4; ++q) { float s1 = 0.f, s2 = 0.f; const int n = 32 * q + c;
#pragma unroll
        for (int k = 0; k < 8; ++k) { s1 += stat[(k * 128 + n) * 2]; s2 += stat[(k * 128 + n) * 2 + 1]; }
        const float mu = s1 * (1.0f / 256.0f); float var = s2 * (1.0f / 256.0f) - mu * mu; var = var < 0.f ? 0.f : var; const float rs = rsqrtf(var + EPS);
#pragma unroll
        for (int g4 = 0; g4 < 4; ++g4) { u32x2 pw; pw.x = cvt_pk_bf16((acc[q][4 * g4] - mu) * rs, (acc[q][4 * g4 + 1] - mu) * rs); pw.y = cvt_pk_bf16((acc[q][4 * g4 + 2] - mu) * rs, (acc[q][4 * g4 + 3] - mu) * rs);
            *(LAS u32x2*)(Ol + n * OL_STRIDE + 32 * w + 8 * g4 + 4 * hh) = pw; } }
    __syncthreads();
#pragma unroll
    for (int it = 0; it < 8; ++it) { const int id = tid + NTHREADS * it, tq = id >> 5, d8 = (id & 31) * 8;
        float y[8], rg[8], o[8]; unpack8(*(const LAS u32x4*)(Ol + tq * OL_STRIDE + d8), y);
        unpack8(*(const u32x4*)(proj + (size_t)(tok0 + tq) * NPROJ + 2048 + h * 256 + d8), rg);
        const f32x4 g0 = *(const f32x4*)(gn + h * 256 + d8), g1 = *(const f32x4*)(gn + h * 256 + d8 + 4);
#pragma unroll
        for (int j = 0; j < 8; ++j) { const float gv = j < 4 ? g0[j & 3] : g1[j & 3]; o[j] = rg[j] * sigmoidf_(rg[j]) * y[j] * gv; }
        *(u32x4*)(ro + (size_t)(tok0 + tq) * 1536 + 512 + h * 256 + d8) = pack8(o); }
    __syncthreads();
}


#define XB_TMO      128
#define XB_XCNT(j)  (256  + 64 * (j))
#define XB_XSUB(j)  (1280 + 64 * (j))
#define XB_XGEN(j)  (2304 + 64 * (j))
#define XB_TOP      3328
#define XB_TOPGEN   3392
#define XCD_BAR_WORDS 3456
#define XB_SPIN_CAP (1u << 22)
__device__ __forceinline__ unsigned xb_ld(unsigned* p)              { return __hip_atomic_load(p, __ATOMIC_RELAXED, __HIP_MEMORY_SCOPE_AGENT); }
__device__ __forceinline__ unsigned xb_add(unsigned* p, unsigned v) { return __hip_atomic_fetch_add(p, v, __ATOMIC_RELAXED, __HIP_MEMORY_SCOPE_AGENT); }
__device__ __forceinline__ unsigned xb_xcc_id() { return (unsigned)__builtin_amdgcn_s_getreg((3 << 11) | 20) & 0xFu; }
#define XB_SPIN(cond, bar) do { unsigned _sp = 0; while (cond) { __builtin_amdgcn_s_sleep(1); \
    if ((++_sp & 255u) == 0u) { if (xb_ld(&(bar)[XB_TMO])) break; if (_sp > XB_SPIN_CAP) { atomicAdd(&(bar)[XB_TMO], 1u); break; } } } } while (0)
struct XcdBarrier { unsigned* bar; unsigned x; volatile LAS unsigned* st; };
__device__ __forceinline__ XcdBarrier xcd_barrier_post(unsigned* bar, volatile LAS unsigned* st) {
    XcdBarrier b; b.bar = bar; b.x = xb_xcc_id(); b.st = st;
    if (threadIdx.x == 0) (void)xb_add(&bar[XB_XCNT(b.x)], 1u);
    return b;
}
__device__ __forceinline__ void xcd_barrier_complete(unsigned* bar, unsigned x, unsigned& nloc, unsigned& nx) {
    const unsigned G = gridDim.x * gridDim.y * gridDim.z;
    unsigned sum, cnt, mine, sp = 0u;
    for (;;) {
        sum = 0u; cnt = 0u; mine = 0u;
#pragma unroll
        for (unsigned j = 0; j < 16; ++j) { const unsigned c = xb_ld(&bar[XB_XCNT(j)]); sum += c; cnt += (c > 0u) ? 1u : 0u; mine = (j == x) ? c : mine; }
        if (sum == G) break;
        __builtin_amdgcn_s_sleep(1);
        if ((++sp & 255u) == 0u) { if (xb_ld(&bar[XB_TMO])) break; if (sp > XB_SPIN_CAP) { atomicAdd(&bar[XB_TMO], 1u); break; } }
    }
    nloc = mine > 0u ? mine : 1u; nx = cnt > 0u ? cnt : 1u;
}
__device__ __forceinline__ void xcd_barrier(const XcdBarrier& b) {
    asm volatile("s_waitcnt vmcnt(0)" ::: "memory");
    __syncthreads();
    if (threadIdx.x == 0) {
        unsigned* bar = b.bar;
        __builtin_amdgcn_s_waitcnt(0);
        unsigned nloc = b.st[0], nx = b.st[1];
        if (nloc == 0u) { xcd_barrier_complete(bar, b.x, nloc, nx); b.st[0] = nloc; b.st[1] = nx; }
        const unsigned old = xb_add(&bar[XB_XSUB(b.x)], 1u);
        const unsigned gen = old / nloc;
        if (old + 1u == (gen + 1u) * nloc) {
            __builtin_amdgcn_fence(__ATOMIC_RELEASE, "agent");
            asm volatile("s_waitcnt vmcnt(0)" ::: "memory");
            const unsigned og = xb_add(&bar[XB_TOP], 1u);
            const unsigned tg = og / nx;
            if (og + 1u == (tg + 1u) * nx) xb_add(&bar[XB_TOPGEN], 1u);
            else XB_SPIN(xb_ld(&bar[XB_TOPGEN]) == tg, bar);
            __builtin_amdgcn_fence(__ATOMIC_ACQUIRE, "agent");
            xb_add(&bar[XB_XGEN(b.x)], 1u);
            asm volatile("s_waitcnt vmcnt(0)" ::: "memory");
        } else {
            XB_SPIN(xb_ld(&bar[XB_XGEN(b.x)]) == gen, bar);
            __builtin_amdgcn_fence(__ATOMIC_ACQUIRE, "agent");
            asm volatile("s_waitcnt vmcnt(0)" ::: "memory");
        }
    }
    __syncthreads();
}

__device__ __forceinline__ unsigned char* opq(unsigned char* p) { asm volatile("" : "+s"(p)); return p; }
#define WSP(T, off) ((T*)(opq(P.ws) + (off)))
#define XBAR() do { XcdBarrier _b; _b.bar = (unsigned*)(opq(P.ws) + WS_CTL); _b.x = (unsigned)__builtin_amdgcn_readfirstlane((int)xb_xcc_id()); _b.st = (volatile LAS unsigned*)(lds + 131072); xcd_barrier(_b); } while (0)
__global__ void __launch_bounds__(NTHREADS, 2) fwd_megakernel(Params P) {
    extern __shared__ __attribute__((aligned(16))) unsigned char lds_raw[];
    LAS unsigned char* lds = (LAS unsigned char*)lds_raw;
    cg::grid_group grid = cg::this_grid();
    const int G = ogrid(), bid = blockIdx.x;
    volatile LAS unsigned* xst = (volatile LAS unsigned*)(lds + 131072);
    if (threadIdx.x < 4) xst[threadIdx.x] = 0u;
    __syncthreads();
    (void)xcd_barrier_post((unsigned*)(P.ws + WS_CTL), xst);

    phase_prologue(P, lds);
    grid.sync();
    XBAR();

    for (int pr = 0; pr < 3; ++pr) {
        const int ngr = pr < 2 ? 2 : 1, g0 = 2 * pr, seqlen = pr < 2 ? 4096 : 16384, MM = ngr * MG;
        for (int gi = 0; gi < ngr; ++gi) { const int grp = g0 + gi;
            const float* xin = grp < 4 ? P.x_prompt + (size_t)grp * MG * D : P.x_sample;
            phase_init(xin, WSP(bf16_t, WS_XB) + (size_t)gi * MG * D, WSP(float, WS_ROWSS1) + (size_t)gi * MG * 16, WSP(float, WS_ROWSS2)); }
        XBAR();
        for (int l = 0; l < DEPTH; ++l) {
            const size_t wl = WS_W + (size_t)l * W_LAYER;
            for (int gi = 0; gi < ngr; ++gi) {
                const size_t xoff = (size_t)gi * MG * D, roff = (size_t)gi * MG * 16;
                { pg8::Gemm g{WSP(bf16_t, WS_XB) + xoff, WSP(const bf16_t, wl + W_IN_OFF), MG, NPROJ, D};
                  pg8::P1Order S; S.init(G, bid, WSP(const bf16_t, wl + W_IN_OFF + (size_t)NPROJ * D * 2));
                  LAS float* rl = (LAS float*)(lds + LDS_RSTD_OFF); fill_rstd(rl, WSP(float, WS_ROWSS1) + roff, S, -1);
                  pg8::EpiP1 E{pg8::EpiRowScale{WSP(bf16_t, WS_PROJ), NPROJ, rl}, pg8::EpiColScale{WSP(bf16_t, WS_PROJT), MG, rl}}; pg8::gemm_phase(lds, g, S, E); }
                XBAR();
                { { const int tid = otid(), wv = __builtin_amdgcn_readfirstlane(tid >> 6), ln = tid & 63;
                    for (int it = bid * 8 + wv; it < 2048; it += G * 8) na_item(WSP(bf16_t, WS_PROJ), WSP(bf16_t, WS_PROJT), WSP(bf16_t, WS_A), P.na_rel_bias + (size_t)l * 8 * 465, it, seqlen, lds, wv, ln);
                    __syncthreads(); }
                  for (int it = bid; it < 512; it += G) { const int h = it & 3;
                      const float* tab = WSP(const float, WS_LG2) + (l * 4 + h) * 2; const float lgf2 = tab[0], lgb2 = tab[1];
                      r1_item(WSP(bf16_t, WS_PROJT), WSP(bf16_t, WS_STLOC), WSP(float, WS_COST), WSP(float, WS_SINT), lgf2, lgb2, it, seqlen, lds); } }
                XBAR();
                phase_scan(WSP(bf16_t, WS_STLOC), WSP(bf16_t, WS_ST), P.dec_f + l * 4, P.dec_b + l * 4, seqlen);
                XBAR();
                for (int it = bid; it < 512; it += G) { const int h = it & 3;
                    const float* tab = WSP(const float, WS_LG2) + (l * 4 + h) * 2; const float lgf2 = tab[0], lgb2 = tab[1];
                    r3_item(WSP(bf16_t, WS_PROJ), WSP(bf16_t, WS_PROJT), WSP(bf16_t, WS_ST), WSP(bf16_t, WS_A), WSP(float, WS_COSN), WSP(float, WS_SINN), P.ret_norm_g + (size_t)l * 1024, lgf2, lgb2, it, seqlen, lds); }
                XBAR();
                { pg8::Gemm g{WSP(bf16_t, WS_A), WSP(const bf16_t, wl + W_A_OFF), MG, D, 1536}; pg8::StaticOrder S; S.init(MG, D, G, bid);
                  pg8::EpiMerge E{WSP(bf16_t, WS_PROJ) + 3072, WSP(bf16_t, WS_PROJ) + 4096, WSP(bf16_t, WS_MIXED2) + xoff}; pg8::gemm_phase(lds, g, S, E); }
                XBAR();
            }
            { pg8::Gemm g{WSP(bf16_t, WS_MIXED2), WSP(const bf16_t, wl + W_O_OFF), MM, D, D}; pg8::StaticOrder S; S.init(MM, D, G, bid);
              pg8::EpiResid E{WSP(bf16_t, WS_XB), WSP(float, WS_ROWSS2)}; pg8::gemm_phase(lds, g, S, E); }
            XBAR();
            { pg8::Gemm g{WSP(bf16_t, WS_XB), WSP(const bf16_t, wl + W_UP_OFF), MM, DFF2, D}; pg8::StaticOrder S; S.init(MM, DFF2, G, bid);
              LAS float* rl = (LAS float*)(lds + LDS_RSTD_OFF); fill_rstd(rl, WSP(float, WS_ROWSS2), S, 0);
              pg8::EpiRowScale E{WSP(bf16_t, WS_U), DFF2, rl}; pg8::gemm_phase(lds, g, S, E); }
            XBAR();
            phase_convact(WSP(bf16_t, WS_U), WSP(bf16_t, WS_ACT), P.conv_w + (size_t)l * 3 * DFF2, seqlen, MM);
            XBAR();
            { pg8::Gemm g{WSP(bf16_t, WS_ACT), WSP(const bf16_t, wl + W_D_OFF), MM, D, DFF}; pg8::StaticOrder S; S.init(MM, D, G, bid);
              pg8::EpiResid E{WSP(bf16_t, WS_XB), WSP(float, WS_ROWSS1)}; pg8::gemm_phase(lds, g, S, E); }
            XBAR();
        }
        for (int gi = 0; gi < ngr; ++gi) { const int grp = g0 + gi;
            phase_final(WSP(bf16_t, WS_XB) + (size_t)gi * MG * D, P.out + (size_t)grp * MG * D, WSP(float, WS_ROWSS1) + (size_t)gi * MG * 16, P.norm_final_g); }
        XBAR();
    }
}

extern "C" void kernel_launch(void* const* d_in, const int* in_sizes, int n_in, void* d_out, int out_size, void* d_ws, size_t ws_size, hipStream_t stream) {
    static int grid_blocks = 0;
    if (grid_blocks == 0) {
        if (n_in != 16 || ws_size < WS_END) { fprintf(stderr, "kernel_launch: unexpected n_in %d or ws_size %zu (< %zu)\n", n_in, ws_size, (size_t)WS_END); grid_blocks = -1; return; }
        int dev = 0, cus = 0, per_cu = 0;
        hipGetDevice(&dev);
        hipDeviceGetAttribute(&cus, hipDeviceAttributeMultiprocessorCount, dev);
        if (hipFuncSetAttribute((const void*)fwd_megakernel, hipFuncAttributeMaxDynamicSharedMemorySize, LDS_BYTES) != hipSuccess) { fprintf(stderr, "kernel_launch: hipFuncSetAttribute failed\n"); grid_blocks = -1; return; }
        hipOccupancyMaxActiveBlocksPerMultiprocessor(&per_cu, (const void*)fwd_megakernel, NTHREADS, LDS_BYTES);
        if (per_cu < 1) { fprintf(stderr, "kernel_launch: occupancy query says %d blocks per CU\n", per_cu); per_cu = 1; }
        (void)hipGetLastError();
        grid_blocks = cus;
    }
    if (grid_blocks < 0) return;
    if (hipMemsetAsync((char*)d_ws + WS_CTL, 0, 16384, stream) != hipSuccess) { fprintf(stderr, "kernel_launch: memset of barrier words failed\n"); return; }
    Params p{};
    p.x_prompt = (const float*)d_in[0]; p.x_sample = (const float*)d_in[1]; p.norm_mix_g = (const float*)d_in[2]; p.w_in = (const float*)d_in[3]; p.na_rel_bias = (const float*)d_in[4];
    p.dec_f = (const float*)d_in[5]; p.dec_b = (const float*)d_in[6]; p.ret_norm_g = (const float*)d_in[7]; p.w_ba = (const float*)d_in[8]; p.w_br = (const float*)d_in[9]; p.w_out = (const float*)d_in[10];
    p.norm_ffn_g = (const float*)d_in[11]; p.w_up = (const float*)d_in[12]; p.conv_w = (const float*)d_in[13]; p.w_down = (const float*)d_in[14]; p.norm_final_g = (const float*)d_in[15];
    p.out = (float*)d_out; p.ws = (unsigned char*)d_ws;
    void* args[] = {&p};
    hipError_t e = hipLaunchCooperativeKernel((const void*)fwd_megakernel, dim3(grid_blocks), dim3(NTHREADS), args, LDS_BYTES, stream);
    if (e != hipSuccess) fprintf(stderr, "kernel_launch: cooperative launch failed: %s (grid %d)\n", hipGetErrorString(e), grid_blocks);
}
```

```cpp
#include <hip/hip_runtime.h>
#include <hip/hip_cooperative_groups.h>
#include <cstdio>
namespace cg = cooperative_groups;

#define LAS __attribute__((address_space(3)))
typedef unsigned short bf16_t;
typedef short bf16x8 __attribute__((ext_vector_type(8)));
typedef short bf16x4 __attribute__((ext_vector_type(4)));
typedef float f32x4 __attribute__((ext_vector_type(4)));
typedef float f32x16 __attribute__((ext_vector_type(16)));
typedef unsigned u32x4 __attribute__((ext_vector_type(4)));
typedef unsigned u32x2 __attribute__((ext_vector_type(2)));

constexpr int D = 1024, MG = 16384, NPROJ = 5120, NPT = 2048, DFF = 2816, DFF2 = 5632, DEPTH = 4, NGROUPS = 5, DIN = 6656;
constexpr float EPS = 1e-6f;
constexpr int NTHREADS = 512;
constexpr int LDS_RSTD_OFF = 131072 + 1024;
constexpr int LDS_BYTES = 131072 + 1024 + 12288;

constexpr size_t WS_CTL = 0;
constexpr size_t WS_LG2 = 32768;
constexpr size_t WS_ROWSS1 = 262144;
constexpr size_t WS_ROWSS2 = WS_ROWSS1 + (size_t)2 * MG * 16 * 4;
constexpr size_t WS_COSN = WS_ROWSS2 + (size_t)2 * MG * 16 * 4;
constexpr size_t TAB_BYTES = (size_t)16384 * 64 * 4;
constexpr size_t WS_SINN = WS_COSN + TAB_BYTES;
constexpr size_t WS_COST = WS_SINN + TAB_BYTES;
constexpr size_t WS_SINT = WS_COST + TAB_BYTES;
constexpr size_t WS_W = WS_SINT + TAB_BYTES;
constexpr size_t W_IN_OFF = 0;
constexpr size_t W_A_OFF = W_IN_OFF + (size_t)7168 * 1024 * 2;
constexpr size_t W_R_OFF = W_A_OFF + (size_t)1024 * 512 * 2;
constexpr size_t W_O_OFF = W_R_OFF + (size_t)1024 * 1024 * 2;
constexpr size_t W_UP_OFF = W_O_OFF + (size_t)1024 * 1024 * 2;
constexpr size_t W_D_OFF = W_UP_OFF + (size_t)5632 * 1024 * 2;
constexpr size_t W_LAYER = W_D_OFF + (size_t)1024 * 2816 * 2;
constexpr size_t WS_XB = WS_W + W_LAYER * DEPTH;
constexpr size_t WS_S = WS_XB + (size_t)2 * MG * D * 2;
constexpr size_t WS_PROJ = WS_S;
constexpr size_t WS_PROJT = WS_PROJ + (size_t)MG * NPROJ * 2;
constexpr size_t WS_A = WS_PROJT + (size_t)NPT * MG * 2;
constexpr size_t WS_MIXED = WS_A + (size_t)MG * 1536 * 2;
constexpr size_t WS_STLOC = WS_MIXED + (size_t)MG * D * 2;
constexpr size_t WS_ST = WS_STLOC + (size_t)128 * 4 * 2 * 32768 * 2;
constexpr size_t WS_MIX_END = WS_ST + (size_t)128 * 4 * 2 * 32768 * 2;
constexpr size_t WS_U = WS_S;
constexpr size_t WS_ACT = WS_U + (size_t)2 * MG * DFF2 * 2;
constexpr size_t WS_FFN_END = WS_ACT + (size_t)2 * MG * DFF * 2;
constexpr size_t WS_MIXED2 = WS_MIX_END > WS_FFN_END ? WS_MIX_END : WS_FFN_END;
constexpr size_t WS_END = WS_MIXED2 + (size_t)2 * MG * D * 2;
static_assert(WS_END <= ((size_t)1 << 30), "workspace over 1 GiB");

struct Params {
    const float* x_prompt; const float* x_sample; const float* norm_mix_g; const float* w_in; const float* na_rel_bias;
    const float* dec_f; const float* dec_b; const float* ret_norm_g; const float* w_ba; const float* w_br; const float* w_out;
    const float* norm_ffn_g; const float* w_up; const float* conv_w; const float* w_down; const float* norm_final_g;
    float* out; unsigned char* ws;
};

typedef __bf16 bf16v2_t __attribute__((ext_vector_type(2)));
typedef float f32v2_t __attribute__((ext_vector_type(2)));
__device__ __forceinline__ unsigned cvt_pk_bf16(float lo, float hi) { const f32v2_t v = {lo, hi}; const bf16v2_t r = __builtin_convertvector(v, bf16v2_t); return __builtin_bit_cast(unsigned, r); }
__device__ __forceinline__ float bf_lo(unsigned w) { return __uint_as_float(w << 16); }
__device__ __forceinline__ float bf_hi(unsigned w) { return __uint_as_float(w & 0xffff0000u); }
__device__ __forceinline__ float bf2f(bf16_t b) { return __uint_as_float(((unsigned)b) << 16); }
__device__ __forceinline__ float sigmoidf_(float x) { return __builtin_amdgcn_rcpf(1.0f + __expf(-x)); }
__device__ __forceinline__ void unpack8(const u32x4 w, float* f) { f[0] = bf_lo(w.x); f[1] = bf_hi(w.x); f[2] = bf_lo(w.y); f[3] = bf_hi(w.y); f[4] = bf_lo(w.z); f[5] = bf_hi(w.z); f[6] = bf_lo(w.w); f[7] = bf_hi(w.w); }
__device__ __forceinline__ u32x4 pack8(const float* f) { u32x4 w; w.x = cvt_pk_bf16(f[0], f[1]); w.y = cvt_pk_bf16(f[2], f[3]); w.z = cvt_pk_bf16(f[4], f[5]); w.w = cvt_pk_bf16(f[6], f[7]); return w; }
__device__ __forceinline__ f32x16 mfma32(bf16x8 a, bf16x8 b, f32x16 c) { return __builtin_amdgcn_mfma_f32_32x32x16_bf16(a, b, c, 0, 0, 0); }
__device__ __forceinline__ int otid() { int t = threadIdx.x; asm volatile("" : "+v"(t)); return t; }
__device__ __forceinline__ int ogrid() { int g = gridDim.x; asm volatile("" : "+s"(g)); return g; }
__device__ __forceinline__ f32x16 zero16() { return (f32x16){0.f, 0.f, 0.f, 0.f, 0.f, 0.f, 0.f, 0.f, 0.f, 0.f, 0.f, 0.f, 0.f, 0.f, 0.f, 0.f}; }
__device__ __forceinline__ float sum16(const float* p) { const f32x4 a = *(const f32x4*)p, b = *(const f32x4*)(p + 4), c = *(const f32x4*)(p + 8), d = *(const f32x4*)(p + 12); const f32x4 t = (a + b) + (c + d); return (t[0] + t[1]) + (t[2] + t[3]); }
__device__ __forceinline__ float shx(float v, int m, int lane) { return __int_as_float(__builtin_amdgcn_ds_bpermute((lane ^ m) << 2, __float_as_int(v))); }
__device__ __forceinline__ float wave_sum(float v, int lane) { v += shx(v, 32, lane); v += shx(v, 16, lane); v += shx(v, 8, lane); v += shx(v, 4, lane); v += shx(v, 2, lane); v += shx(v, 1, lane); return v; }

namespace pg8 {
constexpr int BM = 256, BK = 64, HALF = 128, HTB = HALF * BK * 2, STAGE_BYTES = 8 * HTB, NXCD = 8, WGM = 8;
__host__ __device__ __forceinline__ int lds_byte(int r, int c) { const int st = (r >> 4) * 2 + (c >> 5), rr = r & 15, cc = c & 31, ob = rr * 64 + cc * 2; return st * 1024 + (ob ^ (((ob >> 9) & 1) << 5)); }
__host__ __device__ __forceinline__ void stage_rc(int b, int& R, int& C) { const int st = b / 1024, sb = b % 1024, swz = sb ^ (((sb >> 9) & 1) << 5); R = (st >> 1) * 16 + swz / 64; C = (st & 1) * 32 + (swz % 64) / 2; }
__host__ __device__ __forceinline__ int perm32(int rho) { const int n = rho >> 4, i = rho & 15; return 8 * (i >> 2) + 4 * n + (i & 3); }
struct Unit { int pm, pn, idx, kind; };
struct Gemm { const bf16_t* A; const bf16_t* Bt; int M, N, K; };
struct StaticOrder {
    int nM, nN, nwg, G, c;
    __host__ __device__ void init(int M, int N, int G_, int c_) { nM = M / BM; nN = N / BM; nwg = nM * nN; G = G_; c = c_; }
    __host__ __device__ bool next(int i, Unit& u) const { return at((long)i * G + c, u); }
    __host__ __device__ bool at(long L, Unit& u) const {
        if (L >= nwg) return false;
        u.kind = 0;
        int wgid = (int)L; { const int q = nwg / NXCD, r = nwg % NXCD, xcd = wgid % NXCD, off = wgid / NXCD; wgid = (xcd < r ? xcd * (q + 1) : r * (q + 1) + (xcd - r) * q) + off; }
        const int nig = WGM * nN, gid = wgid / nig, fm = gid * WGM, gsz = (nM - fm) < WGM ? (nM - fm) : WGM;
        u.pm = fm + ((wgid % nig) % gsz); u.pn = (wgid % nig) / gsz; return true;
    }
    __device__ __forceinline__ void a_ready(const Unit&) const {}
    __device__ __forceinline__ void done(const Unit&) const {}
    __device__ __forceinline__ const char* abase(const Gemm& g, const Unit& u, size_t tstep) const { return (const char*)g.A + (size_t)u.pm * tstep; }
    __device__ __forceinline__ const char* bbase(const Gemm& g, const Unit& u, size_t tstep) const { return (const char*)g.Bt + (size_t)u.pn * tstep; }
};
struct P1Order {
    StaticOrder s0, s1; int G, c; const bf16_t* wt2;
    __device__ void init(int G_, int c_, const bf16_t* wt2_) { s0.init(MG, NPROJ, G_, c_); s1.init(NPT, MG, G_, c_); G = G_; c = c_; wt2 = wt2_; }
    __device__ bool next(int i, Unit& u) const { const long L = (long)i * G + c; if (L < 1280) return s0.at(L, u); if (!s1.at(L - 1280, u)) return false; u.kind = 1; return true; }
    __device__ __forceinline__ void a_ready(const Unit&) const {}
    __device__ __forceinline__ void done(const Unit&) const {}
    __device__ __forceinline__ const char* abase(const Gemm& g, const Unit& u, size_t tstep) const { return (u.kind ? (const char*)wt2 : (const char*)g.A) + (size_t)u.pm * tstep; }
    __device__ __forceinline__ const char* bbase(const Gemm& g, const Unit& u, size_t tstep) const { return (u.kind ? (const char*)g.A : (const char*)g.Bt) + (size_t)u.pn * tstep; }
};

template <class Epi, class Sched>
__device__ __forceinline__ void gemm_phase(LAS unsigned char* lds, const Gemm g, const Sched& S, const Epi& E) {
    const int tid = otid(), wid = __builtin_amdgcn_readfirstlane(tid >> 6), lane = tid & 63, wr = wid >> 2, wc = wid & 3, fr = lane & 15, fq = lane >> 4;
    const int K = g.K, nt = K / BK;
    unsigned voffA[2], voffB[2];
#pragma unroll
    for (int i = 0; i < 2; ++i) { int R, C; stage_rc(tid * 16 + i * 8192, R, C); const int Rb = Epi::PERM ? ((R & ~31) + perm32(R & 31)) : R;
        voffA[i] = (unsigned)(R * K + C) * 2u; voffB[i] = (unsigned)(Rb * K + C) * 2u; }
    const size_t kstep = (size_t)(BK * 2);
    const size_t hstep = (size_t)HALF * K * 2;
    const size_t tstep = 2 * hstep;
    const unsigned ldsw = (unsigned)wid * 1024u;
    const int aoff = lds_byte(wr * 64 + fr, fq * 8), boff = lds_byte(wc * 32 + fr, fq * 8);
#define PG8_SA(b, h) (((b) * 2 + (h)) * HTB)
#define PG8_SB(b, h) ((4 + (b) * 2 + (h)) * HTB)
#define PG8_STAGE(bufoff, gbase, voff) do { _Pragma("unroll") for (int _i = 0; _i < 2; ++_i) \
        __builtin_amdgcn_global_load_lds((const unsigned*)((const char*)(gbase) + (voff)[_i]), (LAS unsigned*)(lds + (bufoff) + ldsw + _i * 8192), 16, 0, 0); } while (0)
#define PG8_LDA(dst, b, h) do { _Pragma("unroll") for (int m = 0; m < 4; ++m) _Pragma("unroll") for (int k = 0; k < 2; ++k) dst[m][k] = *(const LAS bf16x8*)(lds + PG8_SA(b, h) + aoff + m * 2048 + k * 1024); } while (0)
#define PG8_LDB(dst, b, h) do { _Pragma("unroll") for (int n = 0; n < 2; ++n) _Pragma("unroll") for (int k = 0; k < 2; ++k) dst[n][k] = *(const LAS bf16x8*)(lds + PG8_SB(b, h) + boff + n * 2048 + k * 1024); } while (0)
#define PG8_MMA(ai, bj, At, Bt) do { __builtin_amdgcn_s_setprio(1); _Pragma("unroll") for (int m = 0; m < 4; ++m) _Pragma("unroll") for (int n = 0; n < 2; ++n) _Pragma("unroll") for (int k = 0; k < 2; ++k) \
        acc[ai][bj][m][n] = __builtin_amdgcn_mfma_f32_16x16x32_bf16(Bt[n][k], At[m][k], acc[ai][bj][m][n], 0, 0, 0); __builtin_amdgcn_s_setprio(0); } while (0)
#define PG8_WAIT_V(n) asm volatile("s_waitcnt vmcnt(" #n ")" ::: "memory")
#define PG8_WAIT_L(n) asm volatile("s_waitcnt lgkmcnt(" #n ")" ::: "memory")
#define PG8_BAR __builtin_amdgcn_s_barrier()
#define PG8_SCHED __builtin_amdgcn_sched_barrier(0)
    Unit cur, nxt; int ui = 0;
    if (!S.next(0, cur)) return;
    cur.idx = 0;
    f32x4 acc[2][2][4][2];
#pragma unroll
    for (int a = 0; a < 2; ++a)
#pragma unroll
        for (int b = 0; b < 2; ++b)
#pragma unroll
            for (int m = 0; m < 4; ++m)
#pragma unroll
                for (int n = 0; n < 2; ++n) acc[a][b][m][n] = (f32x4){0.f, 0.f, 0.f, 0.f};
    bf16x8 At[4][2], B0[2][2], B1[2][2];
    const char* cA = S.abase(g, cur, tstep); const char* cB = S.bbase(g, cur, tstep);
    S.a_ready(cur);
    PG8_STAGE(PG8_SB(0, 0), cB, voffB); PG8_STAGE(PG8_SA(0, 0), cA, voffA); PG8_STAGE(PG8_SB(0, 1), cB + hstep, voffB); PG8_STAGE(PG8_SA(0, 1), cA + hstep, voffA);
    if (wr == 1) PG8_BAR;
    PG8_WAIT_V(4); PG8_BAR;
    PG8_STAGE(PG8_SB(1, 0), cB + kstep, voffB); PG8_STAGE(PG8_SA(1, 0), cA + kstep, voffA); PG8_STAGE(PG8_SB(1, 1), cB + hstep + kstep, voffB);
    PG8_WAIT_V(6); PG8_BAR;
    for (;;) {
        const bool has_next = S.next(ui + 1, nxt); nxt.idx = ui + 1;
        const char* nA = has_next ? S.abase(g, nxt, tstep) : cA; const char* nB = has_next ? S.bbase(g, nxt, tstep) : cB;
        for (int t = 0; t < nt; t += 2) {
            const bool last = (t == nt - 2);
            const char* a1 = cA + (size_t)(t + 1) * kstep;
            const char* a2 = last ? nA : cA + (size_t)(t + 2) * kstep; const char* b2 = last ? nB : cB + (size_t)(t + 2) * kstep;
            const char* a3 = a2 + kstep; const char* b3 = b2 + kstep;
            if (last && has_next) S.a_ready(nxt);
            if constexpr (Epi::MID > 0) { if (t == Epi::MID) E.mid(acc, cur, wr, wc, fr, fq); }
            PG8_LDB(B0, 0, 0); PG8_SCHED; PG8_LDA(At, 0, 0); PG8_STAGE(PG8_SA(1, 1), a1 + hstep, voffA);
            PG8_WAIT_L(8); PG8_BAR; PG8_WAIT_L(0); PG8_MMA(0, 0, At, B0); PG8_BAR; PG8_SCHED;
            PG8_LDB(B1, 0, 1); PG8_STAGE(PG8_SB(0, 0), b2, voffB);
            PG8_BAR; PG8_WAIT_L(0); PG8_MMA(0, 1, At, B1); PG8_BAR;
            PG8_LDA(At, 0, 1); PG8_STAGE(PG8_SA(0, 0), a2, voffA);
            PG8_BAR; PG8_WAIT_L(0); PG8_MMA(1, 0, At, B0); PG8_BAR; PG8_SCHED;
            PG8_STAGE(PG8_SB(0, 1), b2 + hstep, voffB);
            PG8_WAIT_V(6); PG8_BAR; PG8_MMA(1, 1, At, B1); PG8_BAR;
            PG8_LDB(B0, 1, 0); PG8_SCHED; PG8_LDA(At, 1, 0); PG8_STAGE(PG8_SA(0, 1), a2 + hstep, voffA);
            PG8_WAIT_L(8); PG8_BAR; PG8_WAIT_L(0); PG8_MMA(0, 0, At, B0); PG8_BAR; PG8_SCHED;
            PG8_LDB(B1, 1, 1); PG8_STAGE(PG8_SB(1, 0), b3, voffB);
            PG8_BAR; PG8_WAIT_L(0); PG8_MMA(0, 1, At, B1); PG8_BAR;
            PG8_LDA(At, 1, 1); PG8_STAGE(PG8_SA(1, 0), a3, voffA);
            PG8_BAR; PG8_WAIT_L(0); PG8_MMA(1, 0, At, B0); PG8_BAR; PG8_SCHED;
            PG8_STAGE(PG8_SB(1, 1), b3 + hstep, voffB);
            PG8_WAIT_V(6); PG8_BAR; PG8_MMA(1, 1, At, B1); PG8_BAR;
        }
        E(acc, cur, wr, wc, fr, fq); S.done(cur);
        if (!has_next) break;
#pragma unroll
        for (int a = 0; a < 2; ++a)
#pragma unroll
            for (int b = 0; b < 2; ++b)
#pragma unroll
                for (int m = 0; m < 4; ++m)
#pragma unroll
                    for (int n = 0; n < 2; ++n) acc[a][b][m][n] = (f32x4){0.f, 0.f, 0.f, 0.f};
        cur = nxt; cA = nA; cB = nB; ++ui;
    }
    PG8_WAIT_V(0);
    if (wr == 0) PG8_BAR;
    PG8_BAR;
#undef PG8_SA
#undef PG8_SB
#undef PG8_STAGE
#undef PG8_LDA
#undef PG8_LDB
#undef PG8_MMA
#undef PG8_WAIT_V
#undef PG8_WAIT_L
#undef PG8_BAR
#undef PG8_SCHED
}

struct EpiRowScale {
    static constexpr bool PERM = true; static constexpr int MID = 0;
    bf16_t* O; int ldc; const LAS float* rl;
    __device__ __forceinline__ void operator()(const f32x4 (&acc)[2][2][4][2], const Unit& u, int wr, int wc, int fr, int fq) const {
        const int row0 = u.pm * BM + wr * 64 + fr, col0 = u.pn * BM + wc * 32 + 8 * fq;
#pragma unroll
        for (int ai = 0; ai < 2; ++ai)
#pragma unroll
            for (int m = 0; m < 4; ++m) { const int row = row0 + ai * HALF + m * 16; const float rs = rl[u.idx * 256 + wr * 64 + fr + ai * HALF + m * 16];
                bf16_t* rowp = O + (size_t)row * ldc + col0;
#pragma unroll
                for (int bj = 0; bj < 2; ++bj) { const f32x4 v0 = acc[ai][bj][m][0] * rs, v1 = acc[ai][bj][m][1] * rs;
                    u32x4 w; w.x = cvt_pk_bf16(v0[0], v0[1]); w.y = cvt_pk_bf16(v0[2], v0[3]); w.z = cvt_pk_bf16(v1[0], v1[1]); w.w = cvt_pk_bf16(v1[2], v1[3]);
                    *(u32x4*)(rowp + bj * HALF) = w; } }
    }
};
struct EpiColScale {
    static constexpr bool PERM = true; static constexpr int MID = 0;
    bf16_t* O; int ldc; const LAS float* rl;
    __device__ __forceinline__ void operator()(const f32x4 (&acc)[2][2][4][2], const Unit& u, int wr, int wc, int fr, int fq) const {
        const int row0 = u.pm * BM + wr * 64 + fr, col0 = u.pn * BM + wc * 32 + 8 * fq;
        f32x4 sc[2][2];
#pragma unroll
        for (int bj = 0; bj < 2; ++bj)
#pragma unroll
            for (int n = 0; n < 2; ++n) sc[bj][n] = *(const LAS f32x4*)(rl + u.idx * 256 + wc * 32 + 8 * fq + bj * HALF + 4 * n);
#pragma unroll
        for (int ai = 0; ai < 2; ++ai)
#pragma unroll
            for (int m = 0; m < 4; ++m) { const int row = row0 + ai * HALF + m * 16; bf16_t* rowp = O + (size_t)row * ldc + col0;
#pragma unroll
                for (int bj = 0; bj < 2; ++bj) { const f32x4 v0 = acc[ai][bj][m][0] * sc[bj][0], v1 = acc[ai][bj][m][1] * sc[bj][1];
                    u32x4 w; w.x = cvt_pk_bf16(v0[0], v0[1]); w.y = cvt_pk_bf16(v0[2], v0[3]); w.z = cvt_pk_bf16(v1[0], v1[1]); w.w = cvt_pk_bf16(v1[2], v1[3]);
                    *(u32x4*)(rowp + bj * HALF) = w; } }
    }
};
struct EpiP1 {
    static constexpr bool PERM = true; static constexpr int MID = 0;
    EpiRowScale e0; EpiColScale e1;
    __device__ __forceinline__ void operator()(const f32x4 (&acc)[2][2][4][2], const Unit& u, int wr, int wc, int fr, int fq) const { if (u.kind == 0) e0(acc, u, wr, wc, fr, fq); else e1(acc, u, wr, wc, fr, fq); }
};
struct EpiGate {
    static constexpr bool PERM = true; static constexpr int MID = 0;
    const bf16_t* gate; const bf16_t* addsrc; bf16_t* O;
    __device__ __forceinline__ void operator()(const f32x4 (&acc)[2][2][4][2], const Unit& u, int wr, int wc, int fr, int fq) const {
        const int row0 = u.pm * BM + wr * 64 + fr, col0 = u.pn * BM + wc * 32 + 8 * fq;
#pragma unroll
        for (int ai = 0; ai < 2; ++ai)
#pragma unroll
            for (int m = 0; m < 4; ++m) { const int row = row0 + ai * HALF + m * 16;
#pragma unroll
                for (int bj = 0; bj < 2; ++bj) { const int col = col0 + bj * HALF;
                    float gf[8], r[8]; unpack8(*(const u32x4*)(gate + (size_t)row * NPROJ + col), gf);
                    const f32x4 v0 = acc[ai][bj][m][0], v1 = acc[ai][bj][m][1];
#pragma unroll
                    for (int j = 0; j < 4; ++j) { r[j] = v0[j] * sigmoidf_(gf[j]); r[4 + j] = v1[j] * sigmoidf_(gf[4 + j]); }
                    if (addsrc) { float af[8]; unpack8(*(const u32x4*)(addsrc + (size_t)row * D + col), af);
#pragma unroll
                        for (int j = 0; j < 8; ++j) r[j] += af[j]; }
                    *(u32x4*)(O + (size_t)row * D + col) = pack8(r); } }
    }
};
struct EpiMerge {
    static constexpr bool PERM = true; static constexpr int MID = 8;
    const bf16_t* ga; const bf16_t* gr; bf16_t* O;
    __device__ __forceinline__ void mid(f32x4 (&acc)[2][2][4][2], const Unit& u, int wr, int wc, int fr, int fq) const {
        const int row0 = u.pm * BM + wr * 64 + fr, col0 = u.pn * BM + wc * 32 + 8 * fq;
#pragma unroll
        for (int ai = 0; ai < 2; ++ai)
#pragma unroll
            for (int m = 0; m < 4; ++m) { int row = row0 + ai * HALF + m * 16; asm volatile("" : "+v"(row));
#pragma unroll
                for (int bj = 0; bj < 2; ++bj) { const size_t off = (size_t)row * NPROJ + col0 + bj * HALF;
                    float fa[8], fb[8]; unpack8(*(const u32x4*)(ga + off), fa); unpack8(*(const u32x4*)(gr + off), fb);
#pragma unroll
                    for (int j = 0; j < 8; ++j) { const float rt = (1.0f + __builtin_amdgcn_exp2f(fb[j] * -1.4426950408889634f)) * __builtin_amdgcn_rcpf(1.0f + __builtin_amdgcn_exp2f(fa[j] * -1.4426950408889634f));
                        if (j < 4) acc[ai][bj][m][0][j] *= rt; else acc[ai][bj][m][1][j - 4] *= rt; } }
                asm volatile("" ::: "memory"); }
    }
    __device__ __forceinline__ void operator()(const f32x4 (&acc)[2][2][4][2], const Unit& u, int wr, int wc, int fr, int fq) const {
        const int row0 = u.pm * BM + wr * 64 + fr, col0 = u.pn * BM + wc * 32 + 8 * fq;
#pragma unroll
        for (int ai = 0; ai < 2; ++ai)
#pragma unroll
            for (int m = 0; m < 4; ++m) { const int row = row0 + ai * HALF + m * 16;
#pragma unroll
                for (int bj = 0; bj < 2; ++bj) { const int col = col0 + bj * HALF;
                    float gf[8], r[8]; unpack8(*(const u32x4*)(gr + (size_t)row * NPROJ + col), gf);
                    const f32x4 v0 = acc[ai][bj][m][0], v1 = acc[ai][bj][m][1];
#pragma unroll
                    for (int j = 0; j < 4; ++j) { r[j] = v0[j] * sigmoidf_(gf[j]); r[4 + j] = v1[j] * sigmoidf_(gf[4 + j]); }
                    *(u32x4*)(O + (size_t)row * D + col) = pack8(r); } }
    }
};
struct EpiResid {
    static constexpr bool PERM = true; static constexpr int MID = 0;
    bf16_t* xb; float* rowss;
    __device__ __forceinline__ void operator()(const f32x4 (&acc)[2][2][4][2], const Unit& u, int wr, int wc, int fr, int fq) const {
        const int row0 = u.pm * BM + wr * 64 + fr, col0 = u.pn * BM + wc * 32 + 8 * fq;
#pragma unroll
        for (int ai = 0; ai < 2; ++ai)
#pragma unroll
            for (int m = 0; m < 4; ++m) { const int row = row0 + ai * HALF + m * 16; float ss = 0.f;
#pragma unroll
                for (int bj = 0; bj < 2; ++bj) { const size_t off = (size_t)row * D + col0 + bj * HALF;
                    float b[8], r[8]; unpack8(*(const u32x4*)(xb + off), b);
                    const f32x4 v0 = acc[ai][bj][m][0], v1 = acc[ai][bj][m][1];
#pragma unroll
                    for (int j = 0; j < 4; ++j) { b[j] += v0[j]; b[4 + j] += v1[j]; }
                    const u32x4 w = pack8(b);
                    *(u32x4*)(xb + off) = w;
                    unpack8(w, r);
#pragma unroll
                    for (int j = 0; j < 8; ++j) ss += r[j] * r[j]; }
                { const int ln = fr + 16 * fq; ss += shx(ss, 16, ln); ss += shx(ss, 32, ln); }
                if (fq == 0) rowss[(size_t)row * 16 + u.pn * 4 + wc] = ss; }
    }
};
}

template <class Sched> __device__ __forceinline__ void fill_rstd(LAS float* rl, const float* rowss, const Sched& S, int by_col  ) {
    const int tid = otid();
    for (int e = tid; e < 12 * 256; e += NTHREADS) { pg8::Unit u; const int i = e >> 8;
        if (S.next(i, u)) { const bool bc = by_col < 0 ? (u.kind != 0) : (by_col != 0); const int r = (bc ? u.pn : u.pm) * 256 + (e & 255); rl[e] = rsqrtf(sum16(rowss + (size_t)r * 16) * (1.0f / 1024.0f) + EPS); } }
    __syncthreads();
}

__device__ __forceinline__ int win_srccol(int nd) {
    if (nd < 1024) return nd;
    if (nd < 1536) return 1536 + (nd - 1024);
    if (nd < 2048) return 2048 + (nd - 1536);
    if (nd < 3072) return 3584 + (nd - 2048);
    if (nd < 4096) return 4608 + (nd - 3072);
    if (nd < 5120) return 5632 + (nd - 4096);
    nd -= 5120;
    if (nd < 512) return 1024 + nd;
    if (nd < 1024) return 2048 + (nd - 512);
    return 2560 + (nd - 1024);
}
struct TileJob { const float* src; const float* gsc; bf16_t* dst; int ld_src, k0, nsrc0, ldd, ndst0, kdst0; };
__device__ __forceinline__ TileJob tile_job(const Params& P, int job) {
    constexpr int T_IN = 16 * 112, T_A = 8 * 16, T_R = 16 * 16, T_O = 16 * 16, T_UP = 16 * 88, T_D = 44 * 16, T_L = T_IN + T_A + T_R + T_O + T_UP + T_D;
    const int l = job / T_L; int r = job % T_L;
    unsigned char* wl = P.ws + WS_W + (size_t)l * W_LAYER;
    TileJob j;
    if (r < T_IN) { const int kt = r / 112, nt = r % 112; j = TileJob{P.w_in + (size_t)l * D * DIN, P.norm_mix_g + l * D, (bf16_t*)(wl + W_IN_OFF), DIN, kt * 64, win_srccol(nt * 64), 1024, nt * 64, 0}; return j; }
    r -= T_IN;
    if (r < T_A) { const int kt = r / 16, nt = r % 16; j = TileJob{P.w_ba + (size_t)l * 512 * D, nullptr, (bf16_t*)(wl + W_A_OFF), D, kt * 64, nt * 64, 1536, nt * 64, 0}; return j; }
    r -= T_A;
    if (r < T_R) { const int kt = r / 16, nt = r % 16; j = TileJob{P.w_br + (size_t)l * D * D, nullptr, (bf16_t*)(wl + W_A_OFF), D, kt * 64, nt * 64, 1536, nt * 64, 512}; return j; }
    r -= T_R;
    if (r < T_O) { const int kt = r / 16, nt = r % 16; j = TileJob{P.w_out + (size_t)l * D * D, nullptr, (bf16_t*)(wl + W_O_OFF), D, kt * 64, nt * 64, 1024, nt * 64, 0}; return j; }
    r -= T_O;
    if (r < T_UP) { const int kt = r / 88, nt = r % 88; j = TileJob{P.w_up + (size_t)l * D * DFF2, P.norm_ffn_g + l * D, (bf16_t*)(wl + W_UP_OFF), DFF2, kt * 64, nt * 64, 1024, nt * 64, 0}; return j; }
    r -= T_UP;
    { const int kt = r / 16, nt = r % 16; j = TileJob{P.w_down + (size_t)l * DFF * D, nullptr, (bf16_t*)(wl + W_D_OFF), D, kt * 64, nt * 64, DFF, nt * 64, 0}; return j; }
}
struct TileRegs { float4 v[2]; float s[2]; };
__device__ __forceinline__ void tile_load(TileRegs& tr, const TileJob& j, int t) {
#pragma unroll
    for (int i = 0; i < 2; ++i) { const int r = (t >> 4) + 32 * i, c = (t & 15) * 4;
        tr.v[i] = *(const float4*)(j.src + (size_t)(j.k0 + r) * j.ld_src + j.nsrc0 + c);
        tr.s[i] = j.gsc ? j.gsc[j.k0 + r] : 1.0f; }
}
__device__ __forceinline__ void tile_store(const TileRegs& tr, const TileJob& j, int t, LAS float* tile) {
#pragma unroll
    for (int i = 0; i < 2; ++i) { const int r = (t >> 4) + 32 * i, c = (t & 15) * 4; const float sc = tr.s[i];
        tile[r * 65 + c] = tr.v[i].x * sc; tile[r * 65 + c + 1] = tr.v[i].y * sc; tile[r * 65 + c + 2] = tr.v[i].z * sc; tile[r * 65 + c + 3] = tr.v[i].w * sc; }
    __syncthreads();
    { const int n = t >> 3, k8 = (t & 7) * 8; float f[8];
#pragma unroll
      for (int jj = 0; jj < 8; ++jj) f[jj] = tile[(k8 + jj) * 65 + n];
      *(u32x4*)(j.dst + (size_t)(j.ndst0 + n) * j.ldd + j.kdst0 + j.k0 + k8) = pack8(f); }
    __syncthreads();
}
__device__ __forceinline__ void phase_prologue(const Params& P, LAS unsigned char* lds) {
    LAS float* tile = (LAS float*)lds;
    constexpr int NJOBS = (16 * 112 + 8 * 16 + 16 * 16 + 16 * 16 + 16 * 88 + 44 * 16) * DEPTH;
    { const int t = otid(), G = ogrid();
      int job = blockIdx.x;
      if (job < NJOBS) { TileJob jc = tile_job(P, job); TileRegs rc; tile_load(rc, jc, t);
          while (true) { const int jn = job + G; const bool more = jn < NJOBS;
              TileJob jx = jc; TileRegs rx = rc; if (more) { jx = tile_job(P, jn); tile_load(rx, jx, t); }
              tile_store(rc, jc, t, tile);
              if (!more) break; jc = jx; rc = rx; job = jn; } } }
    if (blockIdx.x == 0 && otid() < DEPTH * 4) { const int i = otid(); float* tab = (float*)(P.ws + WS_LG2);
        tab[2 * i] = -log1pf(expf(-P.dec_f[i])) * 1.4426950408889634f; tab[2 * i + 1] = -log1pf(expf(-P.dec_b[i])) * 1.4426950408889634f; }
    float* cosN = (float*)(P.ws + WS_COSN); float* sinN = (float*)(P.ws + WS_SINN); float* cosT = (float*)(P.ws + WS_COST); float* sinT = (float*)(P.ws + WS_SINT);
    for (int idx = blockIdx.x * NTHREADS + otid(); idx < 16384 * 64; idx += ogrid() * NTHREADS) {
        const int pos = idx >> 6, i = idx & 63;
        const float invf = powf(10000.0f, -(float)i / 64.0f);
        const float ang = (float)pos * invf;
        const float c = cosf(ang), s = sinf(ang);
        cosN[idx] = c; sinN[idx] = s; cosT[(size_t)i * 16384 + pos] = c; sinT[(size_t)i * 16384 + pos] = s;
    }
}

__device__ __forceinline__ void phase_init(const float* __restrict__ xin, bf16_t* xb, float* rowss1, float* rowss2) {
    const int tid = otid(), lane = tid & 63, nw = ogrid() * 8;
    for (int row = blockIdx.x * 8 + (tid >> 6); row < MG; row += nw) {
        const float4* p = (const float4*)(xin + (size_t)row * D); float ss = 0.f;
#pragma unroll
        for (int i = 0; i < 4; ++i) { const float4 v = p[lane + 64 * i];
            u32x2 w; w.x = cvt_pk_bf16(v.x, v.y); w.y = cvt_pk_bf16(v.z, v.w); *(u32x2*)(xb + (size_t)row * D + (lane + 64 * i) * 4) = w;
            const float a0 = bf_lo(w.x), a1 = bf_hi(w.x), a2 = bf_lo(w.y), a3 = bf_hi(w.y); ss += a0 * a0 + a1 * a1 + a2 * a2 + a3 * a3; }
        ss = wave_sum(ss, lane);
        if (lane < 16) rowss1[(size_t)row * 16 + lane] = lane == 0 ? ss : 0.f;
    }
}
__device__ __forceinline__ void phase_final(const bf16_t* __restrict__ xb, float* xo, const float* rowss1, const float* __restrict__ gfin) {
    const int tid = otid(), lane = tid & 63, nw = ogrid() * 8;
    for (int row = blockIdx.x * 8 + (tid >> 6); row < MG; row += nw) {
        const float rs = rsqrtf(sum16(rowss1 + (size_t)row * 16) * (1.0f / 1024.0f) + EPS);
#pragma unroll
        for (int i = 0; i < 2; ++i) { const int c8 = (lane + 64 * i) * 8; float x[8]; unpack8(*(const u32x4*)(xb + (size_t)row * D + c8), x);
            const f32x4 g0 = *(const f32x4*)(gfin + c8), g1 = *(const f32x4*)(gfin + c8 + 4);
            *(f32x4*)(xo + (size_t)row * D + c8) = (f32x4){x[0] * rs * g0[0], x[1] * rs * g0[1], x[2] * rs * g0[2], x[3] * rs * g0[3]};
            *(f32x4*)(xo + (size_t)row * D + c8 + 4) = (f32x4){x[4] * rs * g1[0], x[5] * rs * g1[1], x[6] * rs * g1[2], x[7] * rs * g1[3]}; }
    }
}
__device__ __forceinline__ float gelu_tanh(float x) { const float t = fmaf(x * x, -0.10294324f, -2.30220819f);
    return x * __builtin_amdgcn_rcpf(1.0f + __builtin_amdgcn_exp2f(x * t)); }
__device__ __forceinline__ void phase_convact(const bf16_t* __restrict__ u, bf16_t* act, const float* __restrict__ cw  , int seqlen, int nrows) {
    const int gt = blockIdx.x * NTHREADS + otid(), nth = ogrid() * NTHREADS;
    int nr = nrows; asm volatile("" : "+s"(nr));
    const int ntask = (nr >> 3) * 352;
    for (int id = gt; id < ntask; id += nth) {
        const int tb = id / 352, c = (id % 352) * 8, t0 = tb * 8;
        const u32x4 z = (u32x4){0u, 0u, 0u, 0u};
        u32x4 g[10], v[10];
        const bool has_prev = (t0 & (seqlen - 1)) != 0, has_next = ((t0 + 8) & (seqlen - 1)) != 0;
#pragma unroll
        for (int r = 0; r < 10; ++r) { const bool ok = (r == 0) ? has_prev : ((r == 9) ? has_next : true);
            g[r] = z; v[r] = z;
            if (ok) { g[r] = *(const u32x4*)(u + (size_t)(t0 - 1 + r) * DFF2 + c); v[r] = *(const u32x4*)(u + (size_t)(t0 - 1 + r) * DFF2 + DFF + c); } }
        float wg[3][8], wv[3][8];
#pragma unroll
        for (int k = 0; k < 3; ++k) {
            const f32x4 a0 = *(const f32x4*)(cw + k * DFF2 + c), a1 = *(const f32x4*)(cw + k * DFF2 + c + 4);
            const f32x4 b0 = *(const f32x4*)(cw + k * DFF2 + DFF + c), b1 = *(const f32x4*)(cw + k * DFF2 + DFF + c + 4);
#pragma unroll
            for (int j = 0; j < 4; ++j) { wg[k][j] = a0[j]; wg[k][4 + j] = a1[j]; wv[k][j] = b0[j]; wv[k][4 + j] = b1[j]; } }
#pragma unroll
        for (int i = 0; i < 8; ++i) {
            float a[8], b[8], cc[8], r[8], gg[8], vv[8];
            unpack8(g[i], a); unpack8(g[i + 1], b); unpack8(g[i + 2], cc);
#pragma unroll
            for (int j = 0; j < 8; ++j) gg[j] = a[j] * wg[0][j] + b[j] * wg[1][j] + cc[j] * wg[2][j];
            unpack8(v[i], a); unpack8(v[i + 1], b); unpack8(v[i + 2], cc);
#pragma unroll
            for (int j = 0; j < 8; ++j) vv[j] = a[j] * wv[0][j] + b[j] * wv[1][j] + cc[j] * wv[2][j];
#pragma unroll
            for (int j = 0; j < 8; ++j) r[j] = gelu_tanh(gg[j]) * vv[j];
            *(u32x4*)(act + (size_t)(t0 + i) * DFF + c) = pack8(r);
        }
    }
}

constexpr int NA_LDS_WAVE = 12288;
struct NaFrags { bf16x8 k[4]; u32x2 v[2][2][2]; };
__device__ __forceinline__ void na_load(NaFrags& f, const bf16_t* __restrict__ proj, const bf16_t* __restrict__ projT, int ktok, int h, int c, int hh) {
    const bf16_t* kp = proj + (size_t)(ktok + c) * NPROJ + 512 + h * 64 + 8 * hh;
#pragma unroll
    for (int s = 0; s < 4; ++s) f.k[s] = *(const bf16x8*)(kp + 16 * s);
#pragma unroll
    for (int dt = 0; dt < 2; ++dt)
#pragma unroll
        for (int s2 = 0; s2 < 2; ++s2) { const bf16_t* vp = projT + (size_t)(h * 64 + dt * 32 + c) * MG + (ktok + 16 * s2 + 4 * hh);
            f.v[dt][s2][0] = *(const u32x2*)vp; f.v[dt][s2][1] = *(const u32x2*)(vp + 8); }
}
__device__ __forceinline__ void na_item(const bf16_t* __restrict__ proj, const bf16_t* __restrict__ projT, bf16_t* aout, const float* __restrict__ relb  , int item, int seqlen, LAS unsigned char* lds, int w, int lane) {
    const int c = lane & 31, hh = lane >> 5;
    const int R = item >> 3, h = item & 7;
    const int rps = seqlen >> 6, seq = R / rps, r = R % rps;
    int rs = r - 4; rs = rs < 0 ? 0 : rs; rs = rs > rps - 8 ? rps - 8 : rs;
    const int qtok0 = seq * seqlen + r * 64, ktok0 = seq * seqlen + rs * 64;
    LAS float* bias = (LAS float*)(lds + w * NA_LDS_WAVE) + 64;
    LAS bf16_t* Otile = (LAS bf16_t*)(lds + w * NA_LDS_WAVE + 3072);
    for (int i = lane; i < 768; i += 64) { const int j = i - 64; bias[j] = (j >= 0 && j < 465) ? relb[h * 465 + j] * 1.4426950408889634f : 0.f; }
    bf16x8 qf[2][4];
#pragma unroll
    for (int qh = 0; qh < 2; ++qh) { const bf16_t* qp = proj + (size_t)(qtok0 + 32 * qh + c) * NPROJ + h * 64 + 8 * hh;
#pragma unroll
        for (int s = 0; s < 4; ++s) qf[qh][s] = *(const bf16x8*)(qp + 16 * s); }
    f32x16 O[2][2];
    float mrun[2], lrun[2]; int cs[2];
#pragma unroll
    for (int qh = 0; qh < 2; ++qh) { O[qh][0] = zero16(); O[qh][1] = zero16(); mrun[qh] = -1e30f; lrun[qh] = 0.f;
        int x = 32 * qh + c - 8; x = x < 0 ? 0 : x; x = x > 48 ? 48 : x; cs[qh] = x; }
    NaFrags cur, nxt;
    na_load(cur, proj, projT, ktok0, h, c, hh);
#pragma unroll 1
    for (int t = 0; t < 16; ++t) {
        if (t + 1 < 16) na_load(nxt, proj, projT, ktok0 + 32 * (t + 1), h, c, hh);
        const int kr = rs + (t >> 1), chalf = t & 1, brow = (kr - r + 7) * 31;
#pragma unroll
        for (int qh = 0; qh < 2; ++qh) {
            f32x16 x = zero16();
#pragma unroll
            for (int s = 0; s < 4; ++s) x = mfma32(cur.k[s], qf[qh][s], x);
            const int qc = 32 * qh + c; float mt = -1e30f;
#pragma unroll
            for (int rg = 0; rg < 16; ++rg) { const int kc = 32 * chalf + (rg & 3) + 8 * (rg >> 2) + 4 * hh;
                const bool valid = (kc >= cs[qh]) && (kc < cs[qh] + 16);
                const float sv = fmaf(x[rg], 0.18033688011112042f, bias[brow + kc - qc + 15]) + (valid ? 0.f : -__builtin_inff());
                x[rg] = sv; mt = fmaxf(mt, sv); }
            mt = fmaxf(mt, shx(mt, 32, lane));
            const float mnew = fmaxf(mrun[qh], mt), alpha = __builtin_amdgcn_exp2f(mrun[qh] - mnew);
            const bool grew = mnew > mrun[qh];
            mrun[qh] = mnew;
            float ps = 0.f;
#pragma unroll
            for (int rg = 0; rg < 16; ++rg) { const float p = __builtin_amdgcn_exp2f(x[rg] - mnew); x[rg] = p; ps += p; }
            lrun[qh] = lrun[qh] * alpha + ps;
            if (__builtin_amdgcn_ballot_w64(grew) != 0ull) { O[qh][0] *= alpha; O[qh][1] *= alpha; }
#pragma unroll
            for (int s2 = 0; s2 < 2; ++s2) {
                u32x4 pw; pw.x = cvt_pk_bf16(x[8 * s2 + 0], x[8 * s2 + 1]); pw.y = cvt_pk_bf16(x[8 * s2 + 2], x[8 * s2 + 3]); pw.z = cvt_pk_bf16(x[8 * s2 + 4], x[8 * s2 + 5]); pw.w = cvt_pk_bf16(x[8 * s2 + 6], x[8 * s2 + 7]);
                const bf16x8 pb = __builtin_bit_cast(bf16x8, pw);
#pragma unroll
                for (int dt = 0; dt < 2; ++dt) { u32x4 aw; aw.x = cur.v[dt][s2][0].x; aw.y = cur.v[dt][s2][0].y; aw.z = cur.v[dt][s2][1].x; aw.w = cur.v[dt][s2][1].y;
                    O[qh][dt] = mfma32(__builtin_bit_cast(bf16x8, aw), pb, O[qh][dt]); } }
        }
        cur = nxt;
    }
#pragma unroll
    for (int qh = 0; qh < 2; ++qh) { const float inv = 1.0f / (lrun[qh] + shx(lrun[qh], 32, lane));
#pragma unroll
        for (int dt = 0; dt < 2; ++dt)
#pragma unroll
            for (int g4 = 0; g4 < 4; ++g4) { u32x2 pw; pw.x = cvt_pk_bf16(O[qh][dt][4 * g4] * inv, O[qh][dt][4 * g4 + 1] * inv); pw.y = cvt_pk_bf16(O[qh][dt][4 * g4 + 2] * inv, O[qh][dt][4 * g4 + 3] * inv);
                *(LAS u32x2*)(Otile + (32 * qh + c) * 72 + dt * 32 + 8 * g4 + 4 * hh) = pw; } }
#pragma unroll
    for (int i = 0; i < 8; ++i) { const int id = lane + 64 * i, q = id >> 3, d8 = (id & 7) * 8;
        *(u32x4*)(aout + (size_t)(qtok0 + q) * 1536 + h * 64 + d8) = *(const LAS u32x4*)(Otile + q * 72 + d8); }
}

constexpr int KT_STRIDE = 136;
__device__ __forceinline__ void r1_item(const bf16_t* __restrict__ projT, bf16_t* stloc, const float* __restrict__ cosT, const float* __restrict__ sinT, float lgf2, float lgb2, int item, int seqlen, LAS unsigned char* lds) {
    const int tid = otid(), w = __builtin_amdgcn_readfirstlane(tid >> 6), lane = tid & 63, c = lane & 31, hh = lane >> 5;
    const int ch = item >> 2, h = item & 3, tok0 = ch * 128, pos0 = tok0 % seqlen;
    LAS bf16_t* KTf = (LAS bf16_t*)lds; LAS bf16_t* KTb = (LAS bf16_t*)(lds + 128 * KT_STRIDE * 2);
    const float scale = 0.08838834764831845f;
    bf16x8 af[8];
    { const bf16_t* vp = projT + (size_t)(1024 + h * 256 + 32 * w + c) * MG + tok0 + 8 * hh;
#pragma unroll
      for (int s = 0; s < 8; ++s) af[s] = *(const bf16x8*)(vp + 16 * s); }
#pragma unroll
    for (int it = 0; it < 2; ++it) {
        const int id = tid + NTHREADS * it, d = id >> 4, t8 = id & 15;
        float k1[8], k2[8];
        unpack8(*(const u32x4*)(projT + (size_t)(512 + h * 128 + d) * MG + tok0 + 8 * t8), k1);
        unpack8(*(const u32x4*)(projT + (size_t)(512 + h * 128 + d + 64) * MG + tok0 + 8 * t8), k2);
        const f32x4 c0 = *(const f32x4*)(cosT + (size_t)d * 16384 + pos0 + 8 * t8), c1 = *(const f32x4*)(cosT + (size_t)d * 16384 + pos0 + 8 * t8 + 4);
        const f32x4 s0 = *(const f32x4*)(sinT + (size_t)d * 16384 + pos0 + 8 * t8), s1 = *(const f32x4*)(sinT + (size_t)d * 16384 + pos0 + 8 * t8 + 4);
        float f1[8], f2[8], b1[8], b2[8];
#pragma unroll
        for (int j = 0; j < 8; ++j) { const float cv = j < 4 ? c0[j & 3] : c1[j & 3], sv = j < 4 ? s0[j & 3] : s1[j & 3];
            const float r1 = (k1[j] * cv - k2[j] * sv) * scale, r2 = (k1[j] * sv + k2[j] * cv) * scale;
            const int tl = 8 * t8 + j; const float df = __builtin_amdgcn_exp2f((float)(127 - tl) * lgf2), db = __builtin_amdgcn_exp2f((float)tl * lgb2);
            f1[j] = r1 * df; f2[j] = r2 * df; b1[j] = r1 * db; b2[j] = r2 * db; }
        *(LAS u32x4*)(KTf + d * KT_STRIDE + 8 * t8) = pack8(f1); *(LAS u32x4*)(KTf + (d + 64) * KT_STRIDE + 8 * t8) = pack8(f2);
        *(LAS u32x4*)(KTb + d * KT_STRIDE + 8 * t8) = pack8(b1); *(LAS u32x4*)(KTb + (d + 64) * KT_STRIDE + 8 * t8) = pack8(b2);
    }
    __syncthreads();
#pragma unroll
    for (int dir = 0; dir < 2; ++dir) {
        LAS bf16_t* KT = dir ? KTb : KTf;
        bf16_t* dst = stloc + ((size_t)(ch * 4 + h) * 2 + dir) * 32768;
#pragma unroll
        for (int ct = 0; ct < 4; ++ct) {
            f32x16 acc = zero16();
#pragma unroll
            for (int s = 0; s < 8; ++s) { const bf16x8 bfr = *(const LAS bf16x8*)(KT + (32 * ct + c) * KT_STRIDE + 16 * s + 8 * hh); acc = mfma32(af[s], bfr, acc); }
#pragma unroll
            for (int rg = 0; rg < 16; ++rg) { const int dv = 32 * w + (rg & 3) + 8 * (rg >> 2) + 4 * hh; dst[dv * 128 + 32 * ct + c] = (bf16_t)(cvt_pk_bf16(acc[rg], 0.f) & 0xffffu); }
        }
    }
    __syncthreads();
}

__device__ __forceinline__ void phase_scan(const bf16_t* __restrict__ stloc, bf16_t* st, const float* __restrict__ decf, const float* __restrict__ decb, int seqlen) {
    const int gt = blockIdx.x * NTHREADS + otid(), nth = ogrid() * NTHREADS;
    constexpr size_t CSTR = (size_t)4 * 2 * 32768;
    if (seqlen == 4096) {
        constexpr int NCH = 32, NTASK = 4 * 4 * 2 * 4096;
        for (int id = gt; id < NTASK; id += nth) {
            const int e8 = id & 4095, dir = (id >> 12) & 1, h = (id >> 13) & 3, seq = id >> 15;
            const float x = dir ? decb[h] : decf[h]; const float cd = exp2f(-128.0f * log1pf(expf(-x)) * 1.4426950408889634f);
            const size_t base = ((size_t)(seq * NCH * 4 + h) * 2 + dir) * 32768 + (size_t)e8 * 8;
            float zz = 0.f; asm volatile("" : "+v"(zz));
            float S[8];
#pragma unroll
            for (int j = 0; j < 8; ++j) S[j] = zz;
            for (int i0 = 0; i0 < NCH; i0 += 8) {
                u32x4 loc[8];
#pragma unroll
                for (int j = 0; j < 8; ++j) { const int ci = dir ? (NCH - 1 - (i0 + j)) : (i0 + j); loc[j] = *(const u32x4*)(stloc + base + (size_t)ci * CSTR); }
#pragma unroll
                for (int j = 0; j < 8; ++j) { const int ci = dir ? (NCH - 1 - (i0 + j)) : (i0 + j);
                    *(u32x4*)(st + base + (size_t)ci * CSTR) = pack8(S);
                    float lf[8]; unpack8(loc[j], lf);
#pragma unroll
                    for (int k = 0; k < 8; ++k) S[k] = S[k] * cd + lf[k]; }
            }
        }
    } else {
        constexpr int NCH = 128, NTASK = 4 * 2 * 16384;
        for (int id = gt; id < NTASK; id += nth) {
            const int e2 = id & 16383, dir = (id >> 14) & 1, h = (id >> 15) & 3;
            const float x = dir ? decb[h] : decf[h]; const float cd = exp2f(-128.0f * log1pf(expf(-x)) * 1.4426950408889634f);
            const size_t base = ((size_t)h * 2 + dir) * 32768 + (size_t)e2 * 2;
            float zz = 0.f; asm volatile("" : "+v"(zz));
            float S0 = zz, S1 = zz;
            for (int i0 = 0; i0 < NCH; i0 += 8) {
                unsigned loc[8];
#pragma unroll
                for (int j = 0; j < 8; ++j) { const int ci = dir ? (NCH - 1 - (i0 + j)) : (i0 + j); loc[j] = *(const unsigned*)(stloc + base + (size_t)ci * CSTR); }
#pragma unroll
                for (int j = 0; j < 8; ++j) { const int ci = dir ? (NCH - 1 - (i0 + j)) : (i0 + j);
                    *(unsigned*)(st + base + (size_t)ci * CSTR) = cvt_pk_bf16(S0, S1);
                    S0 = S0 * cd + bf_lo(loc[j]); S1 = S1 * cd + bf_hi(loc[j]); }
            }
        }
    }
}

constexpr int OL_STRIDE = 264;
__device__ __forceinline__ void r3_item(const bf16_t* __restrict__ proj, const bf16_t* __restrict__ projT, const bf16_t* __restrict__ st, bf16_t* ro,
                        const float* __restrict__ cosN, const float* __restrict__ sinN, const float* __restrict__ gn  , float lgf2, float lgb2,
                        int item, int seqlen, LAS unsigned char* lds) {
    const int tid = otid(), w = __builtin_amdgcn_readfirstlane(tid >> 6), lane = tid & 63, c = lane & 31, hh = lane >> 5;
    const int ch = item >> 2, h = item & 3, tok0 = ch * 128, pos0 = tok0 % seqlen;
    LAS bf16_t* Ql = (LAS bf16_t*)lds; LAS bf16_t* Kl = (LAS bf16_t*)(lds + 34816); LAS bf16_t* Pl = (LAS bf16_t*)(lds + 69632);
    LAS float* stat = (LAS float*)(lds + 104448);
    LAS bf16_t* Ol = (LAS bf16_t*)lds;
    const float scale = 0.08838834764831845f;
    bf16x8 asb[8], asf[8], avt[8];
    const size_t stb0 = ((size_t)(ch * 4 + h) * 2) * 32768 + (size_t)(32 * w + c) * 128 + 8 * hh;
#pragma unroll
    for (int s = 0; s < 8; ++s) asb[s] = *(const bf16x8*)(st + stb0 + 32768 + 16 * s);
#pragma unroll
    for (int it = 0; it < 2; ++it) {
        const int id = tid + NTHREADS * it, t = id >> 3, d8 = (id & 7) * 8;
        const f32x4 c0 = *(const f32x4*)(cosN + (size_t)(pos0 + t) * 64 + d8), c1 = *(const f32x4*)(cosN + (size_t)(pos0 + t) * 64 + d8 + 4);
        const f32x4 s0 = *(const f32x4*)(sinN + (size_t)(pos0 + t) * 64 + d8), s1 = *(const f32x4*)(sinN + (size_t)(pos0 + t) * 64 + d8 + 4);
        float a[8], b[8], o1[8], o2[8];
        const bf16_t* qp = proj + (size_t)(tok0 + t) * NPROJ + 1024 + h * 128 + d8;
        unpack8(*(const u32x4*)qp, a); unpack8(*(const u32x4*)(qp + 64), b);
#pragma unroll
        for (int j = 0; j < 8; ++j) { const float cv = j < 4 ? c0[j & 3] : c1[j & 3], sv = j < 4 ? s0[j & 3] : s1[j & 3]; o1[j] = a[j] * cv - b[j] * sv; o2[j] = a[j] * sv + b[j] * cv; }
        *(LAS u32x4*)(Ql + t * KT_STRIDE + d8) = pack8(o1); *(LAS u32x4*)(Ql + t * KT_STRIDE + 64 + d8) = pack8(o2);
        const bf16_t* kp = proj + (size_t)(tok0 + t) * NPROJ + 1536 + h * 128 + d8;
        unpack8(*(const u32x4*)kp, a); unpack8(*(const u32x4*)(kp + 64), b);
#pragma unroll
        for (int j = 0; j < 8; ++j) { const float cv = j < 4 ? c0[j & 3] : c1[j & 3], sv = j < 4 ? s0[j & 3] : s1[j & 3]; o1[j] = (a[j] * cv - b[j] * sv) * scale; o2[j] = (a[j] * sv + b[j] * cv) * scale; }
        *(LAS u32x4*)(Kl + t * KT_STRIDE + d8) = pack8(o1); *(LAS u32x4*)(Kl + t * KT_STRIDE + 64 + d8) = pack8(o2);
    }
    __syncthreads();
    { const int kt = w >> 1;
#pragma unroll
      for (int q2 = 0; q2 < 2; ++q2) { const int tqt = 2 * (w & 1) + q2;
          f32x16 x = zero16();
#pragma unroll
          for (int s = 0; s < 8; ++s) { const bf16x8 kf = *(const LAS bf16x8*)(Kl + (32 * kt + c) * KT_STRIDE + 16 * s + 8 * hh);
              const bf16x8 qf = *(const LAS bf16x8*)(Ql + (32 * tqt + c) * KT_STRIDE + 16 * s + 8 * hh); x = mfma32(kf, qf, x); }
          const int n = 32 * tqt + c;
#pragma unroll
          for (int g4 = 0; g4 < 4; ++g4) { float pv[4];
#pragma unroll
              for (int j = 0; j < 4; ++j) { const int mk = 32 * kt + 8 * g4 + 4 * hh + j; const int diff = n - mk;
                  const float dec = __builtin_amdgcn_exp2f(diff >= 0 ? (float)diff * lgf2 : (float)(-diff) * lgb2); pv[j] = x[4 * g4 + j] * dec; }
              u32x2 pw; pw.x = cvt_pk_bf16(pv[0], pv[1]); pw.y = cvt_pk_bf16(pv[2], pv[3]);
              *(LAS u32x2*)(Pl + n * KT_STRIDE + 32 * kt + 8 * g4 + 4 * hh) = pw; } } }
    __syncthreads();
    f32x16 acc[4];
#pragma unroll
    for (int q = 0; q < 4; ++q) acc[q] = zero16();
    { const bf16_t* vp0 = projT + (size_t)(1024 + h * 256 + 32 * w + c) * MG + tok0 + 8 * hh;
#pragma unroll
      for (int s = 0; s < 8; ++s) { asf[s] = *(const bf16x8*)(st + stb0 + 16 * s); avt[s] = *(const bf16x8*)(vp0 + 16 * s); } }
#pragma unroll
    for (int s = 0; s < 8; ++s) { const bf16x8 a = asb[s];
#pragma unroll
        for (int q = 0; q < 4; ++q) { const bf16x8 b = *(const LAS bf16x8*)(Ql + (32 * q + c) * KT_STRIDE + 16 * s + 8 * hh); acc[q] = mfma32(a, b, acc[q]); } }
#pragma unroll
    for (int q = 0; q < 4; ++q) { const int n = 32 * q + c; const float f = __builtin_amdgcn_exp2f((float)(128 - n) * lgb2 - (float)(n + 1) * lgf2); acc[q] *= f; }
#pragma unroll
    for (int s = 0; s < 8; ++s) { const bf16x8 a = asf[s];
#pragma unroll
        for (int q = 0; q < 4; ++q) { const bf16x8 b = *(const LAS bf16x8*)(Ql + (32 * q + c) * KT_STRIDE + 16 * s + 8 * hh); acc[q] = mfma32(a, b, acc[q]); } }
#pragma unroll
    for (int q = 0; q < 4; ++q) { const int n = 32 * q + c; const float f = __builtin_amdgcn_exp2f((float)(n + 1) * lgf2); acc[q] *= f; }
#pragma unroll
    for (int s = 0; s < 8; ++s) { const bf16x8 a = avt[s];
#pragma unroll
        for (int q = 0; q < 4; ++q) { const bf16x8 b = *(const LAS bf16x8*)(Pl + (32 * q + c) * KT_STRIDE + 16 * s + 8 * hh); acc[q] = mfma32(a, b, acc[q]); } }
#pragma unroll
    for (int q = 0; q < 4; ++q) { float s1 = 0.f, s2 = 0.f;
#pragma unroll
        for (int i = 0; i < 16; ++i) { s1 += acc[q][i]; s2 += acc[q][i] * acc[q][i]; }
        s1 += shx(s1, 32, lane); s2 += shx(s2, 32, lane);
        if (hh == 0) { stat[(w * 128 + 32 * q + c) * 2] = s1; stat[(w * 128 + 32 * q + c) * 2 + 1] = s2; } }
    __syncthreads();
#pragma unroll
    for (int q = 0; q < 4; ++q) { float s1 = 0.f, s2 = 0.f; const int n = 32 * q + c;
#pragma unroll
        for (int k = 0; k < 8; ++k) { s1 += stat[(k * 128 + n) * 2]; s2 += stat[(k * 128 + n) * 2 + 1]; }
        const float mu = s1 * (1.0f / 256.0f); float var = s2 * (1.0f / 256.0f) - mu * mu; var = var < 0.f ? 0.f : var; const float rs = rsqrtf(var + EPS);
#pragma unroll
        for (int g4 = 0; g4 < 4; ++g4) { u32x2 pw; pw.x = cvt_pk_bf16((acc[q][4 * g4] - mu) * rs, (acc[q][4 * g4 + 1] - mu) * rs); pw.y = cvt_pk_bf16((acc[q][4 * g4 + 2] - mu) * rs, (acc[q][4 * g4 + 3] - mu) * rs);
            *(LAS u32x2*)(Ol + n * OL_STRIDE + 32 * w + 8 * g4 + 4 * hh) = pw; } }
    __syncthreads();
#pragma unroll
    for (int it = 0; it < 8; ++it) { const int id = tid + NTHREADS * it, tq = id >> 5, d8 = (id & 31) * 8;
        float y[8], rg[8], o[8]; unpack8(*(const LAS u32x4*)(Ol + tq * OL_STRIDE + d8), y);
        unpack8(*(const u32x4*)(proj + (size_t)(tok0 + tq) * NPROJ + 2048 + h * 256 + d8), rg);
        const f32x4 g0 = *(const f32x4*)(gn + h * 256 + d8), g1 = *(const f32x4*)(gn + h * 256 + d8 + 4);
#pragma unroll
        for (int j = 0; j < 8; ++j) { const float gv = j < 4 ? g0[j & 3] : g1[j & 3]; o[j] = rg[j] * sigmoidf_(rg[j]) * y[j] * gv; }
        *(u32x4*)(ro + (size_t)(tok0 + tq) * 1536 + 512 + h * 256 + d8) = pack8(o); }
    __syncthreads();
}


#define XB_TMO      128
#define XB_XCNT(j)  (256  + 64 * (j))
#define XB_XSUB(j)  (1280 + 64 * (j))
#define XB_XGEN(j)  (2304 + 64 * (j))
#define XB_TOP      3328
#define XB_TOPGEN   3392
#define XCD_BAR_WORDS 3456
#define XB_SPIN_CAP (1u << 22)
__device__ __forceinline__ unsigned xb_ld(unsigned* p)              { return __hip_atomic_load(p, __ATOMIC_RELAXED, __HIP_MEMORY_SCOPE_AGENT); }
__device__ __forceinline__ unsigned xb_add(unsigned* p, unsigned v) { return __hip_atomic_fetch_add(p, v, __ATOMIC_RELAXED, __HIP_MEMORY_SCOPE_AGENT); }
__device__ __forceinline__ unsigned xb_xcc_id() { return (unsigned)__builtin_amdgcn_s_getreg((3 << 11) | 20) & 0xFu; }
#define XB_SPIN(cond, bar) do { unsigned _sp = 0; while (cond) { __builtin_amdgcn_s_sleep(1); \
    if ((++_sp & 255u) == 0u) { if (xb_ld(&(bar)[XB_TMO])) break; if (_sp > XB_SPIN_CAP) { atomicAdd(&(bar)[XB_TMO], 1u); break; } } } } while (0)
struct XcdBarrier { unsigned* bar; unsigned x; volatile LAS unsigned* st; };
__device__ __forceinline__ XcdBarrier xcd_barrier_post(unsigned* bar, volatile LAS unsigned* st) {
    XcdBarrier b; b.bar = bar; b.x = xb_xcc_id(); b.st = st;
    if (threadIdx.x == 0) (void)xb_add(&bar[XB_XCNT(b.x)], 1u);
    return b;
}
__device__ __forceinline__ void xcd_barrier_complete(unsigned* bar, unsigned x, unsigned& nloc, unsigned& nx) {
    const unsigned G = gridDim.x * gridDim.y * gridDim.z;
    unsigned sum, cnt, mine, sp = 0u;
    for (;;) {
        sum = 0u; cnt = 0u; mine = 0u;
#pragma unroll
        for (unsigned j = 0; j < 16; ++j) { const unsigned c = xb_ld(&bar[XB_XCNT(j)]); sum += c; cnt += (c > 0u) ? 1u : 0u; mine = (j == x) ? c : mine; }
        if (sum == G) break;
        __builtin_amdgcn_s_sleep(1);
        if ((++sp & 255u) == 0u) { if (xb_ld(&bar[XB_TMO])) break; if (sp > XB_SPIN_CAP) { atomicAdd(&bar[XB_TMO], 1u); break; } }
    }
    nloc = mine > 0u ? mine : 1u; nx = cnt > 0u ? cnt : 1u;
}
__device__ __forceinline__ void xcd_barrier(const XcdBarrier& b) {
    asm volatile("s_waitcnt vmcnt(0)" ::: "memory");
    __syncthreads();
    if (threadIdx.x == 0) {
        unsigned* bar = b.bar;
        __builtin_amdgcn_s_waitcnt(0);
        unsigned nloc = b.st[0], nx = b.st[1];
        if (nloc == 0u) { xcd_barrier_complete(bar, b.x, nloc, nx); b.st[0] = nloc; b.st[1] = nx; }
        const unsigned old = xb_add(&bar[XB_XSUB(b.x)], 1u);
        const unsigned gen = old / nloc;
        if (old + 1u == (gen + 1u) * nloc) {
            __builtin_amdgcn_fence(__ATOMIC_RELEASE, "agent");
            asm volatile("s_waitcnt vmcnt(0)" ::: "memory");
            const unsigned og = xb_add(&bar[XB_TOP], 1u);
            const unsigned tg = og / nx;
            if (og + 1u == (tg + 1u) * nx) xb_add(&bar[XB_TOPGEN], 1u);
            else XB_SPIN(xb_ld(&bar[XB_TOPGEN]) == tg, bar);
            __builtin_amdgcn_fence(__ATOMIC_ACQUIRE, "agent");
            xb_add(&bar[XB_XGEN(b.x)], 1u);
            asm volatile("s_waitcnt vmcnt(0)" ::: "memory");
        } else {
            XB_SPIN(xb_ld(&bar[XB_XGEN(b.x)]) == gen, bar);
            __builtin_amdgcn_fence(__ATOMIC_ACQUIRE, "agent");
            asm volatile("s_waitcnt vmcnt(0)" ::: "memory");
        }
    }
    __syncthreads();
}

__device__ __forceinline__ size_t opz() { size_t z = 0; asm volatile("" : "+s"(z)); return z; }
#define WSP(T, off) ((T*)(P.ws + opz() + (off)))
#define XBAR() do { XcdBarrier _b; _b.bar = (unsigned*)(P.ws + opz() + WS_CTL); _b.x = (unsigned)__builtin_amdgcn_readfirstlane((int)xb_xcc_id()); _b.st = (volatile LAS unsigned*)(lds + 131072); xcd_barrier(_b); } while (0)
__global__ void __launch_bounds__(NTHREADS, 2) fwd_megakernel(Params P) {
    extern __shared__ __attribute__((aligned(16))) unsigned char lds_raw[];
    LAS unsigned char* lds = (LAS unsigned char*)lds_raw;
    cg::grid_group grid = cg::this_grid();
    const int G = ogrid(), bid = blockIdx.x;
    volatile LAS unsigned* xst = (volatile LAS unsigned*)(lds + 131072);
    if (threadIdx.x < 4) xst[threadIdx.x] = 0u;
    __syncthreads();
    (void)xcd_barrier_post((unsigned*)(P.ws + WS_CTL), xst);

    phase_prologue(P, lds);
    grid.sync();
    XBAR();

    for (int pr = 0; pr < 3; ++pr) {
        const int ngr = pr < 2 ? 2 : 1, g0 = 2 * pr, seqlen = pr < 2 ? 4096 : 16384, MM = ngr * MG;
        for (int gi = 0; gi < ngr; ++gi) { const int grp = g0 + gi;
            const float* xin = grp < 4 ? P.x_prompt + (size_t)grp * MG * D : P.x_sample;
            phase_init(xin, WSP(bf16_t, WS_XB) + (size_t)gi * MG * D, WSP(float, WS_ROWSS1) + (size_t)gi * MG * 16, WSP(float, WS_ROWSS2)); }
        XBAR();
        for (int l = 0; l < DEPTH; ++l) {
            const size_t wl = WS_W + (size_t)l * W_LAYER;
            for (int gi = 0; gi < ngr; ++gi) {
                const size_t xoff = (size_t)gi * MG * D, roff = (size_t)gi * MG * 16;
                { pg8::Gemm g{WSP(bf16_t, WS_XB) + xoff, WSP(const bf16_t, wl + W_IN_OFF), MG, NPROJ, D};
                  pg8::P1Order S; S.init(G, bid, WSP(const bf16_t, wl + W_IN_OFF + (size_t)NPROJ * D * 2));
                  LAS float* rl = (LAS float*)(lds + LDS_RSTD_OFF); fill_rstd(rl, WSP(float, WS_ROWSS1) + roff, S, -1);
                  pg8::EpiP1 E{pg8::EpiRowScale{WSP(bf16_t, WS_PROJ), NPROJ, rl}, pg8::EpiColScale{WSP(bf16_t, WS_PROJT), MG, rl}}; pg8::gemm_phase(lds, g, S, E); }
                XBAR();
                { { const int tid = otid(), wv = __builtin_amdgcn_readfirstlane(tid >> 6), ln = tid & 63;
                    for (int it = bid * 8 + wv; it < 2048; it += G * 8) na_item(WSP(bf16_t, WS_PROJ), WSP(bf16_t, WS_PROJT), WSP(bf16_t, WS_A), P.na_rel_bias + (size_t)l * 8 * 465, it, seqlen, lds, wv, ln);
                    __syncthreads(); }
                  for (int it = bid; it < 512; it += G) { const int h = it & 3;
                      const float* tab = WSP(const float, WS_LG2) + (l * 4 + h) * 2; const float lgf2 = tab[0], lgb2 = tab[1];
                      r1_item(WSP(bf16_t, WS_PROJT), WSP(bf16_t, WS_STLOC), WSP(float, WS_COST), WSP(float, WS_SINT), lgf2, lgb2, it, seqlen, lds); } }
                XBAR();
                phase_scan(WSP(bf16_t, WS_STLOC), WSP(bf16_t, WS_ST), P.dec_f + l * 4, P.dec_b + l * 4, seqlen);
                XBAR();
                for (int it = bid; it < 512; it += G) { const int h = it & 3;
                    const float* tab = WSP(const float, WS_LG2) + (l * 4 + h) * 2; const float lgf2 = tab[0], lgb2 = tab[1];
                    r3_item(WSP(bf16_t, WS_PROJ), WSP(bf16_t, WS_PROJT), WSP(bf16_t, WS_ST), WSP(bf16_t, WS_A), WSP(float, WS_COSN), WSP(float, WS_SINN), P.ret_norm_g + (size_t)l * 1024, lgf2, lgb2, it, seqlen, lds); }
                XBAR();
                { pg8::Gemm g{WSP(bf16_t, WS_A), WSP(const bf16_t, wl + W_A_OFF), MG, D, 1536}; pg8::StaticOrder S; S.init(MG, D, G, bid);
                  pg8::EpiMerge E{WSP(bf16_t, WS_PROJ) + 3072, WSP(bf16_t, WS_PROJ) + 4096, WSP(bf16_t, WS_MIXED2) + xoff}; pg8::gemm_phase(lds, g, S, E); }
                XBAR();
            }
            { pg8::Gemm g{WSP(bf16_t, WS_MIXED2), WSP(const bf16_t, wl + W_O_OFF), MM, D, D}; pg8::StaticOrder S; S.init(MM, D, G, bid);
              pg8::EpiResid E{WSP(bf16_t, WS_XB), WSP(float, WS_ROWSS2)}; pg8::gemm_phase(lds, g, S, E); }
            XBAR();
            { pg8::Gemm g{WSP(bf16_t, WS_XB), WSP(const bf16_t, wl + W_UP_OFF), MM, DFF2, D}; pg8::StaticOrder S; S.init(MM, DFF2, G, bid);
              LAS float* rl = (LAS float*)(lds + LDS_RSTD_OFF); fill_rstd(rl, WSP(float, WS_ROWSS2), S, 0);
              pg8::EpiRowScale E{WSP(bf16_t, WS_U), DFF2, rl}; pg8::gemm_phase(lds, g, S, E); }
            XBAR();
            phase_convact(WSP(bf16_t, WS_U), WSP(bf16_t, WS_ACT), P.conv_w + (size_t)l * 3 * DFF2, seqlen, MM);
            XBAR();
            { pg8::Gemm g{WSP(bf16_t, WS_ACT), WSP(const bf16_t, wl + W_D_OFF), MM, D, DFF}; pg8::StaticOrder S; S.init(MM, D, G, bid);
              pg8::EpiResid E{WSP(bf16_t, WS_XB), WSP(float, WS_ROWSS1)}; pg8::gemm_phase(lds, g, S, E); }
            XBAR();
        }
        for (int gi = 0; gi < ngr; ++gi) { const int grp = g0 + gi;
            phase_final(WSP(bf16_t, WS_XB) + (size_t)gi * MG * D, P.out + (size_t)grp * MG * D, WSP(float, WS_ROWSS1) + (size_t)gi * MG * 16, P.norm_final_g); }
        XBAR();
    }
}

extern "C" void kernel_launch(void* const* d_in, const int* in_sizes, int n_in, void* d_out, int out_size, void* d_ws, size_t ws_size, hipStream_t stream) {
    static int grid_blocks = 0;
    if (grid_blocks == 0) {
        if (n_in != 16 || ws_size < WS_END) { fprintf(stderr, "kernel_launch: unexpected n_in %d or ws_size %zu (< %zu)\n", n_in, ws_size, (size_t)WS_END); grid_blocks = -1; return; }
        int dev = 0, cus = 0, per_cu = 0;
        hipGetDevice(&dev);
        hipDeviceGetAttribute(&cus, hipDeviceAttributeMultiprocessorCount, dev);
        if (hipFuncSetAttribute((const void*)fwd_megakernel, hipFuncAttributeMaxDynamicSharedMemorySize, LDS_BYTES) != hipSuccess) { fprintf(stderr, "kernel_launch: hipFuncSetAttribute failed\n"); grid_blocks = -1; return; }
        hipOccupancyMaxActiveBlocksPerMultiprocessor(&per_cu, (const void*)fwd_megakernel, NTHREADS, LDS_BYTES);
        if (per_cu < 1) { fprintf(stderr, "kernel_launch: occupancy query says %d blocks per CU\n", per_cu); per_cu = 1; }
        (void)hipGetLastError();
        grid_blocks = cus;
    }
    if (grid_blocks < 0) return;
    if (hipMemsetAsync((char*)d_ws + WS_CTL, 0, 16384, stream) != hipSuccess) { fprintf(stderr, "kernel_launch: memset of barrier words failed\n"); return; }
    Params p{};
    p.x_prompt = (const float*)d_in[0]; p.x_sample = (const float*)d_in[1]; p.norm_mix_g = (const float*)d_in[2]; p.w_in = (const float*)d_in[3]; p.na_rel_bias = (const float*)d_in[4];
    p.dec_f = (const float*)d_in[5]; p.dec_b = (const float*)d_in[6]; p.ret_norm_g = (const float*)d_in[7]; p.w_ba = (const float*)d_in[8]; p.w_br = (const float*)d_in[9]; p.w_out = (const float*)d_in[10];
    p.norm_ffn_g = (const float*)d_in[11]; p.w_up = (const float*)d_in[12]; p.conv_w = (const float*)d_in[13]; p.w_down = (const float*)d_in[14]; p.norm_final_g = (const float*)d_in[15];
    p.out = (float*)d_out; p.ws = (unsigned char*)d_ws;
    void* args[] = {&p};
    hipError_t e = hipLaunchCooperativeKernel((const void*)fwd_megakernel, dim3(grid_blocks), dim3(NTHREADS), args, LDS_BYTES, stream);
    if (e != hipSuccess) fprintf(stderr, "kernel_launch: cooperative launch failed: %s (grid %d)\n", hipGetErrorString(e), grid_blocks);
}
```

```cpp
#include <hip/hip_runtime.h>
#include <hip/hip_cooperative_groups.h>
#include <cstdio>
namespace cg = cooperative_groups;

#define LAS __attribute__((address_space(3)))
typedef unsigned short bf16_t;
typedef short bf16x8 __attribute__((ext_vector_type(8)));
typedef short bf16x4 __attribute__((ext_vector_type(4)));
typedef float f32x4 __attribute__((ext_vector_type(4)));
typedef float f32x16 __attribute__((ext_vector_type(16)));
typedef unsigned u32x4 __attribute__((ext_vector_type(4)));
typedef unsigned u32x2 __attribute__((ext_vector_type(2)));

constexpr int D = 1024, MG = 16384, NPROJ = 5120, NPT = 2048, DFF = 2816, DFF2 = 5632, DEPTH = 4, NGROUPS = 5, DIN = 6656;
constexpr float EPS = 1e-6f;
constexpr int NTHREADS = 512;
constexpr int LDS_RSTD_OFF = 131072 + 1024;
constexpr int LDS_BYTES = 131072 + 1024 + 12288;

constexpr size_t WS_CTL = 0;
constexpr size_t WS_LG2 = 32768;
constexpr size_t WS_ROWSS1 = 262144;
constexpr size_t WS_ROWSS2 = WS_ROWSS1 + (size_t)2 * MG * 16 * 4;
constexpr size_t WS_COSN = WS_ROWSS2 + (size_t)2 * MG * 16 * 4;
constexpr size_t TAB_BYTES = (size_t)16384 * 64 * 4;
constexpr size_t WS_SINN = WS_COSN + TAB_BYTES;
constexpr size_t WS_COST = WS_SINN + TAB_BYTES;
constexpr size_t WS_SINT = WS_COST + TAB_BYTES;
constexpr size_t WS_W = WS_SINT + TAB_BYTES;
constexpr size_t W_IN_OFF = 0;
constexpr size_t W_A_OFF = W_IN_OFF + (size_t)7168 * 1024 * 2;
constexpr size_t W_R_OFF = W_A_OFF + (size_t)1024 * 512 * 2;
constexpr size_t W_O_OFF = W_R_OFF + (size_t)1024 * 1024 * 2;
constexpr size_t W_UP_OFF = W_O_OFF + (size_t)1024 * 1024 * 2;
constexpr size_t W_D_OFF = W_UP_OFF + (size_t)5632 * 1024 * 2;
constexpr size_t W_LAYER = W_D_OFF + (size_t)1024 * 2816 * 2;
constexpr size_t WS_XB = WS_W + W_LAYER * DEPTH;
constexpr size_t WS_S = WS_XB + (size_t)2 * MG * D * 2;
constexpr size_t WS_PROJ = WS_S;
constexpr size_t WS_PROJT = WS_PROJ + (size_t)MG * NPROJ * 2;
constexpr size_t WS_A = WS_PROJT + (size_t)NPT * MG * 2;
constexpr size_t WS_MIXED = WS_A + (size_t)MG * 1536 * 2;
constexpr size_t WS_STLOC = WS_MIXED + (size_t)MG * D * 2;
constexpr size_t WS_ST = WS_STLOC + (size_t)128 * 4 * 2 * 32768 * 2;
constexpr size_t WS_MIX_END = WS_ST + (size_t)128 * 4 * 2 * 32768 * 2;
constexpr size_t WS_U = WS_S;
constexpr size_t WS_ACT = WS_U + (size_t)2 * MG * DFF2 * 2;
constexpr size_t WS_FFN_END = WS_ACT + (size_t)2 * MG * DFF * 2;
constexpr size_t WS_MIXED2 = WS_MIX_END > WS_FFN_END ? WS_MIX_END : WS_FFN_END;
constexpr size_t WS_END = WS_MIXED2 + (size_t)2 * MG * D * 2;
static_assert(WS_END <= ((size_t)1 << 30), "workspace over 1 GiB");

struct Params {
    const float* x_prompt; const float* x_sample; const float* norm_mix_g; const float* w_in; const float* na_rel_bias;
    const float* dec_f; const float* dec_b; const float* ret_norm_g; const float* w_ba; const float* w_br; const float* w_out;
    const float* norm_ffn_g; const float* w_up; const float* conv_w; const float* w_down; const float* norm_final_g;
    float* out; unsigned char* ws;
};

typedef __bf16 bf16v2_t __attribute__((ext_vector_type(2)));
typedef float f32v2_t __attribute__((ext_vector_type(2)));
__device__ __forceinline__ unsigned cvt_pk_bf16(float lo, float hi) { const f32v2_t v = {lo, hi}; const bf16v2_t r = __builtin_convertvector(v, bf16v2_t); return __builtin_bit_cast(unsigned, r); }
__device__ __forceinline__ float bf_lo(unsigned w) { return __uint_as_float(w << 16); }
__device__ __forceinline__ float bf_hi(unsigned w) { return __uint_as_float(w & 0xffff0000u); }
__device__ __forceinline__ float bf2f(bf16_t b) { return __uint_as_float(((unsigned)b) << 16); }
__device__ __forceinline__ float sigmoidf_(float x) { return __builtin_amdgcn_rcpf(1.0f + __expf(-x)); }
__device__ __forceinline__ void unpack8(const u32x4 w, float* f) { f[0] = bf_lo(w.x); f[1] = bf_hi(w.x); f[2] = bf_lo(w.y); f[3] = bf_hi(w.y); f[4] = bf_lo(w.z); f[5] = bf_hi(w.z); f[6] = bf_lo(w.w); f[7] = bf_hi(w.w); }
__device__ __forceinline__ u32x4 pack8(const float* f) { u32x4 w; w.x = cvt_pk_bf16(f[0], f[1]); w.y = cvt_pk_bf16(f[2], f[3]); w.z = cvt_pk_bf16(f[4], f[5]); w.w = cvt_pk_bf16(f[6], f[7]); return w; }
__device__ __forceinline__ f32x16 mfma32(bf16x8 a, bf16x8 b, f32x16 c) { return __builtin_amdgcn_mfma_f32_32x32x16_bf16(a, b, c, 0, 0, 0); }
__device__ __forceinline__ int otid() { int t = threadIdx.x; asm volatile("" : "+v"(t)); return t; }
__device__ __forceinline__ int ogrid() { int g = gridDim.x; asm volatile("" : "+s"(g)); return g; }
__device__ __forceinline__ f32x16 zero16() { return (f32x16){0.f, 0.f, 0.f, 0.f, 0.f, 0.f, 0.f, 0.f, 0.f, 0.f, 0.f, 0.f, 0.f, 0.f, 0.f, 0.f}; }
__device__ __forceinline__ float sum16(const float* p) { const f32x4 a = *(const f32x4*)p, b = *(const f32x4*)(p + 4), c = *(const f32x4*)(p + 8), d = *(const f32x4*)(p + 12); const f32x4 t = (a + b) + (c + d); return (t[0] + t[1]) + (t[2] + t[3]); }
__device__ __forceinline__ float shx(float v, int m, int lane) { return __int_as_float(__builtin_amdgcn_ds_bpermute((lane ^ m) << 2, __float_as_int(v))); }
__device__ __forceinline__ float xhalf_max(float x) { const auto rr = __builtin_amdgcn_permlane32_swap(__float_as_uint(x), __float_as_uint(x), false, false); return fmaxf(__uint_as_float(rr[0]), __uint_as_float(rr[1])); }
__device__ __forceinline__ float xhalf_sum(float x) { const auto rr = __builtin_amdgcn_permlane32_swap(__float_as_uint(x), __float_as_uint(x), false, false); return __uint_as_float(rr[0]) + __uint_as_float(rr[1]); }
__device__ __forceinline__ float wave_sum(float v, int lane) { v += shx(v, 32, lane); v += shx(v, 16, lane); v += shx(v, 8, lane); v += shx(v, 4, lane); v += shx(v, 2, lane); v += shx(v, 1, lane); return v; }

namespace pg8 {
constexpr int BM = 256, BK = 64, HALF = 128, HTB = HALF * BK * 2, STAGE_BYTES = 8 * HTB, NXCD = 8, WGM = 8;
__host__ __device__ __forceinline__ int lds_byte(int r, int c) { const int st = (r >> 4) * 2 + (c >> 5), rr = r & 15, cc = c & 31, ob = rr * 64 + cc * 2; return st * 1024 + (ob ^ (((ob >> 9) & 1) << 5)); }
__host__ __device__ __forceinline__ void stage_rc(int b, int& R, int& C) { const int st = b / 1024, sb = b % 1024, swz = sb ^ (((sb >> 9) & 1) << 5); R = (st >> 1) * 16 + swz / 64; C = (st & 1) * 32 + (swz % 64) / 2; }
__host__ __device__ __forceinline__ int perm32(int rho) { const int n = rho >> 4, i = rho & 15; return 8 * (i >> 2) + 4 * n + (i & 3); }
struct Unit { int pm, pn, idx, kind; };
struct Gemm { const bf16_t* A; const bf16_t* Bt; int M, N, K; };
struct StaticOrder {
    int nM, nN, nwg, G, c;
    __host__ __device__ void init(int M, int N, int G_, int c_) { nM = M / BM; nN = N / BM; nwg = nM * nN; G = G_; c = c_; }
    __host__ __device__ bool next(int i, Unit& u) const { return at((long)i * G + c, u); }
    __host__ __device__ bool at(long L, Unit& u) const {
        if (L >= nwg) return false;
        u.kind = 0;
        int wgid = (int)L; { const int q = nwg / NXCD, r = nwg % NXCD, xcd = wgid % NXCD, off = wgid / NXCD; wgid = (xcd < r ? xcd * (q + 1) : r * (q + 1) + (xcd - r) * q) + off; }
        const int nig = WGM * nN, gid = wgid / nig, fm = gid * WGM, gsz = (nM - fm) < WGM ? (nM - fm) : WGM;
        u.pm = fm + ((wgid % nig) % gsz); u.pn = (wgid % nig) / gsz; return true;
    }
    __device__ __forceinline__ void a_ready(const Unit&) const {}
    __device__ __forceinline__ void done(const Unit&) const {}
    __device__ __forceinline__ const char* abase(const Gemm& g, const Unit& u, size_t tstep) const { return (const char*)g.A + (size_t)u.pm * tstep; }
    __device__ __forceinline__ const char* bbase(const Gemm& g, const Unit& u, size_t tstep) const { return (const char*)g.Bt + (size_t)u.pn * tstep; }
};
struct P1Order {
    StaticOrder s0, s1; int G, c; const bf16_t* wt2;
    __device__ void init(int G_, int c_, const bf16_t* wt2_) { s0.init(MG, NPROJ, G_, c_); s1.init(NPT, MG, G_, c_); G = G_; c = c_; wt2 = wt2_; }
    __device__ bool next(int i, Unit& u) const { const long L = (long)i * G + c; if (L < 1280) return s0.at(L, u); if (!s1.at(L - 1280, u)) return false; u.kind = 1; return true; }
    __device__ __forceinline__ void a_ready(const Unit&) const {}
    __device__ __forceinline__ void done(const Unit&) const {}
    __device__ __forceinline__ const char* abase(const Gemm& g, const Unit& u, size_t tstep) const { return (u.kind ? (const char*)wt2 : (const char*)g.A) + (size_t)u.pm * tstep; }
    __device__ __forceinline__ const char* bbase(const Gemm& g, const Unit& u, size_t tstep) const { return (u.kind ? (const char*)g.A : (const char*)g.Bt) + (size_t)u.pn * tstep; }
};

template <class Epi, class Sched>
__device__ __forceinline__ void gemm_phase(LAS unsigned char* lds, const Gemm g, const Sched& S, const Epi& E) {
    const int tid = otid(), wid = __builtin_amdgcn_readfirstlane(tid >> 6), lane = tid & 63, wr = wid >> 2, wc = wid & 3, fr = lane & 15, fq = lane >> 4;
    const int K = g.K, nt = K / BK;
    unsigned voffA[2], voffB[2];
#pragma unroll
    for (int i = 0; i < 2; ++i) { int R, C; stage_rc(tid * 16 + i * 8192, R, C); const int Rb = Epi::PERM ? ((R & ~31) + perm32(R & 31)) : R;
        voffA[i] = (unsigned)(R * K + C) * 2u; voffB[i] = (unsigned)(Rb * K + C) * 2u; }
    const size_t kstep = (size_t)(BK * 2);
    const size_t hstep = (size_t)HALF * K * 2;
    const size_t tstep = 2 * hstep;
    const unsigned ldsw = (unsigned)wid * 1024u;
    const int aoff = lds_byte(wr * 64 + fr, fq * 8), boff = lds_byte(wc * 32 + fr, fq * 8);
#define PG8_SA(b, h) (((b) * 2 + (h)) * HTB)
#define PG8_SB(b, h) ((4 + (b) * 2 + (h)) * HTB)
#define PG8_STAGE(bufoff, gbase, voff) do { _Pragma("unroll") for (int _i = 0; _i < 2; ++_i) \
        __builtin_amdgcn_global_load_lds((const unsigned*)((const char*)(gbase) + (voff)[_i]), (LAS unsigned*)(lds + (bufoff) + ldsw + _i * 8192), 16, 0, 0); } while (0)
#define PG8_LDA(dst, b, h) do { _Pragma("unroll") for (int m = 0; m < 4; ++m) _Pragma("unroll") for (int k = 0; k < 2; ++k) dst[m][k] = *(const LAS bf16x8*)(lds + PG8_SA(b, h) + aoff + m * 2048 + k * 1024); } while (0)
#define PG8_LDB(dst, b, h) do { _Pragma("unroll") for (int n = 0; n < 2; ++n) _Pragma("unroll") for (int k = 0; k < 2; ++k) dst[n][k] = *(const LAS bf16x8*)(lds + PG8_SB(b, h) + boff + n * 2048 + k * 1024); } while (0)
#define PG8_MMA(ai, bj, At, Bt) do { __builtin_amdgcn_s_setprio(1); _Pragma("unroll") for (int m = 0; m < 4; ++m) _Pragma("unroll") for (int n = 0; n < 2; ++n) _Pragma("unroll") for (int k = 0; k < 2; ++k) \
        acc[ai][bj][m][n] = __builtin_amdgcn_mfma_f32_16x16x32_bf16(Bt[n][k], At[m][k], acc[ai][bj][m][n], 0, 0, 0); __builtin_amdgcn_s_setprio(0); } while (0)
#define PG8_WAIT_V(n) asm volatile("s_waitcnt vmcnt(" #n ")" ::: "memory")
#define PG8_WAIT_L(n) asm volatile("s_waitcnt lgkmcnt(" #n ")" ::: "memory")
#define PG8_BAR __builtin_amdgcn_s_barrier()
#define PG8_SCHED __builtin_amdgcn_sched_barrier(0)
    Unit cur, nxt; int ui = 0;
    if (!S.next(0, cur)) return;
    cur.idx = 0;
    f32x4 acc[2][2][4][2];
#pragma unroll
    for (int a = 0; a < 2; ++a)
#pragma unroll
        for (int b = 0; b < 2; ++b)
#pragma unroll
            for (int m = 0; m < 4; ++m)
#pragma unroll
                for (int n = 0; n < 2; ++n) acc[a][b][m][n] = (f32x4){0.f, 0.f, 0.f, 0.f};
    bf16x8 At[4][2], B0[2][2], B1[2][2];
    const char* cA = S.abase(g, cur, tstep); const char* cB = S.bbase(g, cur, tstep);
    S.a_ready(cur);
    PG8_STAGE(PG8_SB(0, 0), cB, voffB); PG8_STAGE(PG8_SA(0, 0), cA, voffA); PG8_STAGE(PG8_SB(0, 1), cB + hstep, voffB); PG8_STAGE(PG8_SA(0, 1), cA + hstep, voffA);
    if (wr == 1) PG8_BAR;
    PG8_WAIT_V(4); PG8_BAR;
    PG8_STAGE(PG8_SB(1, 0), cB + kstep, voffB); PG8_STAGE(PG8_SA(1, 0), cA + kstep, voffA); PG8_STAGE(PG8_SB(1, 1), cB + hstep + kstep, voffB);
    PG8_WAIT_V(6); PG8_BAR;
    for (;;) {
        const bool has_next = S.next(ui + 1, nxt); nxt.idx = ui + 1;
        const char* nA = has_next ? S.abase(g, nxt, tstep) : cA; const char* nB = has_next ? S.bbase(g, nxt, tstep) : cB;
        for (int t = 0; t < nt; t += 2) {
            const bool last = (t == nt - 2);
            const char* a1 = cA + (size_t)(t + 1) * kstep;
            const char* a2 = last ? nA : cA + (size_t)(t + 2) * kstep; const char* b2 = last ? nB : cB + (size_t)(t + 2) * kstep;
            const char* a3 = a2 + kstep; const char* b3 = b2 + kstep;
            if (last && has_next) S.a_ready(nxt);
            if constexpr (Epi::MID > 0) { if (t == Epi::MID) E.mid(acc, cur, wr, wc, fr, fq); }
            PG8_LDB(B0, 0, 0); PG8_SCHED; PG8_LDA(At, 0, 0); PG8_STAGE(PG8_SA(1, 1), a1 + hstep, voffA);
            PG8_WAIT_L(8); PG8_BAR; PG8_WAIT_L(0); PG8_MMA(0, 0, At, B0); PG8_BAR; PG8_SCHED;
            PG8_LDB(B1, 0, 1); PG8_STAGE(PG8_SB(0, 0), b2, voffB);
            PG8_BAR; PG8_WAIT_L(0); PG8_MMA(0, 1, At, B1); PG8_BAR;
            PG8_LDA(At, 0, 1); PG8_STAGE(PG8_SA(0, 0), a2, voffA);
            PG8_BAR; PG8_WAIT_L(0); PG8_MMA(1, 0, At, B0); PG8_BAR; PG8_SCHED;
            PG8_STAGE(PG8_SB(0, 1), b2 + hstep, voffB);
            PG8_WAIT_V(6); PG8_BAR; PG8_MMA(1, 1, At, B1); PG8_BAR;
            PG8_LDB(B0, 1, 0); PG8_SCHED; PG8_LDA(At, 1, 0); PG8_STAGE(PG8_SA(0, 1), a2 + hstep, voffA);
            PG8_WAIT_L(8); PG8_BAR; PG8_WAIT_L(0); PG8_MMA(0, 0, At, B0); PG8_BAR; PG8_SCHED;
            PG8_LDB(B1, 1, 1); PG8_STAGE(PG8_SB(1, 0), b3, voffB);
            PG8_BAR; PG8_WAIT_L(0); PG8_MMA(0, 1, At, B1); PG8_BAR;
            PG8_LDA(At, 1, 1); PG8_STAGE(PG8_SA(1, 0), a3, voffA);
            PG8_BAR; PG8_WAIT_L(0); PG8_MMA(1, 0, At, B0); PG8_BAR; PG8_SCHED;
            PG8_STAGE(PG8_SB(1, 1), b3 + hstep, voffB);
            PG8_WAIT_V(6); PG8_BAR; PG8_MMA(1, 1, At, B1); PG8_BAR;
        }
        E(acc, cur, wr, wc, fr, fq); S.done(cur);
        if (!has_next) break;
#pragma unroll
        for (int a = 0; a < 2; ++a)
#pragma unroll
            for (int b = 0; b < 2; ++b)
#pragma unroll
                for (int m = 0; m < 4; ++m)
#pragma unroll
                    for (int n = 0; n < 2; ++n) acc[a][b][m][n] = (f32x4){0.f, 0.f, 0.f, 0.f};
        cur = nxt; cA = nA; cB = nB; ++ui;
    }
    PG8_WAIT_V(0);
    if (wr == 0) PG8_BAR;
    PG8_BAR;
#undef PG8_SA
#undef PG8_SB
#undef PG8_STAGE
#undef PG8_LDA
#undef PG8_LDB
#undef PG8_MMA
#undef PG8_WAIT_V
#undef PG8_WAIT_L
#undef PG8_BAR
#undef PG8_SCHED
}

struct EpiRowScale {
    static constexpr bool PERM = true; static constexpr int MID = 0;
    bf16_t* O; int ldc; const LAS float* rl;
    __device__ __forceinline__ void operator()(const f32x4 (&acc)[2][2][4][2], const Unit& u, int wr, int wc, int fr, int fq) const {
        const int row0 = u.pm * BM + wr * 64 + fr, col0 = u.pn * BM + wc * 32 + 8 * fq;
#pragma unroll
        for (int ai = 0; ai < 2; ++ai)
#pragma unroll
            for (int m = 0; m < 4; ++m) { const int row = row0 + ai * HALF + m * 16; const float rs = rl[u.idx * 256 + wr * 64 + fr + ai * HALF + m * 16];
                bf16_t* rowp = O + (size_t)row * ldc + col0;
#pragma unroll
                for (int bj = 0; bj < 2; ++bj) { const f32x4 v0 = acc[ai][bj][m][0] * rs, v1 = acc[ai][bj][m][1] * rs;
                    u32x4 w; w.x = cvt_pk_bf16(v0[0], v0[1]); w.y = cvt_pk_bf16(v0[2], v0[3]); w.z = cvt_pk_bf16(v1[0], v1[1]); w.w = cvt_pk_bf16(v1[2], v1[3]);
                    *(u32x4*)(rowp + bj * HALF) = w; } }
    }
};
struct EpiColScale {
    static constexpr bool PERM = true; static constexpr int MID = 0;
    bf16_t* O; int ldc; const LAS float* rl;
    __device__ __forceinline__ void operator()(const f32x4 (&acc)[2][2][4][2], const Unit& u, int wr, int wc, int fr, int fq) const {
        const int row0 = u.pm * BM + wr * 64 + fr, col0 = u.pn * BM + wc * 32 + 8 * fq;
        f32x4 sc[2][2];
#pragma unroll
        for (int bj = 0; bj < 2; ++bj)
#pragma unroll
            for (int n = 0; n < 2; ++n) sc[bj][n] = *(const LAS f32x4*)(rl + u.idx * 256 + wc * 32 + 8 * fq + bj * HALF + 4 * n);
#pragma unroll
        for (int ai = 0; ai < 2; ++ai)
#pragma unroll
            for (int m = 0; m < 4; ++m) { const int row = row0 + ai * HALF + m * 16; bf16_t* rowp = O + (size_t)row * ldc + col0;
#pragma unroll
                for (int bj = 0; bj < 2; ++bj) { const f32x4 v0 = acc[ai][bj][m][0] * sc[bj][0], v1 = acc[ai][bj][m][1] * sc[bj][1];
                    u32x4 w; w.x = cvt_pk_bf16(v0[0], v0[1]); w.y = cvt_pk_bf16(v0[2], v0[3]); w.z = cvt_pk_bf16(v1[0], v1[1]); w.w = cvt_pk_bf16(v1[2], v1[3]);
                    *(u32x4*)(rowp + bj * HALF) = w; } }
    }
};
struct EpiP1 {
    static constexpr bool PERM = true; static constexpr int MID = 0;
    EpiRowScale e0; EpiColScale e1;
    __device__ __forceinline__ void operator()(const f32x4 (&acc)[2][2][4][2], const Unit& u, int wr, int wc, int fr, int fq) const { if (u.kind == 0) e0(acc, u, wr, wc, fr, fq); else e1(acc, u, wr, wc, fr, fq); }
};
struct EpiGate {
    static constexpr bool PERM = true; static constexpr int MID = 0;
    const bf16_t* gate; const bf16_t* addsrc; bf16_t* O;
    __device__ __forceinline__ void operator()(const f32x4 (&acc)[2][2][4][2], const Unit& u, int wr, int wc, int fr, int fq) const {
        const int row0 = u.pm * BM + wr * 64 + fr, col0 = u.pn * BM + wc * 32 + 8 * fq;
#pragma unroll
        for (int ai = 0; ai < 2; ++ai)
#pragma unroll
            for (int m = 0; m < 4; ++m) { const int row = row0 + ai * HALF + m * 16;
#pragma unroll
                for (int bj = 0; bj < 2; ++bj) { const int col = col0 + bj * HALF;
                    float gf[8], r[8]; unpack8(*(const u32x4*)(gate + (size_t)row * NPROJ + col), gf);
                    const f32x4 v0 = acc[ai][bj][m][0], v1 = acc[ai][bj][m][1];
#pragma unroll
                    for (int j = 0; j < 4; ++j) { r[j] = v0[j] * sigmoidf_(gf[j]); r[4 + j] = v1[j] * sigmoidf_(gf[4 + j]); }
                    if (addsrc) { float af[8]; unpack8(*(const u32x4*)(addsrc + (size_t)row * D + col), af);
#pragma unroll
                        for (int j = 0; j < 8; ++j) r[j] += af[j]; }
                    *(u32x4*)(O + (size_t)row * D + col) = pack8(r); } }
    }
};
struct EpiMerge {
    static constexpr bool PERM = true; static constexpr int MID = 8;
    const bf16_t* ga; const bf16_t* gr; bf16_t* O;
    __device__ __forceinline__ void mid(f32x4 (&acc)[2][2][4][2], const Unit& u, int wr, int wc, int fr, int fq) const {
        const int row0 = u.pm * BM + wr * 64 + fr, col0 = u.pn * BM + wc * 32 + 8 * fq;
#pragma unroll
        for (int ai = 0; ai < 2; ++ai)
#pragma unroll
            for (int m = 0; m < 4; ++m) { int row = row0 + ai * HALF + m * 16; asm volatile("" : "+v"(row));
#pragma unroll
                for (int bj = 0; bj < 2; ++bj) { const size_t off = (size_t)row * NPROJ + col0 + bj * HALF;
                    float fa[8], fb[8]; unpack8(*(const u32x4*)(ga + off), fa); unpack8(*(const u32x4*)(gr + off), fb);
#pragma unroll
                    for (int j = 0; j < 8; ++j) { const float rt = (1.0f + __builtin_amdgcn_exp2f(fb[j] * -1.4426950408889634f)) * __builtin_amdgcn_rcpf(1.0f + __builtin_amdgcn_exp2f(fa[j] * -1.4426950408889634f));
                        if (j < 4) acc[ai][bj][m][0][j] *= rt; else acc[ai][bj][m][1][j - 4] *= rt; } }
                asm volatile("" ::: "memory"); }
    }
    __device__ __forceinline__ void operator()(const f32x4 (&acc)[2][2][4][2], const Unit& u, int wr, int wc, int fr, int fq) const {
        const int row0 = u.pm * BM + wr * 64 + fr, col0 = u.pn * BM + wc * 32 + 8 * fq;
#pragma unroll
        for (int ai = 0; ai < 2; ++ai)
#pragma unroll
            for (int m = 0; m < 4; ++m) { const int row = row0 + ai * HALF + m * 16;
#pragma unroll
                for (int bj = 0; bj < 2; ++bj) { const int col = col0 + bj * HALF;
                    float gf[8], r[8]; unpack8(*(const u32x4*)(gr + (size_t)row * NPROJ + col), gf);
                    const f32x4 v0 = acc[ai][bj][m][0], v1 = acc[ai][bj][m][1];
#pragma unroll
                    for (int j = 0; j < 4; ++j) { r[j] = v0[j] * sigmoidf_(gf[j]); r[4 + j] = v1[j] * sigmoidf_(gf[4 + j]); }
                    *(u32x4*)(O + (size_t)row * D + col) = pack8(r); } }
    }
};
struct EpiResid {
    static constexpr bool PERM = true; static constexpr int MID = 0;
    bf16_t* xb; float* rowss;
    __device__ __forceinline__ void operator()(const f32x4 (&acc)[2][2][4][2], const Unit& u, int wr, int wc, int fr, int fq) const {
        const int row0 = u.pm * BM + wr * 64 + fr, col0 = u.pn * BM + wc * 32 + 8 * fq;
#pragma unroll
        for (int ai = 0; ai < 2; ++ai)
#pragma unroll
            for (int m = 0; m < 4; ++m) { const int row = row0 + ai * HALF + m * 16; float ss = 0.f;
#pragma unroll
                for (int bj = 0; bj < 2; ++bj) { const size_t off = (size_t)row * D + col0 + bj * HALF;
                    float b[8], r[8]; unpack8(*(const u32x4*)(xb + off), b);
                    const f32x4 v0 = acc[ai][bj][m][0], v1 = acc[ai][bj][m][1];
#pragma unroll
                    for (int j = 0; j < 4; ++j) { b[j] += v0[j]; b[4 + j] += v1[j]; }
                    const u32x4 w = pack8(b);
                    *(u32x4*)(xb + off) = w;
                    unpack8(w, r);
#pragma unroll
                    for (int j = 0; j < 8; ++j) ss += r[j] * r[j]; }
                { const int ln = fr + 16 * fq; ss += shx(ss, 16, ln); ss += shx(ss, 32, ln); }
                if (fq == 0) rowss[(size_t)row * 16 + u.pn * 4 + wc] = ss; }
    }
};
}

template <class Sched> __device__ __forceinline__ void fill_rstd(LAS float* rl, const float* rowss, const Sched& S, int by_col  ) {
    const int tid = otid();
    for (int e = tid; e < 12 * 256; e += NTHREADS) { pg8::Unit u; const int i = e >> 8;
        if (S.next(i, u)) { const bool bc = by_col < 0 ? (u.kind != 0) : (by_col != 0); const int r = (bc ? u.pn : u.pm) * 256 + (e & 255); rl[e] = rsqrtf(sum16(rowss + (size_t)r * 16) * (1.0f / 1024.0f) + EPS); } }
    __syncthreads();
}

__device__ __forceinline__ int win_srccol(int nd) {
    if (nd < 1024) return nd;
    if (nd < 1536) return 1536 + (nd - 1024);
    if (nd < 2048) return 2048 + (nd - 1536);
    if (nd < 3072) return 3584 + (nd - 2048);
    if (nd < 4096) return 4608 + (nd - 3072);
    if (nd < 5120) return 5632 + (nd - 4096);
    nd -= 5120;
    if (nd < 512) return 1024 + nd;
    if (nd < 1024) return 2048 + (nd - 512);
    return 2560 + (nd - 1024);
}
struct TileJob { const float* src; const float* gsc; bf16_t* dst; int ld_src, k0, nsrc0, ldd, ndst0, kdst0; };
__device__ __forceinline__ TileJob tile_job(const Params& P, int job) {
    constexpr int T_IN = 16 * 112, T_A = 8 * 16, T_R = 16 * 16, T_O = 16 * 16, T_UP = 16 * 88, T_D = 44 * 16, T_L = T_IN + T_A + T_R + T_O + T_UP + T_D;
    const int l = job / T_L; int r = job % T_L;
    unsigned char* wl = P.ws + WS_W + (size_t)l * W_LAYER;
    TileJob j;
    if (r < T_IN) { const int kt = r / 112, nt = r % 112; j = TileJob{P.w_in + (size_t)l * D * DIN, P.norm_mix_g + l * D, (bf16_t*)(wl + W_IN_OFF), DIN, kt * 64, win_srccol(nt * 64), 1024, nt * 64, 0}; return j; }
    r -= T_IN;
    if (r < T_A) { const int kt = r / 16, nt = r % 16; j = TileJob{P.w_ba + (size_t)l * 512 * D, nullptr, (bf16_t*)(wl + W_A_OFF), D, kt * 64, nt * 64, 1536, nt * 64, 0}; return j; }
    r -= T_A;
    if (r < T_R) { const int kt = r / 16, nt = r % 16; j = TileJob{P.w_br + (size_t)l * D * D, nullptr, (bf16_t*)(wl + W_A_OFF), D, kt * 64, nt * 64, 1536, nt * 64, 512}; return j; }
    r -= T_R;
    if (r < T_O) { const int kt = r / 16, nt = r % 16; j = TileJob{P.w_out + (size_t)l * D * D, nullptr, (bf16_t*)(wl + W_O_OFF), D, kt * 64, nt * 64, 1024, nt * 64, 0}; return j; }
    r -= T_O;
    if (r < T_UP) { const int kt = r / 88, nt = r % 88; j = TileJob{P.w_up + (size_t)l * D * DFF2, P.norm_ffn_g + l * D, (bf16_t*)(wl + W_UP_OFF), DFF2, kt * 64, nt * 64, 1024, nt * 64, 0}; return j; }
    r -= T_UP;
    { const int kt = r / 16, nt = r % 16; j = TileJob{P.w_down + (size_t)l * DFF * D, nullptr, (bf16_t*)(wl + W_D_OFF), D, kt * 64, nt * 64, DFF, nt * 64, 0}; return j; }
}
struct TileRegs { float4 v[2]; float s[2]; };
__device__ __forceinline__ void tile_load(TileRegs& tr, const TileJob& j, int t) {
#pragma unroll
    for (int i = 0; i < 2; ++i) { const int r = (t >> 4) + 32 * i, c = (t & 15) * 4;
        tr.v[i] = *(const float4*)(j.src + (size_t)(j.k0 + r) * j.ld_src + j.nsrc0 + c);
        tr.s[i] = j.gsc ? j.gsc[j.k0 + r] : 1.0f; }
}
__device__ __forceinline__ void tile_store(const TileRegs& tr, const TileJob& j, int t, LAS float* tile) {
#pragma unroll
    for (int i = 0; i < 2; ++i) { const int r = (t >> 4) + 32 * i, c = (t & 15) * 4; const float sc = tr.s[i];
        tile[r * 65 + c] = tr.v[i].x * sc; tile[r * 65 + c + 1] = tr.v[i].y * sc; tile[r * 65 + c + 2] = tr.v[i].z * sc; tile[r * 65 + c + 3] = tr.v[i].w * sc; }
    __syncthreads();
    { const int n = t >> 3, k8 = (t & 7) * 8; float f[8];
#pragma unroll
      for (int jj = 0; jj < 8; ++jj) f[jj] = tile[(k8 + jj) * 65 + n];
      *(u32x4*)(j.dst + (size_t)(j.ndst0 + n) * j.ldd + j.kdst0 + j.k0 + k8) = pack8(f); }
    __syncthreads();
}
__device__ __forceinline__ void phase_prologue(const Params& P, LAS unsigned char* lds) {
    LAS float* tile = (LAS float*)lds;
    constexpr int NJOBS = (16 * 112 + 8 * 16 + 16 * 16 + 16 * 16 + 16 * 88 + 44 * 16) * DEPTH;
    { const int t = otid(), G = ogrid();
      int job = blockIdx.x;
      if (job < NJOBS) { TileJob jc = tile_job(P, job); TileRegs rc; tile_load(rc, jc, t);
          while (true) { const int jn = job + G; const bool more = jn < NJOBS;
              TileJob jx = jc; TileRegs rx = rc; if (more) { jx = tile_job(P, jn); tile_load(rx, jx, t); }
              tile_store(rc, jc, t, tile);
              if (!more) break; jc = jx; rc = rx; job = jn; } } }
    if (blockIdx.x == 0 && otid() < DEPTH * 4) { const int i = otid(); float* tab = (float*)(P.ws + WS_LG2);
        tab[2 * i] = -log1pf(expf(-P.dec_f[i])) * 1.4426950408889634f; tab[2 * i + 1] = -log1pf(expf(-P.dec_b[i])) * 1.4426950408889634f; }
    float* cosN = (float*)(P.ws + WS_COSN); float* sinN = (float*)(P.ws + WS_SINN); float* cosT = (float*)(P.ws + WS_COST); float* sinT = (float*)(P.ws + WS_SINT);
    for (int idx = blockIdx.x * NTHREADS + otid(); idx < 16384 * 64; idx += ogrid() * NTHREADS) {
        const int pos = idx >> 6, i = idx & 63;
        const float invf = powf(10000.0f, -(float)i / 64.0f);
        const float ang = (float)pos * invf;
        const float c = cosf(ang), s = sinf(ang);
        cosN[idx] = c; sinN[idx] = s; cosT[(size_t)i * 16384 + pos] = c; sinT[(size_t)i * 16384 + pos] = s;
    }
}

__device__ __forceinline__ void phase_init(const float* __restrict__ xin, bf16_t* xb, float* rowss1, float* rowss2) {
    const int tid = otid(), lane = tid & 63, nw = ogrid() * 8;
    for (int row = blockIdx.x * 8 + (tid >> 6); row < MG; row += nw) {
        const float4* p = (const float4*)(xin + (size_t)row * D); float ss = 0.f;
#pragma unroll
        for (int i = 0; i < 4; ++i) { const float4 v = p[lane + 64 * i];
            u32x2 w; w.x = cvt_pk_bf16(v.x, v.y); w.y = cvt_pk_bf16(v.z, v.w); *(u32x2*)(xb + (size_t)row * D + (lane + 64 * i) * 4) = w;
            const float a0 = bf_lo(w.x), a1 = bf_hi(w.x), a2 = bf_lo(w.y), a3 = bf_hi(w.y); ss += a0 * a0 + a1 * a1 + a2 * a2 + a3 * a3; }
        ss = wave_sum(ss, lane);
        if (lane < 16) rowss1[(size_t)row * 16 + lane] = lane == 0 ? ss : 0.f;
    }
}
__device__ __forceinline__ void phase_final(const bf16_t* __restrict__ xb, float* xo, const float* rowss1, const float* __restrict__ gfin) {
    const int tid = otid(), lane = tid & 63, nw = ogrid() * 8;
    for (int row = blockIdx.x * 8 + (tid >> 6); row < MG; row += nw) {
        const float rs = rsqrtf(sum16(rowss1 + (size_t)row * 16) * (1.0f / 1024.0f) + EPS);
#pragma unroll
        for (int i = 0; i < 2; ++i) { const int c8 = (lane + 64 * i) * 8; float x[8]; unpack8(*(const u32x4*)(xb + (size_t)row * D + c8), x);
            const f32x4 g0 = *(const f32x4*)(gfin + c8), g1 = *(const f32x4*)(gfin + c8 + 4);
            *(f32x4*)(xo + (size_t)row * D + c8) = (f32x4){x[0] * rs * g0[0], x[1] * rs * g0[1], x[2] * rs * g0[2], x[3] * rs * g0[3]};
            *(f32x4*)(xo + (size_t)row * D + c8 + 4) = (f32x4){x[4] * rs * g1[0], x[5] * rs * g1[1], x[6] * rs * g1[2], x[7] * rs * g1[3]}; }
    }
}
__device__ __forceinline__ float gelu_tanh(float x) { const float t = fmaf(x * x, -0.10294324f, -2.30220819f);
    return x * __builtin_amdgcn_rcpf(1.0f + __builtin_amdgcn_exp2f(x * t)); }
__device__ __forceinline__ void phase_convact(const bf16_t* __restrict__ u, bf16_t* act, const float* __restrict__ cw  , int seqlen, int nrows) {
    const int gt = blockIdx.x * NTHREADS + otid(), nth = ogrid() * NTHREADS;
    int nr = nrows; asm volatile("" : "+s"(nr));
    const int ntask = (nr >> 3) * 352;
    for (int id = gt; id < ntask; id += nth) {
        const int tb = id / 352, c = (id % 352) * 8, t0 = tb * 8;
        const u32x4 z = (u32x4){0u, 0u, 0u, 0u};
        u32x4 g[10], v[10];
        const bool has_prev = (t0 & (seqlen - 1)) != 0, has_next = ((t0 + 8) & (seqlen - 1)) != 0;
#pragma unroll
        for (int r = 0; r < 10; ++r) { const bool ok = (r == 0) ? has_prev : ((r == 9) ? has_next : true);
            g[r] = z; v[r] = z;
            if (ok) { g[r] = *(const u32x4*)(u + (size_t)(t0 - 1 + r) * DFF2 + c); v[r] = *(const u32x4*)(u + (size_t)(t0 - 1 + r) * DFF2 + DFF + c); } }
        float wg[3][8], wv[3][8];
#pragma unroll
        for (int k = 0; k < 3; ++k) {
            const f32x4 a0 = *(const f32x4*)(cw + k * DFF2 + c), a1 = *(const f32x4*)(cw + k * DFF2 + c + 4);
            const f32x4 b0 = *(const f32x4*)(cw + k * DFF2 + DFF + c), b1 = *(const f32x4*)(cw + k * DFF2 + DFF + c + 4);
#pragma unroll
            for (int j = 0; j < 4; ++j) { wg[k][j] = a0[j]; wg[k][4 + j] = a1[j]; wv[k][j] = b0[j]; wv[k][4 + j] = b1[j]; } }
#pragma unroll
        for (int i = 0; i < 8; ++i) {
            float a[8], b[8], cc[8], r[8], gg[8], vv[8];
            unpack8(g[i], a); unpack8(g[i + 1], b); unpack8(g[i + 2], cc);
#pragma unroll
            for (int j = 0; j < 8; ++j) gg[j] = a[j] * wg[0][j] + b[j] * wg[1][j] + cc[j] * wg[2][j];
            unpack8(v[i], a); unpack8(v[i + 1], b); unpack8(v[i + 2], cc);
#pragma unroll
            for (int j = 0; j < 8; ++j) vv[j] = a[j] * wv[0][j] + b[j] * wv[1][j] + cc[j] * wv[2][j];
#pragma unroll
            for (int j = 0; j < 8; ++j) r[j] = gelu_tanh(gg[j]) * vv[j];
            *(u32x4*)(act + (size_t)(t0 + i) * DFF + c) = pack8(r);
        }
    }
}

constexpr int NA_LDS_WAVE = 12288;
struct NaFrags { bf16x8 k[4]; u32x2 v[2][2][2]; };
__device__ __forceinline__ void na_load(NaFrags& f, const bf16_t* __restrict__ proj, const bf16_t* __restrict__ projT, int ktok, int h, int c, int hh) {
    const bf16_t* kp = proj + (size_t)(ktok + c) * NPROJ + 512 + h * 64 + 8 * hh;
#pragma unroll
    for (int s = 0; s < 4; ++s) f.k[s] = *(const bf16x8*)(kp + 16 * s);
#pragma unroll
    for (int dt = 0; dt < 2; ++dt)
#pragma unroll
        for (int s2 = 0; s2 < 2; ++s2) { const bf16_t* vp = projT + (size_t)(h * 64 + dt * 32 + c) * MG + (ktok + 16 * s2 + 4 * hh);
            f.v[dt][s2][0] = *(const u32x2*)vp; f.v[dt][s2][1] = *(const u32x2*)(vp + 8); }
}
__device__ __forceinline__ void na_item(const bf16_t* __restrict__ proj, const bf16_t* __restrict__ projT, bf16_t* aout, const float* __restrict__ relb  , int item, int seqlen, LAS unsigned char* lds, int w, int lane) {
    const int c = lane & 31, hh = lane >> 5;
    const int R = item >> 3, h = item & 7;
    const int rps = seqlen >> 6, seq = R / rps, r = R % rps;
    int rs = r - 4; rs = rs < 0 ? 0 : rs; rs = rs > rps - 8 ? rps - 8 : rs;
    const int qtok0 = seq * seqlen + r * 64, ktok0 = seq * seqlen + rs * 64;
    LAS float* bias = (LAS float*)(lds + w * NA_LDS_WAVE) + 64;
    LAS bf16_t* Otile = (LAS bf16_t*)(lds + w * NA_LDS_WAVE + 3072);
    for (int i = lane; i < 768; i += 64) { const int j = i - 64; bias[j] = (j >= 0 && j < 465) ? relb[h * 465 + j] * 1.4426950408889634f : 0.f; }
    bf16x8 qf[2][4];
#pragma unroll
    for (int qh = 0; qh < 2; ++qh) { const bf16_t* qp = proj + (size_t)(qtok0 + 32 * qh + c) * NPROJ + h * 64 + 8 * hh;
#pragma unroll
        for (int s = 0; s < 4; ++s) qf[qh][s] = *(const bf16x8*)(qp + 16 * s); }
    f32x16 O[2][2];
    float mrun[2], lrun[2]; int cs[2];
#pragma unroll
    for (int qh = 0; qh < 2; ++qh) { O[qh][0] = zero16(); O[qh][1] = zero16(); mrun[qh] = -1e30f; lrun[qh] = 0.f;
        int x = 32 * qh + c - 8; x = x < 0 ? 0 : x; x = x > 48 ? 48 : x; cs[qh] = x; }
    NaFrags cur, nxt;
    na_load(cur, proj, projT, ktok0, h, c, hh);
#pragma unroll 1
    for (int t = 0; t < 16; ++t) {
        if (t + 1 < 16) na_load(nxt, proj, projT, ktok0 + 32 * (t + 1), h, c, hh);
        const int kr = rs + (t >> 1), chalf = t & 1, brow = (kr - r + 7) * 31;
#pragma unroll
        for (int qh = 0; qh < 2; ++qh) {
            f32x16 x = zero16();
#pragma unroll
            for (int s = 0; s < 4; ++s) x = mfma32(cur.k[s], qf[qh][s], x);
            const int qc = 32 * qh + c; float mt = -1e30f;
#pragma unroll
            for (int rg = 0; rg < 16; ++rg) { const int kc = 32 * chalf + (rg & 3) + 8 * (rg >> 2) + 4 * hh;
                const bool valid = (kc >= cs[qh]) && (kc < cs[qh] + 16);
                const float sv = fmaf(x[rg], 0.18033688011112042f, bias[brow + kc - qc + 15]) + (valid ? 0.f : -__builtin_inff());
                x[rg] = sv; mt = fmaxf(mt, sv); }
            mt = xhalf_max(mt);
            if (__builtin_amdgcn_ballot_w64(mt > mrun[qh] + 8.0f) != 0ull) {
                const float mnew = fmaxf(mrun[qh], mt), alpha = __builtin_amdgcn_exp2f(mrun[qh] - mnew);
                mrun[qh] = mnew; lrun[qh] *= alpha; O[qh][0] *= alpha; O[qh][1] *= alpha; }
            const float mcur = mrun[qh];
            float ps = 0.f;
#pragma unroll
            for (int rg = 0; rg < 16; ++rg) { const float p = __builtin_amdgcn_exp2f(x[rg] - mcur); x[rg] = p; ps += p; }
            lrun[qh] += ps;
#pragma unroll
            for (int s2 = 0; s2 < 2; ++s2) {
                u32x4 pw; pw.x = cvt_pk_bf16(x[8 * s2 + 0], x[8 * s2 + 1]); pw.y = cvt_pk_bf16(x[8 * s2 + 2], x[8 * s2 + 3]); pw.z = cvt_pk_bf16(x[8 * s2 + 4], x[8 * s2 + 5]); pw.w = cvt_pk_bf16(x[8 * s2 + 6], x[8 * s2 + 7]);
                const bf16x8 pb = __builtin_bit_cast(bf16x8, pw);
#pragma unroll
                for (int dt = 0; dt < 2; ++dt) { u32x4 aw; aw.x = cur.v[dt][s2][0].x; aw.y = cur.v[dt][s2][0].y; aw.z = cur.v[dt][s2][1].x; aw.w = cur.v[dt][s2][1].y;
                    O[qh][dt] = mfma32(__builtin_bit_cast(bf16x8, aw), pb, O[qh][dt]); } }
        }
        cur = nxt;
    }
#pragma unroll
    for (int qh = 0; qh < 2; ++qh) { const float inv = __builtin_amdgcn_rcpf(xhalf_sum(lrun[qh]));
#pragma unroll
        for (int dt = 0; dt < 2; ++dt)
#pragma unroll
            for (int g4 = 0; g4 < 4; ++g4) { u32x2 pw; pw.x = cvt_pk_bf16(O[qh][dt][4 * g4] * inv, O[qh][dt][4 * g4 + 1] * inv); pw.y = cvt_pk_bf16(O[qh][dt][4 * g4 + 2] * inv, O[qh][dt][4 * g4 + 3] * inv);
                *(LAS u32x2*)(Otile + (32 * qh + c) * 72 + dt * 32 + 8 * g4 + 4 * hh) = pw; } }
#pragma unroll
    for (int i = 0; i < 8; ++i) { const int id = lane + 64 * i, q = id >> 3, d8 = (id & 7) * 8;
        *(u32x4*)(aout + (size_t)(qtok0 + q) * 1536 + h * 64 + d8) = *(const LAS u32x4*)(Otile + q * 72 + d8); }
}

constexpr int KT_STRIDE = 136;
__device__ __forceinline__ void r1_item(const bf16_t* __restrict__ projT, bf16_t* stloc, const float* __restrict__ cosT, const float* __restrict__ sinT, float lgf2, float lgb2, int item, int seqlen, LAS unsigned char* lds) {
    const int tid = otid(), w = __builtin_amdgcn_readfirstlane(tid >> 6), lane = tid & 63, c = lane & 31, hh = lane >> 5;
    const int ch = item >> 2, h = item & 3, tok0 = ch * 128, pos0 = tok0 % seqlen;
    LAS bf16_t* KTf = (LAS bf16_t*)lds; LAS bf16_t* KTb = (LAS bf16_t*)(lds + 128 * KT_STRIDE * 2);
    const float scale = 0.08838834764831845f;
    bf16x8 af[8];
    { const bf16_t* vp = projT + (size_t)(1024 + h * 256 + 32 * w + c) * MG + tok0 + 8 * hh;
#pragma unroll
      for (int s = 0; s < 8; ++s) af[s] = *(const bf16x8*)(vp + 16 * s); }
#pragma unroll
    for (int it = 0; it < 2; ++it) {
        const int id = tid + NTHREADS * it, d = id >> 4, t8 = id & 15;
        float k1[8], k2[8];
        unpack8(*(const u32x4*)(projT + (size_t)(512 + h * 128 + d) * MG + tok0 + 8 * t8), k1);
        unpack8(*(const u32x4*)(projT + (size_t)(512 + h * 128 + d + 64) * MG + tok0 + 8 * t8), k2);
        const f32x4 c0 = *(const f32x4*)(cosT + (size_t)d * 16384 + pos0 + 8 * t8), c1 = *(const f32x4*)(cosT + (size_t)d * 16384 + pos0 + 8 * t8 + 4);
        const f32x4 s0 = *(const f32x4*)(sinT + (size_t)d * 16384 + pos0 + 8 * t8), s1 = *(const f32x4*)(sinT + (size_t)d * 16384 + pos0 + 8 * t8 + 4);
        float f1[8], f2[8], b1[8], b2[8];
#pragma unroll
        for (int j = 0; j < 8; ++j) { const float cv = j < 4 ? c0[j & 3] : c1[j & 3], sv = j < 4 ? s0[j & 3] : s1[j & 3];
            const float r1 = (k1[j] * cv - k2[j] * sv) * scale, r2 = (k1[j] * sv + k2[j] * cv) * scale;
            const int tl = 8 * t8 + j; const float df = __builtin_amdgcn_exp2f((float)(127 - tl) * lgf2), db = __builtin_amdgcn_exp2f((float)tl * lgb2);
            f1[j] = r1 * df; f2[j] = r2 * df; b1[j] = r1 * db; b2[j] = r2 * db; }
        *(LAS u32x4*)(KTf + d * KT_STRIDE + 8 * t8) = pack8(f1); *(LAS u32x4*)(KTf + (d + 64) * KT_STRIDE + 8 * t8) = pack8(f2);
        *(LAS u32x4*)(KTb + d * KT_STRIDE + 8 * t8) = pack8(b1); *(LAS u32x4*)(KTb + (d + 64) * KT_STRIDE + 8 * t8) = pack8(b2);
    }
    __syncthreads();
#pragma unroll
    for (int dir = 0; dir < 2; ++dir) {
        LAS bf16_t* KT = dir ? KTb : KTf;
        bf16_t* dst = stloc + ((size_t)(ch * 4 + h) * 2 + dir) * 32768;
#pragma unroll
        for (int ct = 0; ct < 4; ++ct) {
            f32x16 acc = zero16();
#pragma unroll
            for (int s = 0; s < 8; ++s) { const bf16x8 bfr = *(const LAS bf16x8*)(KT + (32 * ct + c) * KT_STRIDE + 16 * s + 8 * hh); acc = mfma32(af[s], bfr, acc); }
#pragma unroll
            for (int rg = 0; rg < 16; ++rg) { const int dv = 32 * w + (rg & 3) + 8 * (rg >> 2) + 4 * hh; dst[dv * 128 + 32 * ct + c] = (bf16_t)(cvt_pk_bf16(acc[rg], 0.f) & 0xffffu); }
        }
    }
    __syncthreads();
}

__device__ __forceinline__ void phase_scan(const bf16_t* __restrict__ stloc, bf16_t* st, const float* __restrict__ decf, const float* __restrict__ decb, int seqlen) {
    const int gt = blockIdx.x * NTHREADS + otid(), nth = ogrid() * NTHREADS;
    constexpr size_t CSTR = (size_t)4 * 2 * 32768;
    if (seqlen == 4096) {
        constexpr int NCH = 32, NTASK = 4 * 4 * 2 * 4096;
        for (int id = gt; id < NTASK; id += nth) {
            const int e8 = id & 4095, dir = (id >> 12) & 1, h = (id >> 13) & 3, seq = id >> 15;
            const float x = dir ? decb[h] : decf[h]; const float cd = exp2f(-128.0f * log1pf(expf(-x)) * 1.4426950408889634f);
            const size_t base = ((size_t)(seq * NCH * 4 + h) * 2 + dir) * 32768 + (size_t)e8 * 8;
            float zz = 0.f; asm volatile("" : "+v"(zz));
            float S[8];
#pragma unroll
            for (int j = 0; j < 8; ++j) S[j] = zz;
            for (int i0 = 0; i0 < NCH; i0 += 8) {
                u32x4 loc[8];
#pragma unroll
                for (int j = 0; j < 8; ++j) { const int ci = dir ? (NCH - 1 - (i0 + j)) : (i0 + j); loc[j] = *(const u32x4*)(stloc + base + (size_t)ci * CSTR); }
#pragma unroll
                for (int j = 0; j < 8; ++j) { const int ci = dir ? (NCH - 1 - (i0 + j)) : (i0 + j);
                    *(u32x4*)(st + base + (size_t)ci * CSTR) = pack8(S);
                    float lf[8]; unpack8(loc[j], lf);
#pragma unroll
                    for (int k = 0; k < 8; ++k) S[k] = S[k] * cd + lf[k]; }
            }
        }
    } else {
        constexpr int NCH = 128, NTASK = 4 * 2 * 16384;
        for (int id = gt; id < NTASK; id += nth) {
            const int e2 = id & 16383, dir = (id >> 14) & 1, h = (id >> 15) & 3;
            const float x = dir ? decb[h] : decf[h]; const float cd = exp2f(-128.0f * log1pf(expf(-x)) * 1.4426950408889634f);
            const size_t base = ((size_t)h * 2 + dir) * 32768 + (size_t)e2 * 2;
            float zz = 0.f; asm volatile("" : "+v"(zz));
            float S0 = zz, S1 = zz;
            for (int i0 = 0; i0 < NCH; i0 += 8) {
                unsigned loc[8];
#pragma unroll
                for (int j = 0; j < 8; ++j) { const int ci = dir ? (NCH - 1 - (i0 + j)) : (i0 + j); loc[j] = *(const unsigned*)(stloc + base + (size_t)ci * CSTR); }
#pragma unroll
                for (int j = 0; j < 8; ++j) { const int ci = dir ? (NCH - 1 - (i0 + j)) : (i0 + j);
                    *(unsigned*)(st + base + (size_t)ci * CSTR) = cvt_pk_bf16(S0, S1);
                    S0 = S0 * cd + bf_lo(loc[j]); S1 = S1 * cd + bf_hi(loc[j]); }
            }
        }
    }
}

constexpr int OL_STRIDE = 264;
__device__ __forceinline__ void r3_item(const bf16_t* __restrict__ proj, const bf16_t* __restrict__ projT, const bf16_t* __restrict__ st, bf16_t* ro,
                        const float* __restrict__ cosN, const float* __restrict__ sinN, const float* __restrict__ gn  , float lgf2, float lgb2,
                        int item, int seqlen, LAS unsigned char* lds) {
    const int tid = otid(), w = __builtin_amdgcn_readfirstlane(tid >> 6), lane = tid & 63, c = lane & 31, hh = lane >> 5;
    const int ch = item >> 2, h = item & 3, tok0 = ch * 128, pos0 = tok0 % seqlen;
    LAS bf16_t* Ql = (LAS bf16_t*)lds; LAS bf16_t* Kl = (LAS bf16_t*)(lds + 34816); LAS bf16_t* Pl = (LAS bf16_t*)(lds + 69632);
    LAS float* stat = (LAS float*)(lds + 104448);
    LAS bf16_t* Ol = (LAS bf16_t*)lds;
    const float scale = 0.08838834764831845f;
    bf16x8 asb[8], asf[8], avt[8];
    const size_t stb0 = ((size_t)(ch * 4 + h) * 2) * 32768 + (size_t)(32 * w + c) * 128 + 8 * hh;
#pragma unroll
    for (int s = 0; s < 8; ++s) asb[s] = *(const bf16x8*)(st + stb0 + 32768 + 16 * s);
#pragma unroll
    for (int it = 0; it < 2; ++it) {
        const int id = tid + NTHREADS * it, t = id >> 3, d8 = (id & 7) * 8;
        const f32x4 c0 = *(const f32x4*)(cosN + (size_t)(pos0 + t) * 64 + d8), c1 = *(const f32x4*)(cosN + (size_t)(pos0 + t) * 64 + d8 + 4);
        const f32x4 s0 = *(const f32x4*)(sinN + (size_t)(pos0 + t) * 64 + d8), s1 = *(const f32x4*)(sinN + (size_t)(pos0 + t) * 64 + d8 + 4);
        float a[8], b[8], o1[8], o2[8];
        const bf16_t* qp = proj + (size_t)(tok0 + t) * NPROJ + 1024 + h * 128 + d8;
        unpack8(*(const u32x4*)qp, a); unpack8(*(const u32x4*)(qp + 64), b);
#pragma unroll
        for (int j = 0; j < 8; ++j) { const float cv = j < 4 ? c0[j & 3] : c1[j & 3], sv = j < 4 ? s0[j & 3] : s1[j & 3]; o1[j] = a[j] * cv - b[j] * sv; o2[j] = a[j] * sv + b[j] * cv; }
        *(LAS u32x4*)(Ql + t * KT_STRIDE + d8) = pack8(o1); *(LAS u32x4*)(Ql + t * KT_STRIDE + 64 + d8) = pack8(o2);
        const bf16_t* kp = proj + (size_t)(tok0 + t) * NPROJ + 1536 + h * 128 + d8;
        unpack8(*(const u32x4*)kp, a); unpack8(*(const u32x4*)(kp + 64), b);
#pragma unroll
        for (int j = 0; j < 8; ++j) { const float cv = j < 4 ? c0[j & 3] : c1[j & 3], sv = j < 4 ? s0[j & 3] : s1[j & 3]; o1[j] = (a[j] * cv - b[j] * sv) * scale; o2[j] = (a[j] * sv + b[j] * cv) * scale; }
        *(LAS u32x4*)(Kl + t * KT_STRIDE + d8) = pack8(o1); *(LAS u32x4*)(Kl + t * KT_STRIDE + 64 + d8) = pack8(o2);
    }
    __syncthreads();
    { const int kt = w >> 1;
#pragma unroll
      for (int q2 = 0; q2 < 2; ++q2) { const int tqt = 2 * (w & 1) + q2;
          f32x16 x = zero16();
#pragma unroll
          for (int s = 0; s < 8; ++s) { const bf16x8 kf = *(const LAS bf16x8*)(Kl + (32 * kt + c) * KT_STRIDE + 16 * s + 8 * hh);
              const bf16x8 qf = *(const LAS bf16x8*)(Ql + (32 * tqt + c) * KT_STRIDE + 16 * s + 8 * hh); x = mfma32(kf, qf, x); }
          const int n = 32 * tqt + c;
#pragma unroll
          for (int g4 = 0; g4 < 4; ++g4) { float pv[4];
#pragma unroll
              for (int j = 0; j < 4; ++j) { const int mk = 32 * kt + 8 * g4 + 4 * hh + j; const int diff = n - mk;
                  const float dec = __builtin_amdgcn_exp2f(diff >= 0 ? (float)diff * lgf2 : (float)(-diff) * lgb2); pv[j] = x[4 * g4 + j] * dec; }
              u32x2 pw; pw.x = cvt_pk_bf16(pv[0], pv[1]); pw.y = cvt_pk_bf16(pv[2], pv[3]);
              *(LAS u32x2*)(Pl + n * KT_STRIDE + 32 * kt + 8 * g4 + 4 * hh) = pw; } } }
    __syncthreads();
    f32x16 acc[4];
#pragma unroll
    for (int q = 0; q < 4; ++q) acc[q] = zero16();
    { const bf16_t* vp0 = projT + (size_t)(1024 + h * 256 + 32 * w + c) * MG + tok0 + 8 * hh;
#pragma unroll
      for (int s = 0; s < 8; ++s) { asf[s] = *(const bf16x8*)(st + stb0 + 16 * s); avt[s] = *(const bf16x8*)(vp0 + 16 * s); } }
#pragma unroll
    for (int s = 0; s < 8; ++s) { const bf16x8 a = asb[s];
#pragma unroll
        for (int q = 0; q < 4; ++q) { const bf16x8 b = *(const LAS bf16x8*)(Ql + (32 * q + c) * KT_STRIDE + 16 * s + 8 * hh); acc[q] = mfma32(a, b, acc[q]); } }
#pragma unroll
    for (int q = 0; q < 4; ++q) { const int n = 32 * q + c; const float f = __builtin_amdgcn_exp2f((float)(128 - n) * lgb2 - (float)(n + 1) * lgf2); acc[q] *= f; }
#pragma unroll
    for (int s = 0; s < 8; ++s) { const bf16x8 a = asf[s];
#pragma unroll
        for (int q = 0; q < 4; ++q) { const bf16x8 b = *(const LAS bf16x8*)(Ql + (32 * q + c) * KT_STRIDE + 16 * s + 8 * hh); acc[q] = mfma32(a, b, acc[q]); } }
#pragma unroll
    for (int q = 0; q < 4; ++q) { const int n = 32 * q + c; const float f = __builtin_amdgcn_exp2f((float)(n + 1) * lgf2); acc[q] *= f; }
#pragma unroll
    for (int s = 0; s < 8; ++s) { const bf16x8 a = avt[s];
#pragma unroll
        for (int q = 0; q < 4; ++q) { const bf16x8 b = *(const LAS bf16x8*)(Pl + (32 * q + c) * KT_STRIDE + 16 * s + 8 * hh); acc[q] = mfma32(a, b, acc[q]); } }
#pragma unroll
    for (int q = 0; q < 4; ++q) { float s1 = 0.f, s2 = 0.f;
#pragma unroll
        for (int i = 0; i < 16; ++i) { s1 += acc[q][i]; s2 += acc[q][i] * acc[q][i]; }
        s1 = xhalf_sum(s1); s2 = xhalf_sum(s2);
        if (hh == 0) { stat[(w * 128 + 32 * q + c) * 2] = s1; stat[(w * 128 + 32 * q + c) * 2 + 1] = s2; } }
    __syncthreads();
#pragma unroll
    for (int q = 0; q < 4; ++q) { float s1 = 0.f, s2 = 0.f; const int n = 32 * q + c;
#pragma unroll
        for (int k = 0; k < 8; ++k) { s1 += stat[(k * 128 + n) * 2]; s2 += stat[(k * 128 + n) * 2 + 1]; }
        const float mu = s1 * (1.0f / 256.0f); float var = s2 * (1.0f / 256.0f) - mu * mu; var = var < 0.f ? 0.f : var; const float rs = rsqrtf(var + EPS);
#pragma unroll
        for (int g4 = 0; g4 < 4; ++g4) { u32x2 pw; pw.x = cvt_pk_bf16((acc[q][4 * g4] - mu) * rs, (acc[q][4 * g4 + 1] - mu) * rs); pw.y = cvt_pk_bf16((acc[q][4 * g4 + 2] - mu) * rs, (acc[q][4 * g4 + 3] - mu) * rs);
            *(LAS u32x2*)(Ol + n * OL_STRIDE + 32 * w + 8 * g4 + 4 * hh) = pw; } }
    __syncthreads();
#pragma unroll
    for (int it = 0; it < 8; ++it) { const int id = tid + NTHREADS * it, tq = id >> 5, d8 = (id & 31) * 8;
        float y[8], rg[8], o[8]; unpack8(*(const LAS u32x4*)(Ol + tq * OL_STRIDE + d8), y);
        unpack8(*(const u32x4*)(proj + (size_t)(tok0 + tq) * NPROJ + 2048 + h * 256 + d8), rg);
        const f32x4 g0 = *(const f32x4*)(gn + h * 256 + d8), g1 = *(const f32x4*)(gn + h * 256 + d8 + 4);
#pragma unroll
        for (int j = 0; j < 8; ++j) { const float gv = j < 4 ? g0[j & 3] : g1[j & 3]; o[j] = rg[j] * sigmoidf_(rg[j]) * y[j] * gv; }
        *(u32x4*)(ro + (size_t)(tok0 + tq) * 1536 + 512 + h * 256 + d8) = pack8(o); }
    __syncthreads();
}


#define XB_TMO      128
#define XB_XCNT(j)  (256  + 64 * (j))
#define XB_XSUB(j)  (1280 + 64 * (j))
#define XB_XGEN(j)  (2304 + 64 * (j))
#define XB_TOP      3328
#define XB_TOPGEN   3392
#define XCD_BAR_WORDS 3456
#define XB_SPIN_CAP (1u << 22)
__device__ __forceinline__ unsigned xb_ld(unsigned* p)              { return __hip_atomic_load(p, __ATOMIC_RELAXED, __HIP_MEMORY_SCOPE_AGENT); }
__device__ __forceinline__ unsigned xb_add(unsigned* p, unsigned v) { return __hip_atomic_fetch_add(p, v, __ATOMIC_RELAXED, __HIP_MEMORY_SCOPE_AGENT); }
__device__ __forceinline__ unsigned xb_xcc_id() { return (unsigned)__builtin_amdgcn_s_getreg((3 << 11) | 20) & 0xFu; }
#define XB_SPIN(cond, bar) do { unsigned _sp = 0; while (cond) { __builtin_amdgcn_s_sleep(1); \
    if ((++_sp & 255u) == 0u) { if (xb_ld(&(bar)[XB_TMO])) break; if (_sp > XB_SPIN_CAP) { atomicAdd(&(bar)[XB_TMO], 1u); break; } } } } while (0)
struct XcdBarrier { unsigned* bar; unsigned x; volatile LAS unsigned* st; };
__device__ __forceinline__ XcdBarrier xcd_barrier_post(unsigned* bar, volatile LAS unsigned* st) {
    XcdBarrier b; b.bar = bar; b.x = xb_xcc_id(); b.st = st;
    if (threadIdx.x == 0) (void)xb_add(&bar[XB_XCNT(b.x)], 1u);
    return b;
}
__device__ __forceinline__ void xcd_barrier_complete(unsigned* bar, unsigned x, unsigned& nloc, unsigned& nx) {
    const unsigned G = gridDim.x * gridDim.y * gridDim.z;
    unsigned sum, cnt, mine, sp = 0u;
    for (;;) {
        sum = 0u; cnt = 0u; mine = 0u;
#pragma unroll
        for (unsigned j = 0; j < 16; ++j) { const unsigned c = xb_ld(&bar[XB_XCNT(j)]); sum += c; cnt += (c > 0u) ? 1u : 0u; mine = (j == x) ? c : mine; }
        if (sum == G) break;
        __builtin_amdgcn_s_sleep(1);
        if ((++sp & 255u) == 0u) { if (xb_ld(&bar[XB_TMO])) break; if (sp > XB_SPIN_CAP) { atomicAdd(&bar[XB_TMO], 1u); break; } }
    }
    nloc = mine > 0u ? mine : 1u; nx = cnt > 0u ? cnt : 1u;
}
__device__ __forceinline__ void xcd_barrier(const XcdBarrier& b) {
    asm volatile("s_waitcnt vmcnt(0)" ::: "memory");
    __syncthreads();
    if (threadIdx.x == 0) {
        unsigned* bar = b.bar;
        __builtin_amdgcn_s_waitcnt(0);
        unsigned nloc = b.st[0], nx = b.st[1];
        if (nloc == 0u) { xcd_barrier_complete(bar, b.x, nloc, nx); b.st[0] = nloc; b.st[1] = nx; }
        const unsigned old = xb_add(&bar[XB_XSUB(b.x)], 1u);
        const unsigned gen = old / nloc;
        if (old + 1u == (gen + 1u) * nloc) {
            __builtin_amdgcn_fence(__ATOMIC_RELEASE, "agent");
            asm volatile("s_waitcnt vmcnt(0)" ::: "memory");
            const unsigned og = xb_add(&bar[XB_TOP], 1u);
            const unsigned tg = og / nx;
            if (og + 1u == (tg + 1u) * nx) xb_add(&bar[XB_TOPGEN], 1u);
            else XB_SPIN(xb_ld(&bar[XB_TOPGEN]) == tg, bar);
            __builtin_amdgcn_fence(__ATOMIC_ACQUIRE, "agent");
            xb_add(&bar[XB_XGEN(b.x)], 1u);
            asm volatile("s_waitcnt vmcnt(0)" ::: "memory");
        } else {
            XB_SPIN(xb_ld(&bar[XB_XGEN(b.x)]) == gen, bar);
            __builtin_amdgcn_fence(__ATOMIC_ACQUIRE, "agent");
            asm volatile("s_waitcnt vmcnt(0)" ::: "memory");
        }
    }
    __syncthreads();
}

__device__ __forceinline__ size_t opz() { size_t z = 0; asm volatile("" : "+s"(z)); return z; }
#define WSP(T, off) ((T*)(P.ws + opz() + (off)))
#define XBAR() do { XcdBarrier _b; _b.bar = (unsigned*)(P.ws + opz() + WS_CTL); _b.x = (unsigned)__builtin_amdgcn_readfirstlane((int)xb_xcc_id()); _b.st = (volatile LAS unsigned*)(lds + 131072); xcd_barrier(_b); } while (0)
__global__ void __launch_bounds__(NTHREADS, 2) fwd_megakernel(Params P) {
    extern __shared__ __attribute__((aligned(16))) unsigned char lds_raw[];
    LAS unsigned char* lds = (LAS unsigned char*)lds_raw;
    cg::grid_group grid = cg::this_grid();
    const int G = ogrid(), bid = blockIdx.x;
    volatile LAS unsigned* xst = (volatile LAS unsigned*)(lds + 131072);
    if (threadIdx.x < 4) xst[threadIdx.x] = 0u;
    __syncthreads();
    (void)xcd_barrier_post((unsigned*)(P.ws + WS_CTL), xst);

    phase_prologue(P, lds);
    grid.sync();
    XBAR();

    for (int pr = 0; pr < 3; ++pr) {
        const int ngr = pr < 2 ? 2 : 1, g0 = 2 * pr, seqlen = pr < 2 ? 4096 : 16384, MM = ngr * MG;
        for (int gi = 0; gi < ngr; ++gi) { const int grp = g0 + gi;
            const float* xin = grp < 4 ? P.x_prompt + (size_t)grp * MG * D : P.x_sample;
            phase_init(xin, WSP(bf16_t, WS_XB) + (size_t)gi * MG * D, WSP(float, WS_ROWSS1) + (size_t)gi * MG * 16, WSP(float, WS_ROWSS2)); }
        XBAR();
        for (int l = 0; l < DEPTH; ++l) {
            const size_t wl = WS_W + (size_t)l * W_LAYER;
            for (int gi = 0; gi < ngr; ++gi) {
                const size_t xoff = (size_t)gi * MG * D, roff = (size_t)gi * MG * 16;
                { pg8::Gemm g{WSP(bf16_t, WS_XB) + xoff, WSP(const bf16_t, wl + W_IN_OFF), MG, NPROJ, D};
                  pg8::P1Order S; S.init(G, bid, WSP(const bf16_t, wl + W_IN_OFF + (size_t)NPROJ * D * 2));
                  LAS float* rl = (LAS float*)(lds + LDS_RSTD_OFF); fill_rstd(rl, WSP(float, WS_ROWSS1) + roff, S, -1);
                  pg8::EpiP1 E{pg8::EpiRowScale{WSP(bf16_t, WS_PROJ), NPROJ, rl}, pg8::EpiColScale{WSP(bf16_t, WS_PROJT), MG, rl}}; pg8::gemm_phase(lds, g, S, E); }
                XBAR();
                { { const int tid = otid(), wv = __builtin_amdgcn_readfirstlane(tid >> 6), ln = tid & 63;
                    const int vb = (G == 256) ? (bid & 7) * 32 + (bid >> 3) : bid;
                    for (int it = vb * 8 + wv; it < 2048; it += G * 8) na_item(WSP(bf16_t, WS_PROJ), WSP(bf16_t, WS_PROJT), WSP(bf16_t, WS_A), P.na_rel_bias + (size_t)l * 8 * 465, it, seqlen, lds, wv, ln);
                    __syncthreads(); }
                  for (int it = bid; it < 512; it += G) { const int h = it & 3;
                      const float* tab = WSP(const float, WS_LG2) + (l * 4 + h) * 2; const float lgf2 = tab[0], lgb2 = tab[1];
                      r1_item(WSP(bf16_t, WS_PROJT), WSP(bf16_t, WS_STLOC), WSP(float, WS_COST), WSP(float, WS_SINT), lgf2, lgb2, it, seqlen, lds); } }
                XBAR();
                phase_scan(WSP(bf16_t, WS_STLOC), WSP(bf16_t, WS_ST), P.dec_f + l * 4, P.dec_b + l * 4, seqlen);
                XBAR();
                for (int it = bid; it < 512; it += G) { const int h = it & 3;
                    const float* tab = WSP(const float, WS_LG2) + (l * 4 + h) * 2; const float lgf2 = tab[0], lgb2 = tab[1];
                    r3_item(WSP(bf16_t, WS_PROJ), WSP(bf16_t, WS_PROJT), WSP(bf16_t, WS_ST), WSP(bf16_t, WS_A), WSP(float, WS_COSN), WSP(float, WS_SINN), P.ret_norm_g + (size_t)l * 1024, lgf2, lgb2, it, seqlen, lds); }
                XBAR();
                { pg8::Gemm g{WSP(bf16_t, WS_A), WSP(const bf16_t, wl + W_A_OFF), MG, D, 1536}; pg8::StaticOrder S; S.init(MG, D, G, bid);
                  pg8::EpiMerge E{WSP(bf16_t, WS_PROJ) + 3072, WSP(bf16_t, WS_PROJ) + 4096, WSP(bf16_t, WS_MIXED2) + xoff}; pg8::gemm_phase(lds, g, S, E); }
                XBAR();
            }
            { pg8::Gemm g{WSP(bf16_t, WS_MIXED2), WSP(const bf16_t, wl + W_O_OFF), MM, D, D}; pg8::StaticOrder S; S.init(MM, D, G, bid);
              pg8::EpiResid E{WSP(bf16_t, WS_XB), WSP(float, WS_ROWSS2)}; pg8::gemm_phase(lds, g, S, E); }
            XBAR();
            { pg8::Gemm g{WSP(bf16_t, WS_XB), WSP(const bf16_t, wl + W_UP_OFF), MM, DFF2, D}; pg8::StaticOrder S; S.init(MM, DFF2, G, bid);
              LAS float* rl = (LAS float*)(lds + LDS_RSTD_OFF); fill_rstd(rl, WSP(float, WS_ROWSS2), S, 0);
              pg8::EpiRowScale E{WSP(bf16_t, WS_U), DFF2, rl}; pg8::gemm_phase(lds, g, S, E); }
            XBAR();
            phase_convact(WSP(bf16_t, WS_U), WSP(bf16_t, WS_ACT), P.conv_w + (size_t)l * 3 * DFF2, seqlen, MM);
            XBAR();
            { pg8::Gemm g{WSP(bf16_t, WS_ACT), WSP(const bf16_t, wl + W_D_OFF), MM, D, DFF}; pg8::StaticOrder S; S.init(MM, D, G, bid);
              pg8::EpiResid E{WSP(bf16_t, WS_XB), WSP(float, WS_ROWSS1)}; pg8::gemm_phase(lds, g, S, E); }
            XBAR();
        }
        for (int gi = 0; gi < ngr; ++gi) { const int grp = g0 + gi;
            phase_final(WSP(bf16_t, WS_XB) + (size_t)gi * MG * D, P.out + (size_t)grp * MG * D, WSP(float, WS_ROWSS1) + (size_t)gi * MG * 16, P.norm_final_g); }
        XBAR();
    }
}

extern "C" void kernel_launch(void* const* d_in, const int* in_sizes, int n_in, void* d_out, int out_size, void* d_ws, size_t ws_size, hipStream_t stream) {
    static int grid_blocks = 0;
    if (grid_blocks == 0) {
        if (n_in != 16 || ws_size < WS_END) { fprintf(stderr, "kernel_launch: unexpected n_in %d or ws_size %zu (< %zu)\n", n_in, ws_size, (size_t)WS_END); grid_blocks = -1; return; }
        int dev = 0, cus = 0, per_cu = 0;
        hipGetDevice(&dev);
        hipDeviceGetAttribute(&cus, hipDeviceAttributeMultiprocessorCount, dev);
        if (hipFuncSetAttribute((const void*)fwd_megakernel, hipFuncAttributeMaxDynamicSharedMemorySize, LDS_BYTES) != hipSuccess) { fprintf(stderr, "kernel_launch: hipFuncSetAttribute failed\n"); grid_blocks = -1; return; }
        hipOccupancyMaxActiveBlocksPerMultiprocessor(&per_cu, (const void*)fwd_megakernel, NTHREADS, LDS_BYTES);
        if (per_cu < 1) { fprintf(stderr, "kernel_launch: occupancy query says %d blocks per CU\n", per_cu); per_cu = 1; }
        (void)hipGetLastError();
        grid_blocks = cus;
    }
    if (grid_blocks < 0) return;
    if (hipMemsetAsync((char*)d_ws + WS_CTL, 0, 16384, stream) != hipSuccess) { fprintf(stderr, "kernel_launch: memset of barrier words failed\n"); return; }
    Params p{};
    p.x_prompt = (const float*)d_in[0]; p.x_sample = (const float*)d_in[1]; p.norm_mix_g = (const float*)d_in[2]; p.w_in = (const float*)d_in[3]; p.na_rel_bias = (const float*)d_in[4];
    p.dec_f = (const float*)d_in[5]; p.dec_b = (const float*)d_in[6]; p.ret_norm_g = (const float*)d_in[7]; p.w_ba = (const float*)d_in[8]; p.w_br = (const float*)d_in[9]; p.w_out = (const float*)d_in[10];
    p.norm_ffn_g = (const float*)d_in[11]; p.w_up = (const float*)d_in[12]; p.conv_w = (const float*)d_in[13]; p.w_down = (const float*)d_in[14]; p.norm_final_g = (const float*)d_in[15];
    p.out = (float*)d_out; p.ws = (unsigned char*)d_ws;
    void* args[] = {&p};
    hipError_t e = hipLaunchCooperativeKernel((const void*)fwd_megakernel, dim3(grid_blocks), dim3(NTHREADS), args, LDS_BYTES, stream);
    if (e != hipSuccess) fprintf(stderr, "kernel_launch: cooperative launch failed: %s (grid %d)\n", hipGetErrorString(e), grid_blocks);
}
```

```cpp
#include <hip/hip_runtime.h>
#include <hip/hip_cooperative_groups.h>
#include <cstdio>
namespace cg = cooperative_groups;

#define LAS __attribute__((address_space(3)))
typedef unsigned short bf16_t;
typedef short bf16x8 __attribute__((ext_vector_type(8)));
typedef short bf16x4 __attribute__((ext_vector_type(4)));
typedef float f32x4 __attribute__((ext_vector_type(4)));
typedef float f32x16 __attribute__((ext_vector_type(16)));
typedef unsigned u32x4 __attribute__((ext_vector_type(4)));
typedef unsigned u32x2 __attribute__((ext_vector_type(2)));

constexpr int D = 1024, MG = 16384, NPROJ = 5120, NPT = 2048, DFF = 2816, DFF2 = 5632, DEPTH = 4, NGROUPS = 5, DIN = 6656;
constexpr float EPS = 1e-6f;
constexpr int NTHREADS = 512;
constexpr int LDS_RSTD_OFF = 131072 + 1024;
constexpr int LDS_BYTES = 131072 + 1024 + 12288;

constexpr size_t WS_CTL = 0;
constexpr size_t WS_LG2 = 32768;
constexpr size_t WS_ROWSS1 = 262144;
constexpr size_t WS_ROWSS2 = WS_ROWSS1 + (size_t)2 * MG * 16 * 4;
constexpr size_t WS_COSN = WS_ROWSS2 + (size_t)2 * MG * 16 * 4;
constexpr size_t TAB_BYTES = (size_t)16384 * 64 * 4;
constexpr size_t WS_SINN = WS_COSN + TAB_BYTES;
constexpr size_t WS_COST = WS_SINN + TAB_BYTES;
constexpr size_t WS_SINT = WS_COST + TAB_BYTES;
constexpr size_t WS_W = WS_SINT + TAB_BYTES;
constexpr size_t W_IN_OFF = 0;
constexpr size_t W_A_OFF = W_IN_OFF + (size_t)7168 * 1024 * 2;
constexpr size_t W_R_OFF = W_A_OFF + (size_t)1024 * 512 * 2;
constexpr size_t W_O_OFF = W_R_OFF + (size_t)1024 * 1024 * 2;
constexpr size_t W_UP_OFF = W_O_OFF + (size_t)1024 * 1024 * 2;
constexpr size_t W_D_OFF = W_UP_OFF + (size_t)5632 * 1024 * 2;
constexpr size_t W_LAYER = W_D_OFF + (size_t)1024 * 2816 * 2;
constexpr size_t WS_XB = WS_W + W_LAYER * DEPTH;
constexpr size_t WS_S = WS_XB + (size_t)2 * MG * D * 2;
constexpr size_t WS_PROJ = WS_S;
constexpr size_t WS_PROJT = WS_PROJ + (size_t)MG * NPROJ * 2;
constexpr size_t WS_A = WS_PROJT + (size_t)NPT * MG * 2;
constexpr size_t WS_MIXED = WS_A + (size_t)MG * 1536 * 2;
constexpr size_t WS_STLOC = WS_MIXED + (size_t)MG * D * 2;
constexpr size_t WS_ST = WS_STLOC + (size_t)128 * 4 * 2 * 32768 * 2;
constexpr size_t WS_MIX_END = WS_ST + (size_t)128 * 4 * 2 * 32768 * 2;
constexpr size_t WS_U = WS_S;
constexpr size_t WS_ACT = WS_U + (size_t)2 * MG * DFF2 * 2;
constexpr size_t WS_FFN_END = WS_ACT + (size_t)2 * MG * DFF * 2;
constexpr size_t WS_MIXED2 = WS_MIX_END > WS_FFN_END ? WS_MIX_END : WS_FFN_END;
constexpr size_t WS_END = WS_MIXED2 + (size_t)2 * MG * D * 2;
static_assert(WS_END <= ((size_t)1 << 30), "workspace over 1 GiB");

struct Params {
    const float* x_prompt; const float* x_sample; const float* norm_mix_g; const float* w_in; const float* na_rel_bias;
    const float* dec_f; const float* dec_b; const float* ret_norm_g; const float* w_ba; const float* w_br; const float* w_out;
    const float* norm_ffn_g; const float* w_up; const float* conv_w; const float* w_down; const float* norm_final_g;
    float* out; unsigned char* ws;
};

typedef __bf16 bf16v2_t __attribute__((ext_vector_type(2)));
typedef float f32v2_t __attribute__((ext_vector_type(2)));
__device__ __forceinline__ unsigned cvt_pk_bf16(float lo, float hi) { const f32v2_t v = {lo, hi}; const bf16v2_t r = __builtin_convertvector(v, bf16v2_t); return __builtin_bit_cast(unsigned, r); }
__device__ __forceinline__ float bf_lo(unsigned w) { return __uint_as_float(w << 16); }
__device__ __forceinline__ float bf_hi(unsigned w) { return __uint_as_float(w & 0xffff0000u); }
__device__ __forceinline__ float bf2f(bf16_t b) { return __uint_as_float(((unsigned)b) << 16); }
__device__ __forceinline__ float sigmoidf_(float x) { return __builtin_amdgcn_rcpf(1.0f + __expf(-x)); }
__device__ __forceinline__ void unpack8(const u32x4 w, float* f) { f[0] = bf_lo(w.x); f[1] = bf_hi(w.x); f[2] = bf_lo(w.y); f[3] = bf_hi(w.y); f[4] = bf_lo(w.z); f[5] = bf_hi(w.z); f[6] = bf_lo(w.w); f[7] = bf_hi(w.w); }
__device__ __forceinline__ u32x4 pack8(const float* f) { u32x4 w; w.x = cvt_pk_bf16(f[0], f[1]); w.y = cvt_pk_bf16(f[2], f[3]); w.z = cvt_pk_bf16(f[4], f[5]); w.w = cvt_pk_bf16(f[6], f[7]); return w; }
__device__ __forceinline__ f32x16 mfma32(bf16x8 a, bf16x8 b, f32x16 c) { return __builtin_amdgcn_mfma_f32_32x32x16_bf16(a, b, c, 0, 0, 0); }
__device__ __forceinline__ int otid() { int t = threadIdx.x; asm volatile("" : "+v"(t)); return t; }
__device__ __forceinline__ int ogrid() { int g = gridDim.x; asm volatile("" : "+s"(g)); return g; }
__device__ __forceinline__ f32x16 zero16() { return (f32x16){0.f, 0.f, 0.f, 0.f, 0.f, 0.f, 0.f, 0.f, 0.f, 0.f, 0.f, 0.f, 0.f, 0.f, 0.f, 0.f}; }
__device__ __forceinline__ float sum16(const float* p) { const f32x4 a = *(const f32x4*)p, b = *(const f32x4*)(p + 4), c = *(const f32x4*)(p + 8), d = *(const f32x4*)(p + 12); const f32x4 t = (a + b) + (c + d); return (t[0] + t[1]) + (t[2] + t[3]); }
__device__ __forceinline__ float shx(float v, int m, int lane) { return __int_as_float(__builtin_amdgcn_ds_bpermute((lane ^ m) << 2, __float_as_int(v))); }
__device__ __forceinline__ float xhalf_max(float x) { const auto rr = __builtin_amdgcn_permlane32_swap(__float_as_uint(x), __float_as_uint(x), false, false); return fmaxf(__uint_as_float(rr[0]), __uint_as_float(rr[1])); }
__device__ __forceinline__ float xhalf_sum(float x) { const auto rr = __builtin_amdgcn_permlane32_swap(__float_as_uint(x), __float_as_uint(x), false, false); return __uint_as_float(rr[0]) + __uint_as_float(rr[1]); }
__device__ __forceinline__ float wave_sum(float v, int lane) { v += shx(v, 32, lane); v += shx(v, 16, lane); v += shx(v, 8, lane); v += shx(v, 4, lane); v += shx(v, 2, lane); v += shx(v, 1, lane); return v; }

namespace pg8 {
constexpr int BM = 256, BK = 64, HALF = 128, HTB = HALF * BK * 2, STAGE_BYTES = 8 * HTB, NXCD = 8, WGM = 8;
__host__ __device__ __forceinline__ int lds_byte(int r, int c) { const int st = (r >> 4) * 2 + (c >> 5), rr = r & 15, cc = c & 31, ob = rr * 64 + cc * 2; return st * 1024 + (ob ^ (((ob >> 9) & 1) << 5)); }
__host__ __device__ __forceinline__ void stage_rc(int b, int& R, int& C) { const int st = b / 1024, sb = b % 1024, swz = sb ^ (((sb >> 9) & 1) << 5); R = (st >> 1) * 16 + swz / 64; C = (st & 1) * 32 + (swz % 64) / 2; }
__host__ __device__ __forceinline__ int perm32(int rho) { const int n = rho >> 4, i = rho & 15; return 8 * (i >> 2) + 4 * n + (i & 3); }
struct Unit { int pm, pn, idx, kind; };
struct Gemm { const bf16_t* A; const bf16_t* Bt; int M, N, K; };
struct StaticOrder {
    int nM, nN, nwg, G, c;
    __host__ __device__ void init(int M, int N, int G_, int c_) { nM = M / BM; nN = N / BM; nwg = nM * nN; G = G_; c = c_; }
    __host__ __device__ bool next(int i, Unit& u) const { return at((long)i * G + c, u); }
    __host__ __device__ bool at(long L, Unit& u) const {
        if (L >= nwg) return false;
        u.kind = 0;
        int wgid = (int)L; { const int q = nwg / NXCD, r = nwg % NXCD, xcd = wgid % NXCD, off = wgid / NXCD; wgid = (xcd < r ? xcd * (q + 1) : r * (q + 1) + (xcd - r) * q) + off; }
        const int nig = WGM * nN, gid = wgid / nig, fm = gid * WGM, gsz = (nM - fm) < WGM ? (nM - fm) : WGM;
        u.pm = fm + ((wgid % nig) % gsz); u.pn = (wgid % nig) / gsz; return true;
    }
    __device__ __forceinline__ void a_ready(const Unit&) const {}
    __device__ __forceinline__ void done(const Unit&) const {}
    __device__ __forceinline__ const char* abase(const Gemm& g, const Unit& u, size_t tstep) const { return (const char*)g.A + (size_t)u.pm * tstep; }
    __device__ __forceinline__ const char* bbase(const Gemm& g, const Unit& u, size_t tstep) const { return (const char*)g.Bt + (size_t)u.pn * tstep; }
};
struct P1Order {
    StaticOrder s0, s1; int G, c; const bf16_t* wt2;
    __device__ void init(int G_, int c_, const bf16_t* wt2_) { s0.init(MG, NPROJ, G_, c_); s1.init(NPT, MG, G_, c_); G = G_; c = c_; wt2 = wt2_; }
    __device__ bool next(int i, Unit& u) const { const long L = (long)i * G + c; if (L < 1280) return s0.at(L, u); if (!s1.at(L - 1280, u)) return false; u.kind = 1; return true; }
    __device__ __forceinline__ void a_ready(const Unit&) const {}
    __device__ __forceinline__ void done(const Unit&) const {}
    __device__ __forceinline__ const char* abase(const Gemm& g, const Unit& u, size_t tstep) const { return (u.kind ? (const char*)wt2 : (const char*)g.A) + (size_t)u.pm * tstep; }
    __device__ __forceinline__ const char* bbase(const Gemm& g, const Unit& u, size_t tstep) const { return (u.kind ? (const char*)g.A : (const char*)g.Bt) + (size_t)u.pn * tstep; }
};

template <class Epi, class Sched>
__device__ __forceinline__ void gemm_phase(LAS unsigned char* lds, const Gemm g, const Sched& S, const Epi& E) {
    const int tid = otid(), wid = __builtin_amdgcn_readfirstlane(tid >> 6), lane = tid & 63, wr = wid >> 2, wc = wid & 3, fr = lane & 15, fq = lane >> 4;
    const int K = g.K, nt = K / BK;
    unsigned voffA[2], voffB[2];
#pragma unroll
    for (int i = 0; i < 2; ++i) { int R, C; stage_rc(tid * 16 + i * 8192, R, C); const int Rb = Epi::PERM ? ((R & ~31) + perm32(R & 31)) : R;
        voffA[i] = (unsigned)(R * K + C) * 2u; voffB[i] = (unsigned)(Rb * K + C) * 2u; }
    const size_t kstep = (size_t)(BK * 2);
    const size_t hstep = (size_t)HALF * K * 2;
    const size_t tstep = 2 * hstep;
    const unsigned ldsw = (unsigned)wid * 1024u;
    const int aoff = lds_byte(wr * 64 + fr, fq * 8), boff = lds_byte(wc * 32 + fr, fq * 8);
#define PG8_SA(b, h) (((b) * 2 + (h)) * HTB)
#define PG8_SB(b, h) ((4 + (b) * 2 + (h)) * HTB)
#define PG8_STAGE(bufoff, gbase, voff) do { _Pragma("unroll") for (int _i = 0; _i < 2; ++_i) \
        __builtin_amdgcn_global_load_lds((const unsigned*)((const char*)(gbase) + (voff)[_i]), (LAS unsigned*)(lds + (bufoff) + ldsw + _i * 8192), 16, 0, 0); } while (0)
#define PG8_LDA(dst, b, h) do { _Pragma("unroll") for (int m = 0; m < 4; ++m) _Pragma("unroll") for (int k = 0; k < 2; ++k) dst[m][k] = *(const LAS bf16x8*)(lds + PG8_SA(b, h) + aoff + m * 2048 + k * 1024); } while (0)
#define PG8_LDB(dst, b, h) do { _Pragma("unroll") for (int n = 0; n < 2; ++n) _Pragma("unroll") for (int k = 0; k < 2; ++k) dst[n][k] = *(const LAS bf16x8*)(lds + PG8_SB(b, h) + boff + n * 2048 + k * 1024); } while (0)
#define PG8_MMA(ai, bj, At, Bt) do { __builtin_amdgcn_s_setprio(1); _Pragma("unroll") for (int m = 0; m < 4; ++m) _Pragma("unroll") for (int n = 0; n < 2; ++n) _Pragma("unroll") for (int k = 0; k < 2; ++k) \
        acc[ai][bj][m][n] = __builtin_amdgcn_mfma_f32_16x16x32_bf16(Bt[n][k], At[m][k], acc[ai][bj][m][n], 0, 0, 0); __builtin_amdgcn_s_setprio(0); } while (0)
#define PG8_WAIT_V(n) asm volatile("s_waitcnt vmcnt(" #n ")" ::: "memory")
#define PG8_WAIT_L(n) asm volatile("s_waitcnt lgkmcnt(" #n ")" ::: "memory")
#define PG8_BAR __builtin_amdgcn_s_barrier()
#define PG8_SCHED __builtin_amdgcn_sched_barrier(0)
    Unit cur, nxt; int ui = 0;
    if (!S.next(0, cur)) return;
    cur.idx = 0;
    f32x4 acc[2][2][4][2];
#pragma unroll
    for (int a = 0; a < 2; ++a)
#pragma unroll
        for (int b = 0; b < 2; ++b)
#pragma unroll
            for (int m = 0; m < 4; ++m)
#pragma unroll
                for (int n = 0; n < 2; ++n) acc[a][b][m][n] = (f32x4){0.f, 0.f, 0.f, 0.f};
    bf16x8 At[4][2], B0[2][2], B1[2][2];
    const char* cA = S.abase(g, cur, tstep); const char* cB = S.bbase(g, cur, tstep);
    S.a_ready(cur);
    PG8_STAGE(PG8_SB(0, 0), cB, voffB); PG8_STAGE(PG8_SA(0, 0), cA, voffA); PG8_STAGE(PG8_SB(0, 1), cB + hstep, voffB); PG8_STAGE(PG8_SA(0, 1), cA + hstep, voffA);
    if (wr == 1) PG8_BAR;
    PG8_WAIT_V(4); PG8_BAR;
    PG8_STAGE(PG8_SB(1, 0), cB + kstep, voffB); PG8_STAGE(PG8_SA(1, 0), cA + kstep, voffA); PG8_STAGE(PG8_SB(1, 1), cB + hstep + kstep, voffB);
    PG8_WAIT_V(6); PG8_BAR;
    for (;;) {
        const bool has_next = S.next(ui + 1, nxt); nxt.idx = ui + 1;
        const char* nA = has_next ? S.abase(g, nxt, tstep) : cA; const char* nB = has_next ? S.bbase(g, nxt, tstep) : cB;
        for (int t = 0; t < nt; t += 2) {
            const bool last = (t == nt - 2);
            const char* a1 = cA + (size_t)(t + 1) * kstep;
            const char* a2 = last ? nA : cA + (size_t)(t + 2) * kstep; const char* b2 = last ? nB : cB + (size_t)(t + 2) * kstep;
            const char* a3 = a2 + kstep; const char* b3 = b2 + kstep;
            if (last && has_next) S.a_ready(nxt);
            if constexpr (Epi::MID > 0) { if (t == Epi::MID) E.mid(acc, cur, wr, wc, fr, fq); }
            PG8_LDB(B0, 0, 0); PG8_SCHED; PG8_LDA(At, 0, 0); PG8_STAGE(PG8_SA(1, 1), a1 + hstep, voffA);
            PG8_WAIT_L(8); PG8_BAR; PG8_WAIT_L(0); PG8_MMA(0, 0, At, B0); PG8_BAR; PG8_SCHED;
            PG8_LDB(B1, 0, 1); PG8_STAGE(PG8_SB(0, 0), b2, voffB);
            PG8_BAR; PG8_WAIT_L(0); PG8_MMA(0, 1, At, B1); PG8_BAR;
            PG8_LDA(At, 0, 1); PG8_STAGE(PG8_SA(0, 0), a2, voffA);
            PG8_BAR; PG8_WAIT_L(0); PG8_MMA(1, 0, At, B0); PG8_BAR; PG8_SCHED;
            PG8_STAGE(PG8_SB(0, 1), b2 + hstep, voffB);
            PG8_WAIT_V(6); PG8_BAR; PG8_MMA(1, 1, At, B1); PG8_BAR;
            PG8_LDB(B0, 1, 0); PG8_SCHED; PG8_LDA(At, 1, 0); PG8_STAGE(PG8_SA(0, 1), a2 + hstep, voffA);
            PG8_WAIT_L(8); PG8_BAR; PG8_WAIT_L(0); PG8_MMA(0, 0, At, B0); PG8_BAR; PG8_SCHED;
            PG8_LDB(B1, 1, 1); PG8_STAGE(PG8_SB(1, 0), b3, voffB);
            PG8_BAR; PG8_WAIT_L(0); PG8_MMA(0, 1, At, B1); PG8_BAR;
            PG8_LDA(At, 1, 1); PG8_STAGE(PG8_SA(1, 0), a3, voffA);
            PG8_BAR; PG8_WAIT_L(0); PG8_MMA(1, 0, At, B0); PG8_BAR; PG8_SCHED;
            PG8_STAGE(PG8_SB(1, 1), b3 + hstep, voffB);
            PG8_WAIT_V(6); PG8_BAR; PG8_MMA(1, 1, At, B1); PG8_BAR;
        }
        E(acc, cur, wr, wc, fr, fq); S.done(cur);
        if (!has_next) break;
#pragma unroll
        for (int a = 0; a < 2; ++a)
#pragma unroll
            for (int b = 0; b < 2; ++b)
#pragma unroll
                for (int m = 0; m < 4; ++m)
#pragma unroll
                    for (int n = 0; n < 2; ++n) acc[a][b][m][n] = (f32x4){0.f, 0.f, 0.f, 0.f};
        cur = nxt; cA = nA; cB = nB; ++ui;
    }
    PG8_WAIT_V(0);
    if (wr == 0) PG8_BAR;
    PG8_BAR;
#undef PG8_SA
#undef PG8_SB
#undef PG8_STAGE
#undef PG8_LDA
#undef PG8_LDB
#undef PG8_MMA
#undef PG8_WAIT_V
#undef PG8_WAIT_L
#undef PG8_BAR
#undef PG8_SCHED
}

struct EpiRowScale {
    static constexpr bool PERM = true; static constexpr int MID = 0;
    bf16_t* O; int ldc; const LAS float* rl;
    __device__ __forceinline__ void operator()(const f32x4 (&acc)[2][2][4][2], const Unit& u, int wr, int wc, int fr, int fq) const {
        const int row0 = u.pm * BM + wr * 64 + fr, col0 = u.pn * BM + wc * 32 + 8 * fq;
#pragma unroll
        for (int ai = 0; ai < 2; ++ai)
#pragma unroll
            for (int m = 0; m < 4; ++m) { const int row = row0 + ai * HALF + m * 16; const float rs = rl[u.idx * 256 + wr * 64 + fr + ai * HALF + m * 16];
                bf16_t* rowp = O + (size_t)row * ldc + col0;
#pragma unroll
                for (int bj = 0; bj < 2; ++bj) { const f32x4 v0 = acc[ai][bj][m][0] * rs, v1 = acc[ai][bj][m][1] * rs;
                    u32x4 w; w.x = cvt_pk_bf16(v0[0], v0[1]); w.y = cvt_pk_bf16(v0[2], v0[3]); w.z = cvt_pk_bf16(v1[0], v1[1]); w.w = cvt_pk_bf16(v1[2], v1[3]);
                    *(u32x4*)(rowp + bj * HALF) = w; } }
    }
};
struct EpiColScale {
    static constexpr bool PERM = true; static constexpr int MID = 0;
    bf16_t* O; int ldc; const LAS float* rl;
    __device__ __forceinline__ void operator()(const f32x4 (&acc)[2][2][4][2], const Unit& u, int wr, int wc, int fr, int fq) const {
        const int row0 = u.pm * BM + wr * 64 + fr, col0 = u.pn * BM + wc * 32 + 8 * fq;
        f32x4 sc[2][2];
#pragma unroll
        for (int bj = 0; bj < 2; ++bj)
#pragma unroll
            for (int n = 0; n < 2; ++n) sc[bj][n] = *(const LAS f32x4*)(rl + u.idx * 256 + wc * 32 + 8 * fq + bj * HALF + 4 * n);
#pragma unroll
        for (int ai = 0; ai < 2; ++ai)
#pragma unroll
            for (int m = 0; m < 4; ++m) { const int row = row0 + ai * HALF + m * 16; bf16_t* rowp = O + (size_t)row * ldc + col0;
#pragma unroll
                for (int bj = 0; bj < 2; ++bj) { const f32x4 v0 = acc[ai][bj][m][0] * sc[bj][0], v1 = acc[ai][bj][m][1] * sc[bj][1];
                    u32x4 w; w.x = cvt_pk_bf16(v0[0], v0[1]); w.y = cvt_pk_bf16(v0[2], v0[3]); w.z = cvt_pk_bf16(v1[0], v1[1]); w.w = cvt_pk_bf16(v1[2], v1[3]);
                    *(u32x4*)(rowp + bj * HALF) = w; } }
    }
};
struct EpiP1 {
    static constexpr bool PERM = true; static constexpr int MID = 0;
    EpiRowScale e0; EpiColScale e1;
    __device__ __forceinline__ void operator()(const f32x4 (&acc)[2][2][4][2], const Unit& u, int wr, int wc, int fr, int fq) const { if (u.kind == 0) e0(acc, u, wr, wc, fr, fq); else e1(acc, u, wr, wc, fr, fq); }
};
struct EpiGate {
    static constexpr bool PERM = true; static constexpr int MID = 0;
    const bf16_t* gate; const bf16_t* addsrc; bf16_t* O;
    __device__ __forceinline__ void operator()(const f32x4 (&acc)[2][2][4][2], const Unit& u, int wr, int wc, int fr, int fq) const {
        const int row0 = u.pm * BM + wr * 64 + fr, col0 = u.pn * BM + wc * 32 + 8 * fq;
#pragma unroll
        for (int ai = 0; ai < 2; ++ai)
#pragma unroll
            for (int m = 0; m < 4; ++m) { const int row = row0 + ai * HALF + m * 16;
#pragma unroll
                for (int bj = 0; bj < 2; ++bj) { const int col = col0 + bj * HALF;
                    float gf[8], r[8]; unpack8(*(const u32x4*)(gate + (size_t)row * NPROJ + col), gf);
                    const f32x4 v0 = acc[ai][bj][m][0], v1 = acc[ai][bj][m][1];
#pragma unroll
                    for (int j = 0; j < 4; ++j) { r[j] = v0[j] * sigmoidf_(gf[j]); r[4 + j] = v1[j] * sigmoidf_(gf[4 + j]); }
                    if (addsrc) { float af[8]; unpack8(*(const u32x4*)(addsrc + (size_t)row * D + col), af);
#pragma unroll
                        for (int j = 0; j < 8; ++j) r[j] += af[j]; }
                    *(u32x4*)(O + (size_t)row * D + col) = pack8(r); } }
    }
};
struct EpiMerge {
    static constexpr bool PERM = true; static constexpr int MID = 8;
    const bf16_t* ga; const bf16_t* gr; bf16_t* O;
    __device__ __forceinline__ void mid(f32x4 (&acc)[2][2][4][2], const Unit& u, int wr, int wc, int fr, int fq) const {
        const int row0 = u.pm * BM + wr * 64 + fr, col0 = u.pn * BM + wc * 32 + 8 * fq;
#pragma unroll
        for (int ai = 0; ai < 2; ++ai)
#pragma unroll
            for (int m = 0; m < 4; ++m) { int row = row0 + ai * HALF + m * 16; asm volatile("" : "+v"(row));
#pragma unroll
                for (int bj = 0; bj < 2; ++bj) { const size_t off = (size_t)row * NPROJ + col0 + bj * HALF;
                    float fa[8], fb[8]; unpack8(*(const u32x4*)(ga + off), fa); unpack8(*(const u32x4*)(gr + off), fb);
#pragma unroll
                    for (int j = 0; j < 8; ++j) { const float rt = (1.0f + __builtin_amdgcn_exp2f(fb[j] * -1.4426950408889634f)) * __builtin_amdgcn_rcpf(1.0f + __builtin_amdgcn_exp2f(fa[j] * -1.4426950408889634f));
                        if (j < 4) acc[ai][bj][m][0][j] *= rt; else acc[ai][bj][m][1][j - 4] *= rt; } }
                asm volatile("" ::: "memory"); }
    }
    __device__ __forceinline__ void operator()(const f32x4 (&acc)[2][2][4][2], const Unit& u, int wr, int wc, int fr, int fq) const {
        const int row0 = u.pm * BM + wr * 64 + fr, col0 = u.pn * BM + wc * 32 + 8 * fq;
#pragma unroll
        for (int ai = 0; ai < 2; ++ai)
#pragma unroll
            for (int m = 0; m < 4; ++m) { const int row = row0 + ai * HALF + m * 16;
#pragma unroll
                for (int bj = 0; bj < 2; ++bj) { const int col = col0 + bj * HALF;
                    float gf[8], r[8]; unpack8(*(const u32x4*)(gr + (size_t)row * NPROJ + col), gf);
                    const f32x4 v0 = acc[ai][bj][m][0], v1 = acc[ai][bj][m][1];
#pragma unroll
                    for (int j = 0; j < 4; ++j) { r[j] = v0[j] * sigmoidf_(gf[j]); r[4 + j] = v1[j] * sigmoidf_(gf[4 + j]); }
                    *(u32x4*)(O + (size_t)row * D + col) = pack8(r); } }
    }
};
struct EpiResid {
    static constexpr bool PERM = true; static constexpr int MID = 0;
    bf16_t* xb; float* rowss;
    __device__ __forceinline__ void operator()(const f32x4 (&acc)[2][2][4][2], const Unit& u, int wr, int wc, int fr, int fq) const {
        const int row0 = u.pm * BM + wr * 64 + fr, col0 = u.pn * BM + wc * 32 + 8 * fq;
#pragma unroll
        for (int ai = 0; ai < 2; ++ai)
#pragma unroll
            for (int m = 0; m < 4; ++m) { const int row = row0 + ai * HALF + m * 16; float ss = 0.f;
#pragma unroll
                for (int bj = 0; bj < 2; ++bj) { const size_t off = (size_t)row * D + col0 + bj * HALF;
                    float b[8], r[8]; unpack8(*(const u32x4*)(xb + off), b);
                    const f32x4 v0 = acc[ai][bj][m][0], v1 = acc[ai][bj][m][1];
#pragma unroll
                    for (int j = 0; j < 4; ++j) { b[j] += v0[j]; b[4 + j] += v1[j]; }
                    const u32x4 w = pack8(b);
                    *(u32x4*)(xb + off) = w;
                    unpack8(w, r);
#pragma unroll
                    for (int j = 0; j < 8; ++j) ss += r[j] * r[j]; }
                { const int ln = fr + 16 * fq; ss += shx(ss, 16, ln); ss += shx(ss, 32, ln); }
                if (fq == 0) rowss[(size_t)row * 16 + u.pn * 4 + wc] = ss; }
    }
};
}

template <class Sched> __device__ __forceinline__ void fill_rstd(LAS float* rl, const float* rowss, const Sched& S, int by_col  ) {
    const int tid = otid();
    for (int e = tid; e < 12 * 256; e += NTHREADS) { pg8::Unit u; const int i = e >> 8;
        if (S.next(i, u)) { const bool bc = by_col < 0 ? (u.kind != 0) : (by_col != 0); const int r = (bc ? u.pn : u.pm) * 256 + (e & 255); rl[e] = rsqrtf(sum16(rowss + (size_t)r * 16) * (1.0f / 1024.0f) + EPS); } }
    __syncthreads();
}

__device__ __forceinline__ int win_srccol(int nd) {
    if (nd < 1024) return nd;
    if (nd < 1536) return 1536 + (nd - 1024);
    if (nd < 2048) return 2048 + (nd - 1536);
    if (nd < 3072) return 3584 + (nd - 2048);
    if (nd < 4096) return 4608 + (nd - 3072);
    if (nd < 5120) return 5632 + (nd - 4096);
    nd -= 5120;
    if (nd < 512) return 1024 + nd;
    if (nd < 1024) return 2048 + (nd - 512);
    return 2560 + (nd - 1024);
}
struct TileJob { const float* src; const float* gsc; bf16_t* dst; int ld_src, k0, nsrc0, ldd, ndst0, kdst0; };
__device__ __forceinline__ TileJob tile_job(const Params& P, int job) {
    constexpr int T_IN = 16 * 112, T_A = 8 * 16, T_R = 16 * 16, T_O = 16 * 16, T_UP = 16 * 88, T_D = 44 * 16, T_L = T_IN + T_A + T_R + T_O + T_UP + T_D;
    const int l = job / T_L; int r = job % T_L;
    unsigned char* wl = P.ws + WS_W + (size_t)l * W_LAYER;
    TileJob j;
    if (r < T_IN) { const int kt = r / 112, nt = r % 112; j = TileJob{P.w_in + (size_t)l * D * DIN, P.norm_mix_g + l * D, (bf16_t*)(wl + W_IN_OFF), DIN, kt * 64, win_srccol(nt * 64), 1024, nt * 64, 0}; return j; }
    r -= T_IN;
    if (r < T_A) { const int kt = r / 16, nt = r % 16; j = TileJob{P.w_ba + (size_t)l * 512 * D, nullptr, (bf16_t*)(wl + W_A_OFF), D, kt * 64, nt * 64, 1536, nt * 64, 0}; return j; }
    r -= T_A;
    if (r < T_R) { const int kt = r / 16, nt = r % 16; j = TileJob{P.w_br + (size_t)l * D * D, nullptr, (bf16_t*)(wl + W_A_OFF), D, kt * 64, nt * 64, 1536, nt * 64, 512}; return j; }
    r -= T_R;
    if (r < T_O) { const int kt = r / 16, nt = r % 16; j = TileJob{P.w_out + (size_t)l * D * D, nullptr, (bf16_t*)(wl + W_O_OFF), D, kt * 64, nt * 64, 1024, nt * 64, 0}; return j; }
    r -= T_O;
    if (r < T_UP) { const int kt = r / 88, nt = r % 88; j = TileJob{P.w_up + (size_t)l * D * DFF2, P.norm_ffn_g + l * D, (bf16_t*)(wl + W_UP_OFF), DFF2, kt * 64, nt * 64, 1024, nt * 64, 0}; return j; }
    r -= T_UP;
    { const int kt = r / 16, nt = r % 16; j = TileJob{P.w_down + (size_t)l * DFF * D, nullptr, (bf16_t*)(wl + W_D_OFF), D, kt * 64, nt * 64, DFF, nt * 64, 0}; return j; }
}
struct TileRegs { float4 v[2]; float s[2]; };
__device__ __forceinline__ void tile_load(TileRegs& tr, const TileJob& j, int t) {
#pragma unroll
    for (int i = 0; i < 2; ++i) { const int r = (t >> 4) + 32 * i, c = (t & 15) * 4;
        { const f32x4 t4 = __builtin_nontemporal_load((const f32x4*)(j.src + (size_t)(j.k0 + r) * j.ld_src + j.nsrc0 + c)); tr.v[i] = make_float4(t4[0], t4[1], t4[2], t4[3]); }
        tr.s[i] = j.gsc ? j.gsc[j.k0 + r] : 1.0f; }
}
__device__ __forceinline__ void tile_store(const TileRegs& tr, const TileJob& j, int t, LAS float* tile) {
#pragma unroll
    for (int i = 0; i < 2; ++i) { const int r = (t >> 4) + 32 * i, c = (t & 15) * 4; const float sc = tr.s[i];
        tile[r * 65 + c] = tr.v[i].x * sc; tile[r * 65 + c + 1] = tr.v[i].y * sc; tile[r * 65 + c + 2] = tr.v[i].z * sc; tile[r * 65 + c + 3] = tr.v[i].w * sc; }
    __syncthreads();
    { const int n = t >> 3, k8 = (t & 7) * 8; float f[8];
#pragma unroll
      for (int jj = 0; jj < 8; ++jj) f[jj] = tile[(k8 + jj) * 65 + n];
      *(u32x4*)(j.dst + (size_t)(j.ndst0 + n) * j.ldd + j.kdst0 + j.k0 + k8) = pack8(f); }
    __syncthreads();
}
__device__ __forceinline__ void phase_prologue(const Params& P, LAS unsigned char* lds) {
    LAS float* tile = (LAS float*)lds;
    constexpr int NJOBS = (16 * 112 + 8 * 16 + 16 * 16 + 16 * 16 + 16 * 88 + 44 * 16) * DEPTH;
    { const int t = otid(), G = ogrid();
      int job = blockIdx.x;
      if (job < NJOBS) { TileJob jc = tile_job(P, job); TileRegs rc; tile_load(rc, jc, t);
          while (true) { const int jn = job + G; const bool more = jn < NJOBS;
              TileJob jx = jc; TileRegs rx = rc; if (more) { jx = tile_job(P, jn); tile_load(rx, jx, t); }
              tile_store(rc, jc, t, tile);
              if (!more) break; jc = jx; rc = rx; job = jn; } } }
    if (blockIdx.x == 0 && otid() < DEPTH * 4) { const int i = otid(); float* tab = (float*)(P.ws + WS_LG2);
        tab[2 * i] = -log1pf(expf(-P.dec_f[i])) * 1.4426950408889634f; tab[2 * i + 1] = -log1pf(expf(-P.dec_b[i])) * 1.4426950408889634f; }
    float* cosN = (float*)(P.ws + WS_COSN); float* sinN = (float*)(P.ws + WS_SINN); float* cosT = (float*)(P.ws + WS_COST); float* sinT = (float*)(P.ws + WS_SINT);
    for (int idx = blockIdx.x * NTHREADS + otid(); idx < 16384 * 64; idx += ogrid() * NTHREADS) {
        const int pos = idx >> 6, i = idx & 63;
        const float invf = powf(10000.0f, -(float)i / 64.0f);
        const float ang = (float)pos * invf;
        const float c = cosf(ang), s = sinf(ang);
        cosN[idx] = c; sinN[idx] = s; cosT[(size_t)i * 16384 + pos] = c; sinT[(size_t)i * 16384 + pos] = s;
    }
}

__device__ __forceinline__ void phase_init(const float* __restrict__ xin, bf16_t* xb, float* rowss1, float* rowss2) {
    const int tid = otid(), lane = tid & 63, nw = ogrid() * 8;
    for (int row = blockIdx.x * 8 + (tid >> 6); row < MG; row += nw) {
        const float4* p = (const float4*)(xin + (size_t)row * D); float ss = 0.f;
#pragma unroll
        for (int i = 0; i < 4; ++i) { const f32x4 t4 = __builtin_nontemporal_load((const f32x4*)(p + lane + 64 * i)); const float4 v = make_float4(t4[0], t4[1], t4[2], t4[3]);
            u32x2 w; w.x = cvt_pk_bf16(v.x, v.y); w.y = cvt_pk_bf16(v.z, v.w); *(u32x2*)(xb + (size_t)row * D + (lane + 64 * i) * 4) = w;
            const float a0 = bf_lo(w.x), a1 = bf_hi(w.x), a2 = bf_lo(w.y), a3 = bf_hi(w.y); ss += a0 * a0 + a1 * a1 + a2 * a2 + a3 * a3; }
        ss = wave_sum(ss, lane);
        if (lane < 16) rowss1[(size_t)row * 16 + lane] = lane == 0 ? ss : 0.f;
    }
}
__device__ __forceinline__ void phase_final(const bf16_t* __restrict__ xb, float* xo, const float* rowss1, const float* __restrict__ gfin) {
    const int tid = otid(), lane = tid & 63, nw = ogrid() * 8;
    for (int row = blockIdx.x * 8 + (tid >> 6); row < MG; row += nw) {
        const float rs = rsqrtf(sum16(rowss1 + (size_t)row * 16) * (1.0f / 1024.0f) + EPS);
#pragma unroll
        for (int i = 0; i < 2; ++i) { const int c8 = (lane + 64 * i) * 8; float x[8]; unpack8(__builtin_nontemporal_load((const u32x4*)(xb + (size_t)row * D + c8)), x);
            const f32x4 g0 = *(const f32x4*)(gfin + c8), g1 = *(const f32x4*)(gfin + c8 + 4);
            __builtin_nontemporal_store((f32x4){x[0] * rs * g0[0], x[1] * rs * g0[1], x[2] * rs * g0[2], x[3] * rs * g0[3]}, (f32x4*)(xo + (size_t)row * D + c8));
            __builtin_nontemporal_store((f32x4){x[4] * rs * g1[0], x[5] * rs * g1[1], x[6] * rs * g1[2], x[7] * rs * g1[3]}, (f32x4*)(xo + (size_t)row * D + c8 + 4)); }
    }
}
__device__ __forceinline__ float gelu_tanh(float x) { const float t = fmaf(x * x, -0.10294324f, -2.30220819f);
    return x * __builtin_amdgcn_rcpf(1.0f + __builtin_amdgcn_exp2f(x * t)); }
__device__ __forceinline__ void phase_convact(const bf16_t* __restrict__ u, bf16_t* act, const float* __restrict__ cw  , int seqlen, int nrows) {
    const int gt = blockIdx.x * NTHREADS + otid(), nth = ogrid() * NTHREADS;
    int nr = nrows; asm volatile("" : "+s"(nr));
    const int ntask = (nr >> 3) * 352;
    for (int id = gt; id < ntask; id += nth) {
        const int tb = id / 352, c = (id % 352) * 8, t0 = tb * 8;
        const u32x4 z = (u32x4){0u, 0u, 0u, 0u};
        u32x4 g[10], v[10];
        const bool has_prev = (t0 & (seqlen - 1)) != 0, has_next = ((t0 + 8) & (seqlen - 1)) != 0;
#pragma unroll
        for (int r = 0; r < 10; ++r) { const bool ok = (r == 0) ? has_prev : ((r == 9) ? has_next : true);
            g[r] = z; v[r] = z;
            if (ok) { g[r] = __builtin_nontemporal_load((const u32x4*)(u + (size_t)(t0 - 1 + r) * DFF2 + c)); v[r] = __builtin_nontemporal_load((const u32x4*)(u + (size_t)(t0 - 1 + r) * DFF2 + DFF + c)); } }
        float wg[3][8], wv[3][8];
#pragma unroll
        for (int k = 0; k < 3; ++k) {
            const f32x4 a0 = *(const f32x4*)(cw + k * DFF2 + c), a1 = *(const f32x4*)(cw + k * DFF2 + c + 4);
            const f32x4 b0 = *(const f32x4*)(cw + k * DFF2 + DFF + c), b1 = *(const f32x4*)(cw + k * DFF2 + DFF + c + 4);
#pragma unroll
            for (int j = 0; j < 4; ++j) { wg[k][j] = a0[j]; wg[k][4 + j] = a1[j]; wv[k][j] = b0[j]; wv[k][4 + j] = b1[j]; } }
#pragma unroll
        for (int i = 0; i < 8; ++i) {
            float a[8], b[8], cc[8], r[8], gg[8], vv[8];
            unpack8(g[i], a); unpack8(g[i + 1], b); unpack8(g[i + 2], cc);
#pragma unroll
            for (int j = 0; j < 8; ++j) gg[j] = a[j] * wg[0][j] + b[j] * wg[1][j] + cc[j] * wg[2][j];
            unpack8(v[i], a); unpack8(v[i + 1], b); unpack8(v[i + 2], cc);
#pragma unroll
            for (int j = 0; j < 8; ++j) vv[j] = a[j] * wv[0][j] + b[j] * wv[1][j] + cc[j] * wv[2][j];
#pragma unroll
            for (int j = 0; j < 8; ++j) r[j] = gelu_tanh(gg[j]) * vv[j];
            *(u32x4*)(act + (size_t)(t0 + i) * DFF + c) = pack8(r);
        }
    }
}

constexpr int NA_LDS_WAVE = 12288;
struct NaFrags { bf16x8 k[4]; u32x2 v[2][2][2]; };
__device__ __forceinline__ void na_load(NaFrags& f, const bf16_t* __restrict__ proj, const bf16_t* __restrict__ projT, int ktok, int h, int c, int hh) {
    const bf16_t* kp = proj + (size_t)(ktok + c) * NPROJ + 512 + h * 64 + 8 * hh;
#pragma unroll
    for (int s = 0; s < 4; ++s) f.k[s] = *(const bf16x8*)(kp + 16 * s);
#pragma unroll
    for (int dt = 0; dt < 2; ++dt)
#pragma unroll
        for (int s2 = 0; s2 < 2; ++s2) { const bf16_t* vp = projT + (size_t)(h * 64 + dt * 32 + c) * MG + (ktok + 16 * s2 + 4 * hh);
            f.v[dt][s2][0] = *(const u32x2*)vp; f.v[dt][s2][1] = *(const u32x2*)(vp + 8); }
}
__device__ __forceinline__ void na_item(const bf16_t* __restrict__ proj, const bf16_t* __restrict__ projT, bf16_t* aout, const float* __restrict__ relb  , int item, int seqlen, LAS unsigned char* lds, int w, int lane) {
    const int c = lane & 31, hh = lane >> 5;
    const int R = item >> 3, h = item & 7;
    const int rps = seqlen >> 6, seq = R / rps, r = R % rps;
    int rs = r - 4; rs = rs < 0 ? 0 : rs; rs = rs > rps - 8 ? rps - 8 : rs;
    const int qtok0 = seq * seqlen + r * 64, ktok0 = seq * seqlen + rs * 64;
    LAS float* bias = (LAS float*)(lds + w * NA_LDS_WAVE) + 64;
    LAS bf16_t* Otile = (LAS bf16_t*)(lds + w * NA_LDS_WAVE + 3072);
    for (int i = lane; i < 768; i += 64) { const int j = i - 64; bias[j] = (j >= 0 && j < 465) ? relb[h * 465 + j] * 1.4426950408889634f : 0.f; }
    bf16x8 qf[2][4];
#pragma unroll
    for (int qh = 0; qh < 2; ++qh) { const bf16_t* qp = proj + (size_t)(qtok0 + 32 * qh + c) * NPROJ + h * 64 + 8 * hh;
#pragma unroll
        for (int s = 0; s < 4; ++s) qf[qh][s] = *(const bf16x8*)(qp + 16 * s); }
    f32x16 O[2][2];
    float mrun[2], lrun[2]; int cs[2];
#pragma unroll
    for (int qh = 0; qh < 2; ++qh) { O[qh][0] = zero16(); O[qh][1] = zero16(); mrun[qh] = -1e30f; lrun[qh] = 0.f;
        int x = 32 * qh + c - 8; x = x < 0 ? 0 : x; x = x > 48 ? 48 : x; cs[qh] = x; }
    NaFrags cur, nxt;
    na_load(cur, proj, projT, ktok0, h, c, hh);
#pragma unroll 1
    for (int t = 0; t < 16; ++t) {
        if (t + 1 < 16) na_load(nxt, proj, projT, ktok0 + 32 * (t + 1), h, c, hh);
        const int kr = rs + (t >> 1), chalf = t & 1, brow = (kr - r + 7) * 31;
#pragma unroll
        for (int qh = 0; qh < 2; ++qh) {
            f32x16 x = zero16();
#pragma unroll
            for (int s = 0; s < 4; ++s) x = mfma32(cur.k[s], qf[qh][s], x);
            const int qc = 32 * qh + c; float mt = -1e30f;
#pragma unroll
            for (int rg = 0; rg < 16; ++rg) { const int kc = 32 * chalf + (rg & 3) + 8 * (rg >> 2) + 4 * hh;
                const bool valid = (kc >= cs[qh]) && (kc < cs[qh] + 16);
                const float sv = fmaf(x[rg], 0.18033688011112042f, bias[brow + kc - qc + 15]) + (valid ? 0.f : -__builtin_inff());
                x[rg] = sv; mt = fmaxf(mt, sv); }
            mt = xhalf_max(mt);
            if (__builtin_amdgcn_ballot_w64(mt > mrun[qh] + 8.0f) != 0ull) {
                const float mnew = fmaxf(mrun[qh], mt), alpha = __builtin_amdgcn_exp2f(mrun[qh] - mnew);
                mrun[qh] = mnew; lrun[qh] *= alpha; O[qh][0] *= alpha; O[qh][1] *= alpha; }
            const float mcur = mrun[qh];
            float ps = 0.f;
#pragma unroll
            for (int rg = 0; rg < 16; ++rg) { const float p = __builtin_amdgcn_exp2f(x[rg] - mcur); x[rg] = p; ps += p; }
            lrun[qh] += ps;
#pragma unroll
            for (int s2 = 0; s2 < 2; ++s2) {
                u32x4 pw; pw.x = cvt_pk_bf16(x[8 * s2 + 0], x[8 * s2 + 1]); pw.y = cvt_pk_bf16(x[8 * s2 + 2], x[8 * s2 + 3]); pw.z = cvt_pk_bf16(x[8 * s2 + 4], x[8 * s2 + 5]); pw.w = cvt_pk_bf16(x[8 * s2 + 6], x[8 * s2 + 7]);
                const bf16x8 pb = __builtin_bit_cast(bf16x8, pw);
#pragma unroll
                for (int dt = 0; dt < 2; ++dt) { u32x4 aw; aw.x = cur.v[dt][s2][0].x; aw.y = cur.v[dt][s2][0].y; aw.z = cur.v[dt][s2][1].x; aw.w = cur.v[dt][s2][1].y;
                    O[qh][dt] = mfma32(__builtin_bit_cast(bf16x8, aw), pb, O[qh][dt]); } }
        }
        cur = nxt;
    }
#pragma unroll
    for (int qh = 0; qh < 2; ++qh) { const float inv = __builtin_amdgcn_rcpf(xhalf_sum(lrun[qh]));
#pragma unroll
        for (int dt = 0; dt < 2; ++dt)
#pragma unroll
            for (int g4 = 0; g4 < 4; ++g4) { u32x2 pw; pw.x = cvt_pk_bf16(O[qh][dt][4 * g4] * inv, O[qh][dt][4 * g4 + 1] * inv); pw.y = cvt_pk_bf16(O[qh][dt][4 * g4 + 2] * inv, O[qh][dt][4 * g4 + 3] * inv);
                *(LAS u32x2*)(Otile + (32 * qh + c) * 72 + dt * 32 + 8 * g4 + 4 * hh) = pw; } }
#pragma unroll
    for (int i = 0; i < 8; ++i) { const int id = lane + 64 * i, q = id >> 3, d8 = (id & 7) * 8;
        *(u32x4*)(aout + (size_t)(qtok0 + q) * 1536 + h * 64 + d8) = *(const LAS u32x4*)(Otile + q * 72 + d8); }
}

constexpr int KT_STRIDE = 136;
__device__ __forceinline__ void r1_item(const bf16_t* __restrict__ projT, bf16_t* stloc, const float* __restrict__ cosT, const float* __restrict__ sinT, float lgf2, float lgb2, int item, int seqlen, LAS unsigned char* lds) {
    const int tid = otid(), w = __builtin_amdgcn_readfirstlane(tid >> 6), lane = tid & 63, c = lane & 31, hh = lane >> 5;
    const int ch = item >> 2, h = item & 3, tok0 = ch * 128, pos0 = tok0 % seqlen;
    LAS bf16_t* KTf = (LAS bf16_t*)lds; LAS bf16_t* KTb = (LAS bf16_t*)(lds + 128 * KT_STRIDE * 2);
    const float scale = 0.08838834764831845f;
    bf16x8 af[8];
    { const bf16_t* vp = projT + (size_t)(1024 + h * 256 + 32 * w + c) * MG + tok0 + 8 * hh;
#pragma unroll
      for (int s = 0; s < 8; ++s) af[s] = *(const bf16x8*)(vp + 16 * s); }
#pragma unroll
    for (int it = 0; it < 2; ++it) {
        const int id = tid + NTHREADS * it, d = id >> 4, t8 = id & 15;
        float k1[8], k2[8];
        unpack8(__builtin_nontemporal_load((const u32x4*)(projT + (size_t)(512 + h * 128 + d) * MG + tok0 + 8 * t8)), k1);
        unpack8(__builtin_nontemporal_load((const u32x4*)(projT + (size_t)(512 + h * 128 + d + 64) * MG + tok0 + 8 * t8)), k2);
        const f32x4 c0 = *(const f32x4*)(cosT + (size_t)d * 16384 + pos0 + 8 * t8), c1 = *(const f32x4*)(cosT + (size_t)d * 16384 + pos0 + 8 * t8 + 4);
        const f32x4 s0 = *(const f32x4*)(sinT + (size_t)d * 16384 + pos0 + 8 * t8), s1 = *(const f32x4*)(sinT + (size_t)d * 16384 + pos0 + 8 * t8 + 4);
        float f1[8], f2[8], b1[8], b2[8];
#pragma unroll
        for (int j = 0; j < 8; ++j) { const float cv = j < 4 ? c0[j & 3] : c1[j & 3], sv = j < 4 ? s0[j & 3] : s1[j & 3];
            const float r1 = (k1[j] * cv - k2[j] * sv) * scale, r2 = (k1[j] * sv + k2[j] * cv) * scale;
            const int tl = 8 * t8 + j; const float df = __builtin_amdgcn_exp2f((float)(127 - tl) * lgf2), db = __builtin_amdgcn_exp2f((float)tl * lgb2);
            f1[j] = r1 * df; f2[j] = r2 * df; b1[j] = r1 * db; b2[j] = r2 * db; }
        *(LAS u32x4*)(KTf + d * KT_STRIDE + 8 * t8) = pack8(f1); *(LAS u32x4*)(KTf + (d + 64) * KT_STRIDE + 8 * t8) = pack8(f2);
        *(LAS u32x4*)(KTb + d * KT_STRIDE + 8 * t8) = pack8(b1); *(LAS u32x4*)(KTb + (d + 64) * KT_STRIDE + 8 * t8) = pack8(b2);
    }
    __syncthreads();
#pragma unroll
    for (int dir = 0; dir < 2; ++dir) {
        LAS bf16_t* KT = dir ? KTb : KTf;
        bf16_t* dst = stloc + ((size_t)(ch * 4 + h) * 2 + dir) * 32768;
#pragma unroll
        for (int ct = 0; ct < 4; ++ct) {
            f32x16 acc = zero16();
#pragma unroll
            for (int s = 0; s < 8; ++s) { const bf16x8 bfr = *(const LAS bf16x8*)(KT + (32 * ct + c) * KT_STRIDE + 16 * s + 8 * hh); acc = mfma32(af[s], bfr, acc); }
#pragma unroll
            for (int rg = 0; rg < 16; ++rg) { const int dv = 32 * w + (rg & 3) + 8 * (rg >> 2) + 4 * hh; dst[dv * 128 + 32 * ct + c] = (bf16_t)(cvt_pk_bf16(acc[rg], 0.f) & 0xffffu); }
        }
    }
    __syncthreads();
}

__device__ __forceinline__ void phase_scan(const bf16_t* __restrict__ stloc, bf16_t* st, const float* __restrict__ decf, const float* __restrict__ decb, int seqlen) {
    const int gt = blockIdx.x * NTHREADS + otid(), nth = ogrid() * NTHREADS;
    constexpr size_t CSTR = (size_t)4 * 2 * 32768;
    if (seqlen == 4096) {
        constexpr int NCH = 32, NTASK = 4 * 4 * 2 * 4096;
        for (int id = gt; id < NTASK; id += nth) {
            const int e8 = id & 4095, dir = (id >> 12) & 1, h = (id >> 13) & 3, seq = id >> 15;
            const float x = dir ? decb[h] : decf[h]; const float cd = exp2f(-128.0f * log1pf(expf(-x)) * 1.4426950408889634f);
            const size_t base = ((size_t)(seq * NCH * 4 + h) * 2 + dir) * 32768 + (size_t)e8 * 8;
            float zz = 0.f; asm volatile("" : "+v"(zz));
            float S[8];
#pragma unroll
            for (int j = 0; j < 8; ++j) S[j] = zz;
            for (int i0 = 0; i0 < NCH; i0 += 8) {
                u32x4 loc[8];
#pragma unroll
                for (int j = 0; j < 8; ++j) { const int ci = dir ? (NCH - 1 - (i0 + j)) : (i0 + j); loc[j] = __builtin_nontemporal_load((const u32x4*)(stloc + base + (size_t)ci * CSTR)); }
#pragma unroll
                for (int j = 0; j < 8; ++j) { const int ci = dir ? (NCH - 1 - (i0 + j)) : (i0 + j);
                    *(u32x4*)(st + base + (size_t)ci * CSTR) = pack8(S);
                    float lf[8]; unpack8(loc[j], lf);
#pragma unroll
                    for (int k = 0; k < 8; ++k) S[k] = S[k] * cd + lf[k]; }
            }
        }
    } else {
        constexpr int NCH = 128, NTASK = 4 * 2 * 16384;
        for (int id = gt; id < NTASK; id += nth) {
            const int e2 = id & 16383, dir = (id >> 14) & 1, h = (id >> 15) & 3;
            const float x = dir ? decb[h] : decf[h]; const float cd = exp2f(-128.0f * log1pf(expf(-x)) * 1.4426950408889634f);
            const size_t base = ((size_t)h * 2 + dir) * 32768 + (size_t)e2 * 2;
            float zz = 0.f; asm volatile("" : "+v"(zz));
            float S0 = zz, S1 = zz;
            for (int i0 = 0; i0 < NCH; i0 += 8) {
                unsigned loc[8];
#pragma unroll
                for (int j = 0; j < 8; ++j) { const int ci = dir ? (NCH - 1 - (i0 + j)) : (i0 + j); loc[j] = __builtin_nontemporal_load((const unsigned*)(stloc + base + (size_t)ci * CSTR)); }
#pragma unroll
                for (int j = 0; j < 8; ++j) { const int ci = dir ? (NCH - 1 - (i0 + j)) : (i0 + j);
                    *(unsigned*)(st + base + (size_t)ci * CSTR) = cvt_pk_bf16(S0, S1);
                    S0 = S0 * cd + bf_lo(loc[j]); S1 = S1 * cd + bf_hi(loc[j]); }
            }
        }
    }
}

constexpr int OL_STRIDE = 264;
__device__ __forceinline__ void r3_item(const bf16_t* __restrict__ proj, const bf16_t* __restrict__ projT, const bf16_t* __restrict__ st, bf16_t* ro,
                        const float* __restrict__ cosN, const float* __restrict__ sinN, const float* __restrict__ gn  , float lgf2, float lgb2,
                        int item, int seqlen, LAS unsigned char* lds) {
    const int tid = otid(), w = __builtin_amdgcn_readfirstlane(tid >> 6), lane = tid & 63, c = lane & 31, hh = lane >> 5;
    const int ch = item >> 2, h = item & 3, tok0 = ch * 128, pos0 = tok0 % seqlen;
    LAS bf16_t* Ql = (LAS bf16_t*)lds; LAS bf16_t* Kl = (LAS bf16_t*)(lds + 34816); LAS bf16_t* Pl = (LAS bf16_t*)(lds + 69632);
    LAS float* stat = (LAS float*)(lds + 104448);
    LAS bf16_t* Ol = (LAS bf16_t*)lds;
    const float scale = 0.08838834764831845f;
    bf16x8 asb[8], asf[8], avt[8];
    const size_t stb0 = ((size_t)(ch * 4 + h) * 2) * 32768 + (size_t)(32 * w + c) * 128 + 8 * hh;
#pragma unroll
    for (int s = 0; s < 8; ++s) asb[s] = *(const bf16x8*)(st + stb0 + 32768 + 16 * s);
#pragma unroll
    for (int it = 0; it < 2; ++it) {
        const int id = tid + NTHREADS * it, t = id >> 3, d8 = (id & 7) * 8;
        const f32x4 c0 = *(const f32x4*)(cosN + (size_t)(pos0 + t) * 64 + d8), c1 = *(const f32x4*)(cosN + (size_t)(pos0 + t) * 64 + d8 + 4);
        const f32x4 s0 = *(const f32x4*)(sinN + (size_t)(pos0 + t) * 64 + d8), s1 = *(const f32x4*)(sinN + (size_t)(pos0 + t) * 64 + d8 + 4);
        float a[8], b[8], o1[8], o2[8];
        const bf16_t* qp = proj + (size_t)(tok0 + t) * NPROJ + 1024 + h * 128 + d8;
        unpack8(__builtin_nontemporal_load((const u32x4*)qp), a); unpack8(__builtin_nontemporal_load((const u32x4*)(qp + 64)), b);
#pragma unroll
        for (int j = 0; j < 8; ++j) { const float cv = j < 4 ? c0[j & 3] : c1[j & 3], sv = j < 4 ? s0[j & 3] : s1[j & 3]; o1[j] = a[j] * cv - b[j] * sv; o2[j] = a[j] * sv + b[j] * cv; }
        *(LAS u32x4*)(Ql + t * KT_STRIDE + d8) = pack8(o1); *(LAS u32x4*)(Ql + t * KT_STRIDE + 64 + d8) = pack8(o2);
        const bf16_t* kp = proj + (size_t)(tok0 + t) * NPROJ + 1536 + h * 128 + d8;
        unpack8(__builtin_nontemporal_load((const u32x4*)kp), a); unpack8(__builtin_nontemporal_load((const u32x4*)(kp + 64)), b);
#pragma unroll
        for (int j = 0; j < 8; ++j) { const float cv = j < 4 ? c0[j & 3] : c1[j & 3], sv = j < 4 ? s0[j & 3] : s1[j & 3]; o1[j] = (a[j] * cv - b[j] * sv) * scale; o2[j] = (a[j] * sv + b[j] * cv) * scale; }
        *(LAS u32x4*)(Kl + t * KT_STRIDE + d8) = pack8(o1); *(LAS u32x4*)(Kl + t * KT_STRIDE + 64 + d8) = pack8(o2);
    }
    __syncthreads();
    { const int kt = w >> 1;
#pragma unroll
      for (int q2 = 0; q2 < 2; ++q2) { const int tqt = 2 * (w & 1) + q2;
          f32x16 x = zero16();
#pragma unroll
          for (int s = 0; s < 8; ++s) { const bf16x8 kf = *(const LAS bf16x8*)(Kl + (32 * kt + c) * KT_STRIDE + 16 * s + 8 * hh);
              const bf16x8 qf = *(const LAS bf16x8*)(Ql + (32 * tqt + c) * KT_STRIDE + 16 * s + 8 * hh); x = mfma32(kf, qf, x); }
          const int n = 32 * tqt + c;
#pragma unroll
          for (int g4 = 0; g4 < 4; ++g4) { float pv[4];
#pragma unroll
              for (int j = 0; j < 4; ++j) { const int mk = 32 * kt + 8 * g4 + 4 * hh + j; const int diff = n - mk;
                  const float dec = __builtin_amdgcn_exp2f(diff >= 0 ? (float)diff * lgf2 : (float)(-diff) * lgb2); pv[j] = x[4 * g4 + j] * dec; }
              u32x2 pw; pw.x = cvt_pk_bf16(pv[0], pv[1]); pw.y = cvt_pk_bf16(pv[2], pv[3]);
              *(LAS u32x2*)(Pl + n * KT_STRIDE + 32 * kt + 8 * g4 + 4 * hh) = pw; } } }
    __syncthreads();
    f32x16 acc[4];
#pragma unroll
    for (int q = 0; q < 4; ++q) acc[q] = zero16();
    { const bf16_t* vp0 = projT + (size_t)(1024 + h * 256 + 32 * w + c) * MG + tok0 + 8 * hh;
#pragma unroll
      for (int s = 0; s < 8; ++s) { asf[s] = *(const bf16x8*)(st + stb0 + 16 * s); avt[s] = *(const bf16x8*)(vp0 + 16 * s); } }
#pragma unroll
    for (int s = 0; s < 8; ++s) { const bf16x8 a = asb[s];
#pragma unroll
        for (int q = 0; q < 4; ++q) { const bf16x8 b = *(const LAS bf16x8*)(Ql + (32 * q + c) * KT_STRIDE + 16 * s + 8 * hh); acc[q] = mfma32(a, b, acc[q]); } }
#pragma unroll
    for (int q = 0; q < 4; ++q) { const int n = 32 * q + c; const float f = __builtin_amdgcn_exp2f((float)(128 - n) * lgb2 - (float)(n + 1) * lgf2); acc[q] *= f; }
#pragma unroll
    for (int s = 0; s < 8; ++s) { const bf16x8 a = asf[s];
#pragma unroll
        for (int q = 0; q < 4; ++q) { const bf16x8 b = *(const LAS bf16x8*)(Ql + (32 * q + c) * KT_STRIDE + 16 * s + 8 * hh); acc[q] = mfma32(a, b, acc[q]); } }
#pragma unroll
    for (int q = 0; q < 4; ++q) { const int n = 32 * q + c; const float f = __builtin_amdgcn_exp2f((float)(n + 1) * lgf2); acc[q] *= f; }
#pragma unroll
    for (int s = 0; s < 8; ++s) { const bf16x8 a = avt[s];
#pragma unroll
        for (int q = 0; q < 4; ++q) { const bf16x8 b = *(const LAS bf16x8*)(Pl + (32 * q + c) * KT_STRIDE + 16 * s + 8 * hh); acc[q] = mfma32(a, b, acc[q]); } }
#pragma unroll
    for (int q = 0; q < 4; ++q) { float s1 = 0.f, s2 = 0.f;
#pragma unroll
        for (int i = 0; i < 16; ++i) { s1 += acc[q][i]; s2 += acc[q][i] * acc[q][i]; }
        s1 = xhalf_sum(s1); s2 = xhalf_sum(s2);
        if (hh == 0) { stat[(w * 128 + 32 * q + c) * 2] = s1; stat[(w * 128 + 32 * q + c) * 2 + 1] = s2; } }
    __syncthreads();
#pragma unroll
    for (int q = 0; q < 4; ++q) { float s1 = 0.f, s2 = 0.f; const int n = 32 * q + c;
#pragma unroll
        for (int k = 0; k < 8; ++k) { s1 += stat[(k * 128 + n) * 2]; s2 += stat[(k * 128 + n) * 2 + 1]; }
        const float mu = s1 * (1.0f / 256.0f); float var = s2 * (1.0f / 256.0f) - mu * mu; var = var < 0.f ? 0.f : var; const float rs = rsqrtf(var + EPS);
#pragma unroll
        for (int g4 = 0; g4 < 4; ++g4) { u32x2 pw; pw.x = cvt_pk_bf16((acc[q][4 * g4] - mu) * rs, (acc[q][4 * g4 + 1] - mu) * rs); pw.y = cvt_pk_bf16((acc[q][4 * g4 + 2] - mu) * rs, (acc[q][4 * g4 + 3] - mu) * rs);
            *(LAS u32x2*)(Ol + n * OL_STRIDE + 32 * w + 8 * g4 + 4 * hh) = pw; } }
    __syncthreads();
#pragma unroll
    for (int it = 0; it < 8; ++it) { const int id = tid + NTHREADS * it, tq = id >> 5, d8 = (id & 31) * 8;
        float y[8], rg[8], o[8]; unpack8(*(const LAS u32x4*)(Ol + tq * OL_STRIDE + d8), y);
        unpack8(__builtin_nontemporal_load((const u32x4*)(proj + (size_t)(tok0 + tq) * NPROJ + 2048 + h * 256 + d8)), rg);
        const f32x4 g0 = *(const f32x4*)(gn + h * 256 + d8), g1 = *(const f32x4*)(gn + h * 256 + d8 + 4);
#pragma unroll
        for (int j = 0; j < 8; ++j) { const float gv = j < 4 ? g0[j & 3] : g1[j & 3]; o[j] = rg[j] * sigmoidf_(rg[j]) * y[j] * gv; }
        *(u32x4*)(ro + (size_t)(tok0 + tq) * 1536 + 512 + h * 256 + d8) = pack8(o); }
    __syncthreads();
}


#define XB_TMO      128
#define XB_XCNT(j)  (256  + 64 * (j))
#define XB_XSUB(j)  (1280 + 64 * (j))
#define XB_XGEN(j)  (2304 + 64 * (j))
#define XB_TOP      3328
#define XB_TOPGEN   3392
#define XCD_BAR_WORDS 3456
#define XB_SPIN_CAP (1u << 22)
__device__ __forceinline__ unsigned xb_ld(unsigned* p)              { return __hip_atomic_load(p, __ATOMIC_RELAXED, __HIP_MEMORY_SCOPE_AGENT); }
__device__ __forceinline__ unsigned xb_add(unsigned* p, unsigned v) { return __hip_atomic_fetch_add(p, v, __ATOMIC_RELAXED, __HIP_MEMORY_SCOPE_AGENT); }
__device__ __forceinline__ unsigned xb_xcc_id() { return (unsigned)__builtin_amdgcn_s_getreg((3 << 11) | 20) & 0xFu; }
#define XB_SPIN(cond, bar) do { unsigned _sp = 0; while (cond) { __builtin_amdgcn_s_sleep(1); \
    if ((++_sp & 255u) == 0u) { if (xb_ld(&(bar)[XB_TMO])) break; if (_sp > XB_SPIN_CAP) { atomicAdd(&(bar)[XB_TMO], 1u); break; } } } } while (0)
struct XcdBarrier { unsigned* bar; unsigned x; volatile LAS unsigned* st; };
__device__ __forceinline__ XcdBarrier xcd_barrier_post(unsigned* bar, volatile LAS unsigned* st) {
    XcdBarrier b; b.bar = bar; b.x = xb_xcc_id(); b.st = st;
    if (threadIdx.x == 0) (void)xb_add(&bar[XB_XCNT(b.x)], 1u);
    return b;
}
__device__ __forceinline__ void xcd_barrier_complete(unsigned* bar, unsigned x, unsigned& nloc, unsigned& nx) {
    const unsigned G = gridDim.x * gridDim.y * gridDim.z;
    unsigned sum, cnt, mine, sp = 0u;
    for (;;) {
        sum = 0u; cnt = 0u; mine = 0u;
#pragma unroll
        for (unsigned j = 0; j < 16; ++j) { const unsigned c = xb_ld(&bar[XB_XCNT(j)]); sum += c; cnt += (c > 0u) ? 1u : 0u; mine = (j == x) ? c : mine; }
        if (sum == G) break;
        __builtin_amdgcn_s_sleep(1);
        if ((++sp & 255u) == 0u) { if (xb_ld(&bar[XB_TMO])) break; if (sp > XB_SPIN_CAP) { atomicAdd(&bar[XB_TMO], 1u); break; } }
    }
    nloc = mine > 0u ? mine : 1u; nx = cnt > 0u ? cnt : 1u;
}
__device__ __forceinline__ void xcd_barrier(const XcdBarrier& b) {
    asm volatile("s_waitcnt vmcnt(0)" ::: "memory");
    __syncthreads();
    if (threadIdx.x == 0) {
        unsigned* bar = b.bar;
        __builtin_amdgcn_s_waitcnt(0);
        unsigned nloc = b.st[0], nx = b.st[1];
        if (nloc == 0u) { xcd_barrier_complete(bar, b.x, nloc, nx); b.st[0] = nloc; b.st[1] = nx; }
        const unsigned old = xb_add(&bar[XB_XSUB(b.x)], 1u);
        const unsigned gen = old / nloc;
        if (old + 1u == (gen + 1u) * nloc) {
            __builtin_amdgcn_fence(__ATOMIC_RELEASE, "agent");
            asm volatile("s_waitcnt vmcnt(0)" ::: "memory");
            const unsigned og = xb_add(&bar[XB_TOP], 1u);
            const unsigned tg = og / nx;
            if (og + 1u == (tg + 1u) * nx) xb_add(&bar[XB_TOPGEN], 1u);
            else XB_SPIN(xb_ld(&bar[XB_TOPGEN]) == tg, bar);
            __builtin_amdgcn_fence(__ATOMIC_ACQUIRE, "agent");
            xb_add(&bar[XB_XGEN(b.x)], 1u);
            asm volatile("s_waitcnt vmcnt(0)" ::: "memory");
        } else {
            XB_SPIN(xb_ld(&bar[XB_XGEN(b.x)]) == gen, bar);
            __builtin_amdgcn_fence(__ATOMIC_ACQUIRE, "agent");
            asm volatile("s_waitcnt vmcnt(0)" ::: "memory");
        }
    }
    __syncthreads();
}

__device__ __forceinline__ size_t opz() { size_t z = 0; asm volatile("" : "+s"(z)); return z; }
#define WSP(T, off) ((T*)(P.ws + opz() + (off)))
#define XBAR() do { XcdBarrier _b; _b.bar = (unsigned*)(P.ws + opz() + WS_CTL); _b.x = (unsigned)__builtin_amdgcn_readfirstlane((int)xb_xcc_id()); _b.st = (volatile LAS unsigned*)(lds + 131072); xcd_barrier(_b); } while (0)
__global__ void __launch_bounds__(NTHREADS, 2) fwd_megakernel(Params P) {
    extern __shared__ __attribute__((aligned(16))) unsigned char lds_raw[];
    LAS unsigned char* lds = (LAS unsigned char*)lds_raw;
    cg::grid_group grid = cg::this_grid();
    const int G = ogrid(), bid = blockIdx.x;
    volatile LAS unsigned* xst = (volatile LAS unsigned*)(lds + 131072);
    if (threadIdx.x < 4) xst[threadIdx.x] = 0u;
    __syncthreads();
    (void)xcd_barrier_post((unsigned*)(P.ws + WS_CTL), xst);

    phase_prologue(P, lds);
    grid.sync();
    XBAR();

    for (int pr = 0; pr < 3; ++pr) {
        const int ngr = pr < 2 ? 2 : 1, g0 = 2 * pr, seqlen = pr < 2 ? 4096 : 16384, MM = ngr * MG;
        for (int gi = 0; gi < ngr; ++gi) { const int grp = g0 + gi;
            const float* xin = grp < 4 ? P.x_prompt + (size_t)grp * MG * D : P.x_sample;
            phase_init(xin, WSP(bf16_t, WS_XB) + (size_t)gi * MG * D, WSP(float, WS_ROWSS1) + (size_t)gi * MG * 16, WSP(float, WS_ROWSS2)); }
        XBAR();
        for (int l = 0; l < DEPTH; ++l) {
            const size_t wl = WS_W + (size_t)l * W_LAYER;
            for (int gi = 0; gi < ngr; ++gi) {
                const size_t xoff = (size_t)gi * MG * D, roff = (size_t)gi * MG * 16;
                { pg8::Gemm g{WSP(bf16_t, WS_XB) + xoff, WSP(const bf16_t, wl + W_IN_OFF), MG, NPROJ, D};
                  pg8::P1Order S; S.init(G, bid, WSP(const bf16_t, wl + W_IN_OFF + (size_t)NPROJ * D * 2));
                  LAS float* rl = (LAS float*)(lds + LDS_RSTD_OFF); fill_rstd(rl, WSP(float, WS_ROWSS1) + roff, S, -1);
                  pg8::EpiP1 E{pg8::EpiRowScale{WSP(bf16_t, WS_PROJ), NPROJ, rl}, pg8::EpiColScale{WSP(bf16_t, WS_PROJT), MG, rl}}; pg8::gemm_phase(lds, g, S, E); }
                XBAR();
                { { const int tid = otid(), wv = __builtin_amdgcn_readfirstlane(tid >> 6), ln = tid & 63;
                    const int vb = (G == 256) ? (bid & 7) * 32 + (bid >> 3) : bid;
                    for (int it = vb * 8 + wv; it < 2048; it += G * 8) na_item(WSP(bf16_t, WS_PROJ), WSP(bf16_t, WS_PROJT), WSP(bf16_t, WS_A), P.na_rel_bias + (size_t)l * 8 * 465, it, seqlen, lds, wv, ln);
                    __syncthreads(); }
                  for (int it = bid; it < 512; it += G) { const int h = it & 3;
                      const float* tab = WSP(const float, WS_LG2) + (l * 4 + h) * 2; const float lgf2 = tab[0], lgb2 = tab[1];
                      r1_item(WSP(bf16_t, WS_PROJT), WSP(bf16_t, WS_STLOC), WSP(float, WS_COST), WSP(float, WS_SINT), lgf2, lgb2, it, seqlen, lds); } }
                XBAR();
                phase_scan(WSP(bf16_t, WS_STLOC), WSP(bf16_t, WS_ST), P.dec_f + l * 4, P.dec_b + l * 4, seqlen);
                XBAR();
                for (int it = bid; it < 512; it += G) { const int h = it & 3;
                    const float* tab = WSP(const float, WS_LG2) + (l * 4 + h) * 2; const float lgf2 = tab[0], lgb2 = tab[1];
                    r3_item(WSP(bf16_t, WS_PROJ), WSP(bf16_t, WS_PROJT), WSP(bf16_t, WS_ST), WSP(bf16_t, WS_A), WSP(float, WS_COSN), WSP(float, WS_SINN), P.ret_norm_g + (size_t)l * 1024, lgf2, lgb2, it, seqlen, lds); }
                XBAR();
                { pg8::Gemm g{WSP(bf16_t, WS_A), WSP(const bf16_t, wl + W_A_OFF), MG, D, 1536}; pg8::StaticOrder S; S.init(MG, D, G, bid);
                  pg8::EpiMerge E{WSP(bf16_t, WS_PROJ) + 3072, WSP(bf16_t, WS_PROJ) + 4096, WSP(bf16_t, WS_MIXED2) + xoff}; pg8::gemm_phase(lds, g, S, E); }
                XBAR();
            }
            { pg8::Gemm g{WSP(bf16_t, WS_MIXED2), WSP(const bf16_t, wl + W_O_OFF), MM, D, D}; pg8::StaticOrder S; S.init(MM, D, G, bid);
              pg8::EpiResid E{WSP(bf16_t, WS_XB), WSP(float, WS_ROWSS2)}; pg8::gemm_phase(lds, g, S, E); }
            XBAR();
            { pg8::Gemm g{WSP(bf16_t, WS_XB), WSP(const bf16_t, wl + W_UP_OFF), MM, DFF2, D}; pg8::StaticOrder S; S.init(MM, DFF2, G, bid);
              LAS float* rl = (LAS float*)(lds + LDS_RSTD_OFF); fill_rstd(rl, WSP(float, WS_ROWSS2), S, 0);
              pg8::EpiRowScale E{WSP(bf16_t, WS_U), DFF2, rl}; pg8::gemm_phase(lds, g, S, E); }
            XBAR();
            phase_convact(WSP(bf16_t, WS_U), WSP(bf16_t, WS_ACT), P.conv_w + (size_t)l * 3 * DFF2, seqlen, MM);
            XBAR();
            { pg8::Gemm g{WSP(bf16_t, WS_ACT), WSP(const bf16_t, wl + W_D_OFF), MM, D, DFF}; pg8::StaticOrder S; S.init(MM, D, G, bid);
              pg8::EpiResid E{WSP(bf16_t, WS_XB), WSP(float, WS_ROWSS1)}; pg8::gemm_phase(lds, g, S, E); }
            XBAR();
        }
        for (int gi = 0; gi < ngr; ++gi) { const int grp = g0 + gi;
            phase_final(WSP(bf16_t, WS_XB) + (size_t)gi * MG * D, P.out + (size_t)grp * MG * D, WSP(float, WS_ROWSS1) + (size_t)gi * MG * 16, P.norm_final_g); }
        XBAR();
    }
}

extern "C" void kernel_launch(void* const* d_in, const int* in_sizes, int n_in, void* d_out, int out_size, void* d_ws, size_t ws_size, hipStream_t stream) {
    static int grid_blocks = 0;
    if (grid_blocks == 0) {
        if (n_in != 16 || ws_size < WS_END) { fprintf(stderr, "kernel_launch: unexpected n_in %d or ws_size %zu (< %zu)\n", n_in, ws_size, (size_t)WS_END); grid_blocks = -1; return; }
        int dev = 0, cus = 0, per_cu = 0;
        hipGetDevice(&dev);
        hipDeviceGetAttribute(&cus, hipDeviceAttributeMultiprocessorCount, dev);
        if (hipFuncSetAttribute((const void*)fwd_megakernel, hipFuncAttributeMaxDynamicSharedMemorySize, LDS_BYTES) != hipSuccess) { fprintf(stderr, "kernel_launch: hipFuncSetAttribute failed\n"); grid_blocks = -1; return; }
        hipOccupancyMaxActiveBlocksPerMultiprocessor(&per_cu, (const void*)fwd_megakernel, NTHREADS, LDS_BYTES);
        if (per_cu < 1) { fprintf(stderr, "kernel_launch: occupancy query says %d blocks per CU\n", per_cu); per_cu = 1; }
        (void)hipGetLastError();
        grid_blocks = cus;
    }
    if (grid_blocks < 0) return;
    if (hipMemsetAsync((char*)d_ws + WS_CTL, 0, 16384, stream) != hipSuccess) { fprintf(stderr, "kernel_launch: memset of barrier words failed\n"); return; }
    Params p{};
    p.x_prompt = (const float*)d_in[0]; p.x_sample = (const float*)d_in[1]; p.norm_mix_g = (const float*)d_in[2]; p.w_in = (const float*)d_in[3]; p.na_rel_bias = (const float*)d_in[4];
    p.dec_f = (const float*)d_in[5]; p.dec_b = (const float*)d_in[6]; p.ret_norm_g = (const float*)d_in[7]; p.w_ba = (const float*)d_in[8]; p.w_br = (const float*)d_in[9]; p.w_out = (const float*)d_in[10];
    p.norm_ffn_g = (const float*)d_in[11]; p.w_up = (const float*)d_in[12]; p.conv_w = (const float*)d_in[13]; p.w_down = (const float*)d_in[14]; p.norm_final_g = (const float*)d_in[15];
    p.out = (float*)d_out; p.ws = (unsigned char*)d_ws;
    void* args[] = {&p};
    hipError_t e = hipLaunchCooperativeKernel((const void*)fwd_megakernel, dim3(grid_blocks), dim3(NTHREADS), args, LDS_BYTES, stream);
    if (e != hipSuccess) fprintf(stderr, "kernel_launch: cooperative launch failed: %s (grid %d)\n", hipGetErrorString(e), grid_blocks);
}
```

```cpp
#include <hip/hip_runtime.h>
#include <hip/hip_cooperative_groups.h>
#include <cstdio>
namespace cg = cooperative_groups;

#define LAS __attribute__((address_space(3)))
typedef unsigned short bf16_t;
typedef short bf16x8 __attribute__((ext_vector_type(8)));
typedef short bf16x4 __attribute__((ext_vector_type(4)));
typedef float f32x4 __attribute__((ext_vector_type(4)));
typedef float f32x16 __attribute__((ext_vector_type(16)));
typedef unsigned u32x4 __attribute__((ext_vector_type(4)));
typedef unsigned u32x2 __attribute__((ext_vector_type(2)));

constexpr int D = 1024, MG = 16384, NPROJ = 5120, NPT = 2048, DFF = 2816, DFF2 = 5632, DEPTH = 4, NGROUPS = 5, DIN = 6656;
constexpr float EPS = 1e-6f;
constexpr int NTHREADS = 512;
constexpr int LDS_RSTD_OFF = 131072 + 1024;
constexpr int LDS_BYTES = 131072 + 1024 + 12288;

constexpr size_t WS_CTL = 0;
constexpr size_t WS_LG2 = 32768;
constexpr size_t WS_ROWSS1 = 262144;
constexpr size_t WS_ROWSS2 = WS_ROWSS1 + (size_t)2 * MG * 16 * 4;
constexpr size_t WS_COSN = WS_ROWSS2 + (size_t)2 * MG * 16 * 4;
constexpr size_t TAB_BYTES = (size_t)16384 * 64 * 4;
constexpr size_t WS_SINN = WS_COSN + TAB_BYTES;
constexpr size_t WS_COST = WS_SINN + TAB_BYTES;
constexpr size_t WS_SINT = WS_COST + TAB_BYTES;
constexpr size_t WS_W = WS_SINT + TAB_BYTES;
constexpr size_t W_IN_OFF = 0;
constexpr size_t W_A_OFF = W_IN_OFF + (size_t)7168 * 1024 * 2;
constexpr size_t W_R_OFF = W_A_OFF + (size_t)1024 * 512 * 2;
constexpr size_t W_O_OFF = W_R_OFF + (size_t)1024 * 1024 * 2;
constexpr size_t W_UP_OFF = W_O_OFF + (size_t)1024 * 1024 * 2;
constexpr size_t W_D_OFF = W_UP_OFF + (size_t)5632 * 1024 * 2;
constexpr size_t W_LAYER = W_D_OFF + (size_t)1024 * 2816 * 2;
constexpr size_t WS_XB = WS_W + W_LAYER * DEPTH;
constexpr size_t WS_S = WS_XB + (size_t)2 * MG * D * 2;
constexpr size_t WS_PROJ = WS_S;
constexpr size_t WS_PROJT = WS_PROJ + (size_t)MG * NPROJ * 2;
constexpr size_t WS_A = WS_PROJT + (size_t)NPT * MG * 2;
constexpr size_t WS_MIXED = WS_A + (size_t)MG * 1536 * 2;
constexpr size_t WS_STLOC = WS_MIXED + (size_t)MG * D * 2;
constexpr size_t WS_ST = WS_STLOC + (size_t)128 * 4 * 2 * 32768 * 2;
constexpr size_t WS_MIX_END = WS_ST + (size_t)128 * 4 * 2 * 32768 * 2;
constexpr size_t WS_U = WS_S;
constexpr size_t WS_ACT = WS_U + (size_t)2 * MG * DFF2 * 2;
constexpr size_t WS_FFN_END = WS_ACT + (size_t)2 * MG * DFF * 2;
constexpr size_t WS_MIXED2 = WS_MIX_END > WS_FFN_END ? WS_MIX_END : WS_FFN_END;
constexpr size_t WS_END = WS_MIXED2 + (size_t)2 * MG * D * 2;
static_assert(WS_END <= ((size_t)1 << 30), "workspace over 1 GiB");

struct Params {
    const float* x_prompt; const float* x_sample; const float* norm_mix_g; const float* w_in; const float* na_rel_bias;
    const float* dec_f; const float* dec_b; const float* ret_norm_g; const float* w_ba; const float* w_br; const float* w_out;
    const float* norm_ffn_g; const float* w_up; const float* conv_w; const float* w_down; const float* norm_final_g;
    float* out; unsigned char* ws;
};

typedef __bf16 bf16v2_t __attribute__((ext_vector_type(2)));
typedef float f32v2_t __attribute__((ext_vector_type(2)));
__device__ __forceinline__ unsigned cvt_pk_bf16(float lo, float hi) { const f32v2_t v = {lo, hi}; const bf16v2_t r = __builtin_convertvector(v, bf16v2_t); return __builtin_bit_cast(unsigned, r); }
__device__ __forceinline__ float bf_lo(unsigned w) { return __uint_as_float(w << 16); }
__device__ __forceinline__ float bf_hi(unsigned w) { return __uint_as_float(w & 0xffff0000u); }
__device__ __forceinline__ float bf2f(bf16_t b) { return __uint_as_float(((unsigned)b) << 16); }
__device__ __forceinline__ float sigmoidf_(float x) { return __builtin_amdgcn_rcpf(1.0f + __expf(-x)); }
__device__ __forceinline__ void unpack8(const u32x4 w, float* f) { f[0] = bf_lo(w.x); f[1] = bf_hi(w.x); f[2] = bf_lo(w.y); f[3] = bf_hi(w.y); f[4] = bf_lo(w.z); f[5] = bf_hi(w.z); f[6] = bf_lo(w.w); f[7] = bf_hi(w.w); }
__device__ __forceinline__ u32x4 pack8(const float* f) { u32x4 w; w.x = cvt_pk_bf16(f[0], f[1]); w.y = cvt_pk_bf16(f[2], f[3]); w.z = cvt_pk_bf16(f[4], f[5]); w.w = cvt_pk_bf16(f[6], f[7]); return w; }
__device__ __forceinline__ f32x16 mfma32(bf16x8 a, bf16x8 b, f32x16 c) { return __builtin_amdgcn_mfma_f32_32x32x16_bf16(a, b, c, 0, 0, 0); }
__device__ __forceinline__ int otid() { int t = threadIdx.x; asm volatile("" : "+v"(t)); return t; }
__device__ __forceinline__ int ogrid() { int g = gridDim.x; asm volatile("" : "+s"(g)); return g; }
__device__ __forceinline__ f32x16 zero16() { return (f32x16){0.f, 0.f, 0.f, 0.f, 0.f, 0.f, 0.f, 0.f, 0.f, 0.f, 0.f, 0.f, 0.f, 0.f, 0.f, 0.f}; }
__device__ __forceinline__ float sum16(const float* p) { const f32x4 a = *(const f32x4*)p, b = *(const f32x4*)(p + 4), c = *(const f32x4*)(p + 8), d = *(const f32x4*)(p + 12); const f32x4 t = (a + b) + (c + d); return (t[0] + t[1]) + (t[2] + t[3]); }
__device__ __forceinline__ float shx(float v, int m, int lane) { return __int_as_float(__builtin_amdgcn_ds_bpermute((lane ^ m) << 2, __float_as_int(v))); }
__device__ __forceinline__ float xhalf_max(float x) { const auto rr = __builtin_amdgcn_permlane32_swap(__float_as_uint(x), __float_as_uint(x), false, false); return fmaxf(__uint_as_float(rr[0]), __uint_as_float(rr[1])); }
__device__ __forceinline__ float xhalf_sum(float x) { const auto rr = __builtin_amdgcn_permlane32_swap(__float_as_uint(x), __float_as_uint(x), false, false); return __uint_as_float(rr[0]) + __uint_as_float(rr[1]); }
__device__ __forceinline__ float wave_sum(float v, int lane) { v += shx(v, 32, lane); v += shx(v, 16, lane); v += shx(v, 8, lane); v += shx(v, 4, lane); v += shx(v, 2, lane); v += shx(v, 1, lane); return v; }

namespace pg8 {
constexpr int BM = 256, BK = 64, HALF = 128, HTB = HALF * BK * 2, STAGE_BYTES = 8 * HTB, NXCD = 8, WGM = 8;
__host__ __device__ __forceinline__ int lds_byte(int r, int c) { const int st = (r >> 4) * 2 + (c >> 5), rr = r & 15, cc = c & 31, ob = rr * 64 + cc * 2; return st * 1024 + (ob ^ (((ob >> 9) & 1) << 5)); }
__host__ __device__ __forceinline__ void stage_rc(int b, int& R, int& C) { const int st = b / 1024, sb = b % 1024, swz = sb ^ (((sb >> 9) & 1) << 5); R = (st >> 1) * 16 + swz / 64; C = (st & 1) * 32 + (swz % 64) / 2; }
__host__ __device__ __forceinline__ int perm32(int rho) { const int n = rho >> 4, i = rho & 15; return 8 * (i >> 2) + 4 * n + (i & 3); }
struct Unit { int pm, pn, idx, kind; };
struct Gemm { const bf16_t* A; const bf16_t* Bt; int M, N, K; };
struct StaticOrder {
    int nM, nN, nwg, G, c;
    __host__ __device__ void init(int M, int N, int G_, int c_) { nM = M / BM; nN = N / BM; nwg = nM * nN; G = G_; c = c_; }
    __host__ __device__ bool next(int i, Unit& u) const { return at((long)i * G + c, u); }
    __host__ __device__ bool at(long L, Unit& u) const {
        if (L >= nwg) return false;
        u.kind = 0;
        int wgid = (int)L; { const int q = nwg / NXCD, r = nwg % NXCD, xcd = wgid % NXCD, off = wgid / NXCD; wgid = (xcd < r ? xcd * (q + 1) : r * (q + 1) + (xcd - r) * q) + off; }
        const int nig = WGM * nN, gid = wgid / nig, fm = gid * WGM, gsz = (nM - fm) < WGM ? (nM - fm) : WGM;
        u.pm = fm + ((wgid % nig) % gsz); u.pn = (wgid % nig) / gsz; return true;
    }
    __device__ __forceinline__ void a_ready(const Unit&) const {}
    __device__ __forceinline__ void done(const Unit&) const {}
    __device__ __forceinline__ const char* abase(const Gemm& g, const Unit& u, size_t tstep) const { return (const char*)g.A + (size_t)u.pm * tstep; }
    __device__ __forceinline__ const char* bbase(const Gemm& g, const Unit& u, size_t tstep) const { return (const char*)g.Bt + (size_t)u.pn * tstep; }
};
struct P1Order {
    StaticOrder s0, s1; int G, c; const bf16_t* wt2;
    __device__ void init(int G_, int c_, const bf16_t* wt2_) { s0.init(MG, NPROJ, G_, c_); s1.init(NPT, MG, G_, c_); G = G_; c = c_; wt2 = wt2_; }
    __device__ bool next(int i, Unit& u) const { const long L = (long)i * G + c; if (L < 1280) return s0.at(L, u); if (!s1.at(L - 1280, u)) return false; u.kind = 1; return true; }
    __device__ __forceinline__ void a_ready(const Unit&) const {}
    __device__ __forceinline__ void done(const Unit&) const {}
    __device__ __forceinline__ const char* abase(const Gemm& g, const Unit& u, size_t tstep) const { return (u.kind ? (const char*)wt2 : (const char*)g.A) + (size_t)u.pm * tstep; }
    __device__ __forceinline__ const char* bbase(const Gemm& g, const Unit& u, size_t tstep) const { return (u.kind ? (const char*)g.A : (const char*)g.Bt) + (size_t)u.pn * tstep; }
};

template <class Epi, class Sched>
__device__ __forceinline__ void gemm_phase(LAS unsigned char* lds, const Gemm g, const Sched& S, const Epi& E) {
    const int tid = otid(), wid = __builtin_amdgcn_readfirstlane(tid >> 6), lane = tid & 63, wr = wid >> 2, wc = wid & 3, fr = lane & 15, fq = lane >> 4;
    const int K = g.K, nt = K / BK;
    unsigned voffA[2], voffB[2];
#pragma unroll
    for (int i = 0; i < 2; ++i) { int R, C; stage_rc(tid * 16 + i * 8192, R, C); const int Rb = Epi::PERM ? ((R & ~31) + perm32(R & 31)) : R;
        voffA[i] = (unsigned)(R * K + C) * 2u; voffB[i] = (unsigned)(Rb * K + C) * 2u; }
    const size_t kstep = (size_t)(BK * 2);
    const size_t hstep = (size_t)HALF * K * 2;
    const size_t tstep = 2 * hstep;
    const unsigned ldsw = (unsigned)wid * 1024u;
    const int aoff = lds_byte(wr * 64 + fr, fq * 8), boff = lds_byte(wc * 32 + fr, fq * 8);
#define PG8_SA(b, h) (((b) * 2 + (h)) * HTB)
#define PG8_SB(b, h) ((4 + (b) * 2 + (h)) * HTB)
#define PG8_STAGE(bufoff, gbase, voff) do { _Pragma("unroll") for (int _i = 0; _i < 2; ++_i) \
        __builtin_amdgcn_global_load_lds((const unsigned*)((const char*)(gbase) + (voff)[_i]), (LAS unsigned*)(lds + (bufoff) + ldsw + _i * 8192), 16, 0, 0); } while (0)
#define PG8_LDA(dst, b, h) do { _Pragma("unroll") for (int m = 0; m < 4; ++m) _Pragma("unroll") for (int k = 0; k < 2; ++k) dst[m][k] = *(const LAS bf16x8*)(lds + PG8_SA(b, h) + aoff + m * 2048 + k * 1024); } while (0)
#define PG8_LDB(dst, b, h) do { _Pragma("unroll") for (int n = 0; n < 2; ++n) _Pragma("unroll") for (int k = 0; k < 2; ++k) dst[n][k] = *(const LAS bf16x8*)(lds + PG8_SB(b, h) + boff + n * 2048 + k * 1024); } while (0)
#define PG8_MMA(ai, bj, At, Bt) do { __builtin_amdgcn_s_setprio(1); _Pragma("unroll") for (int m = 0; m < 4; ++m) _Pragma("unroll") for (int n = 0; n < 2; ++n) _Pragma("unroll") for (int k = 0; k < 2; ++k) \
        acc[ai][bj][m][n] = __builtin_amdgcn_mfma_f32_16x16x32_bf16(Bt[n][k], At[m][k], acc[ai][bj][m][n], 0, 0, 0); __builtin_amdgcn_s_setprio(0); } while (0)
#define PG8_WAIT_V(n) asm volatile("s_waitcnt vmcnt(" #n ")" ::: "memory")
#define PG8_WAIT_L(n) asm volatile("s_waitcnt lgkmcnt(" #n ")" ::: "memory")
#define PG8_BAR __builtin_amdgcn_s_barrier()
#define PG8_SCHED __builtin_amdgcn_sched_barrier(0)
    Unit cur, nxt; int ui = 0;
    if (!S.next(0, cur)) return;
    cur.idx = 0;
    f32x4 acc[2][2][4][2];
#pragma unroll
    for (int a = 0; a < 2; ++a)
#pragma unroll
        for (int b = 0; b < 2; ++b)
#pragma unroll
            for (int m = 0; m < 4; ++m)
#pragma unroll
                for (int n = 0; n < 2; ++n) acc[a][b][m][n] = (f32x4){0.f, 0.f, 0.f, 0.f};
    bf16x8 At[4][2], B0[2][2], B1[2][2];
    const char* cA = S.abase(g, cur, tstep); const char* cB = S.bbase(g, cur, tstep);
    S.a_ready(cur);
    PG8_STAGE(PG8_SB(0, 0), cB, voffB); PG8_STAGE(PG8_SA(0, 0), cA, voffA); PG8_STAGE(PG8_SB(0, 1), cB + hstep, voffB); PG8_STAGE(PG8_SA(0, 1), cA + hstep, voffA);
    if (wr == 1) PG8_BAR;
    PG8_WAIT_V(4); PG8_BAR;
    PG8_STAGE(PG8_SB(1, 0), cB + kstep, voffB); PG8_STAGE(PG8_SA(1, 0), cA + kstep, voffA); PG8_STAGE(PG8_SB(1, 1), cB + hstep + kstep, voffB);
    PG8_WAIT_V(6); PG8_BAR;
    for (;;) {
        const bool has_next = S.next(ui + 1, nxt); nxt.idx = ui + 1;
        const char* nA = has_next ? S.abase(g, nxt, tstep) : cA; const char* nB = has_next ? S.bbase(g, nxt, tstep) : cB;
        for (int t = 0; t < nt; t += 2) {
            const bool last = (t == nt - 2);
            const char* a1 = cA + (size_t)(t + 1) * kstep;
            const char* a2 = last ? nA : cA + (size_t)(t + 2) * kstep; const char* b2 = last ? nB : cB + (size_t)(t + 2) * kstep;
            const char* a3 = a2 + kstep; const char* b3 = b2 + kstep;
            if (last && has_next) S.a_ready(nxt);
            if constexpr (Epi::MID > 0) { if (t == Epi::MID) E.mid(acc, cur, wr, wc, fr, fq); }
            PG8_LDB(B0, 0, 0); PG8_SCHED; PG8_LDA(At, 0, 0); PG8_STAGE(PG8_SA(1, 1), a1 + hstep, voffA);
            PG8_WAIT_L(8); PG8_BAR; PG8_WAIT_L(0); PG8_MMA(0, 0, At, B0); PG8_BAR; PG8_SCHED;
            PG8_LDB(B1, 0, 1); PG8_STAGE(PG8_SB(0, 0), b2, voffB);
            PG8_BAR; PG8_WAIT_L(0); PG8_MMA(0, 1, At, B1); PG8_BAR;
            PG8_LDA(At, 0, 1); PG8_STAGE(PG8_SA(0, 0), a2, voffA);
            PG8_BAR; PG8_WAIT_L(0); PG8_MMA(1, 0, At, B0); PG8_BAR; PG8_SCHED;
            PG8_STAGE(PG8_SB(0, 1), b2 + hstep, voffB);
            PG8_WAIT_V(6); PG8_BAR; PG8_MMA(1, 1, At, B1); PG8_BAR;
            PG8_LDB(B0, 1, 0); PG8_SCHED; PG8_LDA(At, 1, 0); PG8_STAGE(PG8_SA(0, 1), a2 + hstep, voffA);
            PG8_WAIT_L(8); PG8_BAR; PG8_WAIT_L(0); PG8_MMA(0, 0, At, B0); PG8_BAR; PG8_SCHED;
            PG8_LDB(B1, 1, 1); PG8_STAGE(PG8_SB(1, 0), b3, voffB);
            PG8_BAR; PG8_WAIT_L(0); PG8_MMA(0, 1, At, B1); PG8_BAR;
            PG8_LDA(At, 1, 1); PG8_STAGE(PG8_SA(1, 0), a3, voffA);
            PG8_BAR; PG8_WAIT_L(0); PG8_MMA(1, 0, At, B0); PG8_BAR; PG8_SCHED;
            PG8_STAGE(PG8_SB(1, 1), b3 + hstep, voffB);
            PG8_WAIT_V(6); PG8_BAR; PG8_MMA(1, 1, At, B1); PG8_BAR;
        }
        E(acc, cur, wr, wc, fr, fq); S.done(cur);
        if (!has_next) break;
#pragma unroll
        for (int a = 0; a < 2; ++a)
#pragma unroll
            for (int b = 0; b < 2; ++b)
#pragma unroll
                for (int m = 0; m < 4; ++m)
#pragma unroll
                    for (int n = 0; n < 2; ++n) acc[a][b][m][n] = (f32x4){0.f, 0.f, 0.f, 0.f};
        cur = nxt; cA = nA; cB = nB; ++ui;
    }
    PG8_WAIT_V(0);
    if (wr == 0) PG8_BAR;
    PG8_BAR;
#undef PG8_SA
#undef PG8_SB
#undef PG8_STAGE
#undef PG8_LDA
#undef PG8_LDB
#undef PG8_MMA
#undef PG8_WAIT_V
#undef PG8_WAIT_L
#undef PG8_BAR
#undef PG8_SCHED
}

struct EpiRowScale {
    static constexpr bool PERM = true; static constexpr int MID = 0;
    bf16_t* O; int ldc; const LAS float* rl;
    int nt_from;
    __device__ __forceinline__ void operator()(const f32x4 (&acc)[2][2][4][2], const Unit& u, int wr, int wc, int fr, int fq) const {
        const int row0 = u.pm * BM + wr * 64 + fr, col0 = u.pn * BM + wc * 32 + 8 * fq;
#pragma unroll
        for (int ai = 0; ai < 2; ++ai)
#pragma unroll
            for (int m = 0; m < 4; ++m) { const int row = row0 + ai * HALF + m * 16; const float rs = rl[u.idx * 256 + wr * 64 + fr + ai * HALF + m * 16];
                bf16_t* rowp = O + (size_t)row * ldc + col0;
#pragma unroll
                for (int bj = 0; bj < 2; ++bj) { const f32x4 v0 = acc[ai][bj][m][0] * rs, v1 = acc[ai][bj][m][1] * rs;
                    u32x4 w; w.x = cvt_pk_bf16(v0[0], v0[1]); w.y = cvt_pk_bf16(v0[2], v0[3]); w.z = cvt_pk_bf16(v1[0], v1[1]); w.w = cvt_pk_bf16(v1[2], v1[3]);
                    if (nt_from >= 0 && u.pn >= nt_from) __builtin_nontemporal_store(w, (u32x4*)(rowp + bj * HALF)); else *(u32x4*)(rowp + bj * HALF) = w; } }
    }
};
struct EpiColScale {
    static constexpr bool PERM = true; static constexpr int MID = 0;
    bf16_t* O; int ldc; const LAS float* rl;
    __device__ __forceinline__ void operator()(const f32x4 (&acc)[2][2][4][2], const Unit& u, int wr, int wc, int fr, int fq) const {
        const int row0 = u.pm * BM + wr * 64 + fr, col0 = u.pn * BM + wc * 32 + 8 * fq;
        f32x4 sc[2][2];
#pragma unroll
        for (int bj = 0; bj < 2; ++bj)
#pragma unroll
            for (int n = 0; n < 2; ++n) sc[bj][n] = *(const LAS f32x4*)(rl + u.idx * 256 + wc * 32 + 8 * fq + bj * HALF + 4 * n);
#pragma unroll
        for (int ai = 0; ai < 2; ++ai)
#pragma unroll
            for (int m = 0; m < 4; ++m) { const int row = row0 + ai * HALF + m * 16; bf16_t* rowp = O + (size_t)row * ldc + col0;
#pragma unroll
                for (int bj = 0; bj < 2; ++bj) { const f32x4 v0 = acc[ai][bj][m][0] * sc[bj][0], v1 = acc[ai][bj][m][1] * sc[bj][1];
                    u32x4 w; w.x = cvt_pk_bf16(v0[0], v0[1]); w.y = cvt_pk_bf16(v0[2], v0[3]); w.z = cvt_pk_bf16(v1[0], v1[1]); w.w = cvt_pk_bf16(v1[2], v1[3]);
                    *(u32x4*)(rowp + bj * HALF) = w; } }
    }
};
struct EpiP1 {
    static constexpr bool PERM = true; static constexpr int MID = 0;
    EpiRowScale e0; EpiColScale e1;
    __device__ __forceinline__ void operator()(const f32x4 (&acc)[2][2][4][2], const Unit& u, int wr, int wc, int fr, int fq) const { if (u.kind == 0) e0(acc, u, wr, wc, fr, fq); else e1(acc, u, wr, wc, fr, fq); }
};
struct EpiGate {
    static constexpr bool PERM = true; static constexpr int MID = 0;
    const bf16_t* gate; const bf16_t* addsrc; bf16_t* O;
    __device__ __forceinline__ void operator()(const f32x4 (&acc)[2][2][4][2], const Unit& u, int wr, int wc, int fr, int fq) const {
        const int row0 = u.pm * BM + wr * 64 + fr, col0 = u.pn * BM + wc * 32 + 8 * fq;
#pragma unroll
        for (int ai = 0; ai < 2; ++ai)
#pragma unroll
            for (int m = 0; m < 4; ++m) { const int row = row0 + ai * HALF + m * 16;
#pragma unroll
                for (int bj = 0; bj < 2; ++bj) { const int col = col0 + bj * HALF;
                    float gf[8], r[8]; unpack8(*(const u32x4*)(gate + (size_t)row * NPROJ + col), gf);
                    const f32x4 v0 = acc[ai][bj][m][0], v1 = acc[ai][bj][m][1];
#pragma unroll
                    for (int j = 0; j < 4; ++j) { r[j] = v0[j] * sigmoidf_(gf[j]); r[4 + j] = v1[j] * sigmoidf_(gf[4 + j]); }
                    if (addsrc) { float af[8]; unpack8(*(const u32x4*)(addsrc + (size_t)row * D + col), af);
#pragma unroll
                        for (int j = 0; j < 8; ++j) r[j] += af[j]; }
                    *(u32x4*)(O + (size_t)row * D + col) = pack8(r); } }
    }
};
struct EpiMerge {
    static constexpr bool PERM = true; static constexpr int MID = 8;
    const bf16_t* ga; const bf16_t* gr; bf16_t* O;
    __device__ __forceinline__ void mid(f32x4 (&acc)[2][2][4][2], const Unit& u, int wr, int wc, int fr, int fq) const {
        const int row0 = u.pm * BM + wr * 64 + fr, col0 = u.pn * BM + wc * 32 + 8 * fq;
#pragma unroll
        for (int ai = 0; ai < 2; ++ai)
#pragma unroll
            for (int m = 0; m < 4; ++m) { int row = row0 + ai * HALF + m * 16; asm volatile("" : "+v"(row));
#pragma unroll
                for (int bj = 0; bj < 2; ++bj) { const size_t off = (size_t)row * NPROJ + col0 + bj * HALF;
                    float fa[8], fb[8]; unpack8(*(const u32x4*)(ga + off), fa); unpack8(*(const u32x4*)(gr + off), fb);
#pragma unroll
                    for (int j = 0; j < 8; ++j) { const float rt = (1.0f + __builtin_amdgcn_exp2f(fb[j] * -1.4426950408889634f)) * __builtin_amdgcn_rcpf(1.0f + __builtin_amdgcn_exp2f(fa[j] * -1.4426950408889634f));
                        if (j < 4) acc[ai][bj][m][0][j] *= rt; else acc[ai][bj][m][1][j - 4] *= rt; } }
                asm volatile("" ::: "memory"); }
    }
    __device__ __forceinline__ void operator()(const f32x4 (&acc)[2][2][4][2], const Unit& u, int wr, int wc, int fr, int fq) const {
        const int row0 = u.pm * BM + wr * 64 + fr, col0 = u.pn * BM + wc * 32 + 8 * fq;
#pragma unroll
        for (int ai = 0; ai < 2; ++ai)
#pragma unroll
            for (int m = 0; m < 4; ++m) { const int row = row0 + ai * HALF + m * 16;
#pragma unroll
                for (int bj = 0; bj < 2; ++bj) { const int col = col0 + bj * HALF;
                    float gf[8], r[8]; unpack8(*(const u32x4*)(gr + (size_t)row * NPROJ + col), gf);
                    const f32x4 v0 = acc[ai][bj][m][0], v1 = acc[ai][bj][m][1];
#pragma unroll
                    for (int j = 0; j < 4; ++j) { r[j] = v0[j] * sigmoidf_(gf[j]); r[4 + j] = v1[j] * sigmoidf_(gf[4 + j]); }
                    *(u32x4*)(O + (size_t)row * D + col) = pack8(r); } }
    }
};
struct EpiResid {
    static constexpr bool PERM = true; static constexpr int MID = 0;
    bf16_t* xb; float* rowss;
    __device__ __forceinline__ void operator()(const f32x4 (&acc)[2][2][4][2], const Unit& u, int wr, int wc, int fr, int fq) const {
        const int row0 = u.pm * BM + wr * 64 + fr, col0 = u.pn * BM + wc * 32 + 8 * fq;
#pragma unroll
        for (int ai = 0; ai < 2; ++ai)
#pragma unroll
            for (int m = 0; m < 4; ++m) { const int row = row0 + ai * HALF + m * 16; float ss = 0.f;
#pragma unroll
                for (int bj = 0; bj < 2; ++bj) { const size_t off = (size_t)row * D + col0 + bj * HALF;
                    float b[8], r[8]; unpack8(*(const u32x4*)(xb + off), b);
                    const f32x4 v0 = acc[ai][bj][m][0], v1 = acc[ai][bj][m][1];
#pragma unroll
                    for (int j = 0; j < 4; ++j) { b[j] += v0[j]; b[4 + j] += v1[j]; }
                    const u32x4 w = pack8(b);
                    *(u32x4*)(xb + off) = w;
                    unpack8(w, r);
#pragma unroll
                    for (int j = 0; j < 8; ++j) ss += r[j] * r[j]; }
                { const int ln = fr + 16 * fq; ss += shx(ss, 16, ln); ss += shx(ss, 32, ln); }
                if (fq == 0) rowss[(size_t)row * 16 + u.pn * 4 + wc] = ss; }
    }
};
}

template <class Sched> __device__ __forceinline__ void fill_rstd(LAS float* rl, const float* rowss, const Sched& S, int by_col  ) {
    const int tid = otid();
    for (int e = tid; e < 12 * 256; e += NTHREADS) { pg8::Unit u; const int i = e >> 8;
        if (S.next(i, u)) { const bool bc = by_col < 0 ? (u.kind != 0) : (by_col != 0); const int r = (bc ? u.pn : u.pm) * 256 + (e & 255); rl[e] = rsqrtf(sum16(rowss + (size_t)r * 16) * (1.0f / 1024.0f) + EPS); } }
    __syncthreads();
}

__device__ __forceinline__ int win_srccol(int nd) {
    if (nd < 1024) return nd;
    if (nd < 1536) return 1536 + (nd - 1024);
    if (nd < 2048) return 2048 + (nd - 1536);
    if (nd < 3072) return 3584 + (nd - 2048);
    if (nd < 4096) return 4608 + (nd - 3072);
    if (nd < 5120) return 5632 + (nd - 4096);
    nd -= 5120;
    if (nd < 512) return 1024 + nd;
    if (nd < 1024) return 2048 + (nd - 512);
    return 2560 + (nd - 1024);
}
struct TileJob { const float* src; const float* gsc; bf16_t* dst; int ld_src, k0, nsrc0, ldd, ndst0, kdst0; };
__device__ __forceinline__ TileJob tile_job(const Params& P, int job) {
    constexpr int T_IN = 16 * 112, T_A = 8 * 16, T_R = 16 * 16, T_O = 16 * 16, T_UP = 16 * 88, T_D = 44 * 16, T_L = T_IN + T_A + T_R + T_O + T_UP + T_D;
    const int l = job / T_L; int r = job % T_L;
    unsigned char* wl = P.ws + WS_W + (size_t)l * W_LAYER;
    TileJob j;
    if (r < T_IN) { const int kt = r / 112, nt = r % 112; j = TileJob{P.w_in + (size_t)l * D * DIN, P.norm_mix_g + l * D, (bf16_t*)(wl + W_IN_OFF), DIN, kt * 64, win_srccol(nt * 64), 1024, nt * 64, 0}; return j; }
    r -= T_IN;
    if (r < T_A) { const int kt = r / 16, nt = r % 16; j = TileJob{P.w_ba + (size_t)l * 512 * D, nullptr, (bf16_t*)(wl + W_A_OFF), D, kt * 64, nt * 64, 1536, nt * 64, 0}; return j; }
    r -= T_A;
    if (r < T_R) { const int kt = r / 16, nt = r % 16; j = TileJob{P.w_br + (size_t)l * D * D, nullptr, (bf16_t*)(wl + W_A_OFF), D, kt * 64, nt * 64, 1536, nt * 64, 512}; return j; }
    r -= T_R;
    if (r < T_O) { const int kt = r / 16, nt = r % 16; j = TileJob{P.w_out + (size_t)l * D * D, nullptr, (bf16_t*)(wl + W_O_OFF), D, kt * 64, nt * 64, 1024, nt * 64, 0}; return j; }
    r -= T_O;
    if (r < T_UP) { const int kt = r / 88, nt = r % 88; j = TileJob{P.w_up + (size_t)l * D * DFF2, P.norm_ffn_g + l * D, (bf16_t*)(wl + W_UP_OFF), DFF2, kt * 64, nt * 64, 1024, nt * 64, 0}; return j; }
    r -= T_UP;
    { const int kt = r / 16, nt = r % 16; j = TileJob{P.w_down + (size_t)l * DFF * D, nullptr, (bf16_t*)(wl + W_D_OFF), D, kt * 64, nt * 64, DFF, nt * 64, 0}; return j; }
}
struct TileRegs { float4 v[2]; float s[2]; };
__device__ __forceinline__ void tile_load(TileRegs& tr, const TileJob& j, int t) {
#pragma unroll
    for (int i = 0; i < 2; ++i) { const int r = (t >> 4) + 32 * i, c = (t & 15) * 4;
        { const f32x4 t4 = __builtin_nontemporal_load((const f32x4*)(j.src + (size_t)(j.k0 + r) * j.ld_src + j.nsrc0 + c)); tr.v[i] = make_float4(t4[0], t4[1], t4[2], t4[3]); }
        tr.s[i] = j.gsc ? j.gsc[j.k0 + r] : 1.0f; }
}
__device__ __forceinline__ void tile_store(const TileRegs& tr, const TileJob& j, int t, LAS float* tile) {
#pragma unroll
    for (int i = 0; i < 2; ++i) { const int r = (t >> 4) + 32 * i, c = (t & 15) * 4; const float sc = tr.s[i];
        tile[r * 65 + c] = tr.v[i].x * sc; tile[r * 65 + c + 1] = tr.v[i].y * sc; tile[r * 65 + c + 2] = tr.v[i].z * sc; tile[r * 65 + c + 3] = tr.v[i].w * sc; }
    __syncthreads();
    { const int n = t >> 3, k8 = (t & 7) * 8; float f[8];
#pragma unroll
      for (int jj = 0; jj < 8; ++jj) f[jj] = tile[(k8 + jj) * 65 + n];
      *(u32x4*)(j.dst + (size_t)(j.ndst0 + n) * j.ldd + j.kdst0 + j.k0 + k8) = pack8(f); }
    __syncthreads();
}
__device__ __forceinline__ void phase_prologue(const Params& P, LAS unsigned char* lds) {
    LAS float* tile = (LAS float*)lds;
    constexpr int NJOBS = (16 * 112 + 8 * 16 + 16 * 16 + 16 * 16 + 16 * 88 + 44 * 16) * DEPTH;
    { const int t = otid(), G = ogrid();
      int job = blockIdx.x;
      if (job < NJOBS) { TileJob jc = tile_job(P, job); TileRegs rc; tile_load(rc, jc, t);
          while (true) { const int jn = job + G; const bool more = jn < NJOBS;
              TileJob jx = jc; TileRegs rx = rc; if (more) { jx = tile_job(P, jn); tile_load(rx, jx, t); }
              tile_store(rc, jc, t, tile);
              if (!more) break; jc = jx; rc = rx; job = jn; } } }
    if (blockIdx.x == 0 && otid() < DEPTH * 4) { const int i = otid(); float* tab = (float*)(P.ws + WS_LG2);
        tab[2 * i] = -log1pf(expf(-P.dec_f[i])) * 1.4426950408889634f; tab[2 * i + 1] = -log1pf(expf(-P.dec_b[i])) * 1.4426950408889634f; }
    float* cosN = (float*)(P.ws + WS_COSN); float* sinN = (float*)(P.ws + WS_SINN); float* cosT = (float*)(P.ws + WS_COST); float* sinT = (float*)(P.ws + WS_SINT);
    for (int idx = blockIdx.x * NTHREADS + otid(); idx < 16384 * 64; idx += ogrid() * NTHREADS) {
        const int pos = idx >> 6, i = idx & 63;
        const float invf = powf(10000.0f, -(float)i / 64.0f);
        const float ang = (float)pos * invf;
        const float c = cosf(ang), s = sinf(ang);
        cosN[idx] = c; sinN[idx] = s; cosT[(size_t)i * 16384 + pos] = c; sinT[(size_t)i * 16384 + pos] = s;
    }
}

__device__ __forceinline__ void phase_init(const float* __restrict__ xin, bf16_t* xb, float* rowss1, float* rowss2) {
    const int tid = otid(), lane = tid & 63, nw = ogrid() * 8;
    for (int row = blockIdx.x * 8 + (tid >> 6); row < MG; row += nw) {
        const float4* p = (const float4*)(xin + (size_t)row * D); float ss = 0.f;
#pragma unroll
        for (int i = 0; i < 4; ++i) { const f32x4 t4 = __builtin_nontemporal_load((const f32x4*)(p + lane + 64 * i)); const float4 v = make_float4(t4[0], t4[1], t4[2], t4[3]);
            u32x2 w; w.x = cvt_pk_bf16(v.x, v.y); w.y = cvt_pk_bf16(v.z, v.w); *(u32x2*)(xb + (size_t)row * D + (lane + 64 * i) * 4) = w;
            const float a0 = bf_lo(w.x), a1 = bf_hi(w.x), a2 = bf_lo(w.y), a3 = bf_hi(w.y); ss += a0 * a0 + a1 * a1 + a2 * a2 + a3 * a3; }
        ss = wave_sum(ss, lane);
        if (lane < 16) rowss1[(size_t)row * 16 + lane] = lane == 0 ? ss : 0.f;
    }
}
__device__ __forceinline__ void phase_final(const bf16_t* __restrict__ xb, float* xo, const float* rowss1, const float* __restrict__ gfin) {
    const int tid = otid(), lane = tid & 63, nw = ogrid() * 8;
    for (int row = blockIdx.x * 8 + (tid >> 6); row < MG; row += nw) {
        const float rs = rsqrtf(sum16(rowss1 + (size_t)row * 16) * (1.0f / 1024.0f) + EPS);
#pragma unroll
        for (int i = 0; i < 2; ++i) { const int c8 = (lane + 64 * i) * 8; float x[8]; unpack8(__builtin_nontemporal_load((const u32x4*)(xb + (size_t)row * D + c8)), x);
            const f32x4 g0 = *(const f32x4*)(gfin + c8), g1 = *(const f32x4*)(gfin + c8 + 4);
            __builtin_nontemporal_store((f32x4){x[0] * rs * g0[0], x[1] * rs * g0[1], x[2] * rs * g0[2], x[3] * rs * g0[3]}, (f32x4*)(xo + (size_t)row * D + c8));
            __builtin_nontemporal_store((f32x4){x[4] * rs * g1[0], x[5] * rs * g1[1], x[6] * rs * g1[2], x[7] * rs * g1[3]}, (f32x4*)(xo + (size_t)row * D + c8 + 4)); }
    }
}
__device__ __forceinline__ float gelu_tanh(float x) { const float t = fmaf(x * x, -0.10294324f, -2.30220819f);
    return x * __builtin_amdgcn_rcpf(1.0f + __builtin_amdgcn_exp2f(x * t)); }
__device__ __forceinline__ void phase_convact(const bf16_t* __restrict__ u, bf16_t* act, const float* __restrict__ cw  , int seqlen, int nrows) {
    const int gt = blockIdx.x * NTHREADS + otid(), nth = ogrid() * NTHREADS;
    int nr = nrows; asm volatile("" : "+s"(nr));
    const int ntask = (nr >> 3) * 352;
    for (int id = gt; id < ntask; id += nth) {
        const int tb = id / 352, c = (id % 352) * 8, t0 = tb * 8;
        const u32x4 z = (u32x4){0u, 0u, 0u, 0u};
        u32x4 g[10], v[10];
        const bool has_prev = (t0 & (seqlen - 1)) != 0, has_next = ((t0 + 8) & (seqlen - 1)) != 0;
#pragma unroll
        for (int r = 0; r < 10; ++r) { const bool ok = (r == 0) ? has_prev : ((r == 9) ? has_next : true);
            g[r] = z; v[r] = z;
            if (ok) { g[r] = __builtin_nontemporal_load((const u32x4*)(u + (size_t)(t0 - 1 + r) * DFF2 + c)); v[r] = __builtin_nontemporal_load((const u32x4*)(u + (size_t)(t0 - 1 + r) * DFF2 + DFF + c)); } }
        float wg[3][8], wv[3][8];
#pragma unroll
        for (int k = 0; k < 3; ++k) {
            const f32x4 a0 = *(const f32x4*)(cw + k * DFF2 + c), a1 = *(const f32x4*)(cw + k * DFF2 + c + 4);
            const f32x4 b0 = *(const f32x4*)(cw + k * DFF2 + DFF + c), b1 = *(const f32x4*)(cw + k * DFF2 + DFF + c + 4);
#pragma unroll
            for (int j = 0; j < 4; ++j) { wg[k][j] = a0[j]; wg[k][4 + j] = a1[j]; wv[k][j] = b0[j]; wv[k][4 + j] = b1[j]; } }
#pragma unroll
        for (int i = 0; i < 8; ++i) {
            float a[8], b[8], cc[8], r[8], gg[8], vv[8];
            unpack8(g[i], a); unpack8(g[i + 1], b); unpack8(g[i + 2], cc);
#pragma unroll
            for (int j = 0; j < 8; ++j) gg[j] = a[j] * wg[0][j] + b[j] * wg[1][j] + cc[j] * wg[2][j];
            unpack8(v[i], a); unpack8(v[i + 1], b); unpack8(v[i + 2], cc);
#pragma unroll
            for (int j = 0; j < 8; ++j) vv[j] = a[j] * wv[0][j] + b[j] * wv[1][j] + cc[j] * wv[2][j];
#pragma unroll
            for (int j = 0; j < 8; ++j) r[j] = gelu_tanh(gg[j]) * vv[j];
            *(u32x4*)(act + (size_t)(t0 + i) * DFF + c) = pack8(r);
        }
    }
}

constexpr int NA_LDS_WAVE = 12288;
struct NaFrags { bf16x8 k[4]; u32x2 v[2][2][2]; };
__device__ __forceinline__ void na_load(NaFrags& f, const bf16_t* __restrict__ proj, const bf16_t* __restrict__ projT, int ktok, int h, int c, int hh) {
    const bf16_t* kp = proj + (size_t)(ktok + c) * NPROJ + 512 + h * 64 + 8 * hh;
#pragma unroll
    for (int s = 0; s < 4; ++s) f.k[s] = *(const bf16x8*)(kp + 16 * s);
#pragma unroll
    for (int dt = 0; dt < 2; ++dt)
#pragma unroll
        for (int s2 = 0; s2 < 2; ++s2) { const bf16_t* vp = projT + (size_t)(h * 64 + dt * 32 + c) * MG + (ktok + 16 * s2 + 4 * hh);
            f.v[dt][s2][0] = *(const u32x2*)vp; f.v[dt][s2][1] = *(const u32x2*)(vp + 8); }
}
__device__ __forceinline__ void na_item(const bf16_t* __restrict__ proj, const bf16_t* __restrict__ projT, bf16_t* aout, const float* __restrict__ relb  , int item, int seqlen, LAS unsigned char* lds, int w, int lane) {
    const int c = lane & 31, hh = lane >> 5;
    const int R = item >> 3, h = item & 7;
    const int rps = seqlen >> 6, seq = R / rps, r = R % rps;
    int rs = r - 4; rs = rs < 0 ? 0 : rs; rs = rs > rps - 8 ? rps - 8 : rs;
    const int qtok0 = seq * seqlen + r * 64, ktok0 = seq * seqlen + rs * 64;
    LAS float* bias = (LAS float*)(lds + w * NA_LDS_WAVE) + 64;
    LAS bf16_t* Otile = (LAS bf16_t*)(lds + w * NA_LDS_WAVE + 3072);
    for (int i = lane; i < 768; i += 64) { const int j = i - 64; bias[j] = (j >= 0 && j < 465) ? relb[h * 465 + j] * 1.4426950408889634f : 0.f; }
    bf16x8 qf[2][4];
#pragma unroll
    for (int qh = 0; qh < 2; ++qh) { const bf16_t* qp = proj + (size_t)(qtok0 + 32 * qh + c) * NPROJ + h * 64 + 8 * hh;
#pragma unroll
        for (int s = 0; s < 4; ++s) qf[qh][s] = *(const bf16x8*)(qp + 16 * s); }
    f32x16 O[2][2];
    float mrun[2], lrun[2]; int cs[2];
#pragma unroll
    for (int qh = 0; qh < 2; ++qh) { O[qh][0] = zero16(); O[qh][1] = zero16(); mrun[qh] = -1e30f; lrun[qh] = 0.f;
        int x = 32 * qh + c - 8; x = x < 0 ? 0 : x; x = x > 48 ? 48 : x; cs[qh] = x; }
    NaFrags cur, nxt;
    na_load(cur, proj, projT, ktok0, h, c, hh);
#pragma unroll 1
    for (int t = 0; t < 16; ++t) {
        if (t + 1 < 16) na_load(nxt, proj, projT, ktok0 + 32 * (t + 1), h, c, hh);
        const int kr = rs + (t >> 1), chalf = t & 1, brow = (kr - r + 7) * 31;
#pragma unroll
        for (int qh = 0; qh < 2; ++qh) {
            f32x16 x = zero16();
#pragma unroll
            for (int s = 0; s < 4; ++s) x = mfma32(cur.k[s], qf[qh][s], x);
            const int qc = 32 * qh + c; float mt = -1e30f;
#pragma unroll
            for (int rg = 0; rg < 16; ++rg) { const int kc = 32 * chalf + (rg & 3) + 8 * (rg >> 2) + 4 * hh;
                const bool valid = (kc >= cs[qh]) && (kc < cs[qh] + 16);
                const float sv = fmaf(x[rg], 0.18033688011112042f, bias[brow + kc - qc + 15]) + (valid ? 0.f : -__builtin_inff());
                x[rg] = sv; mt = fmaxf(mt, sv); }
            mt = xhalf_max(mt);
            if (__builtin_amdgcn_ballot_w64(mt > mrun[qh] + 8.0f) != 0ull) {
                const float mnew = fmaxf(mrun[qh], mt), alpha = __builtin_amdgcn_exp2f(mrun[qh] - mnew);
                mrun[qh] = mnew; lrun[qh] *= alpha; O[qh][0] *= alpha; O[qh][1] *= alpha; }
            const float mcur = mrun[qh];
            float ps = 0.f;
#pragma unroll
            for (int rg = 0; rg < 16; ++rg) { const float p = __builtin_amdgcn_exp2f(x[rg] - mcur); x[rg] = p; ps += p; }
            lrun[qh] += ps;
#pragma unroll
            for (int s2 = 0; s2 < 2; ++s2) {
                u32x4 pw; pw.x = cvt_pk_bf16(x[8 * s2 + 0], x[8 * s2 + 1]); pw.y = cvt_pk_bf16(x[8 * s2 + 2], x[8 * s2 + 3]); pw.z = cvt_pk_bf16(x[8 * s2 + 4], x[8 * s2 + 5]); pw.w = cvt_pk_bf16(x[8 * s2 + 6], x[8 * s2 + 7]);
                const bf16x8 pb = __builtin_bit_cast(bf16x8, pw);
#pragma unroll
                for (int dt = 0; dt < 2; ++dt) { u32x4 aw; aw.x = cur.v[dt][s2][0].x; aw.y = cur.v[dt][s2][0].y; aw.z = cur.v[dt][s2][1].x; aw.w = cur.v[dt][s2][1].y;
                    O[qh][dt] = mfma32(__builtin_bit_cast(bf16x8, aw), pb, O[qh][dt]); } }
        }
        cur = nxt;
    }
#pragma unroll
    for (int qh = 0; qh < 2; ++qh) { const float inv = __builtin_amdgcn_rcpf(xhalf_sum(lrun[qh]));
#pragma unroll
        for (int dt = 0; dt < 2; ++dt)
#pragma unroll
            for (int g4 = 0; g4 < 4; ++g4) { u32x2 pw; pw.x = cvt_pk_bf16(O[qh][dt][4 * g4] * inv, O[qh][dt][4 * g4 + 1] * inv); pw.y = cvt_pk_bf16(O[qh][dt][4 * g4 + 2] * inv, O[qh][dt][4 * g4 + 3] * inv);
                *(LAS u32x2*)(Otile + (32 * qh + c) * 72 + dt * 32 + 8 * g4 + 4 * hh) = pw; } }
#pragma unroll
    for (int i = 0; i < 8; ++i) { const int id = lane + 64 * i, q = id >> 3, d8 = (id & 7) * 8;
        *(u32x4*)(aout + (size_t)(qtok0 + q) * 1536 + h * 64 + d8) = *(const LAS u32x4*)(Otile + q * 72 + d8); }
}

constexpr int KT_STRIDE = 136;
__device__ __forceinline__ void r1_item(const bf16_t* __restrict__ projT, bf16_t* stloc, const float* __restrict__ cosT, const float* __restrict__ sinT, float lgf2, float lgb2, int item, int seqlen, LAS unsigned char* lds) {
    const int tid = otid(), w = __builtin_amdgcn_readfirstlane(tid >> 6), lane = tid & 63, c = lane & 31, hh = lane >> 5;
    const int ch = item >> 2, h = item & 3, tok0 = ch * 128, pos0 = tok0 % seqlen;
    LAS bf16_t* KTf = (LAS bf16_t*)lds; LAS bf16_t* KTb = (LAS bf16_t*)(lds + 128 * KT_STRIDE * 2);
    const float scale = 0.08838834764831845f;
    bf16x8 af[8];
    { const bf16_t* vp = projT + (size_t)(1024 + h * 256 + 32 * w + c) * MG + tok0 + 8 * hh;
#pragma unroll
      for (int s = 0; s < 8; ++s) af[s] = *(const bf16x8*)(vp + 16 * s); }
#pragma unroll
    for (int it = 0; it < 2; ++it) {
        const int id = tid + NTHREADS * it, d = id >> 4, t8 = id & 15;
        float k1[8], k2[8];
        unpack8(__builtin_nontemporal_load((const u32x4*)(projT + (size_t)(512 + h * 128 + d) * MG + tok0 + 8 * t8)), k1);
        unpack8(__builtin_nontemporal_load((const u32x4*)(projT + (size_t)(512 + h * 128 + d + 64) * MG + tok0 + 8 * t8)), k2);
        const f32x4 c0 = *(const f32x4*)(cosT + (size_t)d * 16384 + pos0 + 8 * t8), c1 = *(const f32x4*)(cosT + (size_t)d * 16384 + pos0 + 8 * t8 + 4);
        const f32x4 s0 = *(const f32x4*)(sinT + (size_t)d * 16384 + pos0 + 8 * t8), s1 = *(const f32x4*)(sinT + (size_t)d * 16384 + pos0 + 8 * t8 + 4);
        float f1[8], f2[8], b1[8], b2[8];
#pragma unroll
        for (int j = 0; j < 8; ++j) { const float cv = j < 4 ? c0[j & 3] : c1[j & 3], sv = j < 4 ? s0[j & 3] : s1[j & 3];
            const float r1 = (k1[j] * cv - k2[j] * sv) * scale, r2 = (k1[j] * sv + k2[j] * cv) * scale;
            const int tl = 8 * t8 + j; const float df = __builtin_amdgcn_exp2f((float)(127 - tl) * lgf2), db = __builtin_amdgcn_exp2f((float)tl * lgb2);
            f1[j] = r1 * df; f2[j] = r2 * df; b1[j] = r1 * db; b2[j] = r2 * db; }
        *(LAS u32x4*)(KTf + d * KT_STRIDE + 8 * t8) = pack8(f1); *(LAS u32x4*)(KTf + (d + 64) * KT_STRIDE + 8 * t8) = pack8(f2);
        *(LAS u32x4*)(KTb + d * KT_STRIDE + 8 * t8) = pack8(b1); *(LAS u32x4*)(KTb + (d + 64) * KT_STRIDE + 8 * t8) = pack8(b2);
    }
    __syncthreads();
#pragma unroll
    for (int dir = 0; dir < 2; ++dir) {
        LAS bf16_t* KT = dir ? KTb : KTf;
        bf16_t* dst = stloc + ((size_t)(ch * 4 + h) * 2 + dir) * 32768;
#pragma unroll
        for (int ct = 0; ct < 4; ++ct) {
            f32x16 acc = zero16();
#pragma unroll
            for (int s = 0; s < 8; ++s) { const bf16x8 bfr = *(const LAS bf16x8*)(KT + (32 * ct + c) * KT_STRIDE + 16 * s + 8 * hh); acc = mfma32(af[s], bfr, acc); }
#pragma unroll
            for (int rg = 0; rg < 16; ++rg) { const int dv = 32 * w + (rg & 3) + 8 * (rg >> 2) + 4 * hh; dst[dv * 128 + 32 * ct + c] = (bf16_t)(cvt_pk_bf16(acc[rg], 0.f) & 0xffffu); }
        }
    }
    __syncthreads();
}

__device__ __forceinline__ void phase_scan(const bf16_t* __restrict__ stloc, bf16_t* st, const float* __restrict__ decf, const float* __restrict__ decb, int seqlen) {
    const int gt = blockIdx.x * NTHREADS + otid(), nth = ogrid() * NTHREADS;
    constexpr size_t CSTR = (size_t)4 * 2 * 32768;
    if (seqlen == 4096) {
        constexpr int NCH = 32, NTASK = 4 * 4 * 2 * 4096;
        for (int id = gt; id < NTASK; id += nth) {
            const int e8 = id & 4095, dir = (id >> 12) & 1, h = (id >> 13) & 3, seq = id >> 15;
            const float x = dir ? decb[h] : decf[h]; const float cd = exp2f(-128.0f * log1pf(expf(-x)) * 1.4426950408889634f);
            const size_t base = ((size_t)(seq * NCH * 4 + h) * 2 + dir) * 32768 + (size_t)e8 * 8;
            float zz = 0.f; asm volatile("" : "+v"(zz));
            float S[8];
#pragma unroll
            for (int j = 0; j < 8; ++j) S[j] = zz;
            for (int i0 = 0; i0 < NCH; i0 += 8) {
                u32x4 loc[8];
#pragma unroll
                for (int j = 0; j < 8; ++j) { const int ci = dir ? (NCH - 1 - (i0 + j)) : (i0 + j); loc[j] = __builtin_nontemporal_load((const u32x4*)(stloc + base + (size_t)ci * CSTR)); }
#pragma unroll
                for (int j = 0; j < 8; ++j) { const int ci = dir ? (NCH - 1 - (i0 + j)) : (i0 + j);
                    *(u32x4*)(st + base + (size_t)ci * CSTR) = pack8(S);
                    float lf[8]; unpack8(loc[j], lf);
#pragma unroll
                    for (int k = 0; k < 8; ++k) S[k] = S[k] * cd + lf[k]; }
            }
        }
    } else {
        constexpr int NCH = 128, NTASK = 4 * 2 * 16384;
        for (int id = gt; id < NTASK; id += nth) {
            const int e2 = id & 16383, dir = (id >> 14) & 1, h = (id >> 15) & 3;
            const float x = dir ? decb[h] : decf[h]; const float cd = exp2f(-128.0f * log1pf(expf(-x)) * 1.4426950408889634f);
            const size_t base = ((size_t)h * 2 + dir) * 32768 + (size_t)e2 * 2;
            float zz = 0.f; asm volatile("" : "+v"(zz));
            float S0 = zz, S1 = zz;
            for (int i0 = 0; i0 < NCH; i0 += 8) {
                unsigned loc[8];
#pragma unroll
                for (int j = 0; j < 8; ++j) { const int ci = dir ? (NCH - 1 - (i0 + j)) : (i0 + j); loc[j] = __builtin_nontemporal_load((const unsigned*)(stloc + base + (size_t)ci * CSTR)); }
#pragma unroll
                for (int j = 0; j < 8; ++j) { const int ci = dir ? (NCH - 1 - (i0 + j)) : (i0 + j);
                    *(unsigned*)(st + base + (size_t)ci * CSTR) = cvt_pk_bf16(S0, S1);
                    S0 = S0 * cd + bf_lo(loc[j]); S1 = S1 * cd + bf_hi(loc[j]); }
            }
        }
    }
}

constexpr int OL_STRIDE = 264;
__device__ __forceinline__ void r3_item(const bf16_t* __restrict__ proj, const bf16_t* __restrict__ projT, const bf16_t* __restrict__ st, bf16_t* ro,
                        const float* __restrict__ cosN, const float* __restrict__ sinN, const float* __restrict__ gn  , float lgf2, float lgb2,
                        int item, int seqlen, LAS unsigned char* lds) {
    const int tid = otid(), w = __builtin_amdgcn_readfirstlane(tid >> 6), lane = tid & 63, c = lane & 31, hh = lane >> 5;
    const int ch = item >> 2, h = item & 3, tok0 = ch * 128, pos0 = tok0 % seqlen;
    LAS bf16_t* Ql = (LAS bf16_t*)lds; LAS bf16_t* Kl = (LAS bf16_t*)(lds + 34816); LAS bf16_t* Pl = (LAS bf16_t*)(lds + 69632);
    LAS float* stat = (LAS float*)(lds + 104448);
    LAS bf16_t* Ol = (LAS bf16_t*)lds;
    const float scale = 0.08838834764831845f;
    bf16x8 asb[8], asf[8], avt[8];
    const size_t stb0 = ((size_t)(ch * 4 + h) * 2) * 32768 + (size_t)(32 * w + c) * 128 + 8 * hh;
#pragma unroll
    for (int s = 0; s < 8; ++s) asb[s] = *(const bf16x8*)(st + stb0 + 32768 + 16 * s);
#pragma unroll
    for (int it = 0; it < 2; ++it) {
        const int id = tid + NTHREADS * it, t = id >> 3, d8 = (id & 7) * 8;
        const f32x4 c0 = *(const f32x4*)(cosN + (size_t)(pos0 + t) * 64 + d8), c1 = *(const f32x4*)(cosN + (size_t)(pos0 + t) * 64 + d8 + 4);
        const f32x4 s0 = *(const f32x4*)(sinN + (size_t)(pos0 + t) * 64 + d8), s1 = *(const f32x4*)(sinN + (size_t)(pos0 + t) * 64 + d8 + 4);
        float a[8], b[8], o1[8], o2[8];
        const bf16_t* qp = proj + (size_t)(tok0 + t) * NPROJ + 1024 + h * 128 + d8;
        unpack8(__builtin_nontemporal_load((const u32x4*)qp), a); unpack8(__builtin_nontemporal_load((const u32x4*)(qp + 64)), b);
#pragma unroll
        for (int j = 0; j < 8; ++j) { const float cv = j < 4 ? c0[j & 3] : c1[j & 3], sv = j < 4 ? s0[j & 3] : s1[j & 3]; o1[j] = a[j] * cv - b[j] * sv; o2[j] = a[j] * sv + b[j] * cv; }
        *(LAS u32x4*)(Ql + t * KT_STRIDE + d8) = pack8(o1); *(LAS u32x4*)(Ql + t * KT_STRIDE + 64 + d8) = pack8(o2);
        const bf16_t* kp = proj + (size_t)(tok0 + t) * NPROJ + 1536 + h * 128 + d8;
        unpack8(__builtin_nontemporal_load((const u32x4*)kp), a); unpack8(__builtin_nontemporal_load((const u32x4*)(kp + 64)), b);
#pragma unroll
        for (int j = 0; j < 8; ++j) { const float cv = j < 4 ? c0[j & 3] : c1[j & 3], sv = j < 4 ? s0[j & 3] : s1[j & 3]; o1[j] = (a[j] * cv - b[j] * sv) * scale; o2[j] = (a[j] * sv + b[j] * cv) * scale; }
        *(LAS u32x4*)(Kl + t * KT_STRIDE + d8) = pack8(o1); *(LAS u32x4*)(Kl + t * KT_STRIDE + 64 + d8) = pack8(o2);
    }
    __syncthreads();
    { const int kt = w >> 1;
#pragma unroll
      for (int q2 = 0; q2 < 2; ++q2) { const int tqt = 2 * (w & 1) + q2;
          f32x16 x = zero16();
#pragma unroll
          for (int s = 0; s < 8; ++s) { const bf16x8 kf = *(const LAS bf16x8*)(Kl + (32 * kt + c) * KT_STRIDE + 16 * s + 8 * hh);
              const bf16x8 qf = *(const LAS bf16x8*)(Ql + (32 * tqt + c) * KT_STRIDE + 16 * s + 8 * hh); x = mfma32(kf, qf, x); }
          const int n = 32 * tqt + c;
#pragma unroll
          for (int g4 = 0; g4 < 4; ++g4) { float pv[4];
#pragma unroll
              for (int j = 0; j < 4; ++j) { const int mk = 32 * kt + 8 * g4 + 4 * hh + j; const int diff = n - mk;
                  const float dec = __builtin_amdgcn_exp2f(diff >= 0 ? (float)diff * lgf2 : (float)(-diff) * lgb2); pv[j] = x[4 * g4 + j] * dec; }
              u32x2 pw; pw.x = cvt_pk_bf16(pv[0], pv[1]); pw.y = cvt_pk_bf16(pv[2], pv[3]);
              *(LAS u32x2*)(Pl + n * KT_STRIDE + 32 * kt + 8 * g4 + 4 * hh) = pw; } } }
    __syncthreads();
    f32x16 acc[4];
#pragma unroll
    for (int q = 0; q < 4; ++q) acc[q] = zero16();
    { const bf16_t* vp0 = projT + (size_t)(1024 + h * 256 + 32 * w + c) * MG + tok0 + 8 * hh;
#pragma unroll
      for (int s = 0; s < 8; ++s) { asf[s] = *(const bf16x8*)(st + stb0 + 16 * s); avt[s] = *(const bf16x8*)(vp0 + 16 * s); } }
#pragma unroll
    for (int s = 0; s < 8; ++s) { const bf16x8 a = asb[s];
#pragma unroll
        for (int q = 0; q < 4; ++q) { const bf16x8 b = *(const LAS bf16x8*)(Ql + (32 * q + c) * KT_STRIDE + 16 * s + 8 * hh); acc[q] = mfma32(a, b, acc[q]); } }
#pragma unroll
    for (int q = 0; q < 4; ++q) { const int n = 32 * q + c; const float f = __builtin_amdgcn_exp2f((float)(128 - n) * lgb2 - (float)(n + 1) * lgf2); acc[q] *= f; }
#pragma unroll
    for (int s = 0; s < 8; ++s) { const bf16x8 a = asf[s];
#pragma unroll
        for (int q = 0; q < 4; ++q) { const bf16x8 b = *(const LAS bf16x8*)(Ql + (32 * q + c) * KT_STRIDE + 16 * s + 8 * hh); acc[q] = mfma32(a, b, acc[q]); } }
#pragma unroll
    for (int q = 0; q < 4; ++q) { const int n = 32 * q + c; const float f = __builtin_amdgcn_exp2f((float)(n + 1) * lgf2); acc[q] *= f; }
#pragma unroll
    for (int s = 0; s < 8; ++s) { const bf16x8 a = avt[s];
#pragma unroll
        for (int q = 0; q < 4; ++q) { const bf16x8 b = *(const LAS bf16x8*)(Pl + (32 * q + c) * KT_STRIDE + 16 * s + 8 * hh); acc[q] = mfma32(a, b, acc[q]); } }
#pragma unroll
    for (int q = 0; q < 4; ++q) { float s1 = 0.f, s2 = 0.f;
#pragma unroll
        for (int i = 0; i < 16; ++i) { s1 += acc[q][i]; s2 += acc[q][i] * acc[q][i]; }
        s1 = xhalf_sum(s1); s2 = xhalf_sum(s2);
        if (hh == 0) { stat[(w * 128 + 32 * q + c) * 2] = s1; stat[(w * 128 + 32 * q + c) * 2 + 1] = s2; } }
    __syncthreads();
#pragma unroll
    for (int q = 0; q < 4; ++q) { float s1 = 0.f, s2 = 0.f; const int n = 32 * q + c;
#pragma unroll
        for (int k = 0; k < 8; ++k) { s1 += stat[(k * 128 + n) * 2]; s2 += stat[(k * 128 + n) * 2 + 1]; }
        const float mu = s1 * (1.0f / 256.0f); float var = s2 * (1.0f / 256.0f) - mu * mu; var = var < 0.f ? 0.f : var; const float rs = rsqrtf(var + EPS);
#pragma unroll
        for (int g4 = 0; g4 < 4; ++g4) { u32x2 pw; pw.x = cvt_pk_bf16((acc[q][4 * g4] - mu) * rs, (acc[q][4 * g4 + 1] - mu) * rs); pw.y = cvt_pk_bf16((acc[q][4 * g4 + 2] - mu) * rs, (acc[q][4 * g4 + 3] - mu) * rs);
            *(LAS u32x2*)(Ol + n * OL_STRIDE + 32 * w + 8 * g4 + 4 * hh) = pw; } }
    __syncthreads();
#pragma unroll
    for (int it = 0; it < 8; ++it) { const int id = tid + NTHREADS * it, tq = id >> 5, d8 = (id & 31) * 8;
        float y[8], rg[8], o[8]; unpack8(*(const LAS u32x4*)(Ol + tq * OL_STRIDE + d8), y);
        unpack8(__builtin_nontemporal_load((const u32x4*)(proj + (size_t)(tok0 + tq) * NPROJ + 2048 + h * 256 + d8)), rg);
        const f32x4 g0 = *(const f32x4*)(gn + h * 256 + d8), g1 = *(const f32x4*)(gn + h * 256 + d8 + 4);
#pragma unroll
        for (int j = 0; j < 8; ++j) { const float gv = j < 4 ? g0[j & 3] : g1[j & 3]; o[j] = rg[j] * sigmoidf_(rg[j]) * y[j] * gv; }
        *(u32x4*)(ro + (size_t)(tok0 + tq) * 1536 + 512 + h * 256 + d8) = pack8(o); }
    __syncthreads();
}


#define XB_TMO      128
#define XB_XCNT(j)  (256  + 64 * (j))
#define XB_XSUB(j)  (1280 + 64 * (j))
#define XB_XGEN(j)  (2304 + 64 * (j))
#define XB_TOP      3328
#define XB_TOPGEN   3392
#define XCD_BAR_WORDS 3456
#define XB_SPIN_CAP (1u << 22)
__device__ __forceinline__ unsigned xb_ld(unsigned* p)              { return __hip_atomic_load(p, __ATOMIC_RELAXED, __HIP_MEMORY_SCOPE_AGENT); }
__device__ __forceinline__ unsigned xb_add(unsigned* p, unsigned v) { return __hip_atomic_fetch_add(p, v, __ATOMIC_RELAXED, __HIP_MEMORY_SCOPE_AGENT); }
__device__ __forceinline__ unsigned xb_xcc_id() { return (unsigned)__builtin_amdgcn_s_getreg((3 << 11) | 20) & 0xFu; }
#define XB_SPIN(cond, bar) do { unsigned _sp = 0; while (cond) { __builtin_amdgcn_s_sleep(1); \
    if ((++_sp & 255u) == 0u) { if (xb_ld(&(bar)[XB_TMO])) break; if (_sp > XB_SPIN_CAP) { atomicAdd(&(bar)[XB_TMO], 1u); break; } } } } while (0)
struct XcdBarrier { unsigned* bar; unsigned x; volatile LAS unsigned* st; };
__device__ __forceinline__ XcdBarrier xcd_barrier_post(unsigned* bar, volatile LAS unsigned* st) {
    XcdBarrier b; b.bar = bar; b.x = xb_xcc_id(); b.st = st;
    if (threadIdx.x == 0) (void)xb_add(&bar[XB_XCNT(b.x)], 1u);
    return b;
}
__device__ __forceinline__ void xcd_barrier_complete(unsigned* bar, unsigned x, unsigned& nloc, unsigned& nx) {
    const unsigned G = gridDim.x * gridDim.y * gridDim.z;
    unsigned sum, cnt, mine, sp = 0u;
    for (;;) {
        sum = 0u; cnt = 0u; mine = 0u;
#pragma unroll
        for (unsigned j = 0; j < 16; ++j) { const unsigned c = xb_ld(&bar[XB_XCNT(j)]); sum += c; cnt += (c > 0u) ? 1u : 0u; mine = (j == x) ? c : mine; }
        if (sum == G) break;
        __builtin_amdgcn_s_sleep(1);
        if ((++sp & 255u) == 0u) { if (xb_ld(&bar[XB_TMO])) break; if (sp > XB_SPIN_CAP) { atomicAdd(&bar[XB_TMO], 1u); break; } }
    }
    nloc = mine > 0u ? mine : 1u; nx = cnt > 0u ? cnt : 1u;
}
__device__ __forceinline__ void xcd_barrier(const XcdBarrier& b) {
    asm volatile("s_waitcnt vmcnt(0)" ::: "memory");
    __syncthreads();
    if (threadIdx.x == 0) {
        unsigned* bar = b.bar;
        __builtin_amdgcn_s_waitcnt(0);
        unsigned nloc = b.st[0], nx = b.st[1];
        if (nloc == 0u) { xcd_barrier_complete(bar, b.x, nloc, nx); b.st[0] = nloc; b.st[1] = nx; }
        const unsigned old = xb_add(&bar[XB_XSUB(b.x)], 1u);
        const unsigned gen = old / nloc;
        if (old + 1u == (gen + 1u) * nloc) {
            __builtin_amdgcn_fence(__ATOMIC_RELEASE, "agent");
            asm volatile("s_waitcnt vmcnt(0)" ::: "memory");
            const unsigned og = xb_add(&bar[XB_TOP], 1u);
            const unsigned tg = og / nx;
            if (og + 1u == (tg + 1u) * nx) xb_add(&bar[XB_TOPGEN], 1u);
            else XB_SPIN(xb_ld(&bar[XB_TOPGEN]) == tg, bar);
            __builtin_amdgcn_fence(__ATOMIC_ACQUIRE, "agent");
            xb_add(&bar[XB_XGEN(b.x)], 1u);
            asm volatile("s_waitcnt vmcnt(0)" ::: "memory");
        } else {
            XB_SPIN(xb_ld(&bar[XB_XGEN(b.x)]) == gen, bar);
            __builtin_amdgcn_fence(__ATOMIC_ACQUIRE, "agent");
            asm volatile("s_waitcnt vmcnt(0)" ::: "memory");
        }
    }
    __syncthreads();
}

__device__ __forceinline__ size_t opz() { size_t z = 0; asm volatile("" : "+s"(z)); return z; }
#define WSP(T, off) ((T*)(P.ws + opz() + (off)))
#define XBAR() do { XcdBarrier _b; _b.bar = (unsigned*)(P.ws + opz() + WS_CTL); _b.x = (unsigned)__builtin_amdgcn_readfirstlane((int)xb_xcc_id()); _b.st = (volatile LAS unsigned*)(lds + 131072); xcd_barrier(_b); } while (0)
__global__ void __launch_bounds__(NTHREADS, 2) fwd_megakernel(Params P) {
    extern __shared__ __attribute__((aligned(16))) unsigned char lds_raw[];
    LAS unsigned char* lds = (LAS unsigned char*)lds_raw;
    cg::grid_group grid = cg::this_grid();
    const int G = ogrid(), bid = blockIdx.x;
    volatile LAS unsigned* xst = (volatile LAS unsigned*)(lds + 131072);
    if (threadIdx.x < 4) xst[threadIdx.x] = 0u;
    __syncthreads();
    (void)xcd_barrier_post((unsigned*)(P.ws + WS_CTL), xst);

    phase_prologue(P, lds);
    grid.sync();
    XBAR();

    for (int pr = 0; pr < 3; ++pr) {
        const int ngr = pr < 2 ? 2 : 1, g0 = 2 * pr, seqlen = pr < 2 ? 4096 : 16384, MM = ngr * MG;
        for (int gi = 0; gi < ngr; ++gi) { const int grp = g0 + gi;
            const float* xin = grp < 4 ? P.x_prompt + (size_t)grp * MG * D : P.x_sample;
            phase_init(xin, WSP(bf16_t, WS_XB) + (size_t)gi * MG * D, WSP(float, WS_ROWSS1) + (size_t)gi * MG * 16, WSP(float, WS_ROWSS2)); }
        XBAR();
        for (int l = 0; l < DEPTH; ++l) {
            const size_t wl = WS_W + (size_t)l * W_LAYER;
            for (int gi = 0; gi < ngr; ++gi) {
                const size_t xoff = (size_t)gi * MG * D, roff = (size_t)gi * MG * 16;
                { pg8::Gemm g{WSP(bf16_t, WS_XB) + xoff, WSP(const bf16_t, wl + W_IN_OFF), MG, NPROJ, D};
                  pg8::P1Order S; S.init(G, bid, WSP(const bf16_t, wl + W_IN_OFF + (size_t)NPROJ * D * 2));
                  LAS float* rl = (LAS float*)(lds + LDS_RSTD_OFF); fill_rstd(rl, WSP(float, WS_ROWSS1) + roff, S, -1);
                  pg8::EpiP1 E{pg8::EpiRowScale{WSP(bf16_t, WS_PROJ), NPROJ, rl, 4}, pg8::EpiColScale{WSP(bf16_t, WS_PROJT), MG, rl}}; pg8::gemm_phase(lds, g, S, E); }
                XBAR();
                { { const int tid = otid(), wv = __builtin_amdgcn_readfirstlane(tid >> 6), ln = tid & 63;
                    const int vb = (G == 256) ? (bid & 7) * 32 + (bid >> 3) : bid;
                    for (int it = vb * 8 + wv; it < 2048; it += G * 8) na_item(WSP(bf16_t, WS_PROJ), WSP(bf16_t, WS_PROJT), WSP(bf16_t, WS_A), P.na_rel_bias + (size_t)l * 8 * 465, it, seqlen, lds, wv, ln);
                    __syncthreads(); }
                  for (int it = bid; it < 512; it += G) { const int h = it & 3;
                      const float* tab = WSP(const float, WS_LG2) + (l * 4 + h) * 2; const float lgf2 = tab[0], lgb2 = tab[1];
                      r1_item(WSP(bf16_t, WS_PROJT), WSP(bf16_t, WS_STLOC), WSP(float, WS_COST), WSP(float, WS_SINT), lgf2, lgb2, it, seqlen, lds); } }
                XBAR();
                phase_scan(WSP(bf16_t, WS_STLOC), WSP(bf16_t, WS_ST), P.dec_f + l * 4, P.dec_b + l * 4, seqlen);
                XBAR();
                for (int it = bid; it < 512; it += G) { const int h = it & 3;
                    const float* tab = WSP(const float, WS_LG2) + (l * 4 + h) * 2; const float lgf2 = tab[0], lgb2 = tab[1];
                    r3_item(WSP(bf16_t, WS_PROJ), WSP(bf16_t, WS_PROJT), WSP(bf16_t, WS_ST), WSP(bf16_t, WS_A), WSP(float, WS_COSN), WSP(float, WS_SINN), P.ret_norm_g + (size_t)l * 1024, lgf2, lgb2, it, seqlen, lds); }
                XBAR();
                { pg8::Gemm g{WSP(bf16_t, WS_A), WSP(const bf16_t, wl + W_A_OFF), MG, D, 1536}; pg8::StaticOrder S; S.init(MG, D, G, bid);
                  pg8::EpiMerge E{WSP(bf16_t, WS_PROJ) + 3072, WSP(bf16_t, WS_PROJ) + 4096, WSP(bf16_t, WS_MIXED2) + xoff}; pg8::gemm_phase(lds, g, S, E); }
                XBAR();
            }
            { pg8::Gemm g{WSP(bf16_t, WS_MIXED2), WSP(const bf16_t, wl + W_O_OFF), MM, D, D}; pg8::StaticOrder S; S.init(MM, D, G, bid);
              pg8::EpiResid E{WSP(bf16_t, WS_XB), WSP(float, WS_ROWSS2)}; pg8::gemm_phase(lds, g, S, E); }
            XBAR();
            { pg8::Gemm g{WSP(bf16_t, WS_XB), WSP(const bf16_t, wl + W_UP_OFF), MM, DFF2, D}; pg8::StaticOrder S; S.init(MM, DFF2, G, bid);
              LAS float* rl = (LAS float*)(lds + LDS_RSTD_OFF); fill_rstd(rl, WSP(float, WS_ROWSS2), S, 0);
              pg8::EpiRowScale E{WSP(bf16_t, WS_U), DFF2, rl, -1}; pg8::gemm_phase(lds, g, S, E); }
            XBAR();
            phase_convact(WSP(bf16_t, WS_U), WSP(bf16_t, WS_ACT), P.conv_w + (size_t)l * 3 * DFF2, seqlen, MM);
            XBAR();
            { pg8::Gemm g{WSP(bf16_t, WS_ACT), WSP(const bf16_t, wl + W_D_OFF), MM, D, DFF}; pg8::StaticOrder S; S.init(MM, D, G, bid);
              pg8::EpiResid E{WSP(bf16_t, WS_XB), WSP(float, WS_ROWSS1)}; pg8::gemm_phase(lds, g, S, E); }
            XBAR();
        }
        for (int gi = 0; gi < ngr; ++gi) { const int grp = g0 + gi;
            phase_final(WSP(bf16_t, WS_XB) + (size_t)gi * MG * D, P.out + (size_t)grp * MG * D, WSP(float, WS_ROWSS1) + (size_t)gi * MG * 16, P.norm_final_g); }
        XBAR();
    }
}

extern "C" void kernel_launch(void* const* d_in, const int* in_sizes, int n_in, void* d_out, int out_size, void* d_ws, size_t ws_size, hipStream_t stream) {
    static int grid_blocks = 0;
    if (grid_blocks == 0) {
        if (n_in != 16 || ws_size < WS_END) { fprintf(stderr, "kernel_launch: unexpected n_in %d or ws_size %zu (< %zu)\n", n_in, ws_size, (size_t)WS_END); grid_blocks = -1; return; }
        int dev = 0, cus = 0, per_cu = 0;
        hipGetDevice(&dev);
        hipDeviceGetAttribute(&cus, hipDeviceAttributeMultiprocessorCount, dev);
        if (hipFuncSetAttribute((const void*)fwd_megakernel, hipFuncAttributeMaxDynamicSharedMemorySize, LDS_BYTES) != hipSuccess) { fprintf(stderr, "kernel_launch: hipFuncSetAttribute failed\n"); grid_blocks = -1; return; }
        hipOccupancyMaxActiveBlocksPerMultiprocessor(&per_cu, (const void*)fwd_megakernel, NTHREADS, LDS_BYTES);
        if (per_cu < 1) { fprintf(stderr, "kernel_launch: occupancy query says %d blocks per CU\n", per_cu); per_cu = 1; }
        (void)hipGetLastError();
        grid_blocks = cus;
    }
    if (grid_blocks < 0) return;
    if (hipMemsetAsync((char*)d_ws + WS_CTL, 0, 16384, stream) != hipSuccess) { fprintf(stderr, "kernel_launch: memset of barrier words failed\n"); return; }
    Params p{};
    p.x_prompt = (const float*)d_in[0]; p.x_sample = (const float*)d_in[1]; p.norm_mix_g = (const float*)d_in[2]; p.w_in = (const float*)d_in[3]; p.na_rel_bias = (const float*)d_in[4];
    p.dec_f = (const float*)d_in[5]; p.dec_b = (const float*)d_in[6]; p.ret_norm_g = (const float*)d_in[7]; p.w_ba = (const float*)d_in[8]; p.w_br = (const float*)d_in[9]; p.w_out = (const float*)d_in[10];
    p.norm_ffn_g = (const float*)d_in[11]; p.w_up = (const float*)d_in[12]; p.conv_w = (const float*)d_in[13]; p.w_down = (const float*)d_in[14]; p.norm_final_g = (const float*)d_in[15];
    p.out = (float*)d_out; p.ws = (unsigned char*)d_ws;
    void* args[] = {&p};
    hipError_t e = hipLaunchCooperativeKernel((const void*)fwd_megakernel, dim3(grid_blocks), dim3(NTHREADS), args, LDS_BYTES, stream);
    if (e != hipSuccess) fprintf(stderr, "kernel_launch: cooperative launch failed: %s (grid %d)\n", hipGetErrorString(e), grid_blocks);
}
```
